# Optimizing an MI355X kernel written in HIP

```python
import math
import jax, jax.numpy as jnp
from jax import lax
import numpy as np

D_MODEL = 2048
BATCH = 2
SEQ = 4096
DEPTH = 2

GRID_W = 64
CTX_LEN = 256
D_MIX = D_MODEL
W_GRP = D_MIX // 4
EPS = 1e-6
CHUNK = 128
HD_A = 128
H_A = W_GRP // HD_A
HD_V = 128
H_B = W_GRP // HD_V
HD_QK = HD_V // 2
ROPE_BASE = 10000.0
Q_BLOCK = 128
HD_C = 64
H_C = W_GRP // HD_C
LORA_W = 64
LORA_A = 32
RWKV_F = 3 * W_GRP + LORA_W + LORA_A
GN_EPS = 64e-5
H_D = 4
CONV_W = 3

PROJ_SIZES = (W_GRP, W_GRP, W_GRP,
              W_GRP, W_GRP, W_GRP, W_GRP,
              3 * W_GRP, LORA_W + LORA_A, LORA_W + LORA_A, W_GRP,
              W_GRP, W_GRP, W_GRP, W_GRP)
N_IN = sum(PROJ_SIZES)

kernel_name = 'hybrid_dit_parallel_groups_ctx_prefix'


def _f32(a):
    return a.astype(jnp.float32)


def rmsnorm(x, g):
    xf = _f32(x)
    y = xf * lax.rsqrt(jnp.mean(xf * xf, axis=-1, keepdims=True) + EPS)
    return (y * _f32(g)).astype(x.dtype)


def split_proj(p):
    idx = np.cumsum(PROJ_SIZES)[:-1].tolist()
    return jnp.split(p, idx, axis=-1)


def rope_1d(x, pos):
    d = x.shape[-1]
    inv = ROPE_BASE ** (-jnp.arange(0, d, 2, dtype=jnp.float32) / d)
    ang = pos.astype(jnp.float32)[:, None] * inv[None, :]
    cos = jnp.concatenate([jnp.cos(ang), jnp.cos(ang)], -1)[:, None, None, :]
    sin = jnp.concatenate([jnp.sin(ang), jnp.sin(ang)], -1)[:, None, None, :]
    x1, x2 = jnp.split(x, 2, axis=-1)
    rot = jnp.concatenate([-x2, x1], axis=-1)
    return (_f32(x) * cos + _f32(rot) * sin).astype(x.dtype)


def rope_2d(x, row, col):
    half = x.shape[-1] // 2
    return jnp.concatenate([rope_1d(x[..., :half], row), rope_1d(x[..., half:], col)], axis=-1)


def chunk_sgu(u, v, w_s, b_s):
    b, t, _ = u.shape
    n = t // CHUNK
    vf = _f32(v).reshape(b, n, CHUNK, H_A, HD_A)
    mean = jnp.mean(vf, -1, keepdims=True)
    var = jnp.mean(jnp.square(vf - mean), -1, keepdims=True)
    vn = (vf - mean) * lax.rsqrt(var + EPS)
    mixed = jnp.einsum('hpq,bnqhd->bnphd', _f32(w_s), vn) + _f32(b_s).T[None, None, :, :, None]
    return u * mixed.reshape(b, t, W_GRP).astype(u.dtype)


def diff_attn_core(q, k, v, lam):
    s = _f32(jnp.einsum('bqhmd,bkhmd->bhmqk', q, k)) * (HD_QK ** -0.5)
    p = jax.nn.softmax(s, axis=-1)
    a = p[:, :, 0] - lam * p[:, :, 1]
    return jnp.einsum('bhqk,bkhd->bqhd', a.astype(v.dtype), v)


def diff_attention(qc, kc, vc, ql, kl, vl, lam, lam_init, subln_g, need_ctx):
    b, n = ql.shape[:2]
    k_all = jnp.concatenate([kc, kl], axis=1)
    v_all = jnp.concatenate([vc, vl], axis=1)
    nb = n // Q_BLOCK
    qb = ql.reshape(b, nb, Q_BLOCK, H_B, 2, HD_QK).transpose(1, 0, 2, 3, 4, 5)
    ob = lax.map(lambda q: diff_attn_core(q, k_all, v_all, lam), qb)
    o_lat = ob.transpose(1, 0, 2, 3, 4).reshape(b, n, H_B, HD_V)

    def post(o):
        return (rmsnorm(o, subln_g) * (1.0 - lam_init)).reshape(o.shape[0], o.shape[1], W_GRP)

    o_ctx = post(diff_attn_core(qc, kc, vc, lam)) if need_ctx else None
    return o_ctx, post(o_lat)


def rwkv_scan(r, k, v, decay, kk, a, s0):
    def step(S, inp):
        r_t, k_t, v_t, w_t, kk_t, a_t = inp
        sa = jnp.einsum('bhvk,bhk->bhv', S, -kk_t)
        S = (S * w_t[:, :, None, :] + sa[..., None] * (kk_t * a_t)[:, :, None, :]
             + v_t[..., None] * k_t[:, :, None, :])
        y = jnp.einsum('bhvk,bhk->bhv', S, r_t)
        return S, y

    xs = tuple(jnp.moveaxis(z, 1, 0) for z in (r, k, v, decay, kk, a))
    s_final, ys = lax.scan(step, s0, xs)
    return jnp.moveaxis(ys, 0, 1), s_final


def rwkv_direction(feats, s0, mu, w0, w2, a0, a2, k_k, k_a, r_k):
    b, t, _ = feats.shape
    f = _f32(feats)
    prev = jnp.pad(f, ((0, 0), (1, 0), (0, 0)))[:, :t]
    z = f + (prev - f) * _f32(mu)
    r, k, v, zw, za = jnp.split(z, [W_GRP, 2 * W_GRP, 3 * W_GRP, 3 * W_GRP + LORA_W], axis=-1)
    w = -jax.nn.softplus(-(_f32(w0) + jnp.tanh(zw) @ _f32(w2))) - 0.5
    decay = jnp.exp(-jnp.exp(w))
    a = jax.nn.sigmoid(_f32(a0) + za @ _f32(a2))
    heads = lambda y: y.reshape(b, t, H_C, HD_C)
    kk = heads(k * _f32(k_k))
    kk = kk / jnp.maximum(jnp.sqrt(jnp.sum(kk * kk, -1, keepdims=True)), 1e-12)
    k = k * (1.0 + (a - 1.0) * _f32(k_a))
    r, k, v, decay, a = heads(r), heads(k), heads(v), heads(decay), heads(a)
    y, s_final = rwkv_scan(r, k, v, decay, kk, a, s0)
    bonus = jnp.sum(r * k * _f32(r_k), -1, keepdims=True) * v
    return y, bonus, s_final


def rwkv_mixer(rkv_c, lf_c, lb_c, rkv_l, lf_l, lb_l, p_fwd, p_bwd, ln_w, ln_b, need_ctx):
    s0 = jnp.zeros((rkv_l.shape[0], H_C, HD_C, HD_C), jnp.float32)
    flip = lambda y: jnp.flip(y, axis=1)
    cat = lambda p, q: jnp.concatenate([p, q], axis=-1)
    yc_f, bc_f, sc_f = rwkv_direction(cat(rkv_c, lf_c), s0, *p_fwd)
    yl_f, bl_f, _ = rwkv_direction(cat(rkv_l, lf_l), sc_f, *p_fwd)
    yc_b, bc_b, sc_b = rwkv_direction(flip(cat(rkv_c, lb_c)), s0, *p_bwd)
    yl_b, bl_b, _ = rwkv_direction(flip(cat(rkv_l, lb_l)), sc_b, *p_bwd)

    def merge(yf, bf, yb, bb):
        y = yf + flip(yb)
        mean = jnp.mean(y, -1, keepdims=True)
        var = jnp.mean(jnp.square(y - mean), -1, keepdims=True)
        yn = ((y - mean) * lax.rsqrt(var + GN_EPS)).reshape(y.shape[0], y.shape[1], W_GRP)
        yn = yn * _f32(ln_w) + _f32(ln_b)
        return (yn + (bf + flip(bb)).reshape(yn.shape)).astype(rkv_l.dtype)

    o_ctx = merge(yc_f, bc_f, yc_b, bc_b) if need_ctx else None
    return o_ctx, merge(yl_f, bl_f, yl_b, bl_b)


def short_conv(bg, cg, xin, w):
    z = cg * xin
    y = lax.conv_general_dilated(z, w[:, None, :].astype(z.dtype), window_strides=(1,),
                                 padding=[(CONV_W // 2, CONV_W // 2)],
                                 dimension_numbers=('NWC', 'WIO', 'NWC'),
                                 feature_group_count=W_GRP)
    return bg * y


def setup_inputs(seed: int = 0) -> dict:
    key = jax.random.key(seed)
    ks = jax.random.split(key, 32)
    nrm = lambda k, s: jax.random.normal(k, s, jnp.float32)
    return {
        'x': nrm(ks[0], (BATCH, SEQ, D_MODEL)),
        'c': nrm(ks[1], (BATCH, D_MODEL)),
        'ctx': nrm(ks[2], (BATCH, CTX_LEN, D_MODEL)),
        'c_ctx': nrm(ks[3], (D_MODEL,)),
        'w_mod': nrm(ks[4], (DEPTH, D_MODEL, 3 * D_MODEL)) * (0.5 * D_MODEL ** -0.5),
        'b_mod': nrm(ks[5], (DEPTH, 3 * D_MODEL)) * 0.02,
        'g_pre': 1.0 + 0.02 * nrm(ks[6], (DEPTH, D_MODEL)),
        'g_post': 1.0 + 0.02 * nrm(ks[7], (DEPTH, D_MODEL)),
        'w_in': nrm(ks[8], (DEPTH, D_MODEL, N_IN)) * D_MODEL ** -0.5,
        'w_out': nrm(ks[9], (DEPTH, D_MIX, D_MODEL)) * D_MIX ** -0.5,
        'sgu_w': nrm(ks[10], (DEPTH, H_A, CHUNK, CHUNK)) * CHUNK ** -0.5,
        'sgu_b': 1.0 + 0.1 * nrm(ks[11], (DEPTH, H_A, CHUNK)),
        'lam_q1': 0.1 * nrm(ks[12], (DEPTH, HD_QK)),
        'lam_k1': 0.1 * nrm(ks[13], (DEPTH, HD_QK)),
        'lam_q2': 0.1 * nrm(ks[14], (DEPTH, HD_QK)),
        'lam_k2': 0.1 * nrm(ks[15], (DEPTH, HD_QK)),
        'subln_g': 1.0 + 0.02 * nrm(ks[16], (DEPTH, HD_V)),
        'rwkv_mu': jax.random.uniform(ks[17], (DEPTH, 2, RWKV_F), jnp.float32),
        'rwkv_w0': jax.random.uniform(ks[18], (DEPTH, 2, W_GRP), jnp.float32, -4.0, -0.5),
        'rwkv_w2': nrm(ks[19], (DEPTH, 2, LORA_W, W_GRP)) * (0.5 * LORA_W ** -0.5),
        'rwkv_a0': 0.5 * nrm(ks[20], (DEPTH, 2, W_GRP)),
        'rwkv_a2': nrm(ks[21], (DEPTH, 2, LORA_A, W_GRP)) * (0.5 * LORA_A ** -0.5),
        'rwkv_kk': 0.85 + 0.05 * nrm(ks[22], (DEPTH, 2, W_GRP)),
        'rwkv_ka': 1.0 + 0.05 * nrm(ks[23], (DEPTH, 2, W_GRP)),
        'rwkv_rk': 0.1 * nrm(ks[24], (DEPTH, 2, H_C, HD_C)),
        'rwkv_ln_w': 1.0 + 0.02 * nrm(ks[25], (DEPTH, W_GRP)),
        'rwkv_ln_b': 0.02 * nrm(ks[26], (DEPTH, W_GRP)),
        'conv_w': nrm(ks[27], (DEPTH, CONV_W, W_GRP)) * CONV_W ** -0.5,
    }


def reference(x, c, ctx, c_ctx, w_mod, b_mod, g_pre, g_post, w_in, w_out, sgu_w, sgu_b,
              lam_q1, lam_k1, lam_q2, lam_k2, subln_g, rwkv_mu, rwkv_w0, rwkv_w2, rwkv_a0,
              rwkv_a2, rwkv_kk, rwkv_ka, rwkv_rk, rwkv_ln_w, rwkv_ln_b, conv_w):
    b, n, _ = x.shape
    rows = n // GRID_W
    row = jnp.repeat(jnp.arange(rows), GRID_W)
    col = jnp.tile(jnp.arange(GRID_W), rows)
    s_c = jax.nn.silu(c)
    s_cc = jax.nn.silu(c_ctx)
    xc = ctx
    for l in range(DEPTH):
        need_ctx = l < DEPTH - 1
        shift, scale, gate = jnp.split((s_c @ w_mod[l] + b_mod[l])[:, None, :], 3, axis=-1)
        shift_c, scale_c, gate_c = jnp.split(s_cc @ w_mod[l] + b_mod[l], 3, axis=-1)
        hl = rmsnorm(x, g_pre[l]) * (1.0 + scale) + shift
        hc = rmsnorm(xc, g_pre[l]) * (1.0 + scale_c) + shift_c
        pl = split_proj(hl @ w_in[l])
        pc = split_proj(hc @ w_in[l])

        oA_l = chunk_sgu(pl[0], pl[1], sgu_w[l], sgu_b[l]) * jax.nn.silu(pl[2])
        oA_c = chunk_sgu(pc[0], pc[1], sgu_w[l], sgu_b[l]) * jax.nn.silu(pc[2]) if need_ctx else None

        ql = rope_2d(pl[3].reshape(b, n, H_B, 2, HD_QK), row, col)
        kl = rope_2d(pl[4].reshape(b, n, H_B, 2, HD_QK), row, col)
        vl = pl[5].reshape(b, n, H_B, HD_V)
        qc = pc[3].reshape(b, CTX_LEN, H_B, 2, HD_QK)
        kc = pc[4].reshape(b, CTX_LEN, H_B, 2, HD_QK)
        vc = pc[5].reshape(b, CTX_LEN, H_B, HD_V)
        lam_init = 0.8 - 0.6 * math.exp(-0.3 * l)
        lam = (jnp.exp(jnp.sum(_f32(lam_q1[l]) * _f32(lam_k1[l])))
               - jnp.exp(jnp.sum(_f32(lam_q2[l]) * _f32(lam_k2[l]))) + lam_init)
        oB_c, oB_l = diff_attention(qc, kc, vc, ql, kl, vl, lam, lam_init, subln_g[l], need_ctx)
        oB_l = oB_l * jax.nn.silu(pl[6])
        oB_c = oB_c * jax.nn.silu(pc[6]) if need_ctx else None

        p_fwd = (rwkv_mu[l, 0], rwkv_w0[l, 0], rwkv_w2[l, 0], rwkv_a0[l, 0], rwkv_a2[l, 0],
                 rwkv_kk[l, 0], rwkv_ka[l, 0], rwkv_rk[l, 0])
        p_bwd = (rwkv_mu[l, 1], rwkv_w0[l, 1], rwkv_w2[l, 1], rwkv_a0[l, 1], rwkv_a2[l, 1],
                 rwkv_kk[l, 1], rwkv_ka[l, 1], rwkv_rk[l, 1])
        oC_c, oC_l = rwkv_mixer(pc[7], pc[8], pc[9], pl[7], pl[8], pl[9], p_fwd, p_bwd,
                                rwkv_ln_w[l], rwkv_ln_b[l], need_ctx)
        oC_l = oC_l * jax.nn.silu(pl[10])
        oC_c = oC_c * jax.nn.silu(pc[10]) if need_ctx else None

        oD_l = short_conv(pl[11], pl[12], pl[13], conv_w[l]) * jax.nn.silu(pl[14])
        oD_c = short_conv(pc[11], pc[12], pc[13], conv_w[l]) * jax.nn.silu(pc[14]) if need_ctx else None

        o_l = jnp.concatenate([oA_l, oB_l, oC_l, oD_l], axis=-1) @ w_out[l]
        x = x + gate * rmsnorm(o_l, g_post[l])
        if need_ctx:
            o_c = jnp.concatenate([oA_c, oB_c, oC_c, oD_c], axis=-1) @ w_out[l]
            xc = xc + gate_c * rmsnorm(o_c, g_post[l])
    return x
```

```cpp
#include <hip/hip_runtime.h>
#include <hip/hip_cooperative_groups.h>
#include <cstdio>
#include <cstdint>
namespace cg = cooperative_groups;
namespace pg8 {
#define PG8_LAS __attribute__((address_space(3)))
typedef unsigned short bf16_t;
typedef short bf16x8 __attribute__((ext_vector_type(8)));
typedef float f32x4 __attribute__((ext_vector_type(4)));
typedef unsigned u32x4 __attribute__((ext_vector_type(4)));
constexpr int BM = 256, BK = 64, HALF = 128, HTB = HALF * BK * 2  , STAGE_BYTES = 8 * HTB, NXCD = 8, WGM = 8;

__host__ __device__ __forceinline__ int lds_byte(int r, int c) { const int st = (r >> 4) * 2 + (c >> 5), rr = r & 15, cc = c & 31, ob = rr * 64 + cc * 2; return st * 1024 + (ob ^ (((ob >> 9) & 1) << 5)); }
__host__ __device__ __forceinline__ void stage_rc(int b, int& R, int& C) { const int st = b / 1024, sb = b % 1024, swz = sb ^ (((sb >> 9) & 1) << 5); R = (st >> 1) * 16 + swz / 64; C = (st & 1) * 32 + (swz % 64) / 2; }
__host__ __device__ __forceinline__ int perm32(int rho) { const int n = rho >> 4, i = rho & 15; return 8 * (i >> 2) + 4 * n + (i & 3); }

struct Unit { int pm, pn; };
struct Gemm { const bf16_t* A; const bf16_t* Bt; int M, N, K; };

struct StaticOrder {
    int nM, nN, nwg, G, c;
    __host__ __device__ void init(int M, int N, int G_, int c_) { nM = M / BM; nN = N / BM; nwg = nM * nN; G = G_; c = c_; }
    __host__ __device__ bool next(int i, Unit& u) const {
        const long L = (long)i * G + c; if (L >= nwg) return false;
        int wgid = (int)L; { const int q = nwg / NXCD, r = nwg % NXCD, xcd = wgid % NXCD, off = wgid / NXCD; wgid = (xcd < r ? xcd * (q + 1) : r * (q + 1) + (xcd - r) * q) + off; }
        const int nig = WGM * nN, gid = wgid / nig, fm = gid * WGM, gsz = (nM - fm) < WGM ? (nM - fm) : WGM;
        u.pm = fm + ((wgid % nig) % gsz); u.pn = (wgid % nig) / gsz; return true;
    }
    __device__ __forceinline__ void a_ready(const Unit&) const {}
    __device__ __forceinline__ void done(const Unit&) const {}
};

__device__ __forceinline__ unsigned cvt_pk_bf16(float lo, float hi) { unsigned r; asm volatile("v_cvt_pk_bf16_f32 %0, %1, %2" : "=v"(r) : "v"(lo), "v"(hi)); return r; }
struct EpiBf16 {
    static constexpr bool PERM = true, AFTER_DRAIN = false;
    bf16_t* O; int ldc; const float* bias; int split_cols; size_t split_stride; float scale0;
    __device__ __forceinline__ void operator()(const f32x4 (&acc)[2][2][4][2], const Unit& u, int wr, int wc, int fr, int fq) const {
        const int row0 = u.pm * BM + wr * 64 + fr; int colt = u.pn * BM; bf16_t* base = O;
        float sc = 1.f; if (split_cols) { const int t = colt / split_cols; base += (size_t)t * split_stride; colt -= t * split_cols; if (t == 0) sc = scale0; }
        const int col0 = colt + wc * 32 + 8 * fq, bcol0 = u.pn * BM + wc * 32 + 8 * fq;
        f32x4 bv[2][2];
#pragma unroll
        for (int bj = 0; bj < 2; ++bj)
#pragma unroll
            for (int n = 0; n < 2; ++n) bv[bj][n] = bias ? *(const f32x4*)(bias + bcol0 + bj * HALF + 4 * n) : (f32x4){0.f, 0.f, 0.f, 0.f};
#pragma unroll
        for (int ai = 0; ai < 2; ++ai)
#pragma unroll
            for (int m = 0; m < 4; ++m) { bf16_t* rowp = base + (size_t)(row0 + ai * HALF + m * 16) * ldc + col0;
#pragma unroll
                for (int bj = 0; bj < 2; ++bj) { f32x4 v0 = acc[ai][bj][m][0] + bv[bj][0], v1 = acc[ai][bj][m][1] + bv[bj][1];
                    v0 = v0 * sc; v1 = v1 * sc; u32x4 w; w.x = cvt_pk_bf16(v0[0], v0[1]); w.y = cvt_pk_bf16(v0[2], v0[3]); w.z = cvt_pk_bf16(v1[0], v1[1]); w.w = cvt_pk_bf16(v1[2], v1[3]);
                    *(u32x4*)(rowp + bj * HALF) = w; } }
    }
};
struct EpiF32 {
    static constexpr bool PERM = false, AFTER_DRAIN = false;
    float* O; int ldc;
    __device__ __forceinline__ void operator()(const f32x4 (&acc)[2][2][4][2], const Unit& u, int wr, int wc, int fr, int fq) const {
        const int col0 = u.pn * BM + wc * 32 + 4 * fq;
#pragma unroll
        for (int ai = 0; ai < 2; ++ai)
#pragma unroll
            for (int m = 0; m < 4; ++m) { float* rowp = O + (size_t)(u.pm * BM + ai * HALF + wr * 64 + m * 16 + fr) * ldc + col0;
#pragma unroll
                for (int bj = 0; bj < 2; ++bj)
#pragma unroll
                    for (int n = 0; n < 2; ++n) *(f32x4*)(rowp + bj * HALF + n * 16) = acc[ai][bj][m][n]; }
    }
};
template <class Epi, class Sched, bool ALIGN_EPI = false, bool SP2 = false>
__device__ __forceinline__ void gemm_phase(PG8_LAS unsigned char* lds, const Gemm g, const Sched& S, const Epi& E) {
    int tid_ = threadIdx.x; asm volatile("" : "+v"(tid_));
    const int tid = tid_, wid = __builtin_amdgcn_readfirstlane(tid >> 6), lane = tid & 63, wr = wid >> 2, wc = wid & 3, fr = lane & 15, fq = lane >> 4;
    const int K = g.K, nt = K / BK;
    unsigned voffA[2], voffB[2];
#pragma unroll
    for (int i = 0; i < 2; ++i) { int R, C; stage_rc(tid * 16 + i * 8192, R, C); const int Rb = Epi::PERM ? ((R & ~31) + perm32(R & 31)) : R;
        voffA[i] = (unsigned)(R * K + C) * 2u; voffB[i] = (unsigned)(Rb * K + C) * 2u; }
    const size_t kstep = (size_t)(BK * 2);
    const size_t hstep = (size_t)HALF * K * 2;
    const size_t tstep = 2 * hstep;
    const unsigned ldsw = (unsigned)wid * 1024u;
    const int aoff = lds_byte(wr * 64 + fr, fq * 8), boff = lds_byte(wc * 32 + fr, fq * 8);
#define PG8_SA(b, h) (((b) * 2 + (h)) * HTB)
#define PG8_SB(b, h) ((4 + (b) * 2 + (h)) * HTB)
#define PG8_STAGE(bufoff, gbase, voff) do { _Pragma("unroll") for (int _i = 0; _i < 2; ++_i) \
        __builtin_amdgcn_global_load_lds((const unsigned*)((const char*)(gbase) + (voff)[_i]), (PG8_LAS unsigned*)(lds + (bufoff) + ldsw + _i * 8192), 16, 0, 0); } while (0)
#define PG8_LDA(dst, b, h) do { _Pragma("unroll") for (int m = 0; m < 4; ++m) _Pragma("unroll") for (int k = 0; k < 2; ++k) dst[m][k] = *(const PG8_LAS bf16x8*)(lds + PG8_SA(b, h) + aoff + m * 2048 + k * 1024); } while (0)
#define PG8_LDB(dst, b, h) do { _Pragma("unroll") for (int n = 0; n < 2; ++n) _Pragma("unroll") for (int k = 0; k < 2; ++k) dst[n][k] = *(const PG8_LAS bf16x8*)(lds + PG8_SB(b, h) + boff + n * 2048 + k * 1024); } while (0)
#define PG8_MMA(ai, bj, At, Bt) do { __builtin_amdgcn_s_setprio(1); _Pragma("unroll") for (int m = 0; m < 4; ++m) _Pragma("unroll") for (int n = 0; n < 2; ++n) _Pragma("unroll") for (int k = 0; k < 2; ++k) \
        acc[ai][bj][m][n] = __builtin_amdgcn_mfma_f32_16x16x32_bf16(Bt[n][k], At[m][k], acc[ai][bj][m][n], 0, 0, 0); __builtin_amdgcn_s_setprio(0); } while (0)
#define PG8_WAIT_V(n) asm volatile("s_waitcnt vmcnt(" #n ")" ::: "memory")
#define PG8_WAIT_L(n) asm volatile("s_waitcnt lgkmcnt(" #n ")" ::: "memory")
#define PG8_BAR __builtin_amdgcn_s_barrier()
#define PG8_SCHED __builtin_amdgcn_sched_barrier(0)
    Unit cur, nxt; int ui = 0;
    if (!S.next(0, cur)) return;
    f32x4 acc[2][2][4][2];
#pragma unroll
    for (int a = 0; a < 2; ++a)
#pragma unroll
        for (int b = 0; b < 2; ++b)
#pragma unroll
            for (int m = 0; m < 4; ++m)
#pragma unroll
                for (int n = 0; n < 2; ++n) acc[a][b][m][n] = (f32x4){0.f, 0.f, 0.f, 0.f};
    bf16x8 At[4][2], B0[2][2], B1[2][2];
    const char* cA = (const char*)g.A + (size_t)cur.pm * tstep; const char* cB = (const char*)g.Bt + (size_t)cur.pn * tstep;
    S.a_ready(cur);
    if constexpr (SP2) {
        PG8_STAGE(PG8_SB(0, 0), cB, voffB); PG8_STAGE(PG8_SB(0, 1), cB + hstep, voffB); PG8_STAGE(PG8_SA(0, 0), cA, voffA); PG8_STAGE(PG8_SA(0, 1), cA + hstep, voffA);
        if (wr == 1) PG8_BAR;
        PG8_WAIT_V(2); PG8_BAR;
        PG8_STAGE(PG8_SB(1, 0), cB + kstep, voffB); PG8_STAGE(PG8_SA(1, 0), cA + kstep, voffA); PG8_STAGE(PG8_SB(1, 1), cB + hstep + kstep, voffB);
        PG8_WAIT_V(6); PG8_BAR;
    } else {
        PG8_STAGE(PG8_SB(0, 0), cB, voffB); PG8_STAGE(PG8_SA(0, 0), cA, voffA); PG8_STAGE(PG8_SB(0, 1), cB + hstep, voffB); PG8_STAGE(PG8_SA(0, 1), cA + hstep, voffA);
        if (wr == 1) PG8_BAR;
        PG8_WAIT_V(4); PG8_BAR;
        PG8_STAGE(PG8_SB(1, 0), cB + kstep, voffB); PG8_STAGE(PG8_SA(1, 0), cA + kstep, voffA); PG8_STAGE(PG8_SB(1, 1), cB + hstep + kstep, voffB);
        PG8_WAIT_V(6); PG8_BAR;
    }
    for (;;) {
        const bool has_next = S.next(ui + 1, nxt);
        const char* nA = has_next ? (const char*)g.A + (size_t)nxt.pm * tstep : cA; const char* nB = has_next ? (const char*)g.Bt + (size_t)nxt.pn * tstep : cB;
        for (int t = 0; t < nt; t += 2) {
            const bool last = (t == nt - 2);
            const char* a1 = cA + (size_t)(t + 1) * kstep;
            const char* a2 = last ? nA : cA + (size_t)(t + 2) * kstep; const char* b2 = last ? nB : cB + (size_t)(t + 2) * kstep;
            const char* a3 = a2 + kstep; const char* b3 = b2 + kstep;
            if (last && has_next) S.a_ready(nxt);
            if constexpr (SP2) {
            PG8_LDB(B0, 0, 0); PG8_LDB(B1, 0, 1); PG8_SCHED; PG8_LDA(At, 0, 0); PG8_STAGE(PG8_SA(1, 1), a1 + hstep, voffA);
            PG8_WAIT_V(8); PG8_WAIT_L(0); PG8_BAR; PG8_MMA(0, 0, At, B0); PG8_MMA(0, 1, At, B1); PG8_BAR; PG8_SCHED;
            PG8_LDA(At, 0, 1); PG8_STAGE(PG8_SB(0, 0), b2, voffB); PG8_STAGE(PG8_SB(0, 1), b2 + hstep, voffB); PG8_STAGE(PG8_SA(0, 0), a2, voffA);
            PG8_WAIT_V(8); PG8_WAIT_L(0); PG8_BAR; PG8_MMA(1, 0, At, B0); PG8_MMA(1, 1, At, B1); PG8_BAR; PG8_SCHED;
            PG8_LDB(B0, 1, 0); PG8_LDB(B1, 1, 1); PG8_SCHED; PG8_LDA(At, 1, 0); PG8_STAGE(PG8_SA(0, 1), a2 + hstep, voffA);
            PG8_WAIT_V(8); PG8_WAIT_L(0); PG8_BAR; PG8_MMA(0, 0, At, B0); PG8_MMA(0, 1, At, B1); PG8_BAR; PG8_SCHED;
            PG8_LDA(At, 1, 1); PG8_STAGE(PG8_SB(1, 0), b3, voffB); PG8_STAGE(PG8_SB(1, 1), b3 + hstep, voffB); PG8_STAGE(PG8_SA(1, 0), a3, voffA);
            PG8_WAIT_V(8); PG8_WAIT_L(0); PG8_BAR; PG8_MMA(1, 0, At, B0); PG8_MMA(1, 1, At, B1); PG8_BAR; PG8_SCHED;
            } else {
            PG8_LDB(B0, 0, 0); PG8_SCHED; PG8_LDA(At, 0, 0); PG8_STAGE(PG8_SA(1, 1), a1 + hstep, voffA);
            PG8_WAIT_L(8); PG8_BAR; PG8_WAIT_L(0); PG8_MMA(0, 0, At, B0); PG8_BAR; PG8_SCHED;
            PG8_LDB(B1, 0, 1); PG8_STAGE(PG8_SB(0, 0), b2, voffB);
            PG8_BAR; PG8_WAIT_L(0); PG8_MMA(0, 1, At, B1); PG8_BAR;
            PG8_LDA(At, 0, 1); PG8_STAGE(PG8_SA(0, 0), a2, voffA);
            PG8_BAR; PG8_WAIT_L(0); PG8_MMA(1, 0, At, B0); PG8_BAR; PG8_SCHED;
            PG8_STAGE(PG8_SB(0, 1), b2 + hstep, voffB);
            PG8_WAIT_V(6); PG8_BAR; PG8_MMA(1, 1, At, B1); PG8_BAR;
            PG8_LDB(B0, 1, 0); PG8_SCHED; PG8_LDA(At, 1, 0); PG8_STAGE(PG8_SA(0, 1), a2 + hstep, voffA);
            PG8_WAIT_L(8); PG8_BAR; PG8_WAIT_L(0); PG8_MMA(0, 0, At, B0); PG8_BAR; PG8_SCHED;
            PG8_LDB(B1, 1, 1); PG8_STAGE(PG8_SB(1, 0), b3, voffB);
            PG8_BAR; PG8_WAIT_L(0); PG8_MMA(0, 1, At, B1); PG8_BAR;
            PG8_LDA(At, 1, 1); PG8_STAGE(PG8_SA(1, 0), a3, voffA);
            PG8_BAR; PG8_WAIT_L(0); PG8_MMA(1, 0, At, B0); PG8_BAR; PG8_SCHED;
            PG8_STAGE(PG8_SB(1, 1), b3 + hstep, voffB);
            PG8_WAIT_V(6); PG8_BAR; PG8_MMA(1, 1, At, B1); PG8_BAR;
            }
        }
        if constexpr (ALIGN_EPI) { if (wr == 0) PG8_BAR; }
        if constexpr (!Epi::AFTER_DRAIN) { E(acc, cur, wr, wc, fr, fq); S.done(cur); }
        if (!has_next) break;
#pragma unroll
        for (int a = 0; a < 2; ++a)
#pragma unroll
            for (int b = 0; b < 2; ++b)
#pragma unroll
                for (int m = 0; m < 4; ++m)
#pragma unroll
                    for (int n = 0; n < 2; ++n) acc[a][b][m][n] = (f32x4){0.f, 0.f, 0.f, 0.f};
        cur = nxt; cA = nA; cB = nB; ++ui;
        if constexpr (ALIGN_EPI) { if (wr == 1) PG8_BAR; }
    }
    PG8_WAIT_V(0);
    if constexpr (!ALIGN_EPI) { if (wr == 0) PG8_BAR; }
    PG8_BAR;
    if constexpr (Epi::AFTER_DRAIN) { E.fused(acc, cur, wr, wc, fr, fq, lds, wid, lane); S.done(cur); }
#undef PG8_SA
#undef PG8_SB
#undef PG8_STAGE
#undef PG8_LDA
#undef PG8_LDB
#undef PG8_MMA
#undef PG8_WAIT_V
#undef PG8_WAIT_L
#undef PG8_BAR
#undef PG8_SCHED
}
}

constexpr int NB = 2, TL = 4096, DM = 2048, CL = 256, NIN = 7872, NINP = 7936;
constexpr int ML = NB * TL, MC = NB * CL, MT = ML + MC;
constexpr int KEYS = CL + TL;
constexpr int NSTEP = KEYS;
constexpr int RECB = 896;
constexpr int A_U = 0, A_V = 512, A_G = 1024, B_Q = 1536, B_K = 2048, B_V = 2560, B_G = 3072, C_R = 3584, C_K = 4096, C_V = 4608, C_LF = 5120, C_LB = 5216, C_G = 5312,
              D_B = 5824, D_C = 6336, D_X = 6848, D_G = 7360;
constexpr float EPS = 1e-6f, GN_EPS = 64e-5f;
constexpr float QSCALE = 0.125f * 1.4426950408889634f;

constexpr size_t MiB = 1u << 20;
constexpr size_t WS_CTL = 0, CTL_ZERO_BYTES = 1 * MiB;
constexpr size_t CTL_MODACC = 65536;
constexpr size_t WS_ROPE = 1 * MiB - 16384;
constexpr size_t WS_WIN = 1 * MiB;
constexpr size_t WS_WOUT = 63 * MiB;
constexpr size_t WS_XN = 79 * MiB;
constexpr size_t WS_P = 113 * MiB;
constexpr size_t WS_QR = 245 * MiB;
constexpr size_t WS_QC = 253 * MiB;
constexpr size_t WS_KR = 254 * MiB;
constexpr size_t WS_VT = 263 * MiB;
constexpr size_t WS_OPS = 272 * MiB;
constexpr size_t WS_Y = 391 * MiB;
constexpr size_t WS_BON = 425 * MiB;
constexpr size_t WS_OC = 442 * MiB;
constexpr size_t WS_END = 476 * MiB;
static_assert(WS_WIN + (size_t)2 * NINP * DM * 2 <= WS_WOUT && WS_WOUT + (size_t)2 * DM * DM * 2 <= WS_XN && WS_XN + (size_t)MT * DM * 2 <= WS_P && WS_P + (size_t)MT * NINP * 2 <= WS_QR, "ws map 1");
static_assert(WS_QR + (size_t)16 * TL * 64 * 2 <= WS_QC && WS_QC + (size_t)16 * CL * 64 * 2 <= WS_KR && WS_KR + (size_t)16 * KEYS * 64 * 2 <= WS_VT && WS_VT + (size_t)8 * 128 * KEYS * 2 <= WS_OPS, "ws map 2");
static_assert(WS_OPS + (size_t)32 * NSTEP * RECB <= WS_Y && WS_Y + (size_t)2 * MT * 512 * 4 <= WS_BON && WS_BON + (size_t)MT * 512 * 4 <= WS_OC && WS_OC + (size_t)MT * DM * 2 <= WS_END, "ws map 3");
static_assert((size_t)MT * 1024 * 4 <= WS_P - WS_XN && (size_t)MT * DM * 4 <= WS_QR - WS_P, "overlays");

constexpr int LDS_BYTES = 147456;
constexpr int NWAVES = 8, NTHREADS = 512;

typedef unsigned short bf16;
typedef short bf16x8 __attribute__((ext_vector_type(8)));
typedef float f32x4 __attribute__((ext_vector_type(4)));
typedef float f32x2 __attribute__((ext_vector_type(2)));
typedef float f32x16 __attribute__((ext_vector_type(16)));
typedef unsigned u32x4 __attribute__((ext_vector_type(4)));
typedef unsigned u32x2 __attribute__((ext_vector_type(2)));
typedef __bf16 bf16x2_t __attribute__((ext_vector_type(2)));
#define LAS __attribute__((address_space(3)))

struct Params { const float* in[28]; float* out; unsigned char* ws; };

struct Ctx {
    const Params* prm; float* out; unsigned char* ws;
    LAS unsigned char* lds;
    int tid, lane, wave, bx, G, gw, NGW;
};

__device__ __forceinline__ unsigned cvtpk(float lo, float hi) { f32x2 v = {lo, hi}; bf16x2_t b = __builtin_convertvector(v, bf16x2_t); return __builtin_bit_cast(unsigned, b); }
__device__ __forceinline__ float bflo(unsigned u) { return __builtin_bit_cast(float, u << 16); }
__device__ __forceinline__ float bfhi(unsigned u) { return __builtin_bit_cast(float, u & 0xffff0000u); }
__device__ __forceinline__ void unpack8(const u32x4 v, float* f) { f[0] = bflo(v.x); f[1] = bfhi(v.x); f[2] = bflo(v.y); f[3] = bfhi(v.y); f[4] = bflo(v.z); f[5] = bfhi(v.z); f[6] = bflo(v.w); f[7] = bfhi(v.w); }
__device__ __forceinline__ u32x4 pack8(const float* f) { u32x4 r; r.x = cvtpk(f[0], f[1]); r.y = cvtpk(f[2], f[3]); r.z = cvtpk(f[4], f[5]); r.w = cvtpk(f[6], f[7]); return r; }
__device__ __forceinline__ float silu_f(float x) { return x / (1.f + __expf(-x)); }
__device__ __forceinline__ float wave_sum(float v) {
#pragma unroll
    for (int o = 1; o < 64; o <<= 1) v += __shfl_xor(v, o);
    return v;
}
template <int CTRL> __device__ __forceinline__ float dpp_f(float v) { return __builtin_bit_cast(float, __builtin_amdgcn_update_dpp(0, __builtin_bit_cast(int, v), CTRL, 0xf, 0xf, true)); }
__device__ __forceinline__ float red4(float v) { v += dpp_f<0xB1>(v); v += dpp_f<0x4E>(v); return v; }
__device__ __forceinline__ float red8(float v) { v = red4(v); v += dpp_f<0x141>(v); return v; }
__device__ __forceinline__ float red16(float v) { v = red8(v); v += dpp_f<0x140>(v); return v; }
#define LAUNDER(F) do { asm volatile("" : "+v"(F.tid), "+v"(F.lane)); asm volatile("" : "+s"(F.wave), "+s"(F.bx), "+s"(F.gw)); } while (0)
#define LDS_WAIT() asm volatile("s_waitcnt lgkmcnt(0)" ::: "memory")
#define WG_BAR() do { asm volatile("s_waitcnt lgkmcnt(0)" ::: "memory"); __builtin_amdgcn_s_barrier(); asm volatile("" ::: "memory"); } while (0)

__device__ __forceinline__ void p0_transpose_item(const float* W, int K, int N, bf16* WT, LAS float* scr, int item, int lane) {
    const int nblk = N / 32, kb = item / nblk, nb = item % nblk, k0 = 64 * kb, n0 = 32 * nb;
#pragma unroll 8
    for (int i = 0; i < 32; ++i) { const int kk = 2 * i + (lane >> 5); scr[kk * 33 + (lane & 31)] = W[(size_t)(k0 + kk) * N + n0 + (lane & 31)]; }
    LDS_WAIT();
    const int c = lane & 7;
#pragma unroll
    for (int j = 0; j < 4; ++j) { const int n = (lane >> 3) + 8 * j; const LAS float* s = scr + (8 * c) * 33 + n;
        u32x4 o; o.x = cvtpk(s[0 * 33], s[1 * 33]); o.y = cvtpk(s[2 * 33], s[3 * 33]); o.z = cvtpk(s[4 * 33], s[5 * 33]); o.w = cvtpk(s[6 * 33], s[7 * 33]);
        *(u32x4*)(WT + (size_t)(n0 + n) * K + k0 + 8 * c) = o; }
    LDS_WAIT();
}

__device__ __forceinline__ void phase0(Ctx& F) {
    LAS float* scr = (LAS float*)(F.lds + F.wave * 16384);
    const float* w_in = F.prm->in[8]; const float* w_out = F.prm->in[9];
    bf16* WIN = (bf16*)(F.ws + WS_WIN); bf16* WOUT = (bf16*)(F.ws + WS_WOUT);
    constexpr int I_IN = (DM / 64) * (NIN / 32), I_OUT = (DM / 64) * (DM / 32);
    constexpr int NITEMS = 2 * (I_IN + I_OUT);
    for (int it = F.gw; it < NITEMS; it += F.NGW) {
        int r = it;
        if (r < 2 * I_IN) { const int l = r / I_IN; r -= l * I_IN; p0_transpose_item(w_in + (size_t)l * DM * NIN, DM, NIN, WIN + (size_t)l * NINP * DM, scr, r, F.lane); }
        else { r -= 2 * I_IN; const int l = r / I_OUT; r -= l * I_OUT; p0_transpose_item(w_out + (size_t)l * DM * DM, DM, DM, WOUT + (size_t)l * DM * DM, scr, r, F.lane); }
    }
    const float* cvec = F.prm->in[1]; const float* cctx = F.prm->in[3]; const float* w_mod = F.prm->in[4];
    float* MODACC = (float*)(F.ws + WS_CTL + CTL_MODACC);
    constexpr int NMOD = 2 * 32 * 24;
    for (int it = F.gw; it < NMOD; it += F.NGW) {
        const int l = it / (32 * 24), rem = it % (32 * 24), ks = rem / 24, cb = rem % 24, k0 = ks * 64, n0 = cb * 256 + 4 * F.lane;
        scr[F.lane] = silu_f(cvec[k0 + F.lane]); scr[64 + F.lane] = silu_f(cvec[DM + k0 + F.lane]); scr[128 + F.lane] = silu_f(cctx[k0 + F.lane]);
        LDS_WAIT();
        f32x4 a0 = {0.f, 0.f, 0.f, 0.f}, a1 = a0, a2 = a0;
        const float* wp = w_mod + ((size_t)l * DM + k0) * 6144 + n0;
#pragma unroll 8
        for (int k = 0; k < 64; ++k) { const f32x4 w = *(const f32x4*)(wp + (size_t)k * 6144); a0 += w * scr[k]; a1 += w * scr[64 + k]; a2 += w * scr[128 + k]; }
        float* ma = MODACC + (size_t)(l * 3) * 6144 + n0;
#pragma unroll
        for (int e = 0; e < 4; ++e) { atomicAdd(ma + e, a0[e]); atomicAdd(ma + 6144 + e, a1[e]); atomicAdd(ma + 2 * 6144 + e, a2[e]); }
        LDS_WAIT();
    }
    if (F.bx == 0) {
        float* rope = (float*)(F.ws + WS_ROPE);
        for (int i = F.tid; i < 1024; i += NTHREADS) { const int pos = i >> 4, f = i & 15; const float inv = powf(10000.f, -(float)(2 * f) / 32.f); const float ang = (float)pos * inv;
            rope[i] = cosf(ang); rope[1024 + i] = sinf(ang); }
    }
}

__device__ __forceinline__ void ld_row(const float* p, int lane, f32x4* v) {
#pragma unroll
    for (int j = 0; j < 8; ++j) v[j] = *(const f32x4*)(p + 4 * lane + 256 * j);
}
__device__ __forceinline__ float sumsq8(const f32x4* v) { float s = 0.f;
#pragma unroll
    for (int j = 0; j < 8; ++j) s += (v[j].x * v[j].x + v[j].y * v[j].y) + (v[j].z * v[j].z + v[j].w * v[j].w);
    return s; }
__device__ __forceinline__ void ld_mod(const Ctx& F, int l, int r, int part, int lane, f32x4* v) {
    const float* ma = (const float*)(F.ws + WS_CTL + CTL_MODACC) + (size_t)(l * 3 + r) * 6144 + part * DM; const float* bm = F.prm->in[5] + (size_t)l * 6144 + part * DM;
#pragma unroll
    for (int j = 0; j < 8; ++j) v[j] = *(const f32x4*)(ma + 4 * lane + 256 * j) + *(const f32x4*)(bm + 4 * lane + 256 * j);
}
__device__ __forceinline__ void phase1(Ctx& F, int l) {
    const float* x = F.prm->in[0]; const float* ctx = F.prm->in[2]; const float* g_pre = F.prm->in[6] + (size_t)l * DM; const float* g_post0 = F.prm->in[7];
    const float* O = (const float*)(F.ws + WS_P); bf16* XN = (bf16*)(F.ws + WS_XN);
    for (int row = F.gw; row < MT; row += F.NGW) {
        const bool lat = row < ML; const int r = lat ? (row / TL) : 2;
        const float* src = lat ? x + (size_t)row * DM : ctx + (size_t)(row - ML) * DM;
        f32x4 xv[8]; ld_row(src, F.lane, xv);
        if (l == 1) {
            f32x4 ov[8], gt[8], gp[8]; ld_row(O + (size_t)row * DM, F.lane, ov); ld_mod(F, 0, r, 2, F.lane, gt); ld_row(g_post0, F.lane, gp);
            const float rs = 1.f / sqrtf(wave_sum(sumsq8(ov)) * (1.f / DM) + EPS);
#pragma unroll
            for (int j = 0; j < 8; ++j) xv[j] = xv[j] + gt[j] * (ov[j] * rs * gp[j]);
            if (lat) {
#pragma unroll
                for (int j = 0; j < 8; ++j) *(f32x4*)(F.out + (size_t)row * DM + 4 * F.lane + 256 * j) = xv[j];
            }
        }
        const float rs = 1.f / sqrtf(wave_sum(sumsq8(xv)) * (1.f / DM) + EPS);
        f32x4 sh[8], sc[8], g[8]; ld_mod(F, l, r, 0, F.lane, sh); ld_mod(F, l, r, 1, F.lane, sc); ld_row(g_pre, F.lane, g);
#pragma unroll
        for (int j = 0; j < 8; ++j) { const f32x4 h = (xv[j] * rs * g[j]) * (sc[j] + 1.f) + sh[j];
            u32x2 w; w.x = cvtpk(h.x, h.y); w.y = cvtpk(h.z, h.w); *(u32x2*)(XN + (size_t)row * DM + 4 * F.lane + 256 * j) = w; }
    }
}
__device__ __forceinline__ void phase6(Ctx& F) {
    const float* g_post1 = F.prm->in[7] + DM; const float* O = (const float*)(F.ws + WS_P);
    for (int row = F.gw; row < ML; row += F.NGW) {
        const int r = row / TL;
        f32x4 xv[8], ov[8], gt[8], gp[8]; ld_row(F.out + (size_t)row * DM, F.lane, xv); ld_row(O + (size_t)row * DM, F.lane, ov); ld_mod(F, 1, r, 2, F.lane, gt); ld_row(g_post1, F.lane, gp);
        const float rs = 1.f / sqrtf(wave_sum(sumsq8(ov)) * (1.f / DM) + EPS);
#pragma unroll
        for (int j = 0; j < 8; ++j) *(f32x4*)(F.out + (size_t)row * DM + 4 * F.lane + 256 * j) = xv[j] + gt[j] * (ov[j] * rs * gp[j]);
    }
}

__device__ __forceinline__ void sgu_item(Ctx& F, int l, int cb, int h) {
    const bf16* P = (const bf16*)(F.ws + WS_P); bf16* OC = (bf16*)(F.ws + WS_OC);
    const float* w_s = F.prm->in[10] + (size_t)(l * 4 + h) * 128 * 128; const float* b_s = F.prm->in[11] + (size_t)(l * 4 + h) * 128;
    const int row0 = cb < 64 ? (cb >> 5) * TL + (cb & 31) * 128 : ML + ((cb - 64) >> 1) * CL + ((cb - 64) & 1) * 128;
    LAS float* VN = (LAS float*)F.lds;
    LAS float* WT = (LAS float*)(F.lds + 65536);
    {
        const int row = F.tid >> 2, qt = F.tid & 3; const bf16* src = P + (size_t)(row0 + row) * NINP + A_V + h * 128 + qt * 32;
        float v[32];
#pragma unroll
        for (int i = 0; i < 4; ++i) unpack8(*(const u32x4*)(src + 8 * i), v + 8 * i);
        float s = 0.f;
#pragma unroll
        for (int i = 0; i < 32; ++i) s += v[i];
        const float mean = red4(s) * (1.f / 128.f); float q = 0.f;
#pragma unroll
        for (int i = 0; i < 32; ++i) { v[i] -= mean; q += v[i] * v[i]; }
        const float rstd = 1.f / sqrtf(red4(q) * (1.f / 128.f) + EPS);
#pragma unroll
        for (int i = 0; i < 8; ++i) *(LAS f32x4*)(VN + row * 128 + qt * 32 + 4 * i) = (f32x4){v[4 * i] * rstd, v[4 * i + 1] * rstd, v[4 * i + 2] * rstd, v[4 * i + 3] * rstd};
    }
    for (int idx = F.tid; idx < 4096; idx += NTHREADS) { const int p = idx >> 5, q4 = idx & 31; const f32x4 w = *(const f32x4*)(w_s + p * 128 + 4 * q4);
        WT[(4 * q4 + 0) * 128 + p] = w.x; WT[(4 * q4 + 1) * 128 + p] = w.y; WT[(4 * q4 + 2) * 128 + p] = w.z; WT[(4 * q4 + 3) * 128 + p] = w.w; }
    WG_BAR();
    const int pg = F.tid >> 5, dg = F.tid & 31;
    f32x4 acc[8];
#pragma unroll
    for (int i = 0; i < 8; ++i) acc[i] = (f32x4){0.f, 0.f, 0.f, 0.f};
#pragma unroll 4
    for (int q = 0; q < 128; ++q) {
        const f32x4 w0 = *(const LAS f32x4*)(WT + q * 128 + 8 * pg), w1 = *(const LAS f32x4*)(WT + q * 128 + 8 * pg + 4), vv = *(const LAS f32x4*)(VN + q * 128 + 4 * dg);
        acc[0] += vv * w0.x; acc[1] += vv * w0.y; acc[2] += vv * w0.z; acc[3] += vv * w0.w; acc[4] += vv * w1.x; acc[5] += vv * w1.y; acc[6] += vv * w1.z; acc[7] += vv * w1.w;
    }
#pragma unroll
    for (int i = 0; i < 8; ++i) { const int p = 8 * pg + i; const float bs = b_s[p]; const bf16* pr = P + (size_t)(row0 + p) * NINP + h * 128 + 4 * dg;
        const u32x2 uu = *(const u32x2*)(pr + A_U), gg = *(const u32x2*)(pr + A_G);
        const float o0 = bflo(uu.x) * (acc[i].x + bs) * silu_f(bflo(gg.x)), o1 = bfhi(uu.x) * (acc[i].y + bs) * silu_f(bfhi(gg.x));
        const float o2 = bflo(uu.y) * (acc[i].z + bs) * silu_f(bflo(gg.y)), o3 = bfhi(uu.y) * (acc[i].w + bs) * silu_f(bfhi(gg.y));
        u32x2 w; w.x = cvtpk(o0, o1); w.y = cvtpk(o2, o3); *(u32x2*)(OC + (size_t)(row0 + p) * DM + h * 128 + 4 * dg) = w; }
    WG_BAR();
}

__device__ __forceinline__ void conv_item(Ctx& F, int l, int item) {
    const bf16* P = (const bf16*)(F.ws + WS_P); bf16* OC = (bf16*)(F.ws + WS_OC); const float* cw = F.prm->in[27] + (size_t)l * 3 * 512;
    const int row = item * 16 + (F.tid >> 5), c0 = (F.tid & 31) * 16;
    int t, tlen; if (row < ML) { t = row & (TL - 1); tlen = TL; } else { t = (row - ML) & (CL - 1); tlen = CL; }
    const bf16* pr = P + (size_t)row * NINP;
    float z0[16], z1[16], z2[16], tmp[16];
#pragma unroll
    for (int i = 0; i < 2; ++i) {
        float a[8], b[8];
        unpack8(*(const u32x4*)(pr + D_C + c0 + 8 * i), a); unpack8(*(const u32x4*)(pr + D_X + c0 + 8 * i), b);
#pragma unroll
        for (int e = 0; e < 8; ++e) z1[8 * i + e] = a[e] * b[e];
        if (t > 0) { unpack8(*(const u32x4*)(pr - NINP + D_C + c0 + 8 * i), a); unpack8(*(const u32x4*)(pr - NINP + D_X + c0 + 8 * i), b);
#pragma unroll
            for (int e = 0; e < 8; ++e) z0[8 * i + e] = a[e] * b[e]; }
        else {
#pragma unroll
            for (int e = 0; e < 8; ++e) z0[8 * i + e] = 0.f; }
        if (t < tlen - 1) { unpack8(*(const u32x4*)(pr + NINP + D_C + c0 + 8 * i), a); unpack8(*(const u32x4*)(pr + NINP + D_X + c0 + 8 * i), b);
#pragma unroll
            for (int e = 0; e < 8; ++e) z2[8 * i + e] = a[e] * b[e]; }
        else {
#pragma unroll
            for (int e = 0; e < 8; ++e) z2[8 * i + e] = 0.f; }
    }
#pragma unroll
    for (int i = 0; i < 2; ++i) {
        float bg[8], gg[8]; unpack8(*(const u32x4*)(pr + D_B + c0 + 8 * i), bg); unpack8(*(const u32x4*)(pr + D_G + c0 + 8 * i), gg);
#pragma unroll
        for (int e = 0; e < 8; ++e) { const int c = c0 + 8 * i + e; const float y = cw[c] * z0[8 * i + e] + cw[512 + c] * z1[8 * i + e] + cw[1024 + c] * z2[8 * i + e]; tmp[e] = bg[e] * y * silu_f(gg[e]); }
        *(u32x4*)(OC + (size_t)row * DM + 1536 + c0 + 8 * i) = pack8(tmp);
    }
}

__device__ __forceinline__ void attnprep_item(Ctx& F, int l, int rb, int h) {
    const bf16* P = (const bf16*)(F.ws + WS_P); const float* rope = (const float*)(F.ws + WS_ROPE);
    bf16* QR = (bf16*)(F.ws + WS_QR); bf16* QC = (bf16*)(F.ws + WS_QC); bf16* KR = (bf16*)(F.ws + WS_KR); bf16* VT = (bf16*)(F.ws + WS_VT);
    const bool lat = rb < 128; const int b = lat ? (rb >> 6) : ((rb - 128) >> 2), t0 = lat ? (rb & 63) * 64 : ((rb - 128) & 3) * 64;
    const int row0 = lat ? b * TL + t0 : ML + b * CL + t0;
    {
        const int tk = F.tid >> 3, sub = F.tid & 7, isk = sub >> 2, hq = sub & 3, m = hq >> 1, half = hq & 1, t = t0 + tk;
        const bf16* src = P + (size_t)(row0 + tk) * NINP + (isk ? B_K : B_Q) + h * 128 + 32 * hq;
        float xx[32], oo[32];
#pragma unroll
        for (int i = 0; i < 4; ++i) unpack8(*(const u32x4*)(src + 8 * i), xx + 8 * i);
        if (lat) { const int pos = half ? (t & 63) : (t >> 6); const float* cs = rope + pos * 16; const float* sn = rope + 1024 + pos * 16;
#pragma unroll
            for (int i = 0; i < 16; ++i) { const float c = cs[i], s = sn[i]; oo[i] = xx[i] * c - xx[i + 16] * s; oo[i + 16] = xx[i + 16] * c + xx[i] * s; } }
        else {
#pragma unroll
            for (int i = 0; i < 32; ++i) oo[i] = xx[i]; }
        if (!isk) {
#pragma unroll
            for (int i = 0; i < 32; ++i) oo[i] *= QSCALE; }
        const int bhm = (b * 4 + h) * 2 + m;
        bf16* dst = isk ? KR + ((size_t)bhm * KEYS + (lat ? CL + t : t)) * 64 + 32 * half : (lat ? QR + ((size_t)bhm * TL + t) * 64 + 32 * half : QC + ((size_t)bhm * CL + t) * 64 + 32 * half);
        if (isk || lat || l == 0) {
#pragma unroll
            for (int i = 0; i < 4; ++i) *(u32x4*)(dst + 8 * i) = pack8(oo + 8 * i); }
    }
    LAS unsigned char* VL = F.lds;
#pragma unroll
    for (int pass = 0; pass < 2; ++pass) { const int idx = F.tid + 512 * pass, key = idx >> 4, c = idx & 15;
        *(LAS u32x4*)(VL + key * 272 + 16 * c) = *(const u32x4*)(P + (size_t)(row0 + key) * NINP + B_V + h * 128 + 8 * c); }
    WG_BAR();
    const int keybase = lat ? CL + t0 : t0;
#pragma unroll
    for (int pass = 0; pass < 2; ++pass) { const int idx = F.tid + 512 * pass, dv = idx >> 3, kc = idx & 7; unsigned short e[8];
#pragma unroll
        for (int i = 0; i < 8; ++i) e[i] = *(const LAS unsigned short*)(VL + (8 * kc + i) * 272 + 2 * dv);
        u32x4 o; o.x = e[0] | ((unsigned)e[1] << 16); o.y = e[2] | ((unsigned)e[3] << 16); o.z = e[4] | ((unsigned)e[5] << 16); o.w = e[6] | ((unsigned)e[7] << 16);
        *(u32x4*)(VT + ((size_t)(b * 4 + h) * 128 + dv) * KEYS + keybase + 8 * kc) = o; }
    WG_BAR();
}

__device__ __forceinline__ float softplus_f(float x) { return fmaxf(x, 0.f) + log1pf(__expf(-fabsf(x))); }
__device__ __forceinline__ void rwkvprep_item(Ctx& F, int l, int tb, int h) {
    const bf16* P = (const bf16*)(F.ws + WS_P); unsigned char* OPS = F.ws + WS_OPS; float* BON = (float*)(F.ws + WS_BON);
    const bool lat = tb < 128; const int b = lat ? (tb >> 6) : ((tb - 128) >> 2), t0 = lat ? (tb & 63) * 64 : ((tb - 128) & 3) * 64, tlen = lat ? TL : CL;
    const int row0 = lat ? b * TL + t0 : ML + b * CL + t0;
    LAS float* W2S = (LAS float*)F.lds;
    LAS float* A2S = (LAS float*)(F.lds + 16384);
    LAS float* TW = (LAS float*)(F.lds + 24576);
    LAS float* ZA = (LAS float*)(F.lds + 24576 + 16640);
    const int tk = F.tid >> 3, sub = F.tid & 7, t = t0 + tk, c0 = 8 * sub, gc0 = h * 64 + c0;
    const bf16* pr = P + (size_t)(row0 + tk) * NINP;
    float bon[8];
#pragma unroll
    for (int e = 0; e < 8; ++e) bon[e] = 0.f;
    for (int dir = 0; dir < 2; ++dir) {
        const int pd = l * 2 + dir;
        const float* mu = F.prm->in[17] + (size_t)pd * 1632; const float* w0 = F.prm->in[18] + (size_t)pd * 512; const float* w2 = F.prm->in[19] + (size_t)pd * 64 * 512;
        const float* a0 = F.prm->in[20] + (size_t)pd * 512; const float* a2 = F.prm->in[21] + (size_t)pd * 32 * 512; const float* k_k = F.prm->in[22] + (size_t)pd * 512;
        const float* k_a = F.prm->in[23] + (size_t)pd * 512; const float* r_k = F.prm->in[24] + (size_t)pd * 512;
        const bool hasprev = dir == 0 ? (t > 0) : (t < tlen - 1);
        const bf16* pp = dir == 0 ? pr - NINP : pr + NINP;
        const int CLX = dir == 0 ? C_LF : C_LB;
        {
            float f[8], pv[8];
            unpack8(*(const u32x4*)(pr + CLX + c0), f);
            if (hasprev) unpack8(*(const u32x4*)(pp + CLX + c0), pv); else {
#pragma unroll
                for (int e = 0; e < 8; ++e) pv[e] = 0.f; }
#pragma unroll
            for (int e = 0; e < 8; ++e) TW[tk * 65 + c0 + e] = tanhf(f[e] + (pv[e] - f[e]) * mu[1536 + c0 + e]);
            const u32x2 fa = *(const u32x2*)(pr + CLX + 64 + 4 * sub); u32x2 pa = {0u, 0u}; if (hasprev) pa = *(const u32x2*)(pp + CLX + 64 + 4 * sub);
            const float fz[4] = {bflo(fa.x), bfhi(fa.x), bflo(fa.y), bfhi(fa.y)}, pz[4] = {bflo(pa.x), bfhi(pa.x), bflo(pa.y), bfhi(pa.y)};
#pragma unroll
            for (int e = 0; e < 4; ++e) ZA[tk * 33 + 4 * sub + e] = fz[e] + (pz[e] - fz[e]) * mu[1600 + 4 * sub + e];
        }
#pragma unroll
        for (int i = 0; i < 2; ++i) { const int idx = F.tid + 512 * i, r = idx >> 4, c4 = idx & 15; *(LAS f32x4*)(W2S + r * 64 + 4 * c4) = *(const f32x4*)(w2 + (size_t)r * 512 + h * 64 + 4 * c4); }
        { const int r = F.tid >> 4, c4 = F.tid & 15; *(LAS f32x4*)(A2S + r * 64 + 4 * c4) = *(const f32x4*)(a2 + (size_t)r * 512 + h * 64 + 4 * c4); }
        WG_BAR();
        float wp[8], ap[8];
#pragma unroll
        for (int e = 0; e < 8; ++e) { wp[e] = w0[gc0 + e]; ap[e] = a0[gc0 + e]; }
#pragma unroll 4
        for (int i = 0; i < 64; ++i) { const float tw = TW[tk * 65 + i]; const f32x4 u0 = *(const LAS f32x4*)(W2S + i * 64 + c0), u1 = *(const LAS f32x4*)(W2S + i * 64 + c0 + 4);
            wp[0] += tw * u0.x; wp[1] += tw * u0.y; wp[2] += tw * u0.z; wp[3] += tw * u0.w; wp[4] += tw * u1.x; wp[5] += tw * u1.y; wp[6] += tw * u1.z; wp[7] += tw * u1.w; }
#pragma unroll 4
        for (int i = 0; i < 32; ++i) { const float za = ZA[tk * 33 + i]; const f32x4 u0 = *(const LAS f32x4*)(A2S + i * 64 + c0), u1 = *(const LAS f32x4*)(A2S + i * 64 + c0 + 4);
            ap[0] += za * u0.x; ap[1] += za * u0.y; ap[2] += za * u0.z; ap[3] += za * u0.w; ap[4] += za * u1.x; ap[5] += za * u1.y; ap[6] += za * u1.z; ap[7] += za * u1.w; }
        float fr[8], fk[8], fv[8], qr[8], qk[8], qv[8];
        unpack8(*(const u32x4*)(pr + C_R + gc0), fr); unpack8(*(const u32x4*)(pr + C_K + gc0), fk); unpack8(*(const u32x4*)(pr + C_V + gc0), fv);
        if (hasprev) { unpack8(*(const u32x4*)(pp + C_R + gc0), qr); unpack8(*(const u32x4*)(pp + C_K + gc0), qk); unpack8(*(const u32x4*)(pp + C_V + gc0), qv); }
        else {
#pragma unroll
            for (int e = 0; e < 8; ++e) { qr[e] = 0.f; qk[e] = 0.f; qv[e] = 0.f; } }
        float dec[8], nkk[8], bb[8], km[8], rr[8], vv[8]; float n2 = 0.f, bsum = 0.f;
#pragma unroll
        for (int e = 0; e < 8; ++e) {
            const int gc = gc0 + e;
            rr[e] = fr[e] + (qr[e] - fr[e]) * mu[gc]; const float kx = fk[e] + (qk[e] - fk[e]) * mu[512 + gc]; vv[e] = fv[e] + (qv[e] - fv[e]) * mu[1024 + gc];
            const float w = -softplus_f(-wp[e]) - 0.5f; dec[e] = __expf(-__expf(w));
            const float a = 1.f / (1.f + __expf(-ap[e]));
            const float kraw = kx * k_k[gc]; n2 += kraw * kraw; nkk[e] = kraw; bb[e] = a;
            km[e] = kx * (1.f + (a - 1.f) * k_a[gc]);
            bsum += rr[e] * km[e] * r_k[gc];
        }
        n2 = red8(n2); bsum = red8(bsum);
        const float inv = 1.f / fmaxf(sqrtf(n2), 1e-12f);
#pragma unroll
        for (int e = 0; e < 8; ++e) { const float kk = nkk[e] * inv; nkk[e] = -kk; bb[e] = kk * bb[e]; bon[e] += bsum * vv[e]; }
        const int step = dir == 0 ? (lat ? CL + t : t) : (lat ? CL + (TL - 1 - t) : (CL - 1 - t));
        unsigned char* rec = OPS + ((size_t)((dir * 2 + b) * 8 + h) * NSTEP + step) * RECB;
        *(f32x4*)(rec + 4 * c0) = (f32x4){dec[0], dec[1], dec[2], dec[3]}; *(f32x4*)(rec + 4 * c0 + 16) = (f32x4){dec[4], dec[5], dec[6], dec[7]};
        *(u32x4*)(rec + 256 + 0 * 128 + 2 * c0) = pack8(nkk); *(u32x4*)(rec + 256 + 1 * 128 + 2 * c0) = pack8(bb); *(u32x4*)(rec + 256 + 2 * 128 + 2 * c0) = pack8(km);
        *(u32x4*)(rec + 256 + 3 * 128 + 2 * c0) = pack8(rr); *(u32x4*)(rec + 256 + 4 * 128 + 2 * c0) = pack8(vv);
        WG_BAR();
    }
    float* bo = BON + (size_t)(row0 + tk) * 512 + gc0;
    *(f32x4*)bo = (f32x4){bon[0], bon[1], bon[2], bon[3]}; *(f32x4*)(bo + 4) = (f32x4){bon[4], bon[5], bon[6], bon[7]};
}

__device__ __forceinline__ void phase3a(Ctx& F, int l) {
    const int nsgu = (l == 0 ? 68 : 64) * 4, nrw = 136 * 8, nap = 136 * 4, ncv = (l == 0 ? MT : ML) / 16;
    const int total = nsgu + nrw + nap + ncv;
    for (int it = F.bx; it < total; it += F.G) {
        int r = it;
        if (r < nsgu) { sgu_item(F, l, r >> 2, r & 3); continue; } r -= nsgu;
        if (r < nrw) { rwkvprep_item(F, l, r >> 3, r & 7); continue; } r -= nrw;
        if (r < nap) { attnprep_item(F, l, r >> 2, r & 3); continue; } r -= nap;
        conv_item(F, l, r);
    }
}

__device__ __forceinline__ void scan_role(Ctx& F) {
    const int scan = F.bx >> 2, quarter = F.bx & 3, dir = scan >> 4, b = (scan >> 3) & 1, h = scan & 7;
    const unsigned char* rec = F.ws + WS_OPS + (size_t)scan * NSTEP * RECB;
    float* Y = (float*)(F.ws + WS_Y) + (size_t)dir * MT * 512 + h * 64;
    constexpr int CH = 32, NCH = NSTEP / CH, CHB = CH * 1536, CHG = CH * RECB;
    const bool scanner = F.wave < 4;
    const int lt = F.tid - 256;
    u32x4 st[7];
    auto ld_chunk = [&](int c) {
#pragma unroll
        for (int k = 0; k < 7; ++k) st[k] = *(const u32x4*)(rec + (size_t)c * CHG + (size_t)(lt + 256 * k) * 16);
    };
    auto wr_chunk = [&](int c) {
        LAS unsigned char* buf = F.lds + (c & 1) * CHB;
#pragma unroll
        for (int k = 0; k < 7; ++k) { const int p = lt + 256 * k, s = p / 56, q = p % 56;
            if (q < 16) *(LAS u32x4*)(buf + s * 1536 + 16 * q) = st[k];
            else { float f[8]; unpack8(st[k], f); LAS float* d = (LAS float*)(buf + s * 1536 + 256 + 32 * (q - 16)); *(LAS f32x4*)d = (f32x4){f[0], f[1], f[2], f[3]}; *(LAS f32x4*)(d + 4) = (f32x4){f[4], f[5], f[6], f[7]}; } }
    };
    const int srow = quarter * 16 + (F.wave & 3) * 4 + (F.lane >> 4), jj = F.lane & 15;
    f32x4 S = {0.f, 0.f, 0.f, 0.f};
    if (!scanner) { ld_chunk(0); wr_chunk(0); ld_chunk(1); }
    WG_BAR();
    for (int c = 0; c < NCH; ++c) {
        if (scanner) {
            const LAS unsigned char* buf = F.lds + (c & 1) * CHB;
#pragma unroll 2
            for (int s = 0; s < CH; ++s) {
                const LAS unsigned char* base = buf + s * 1536;
                const f32x4 dec = *(const LAS f32x4*)(base + 16 * jj), nk = *(const LAS f32x4*)(base + 256 + 16 * jj), bb = *(const LAS f32x4*)(base + 512 + 16 * jj),
                            km = *(const LAS f32x4*)(base + 768 + 16 * jj), rr = *(const LAS f32x4*)(base + 1024 + 16 * jj);
                const float vv = *(const LAS float*)(base + 1280 + 4 * srow);
                float sa = (S.x * nk.x + S.y * nk.y) + (S.z * nk.z + S.w * nk.w);
                sa = red16(sa);
                S = S * dec + (bb * sa + km * vv);
                float y = (S.x * rr.x + S.y * rr.y) + (S.z * rr.z + S.w * rr.w);
                y = red16(y);
                const int i = c * CH + s;
                const int row = i < CL ? (ML + b * CL + (dir ? CL - 1 - i : i)) : (b * TL + (dir ? TL - 1 - (i - CL) : (i - CL)));
                if (jj == 0) Y[(size_t)row * 512 + srow] = y;
            }
        } else {
            if (c + 1 < NCH) wr_chunk(c + 1);
            if (c + 2 < NCH) ld_chunk(c + 2);
        }
        WG_BAR();
    }
}

__device__ __forceinline__ void attn_unit(Ctx& F, const bf16* Qp, const bf16* Kp, const bf16* Vtp, int nkt, float* Op) {
    constexpr int KB = 9216, TB = 27648;
    const int j = F.lane & 31, hh = F.lane >> 5;
    bf16x8 qf[4];
#pragma unroll
    for (int ks = 0; ks < 4; ++ks) qf[ks] = *(const bf16x8*)(Qp + (size_t)(F.wave * 32 + j) * 64 + ks * 16 + hh * 8);
    const int kkey = F.tid >> 3, kch = F.tid & 7;
    const bf16* ksrc = Kp + (size_t)kkey * 64 + kch * 8;
    const bf16* vsrc0 = Vtp + (size_t)(F.tid >> 3) * KEYS + kch * 8; const bf16* vsrc1 = vsrc0 + (size_t)64 * KEYS;
    const int kdst = kkey * 144 + kch * 16, vdst0 = KB + (F.tid >> 3) * 144 + kch * 16, vdst1 = vdst0 + 64 * 144;
    u32x4 rk, rv0, rv1;
    rk = *(const u32x4*)ksrc; rv0 = *(const u32x4*)vsrc0; rv1 = *(const u32x4*)vsrc1;
    *(LAS u32x4*)(F.lds + kdst) = rk; *(LAS u32x4*)(F.lds + vdst0) = rv0; *(LAS u32x4*)(F.lds + vdst1) = rv1;
    WG_BAR();
    const int sw = (j & ~12) | ((j & 4) << 1) | ((j & 8) >> 1);
    const int ka0 = sw * 144 + hh * 16, ka1 = (32 + sw) * 144 + hh * 16, va = KB + j * 144 + hh * 16;
    f32x16 acc[4];
#pragma unroll
    for (int i = 0; i < 4; ++i)
#pragma unroll
        for (int r = 0; r < 16; ++r) acc[i][r] = 0.f;
    float m_run = -1e30f, l_run = 0.f;
    for (int kt = 0; kt < nkt; ++kt) {
        const LAS unsigned char* buf = F.lds + (kt & 1) * TB;
        if (kt + 1 < nkt) { rk = *(const u32x4*)(ksrc + (size_t)(kt + 1) * 64 * 64); rv0 = *(const u32x4*)(vsrc0 + (kt + 1) * 64); rv1 = *(const u32x4*)(vsrc1 + (kt + 1) * 64); }
        f32x16 s0, s1;
#pragma unroll
        for (int r = 0; r < 16; ++r) { s0[r] = 0.f; s1[r] = 0.f; }
#pragma unroll
        for (int ks = 0; ks < 4; ++ks) {
            const bf16x8 a0 = *(const LAS bf16x8*)(buf + ka0 + ks * 32), a1 = *(const LAS bf16x8*)(buf + ka1 + ks * 32);
            s0 = __builtin_amdgcn_mfma_f32_32x32x16_bf16(a0, qf[ks], s0, 0, 0, 0);
            s1 = __builtin_amdgcn_mfma_f32_32x32x16_bf16(a1, qf[ks], s1, 0, 0, 0);
        }
        float mx = fmaxf(s0[0], s1[0]);
#pragma unroll
        for (int r = 1; r < 16; ++r) mx = fmaxf(mx, fmaxf(s0[r], s1[r]));
        mx = fmaxf(mx, __shfl_xor(mx, 32));
        const float m_new = fmaxf(m_run, mx), alpha = __builtin_amdgcn_exp2f(m_run - m_new);
        m_run = m_new;
        float ls = 0.f;
#pragma unroll
        for (int r = 0; r < 16; ++r) { s0[r] = __builtin_amdgcn_exp2f(s0[r] - m_new); s1[r] = __builtin_amdgcn_exp2f(s1[r] - m_new); ls += s0[r] + s1[r]; }
        l_run = l_run * alpha + ls;
#pragma unroll
        for (int i = 0; i < 4; ++i)
#pragma unroll
            for (int r = 0; r < 16; ++r) acc[i][r] *= alpha;
        bf16x8 pf[4];
        { u32x4 w;
          w.x = cvtpk(s0[0], s0[1]); w.y = cvtpk(s0[2], s0[3]); w.z = cvtpk(s0[4], s0[5]); w.w = cvtpk(s0[6], s0[7]); pf[0] = __builtin_bit_cast(bf16x8, w);
          w.x = cvtpk(s0[8], s0[9]); w.y = cvtpk(s0[10], s0[11]); w.z = cvtpk(s0[12], s0[13]); w.w = cvtpk(s0[14], s0[15]); pf[1] = __builtin_bit_cast(bf16x8, w);
          w.x = cvtpk(s1[0], s1[1]); w.y = cvtpk(s1[2], s1[3]); w.z = cvtpk(s1[4], s1[5]); w.w = cvtpk(s1[6], s1[7]); pf[2] = __builtin_bit_cast(bf16x8, w);
          w.x = cvtpk(s1[8], s1[9]); w.y = cvtpk(s1[10], s1[11]); w.z = cvtpk(s1[12], s1[13]); w.w = cvtpk(s1[14], s1[15]); pf[3] = __builtin_bit_cast(bf16x8, w); }
#pragma unroll
        for (int blk = 0; blk < 4; ++blk)
#pragma unroll
            for (int kstep = 0; kstep < 4; ++kstep) {
                const bf16x8 a = *(const LAS bf16x8*)(buf + va + blk * 32 * 144 + kstep * 32);
                acc[blk] = __builtin_amdgcn_mfma_f32_32x32x16_bf16(a, pf[kstep], acc[blk], 0, 0, 0);
            }
        if (kt + 1 < nkt) { LAS unsigned char* nb = F.lds + ((kt + 1) & 1) * TB; *(LAS u32x4*)(nb + kdst) = rk; *(LAS u32x4*)(nb + vdst0) = rv0; *(LAS u32x4*)(nb + vdst1) = rv1; }
        WG_BAR();
    }
    const float inv = 1.f / (l_run + __shfl_xor(l_run, 32));
    float* orow = Op + (size_t)(F.wave * 32 + j) * 1024 + 4 * hh;
#pragma unroll
    for (int blk = 0; blk < 4; ++blk)
#pragma unroll
        for (int g = 0; g < 4; ++g) *(f32x4*)(orow + 32 * blk + 8 * g) = (f32x4){acc[blk][4 * g] * inv, acc[blk][4 * g + 1] * inv, acc[blk][4 * g + 2] * inv, acc[blk][4 * g + 3] * inv};
}

__device__ __forceinline__ void attn_role(Ctx& F, int l) {
    const int a = F.bx - 128, bh = a & 7, k = a >> 3, b = bh >> 2, h = bh & 3;
    const bf16* QR = (const bf16*)(F.ws + WS_QR); const bf16* QC = (const bf16*)(F.ws + WS_QC); const bf16* KR = (const bf16*)(F.ws + WS_KR); const bf16* VT = (const bf16*)(F.ws + WS_VT);
    float* OATT = (float*)(F.ws + WS_XN);
    const bf16* Vtp = VT + (size_t)bh * 128 * KEYS;
    for (int m = 0; m < 2; ++m) {
        const int bhm = bh * 2 + m;
        attn_unit(F, QR + ((size_t)bhm * TL + k * 256) * 64, KR + (size_t)bhm * KEYS * 64, Vtp, KEYS / 64, OATT + (size_t)(b * TL + k * 256) * 1024 + (h * 2 + m) * 128);
    }
    if (l == 0 && k < 2) {
        const int m = k, bhm = bh * 2 + m;
        attn_unit(F, QC + (size_t)bhm * CL * 64, KR + (size_t)bhm * KEYS * 64, Vtp, CL / 64, OATT + (size_t)(ML + b * CL) * 1024 + (h * 2 + m) * 128);
    }
}

__device__ __forceinline__ void phase4(Ctx& F, int l) {
    const bf16* P = (const bf16*)(F.ws + WS_P); bf16* OC = (bf16*)(F.ws + WS_OC); const float* OATT = (const float*)(F.ws + WS_XN);
    const float* Yf = (const float*)(F.ws + WS_Y); const float* Yb = Yf + (size_t)MT * 512; const float* BON = (const float*)(F.ws + WS_BON);
    const float lam_init = 0.8f - 0.6f * expf(-0.3f * (float)l);
    const float d1 = wave_sum(F.prm->in[12][l * 64 + F.lane] * F.prm->in[13][l * 64 + F.lane]), d2 = wave_sum(F.prm->in[14][l * 64 + F.lane] * F.prm->in[15][l * 64 + F.lane]);
    const float lam = expf(d1) - expf(d2) + lam_init;
    const float* subg = F.prm->in[16] + l * 128; const float* ln_w = F.prm->in[25] + l * 512; const float* ln_b = F.prm->in[26] + l * 512;
    const int nrows = l == 0 ? MT : ML;
    for (int row = F.gw; row < nrows; row += F.NGW) {
        {
            const int h = F.lane >> 4, dv0 = (F.lane & 15) * 8; const float* o1 = OATT + (size_t)row * 1024 + h * 256 + dv0; const float* o2 = o1 + 128;
            float o[8]; const f32x4 a0 = *(const f32x4*)o1, a1 = *(const f32x4*)(o1 + 4), b0 = *(const f32x4*)o2, b1 = *(const f32x4*)(o2 + 4);
            o[0] = a0.x - lam * b0.x; o[1] = a0.y - lam * b0.y; o[2] = a0.z - lam * b0.z; o[3] = a0.w - lam * b0.w; o[4] = a1.x - lam * b1.x; o[5] = a1.y - lam * b1.y; o[6] = a1.z - lam * b1.z; o[7] = a1.w - lam * b1.w;
            float ss = 0.f;
#pragma unroll
            for (int e = 0; e < 8; ++e) ss += o[e] * o[e];
            const float rs = (1.f - lam_init) / sqrtf(red16(ss) * (1.f / 128.f) + EPS);
            float gg[8]; unpack8(*(const u32x4*)(P + (size_t)row * NINP + B_G + h * 128 + dv0), gg);
#pragma unroll
            for (int e = 0; e < 8; ++e) o[e] = o[e] * rs * subg[dv0 + e] * silu_f(gg[e]);
            *(u32x4*)(OC + (size_t)row * DM + 512 + h * 128 + dv0) = pack8(o);
        }
        {
            const int c0 = F.lane * 8; const float* yf = Yf + (size_t)row * 512 + c0; const float* yb = Yb + (size_t)row * 512 + c0; const float* bo = BON + (size_t)row * 512 + c0;
            float y[8]; const f32x4 a0 = *(const f32x4*)yf, a1 = *(const f32x4*)(yf + 4), b0 = *(const f32x4*)yb, b1 = *(const f32x4*)(yb + 4);
            y[0] = a0.x + b0.x; y[1] = a0.y + b0.y; y[2] = a0.z + b0.z; y[3] = a0.w + b0.w; y[4] = a1.x + b1.x; y[5] = a1.y + b1.y; y[6] = a1.z + b1.z; y[7] = a1.w + b1.w;
            float s = 0.f;
#pragma unroll
            for (int e = 0; e < 8; ++e) s += y[e];
            const float mean = red8(s) * (1.f / 64.f); float q = 0.f;
#pragma unroll
            for (int e = 0; e < 8; ++e) { y[e] -= mean; q += y[e] * y[e]; }
            const float rstd = 1.f / sqrtf(red8(q) * (1.f / 64.f) + GN_EPS);
            float gg[8]; unpack8(*(const u32x4*)(P + (size_t)row * NINP + C_G + c0), gg);
            const f32x4 q0 = *(const f32x4*)bo, q1 = *(const f32x4*)(bo + 4); const float bn[8] = {q0.x, q0.y, q0.z, q0.w, q1.x, q1.y, q1.z, q1.w};
#pragma unroll
            for (int e = 0; e < 8; ++e) y[e] = (y[e] * rstd * ln_w[c0 + e] + ln_b[c0 + e] + bn[e]) * silu_f(gg[e]);
            *(u32x4*)(OC + (size_t)row * DM + 1024 + c0) = pack8(y);
        }
    }
}

__global__ void __launch_bounds__(NTHREADS, 2) fwd_kernel(Params prm) {
    extern __shared__ __attribute__((aligned(16))) unsigned char lds_raw[];
    cg::grid_group grid = cg::this_grid();
    Ctx F;
    F.prm = &prm; F.out = prm.out; F.ws = prm.ws; F.lds = (LAS unsigned char*)lds_raw;
    F.tid = threadIdx.x; F.lane = F.tid & 63; F.wave = __builtin_amdgcn_readfirstlane(F.tid >> 6); F.bx = blockIdx.x; F.G = gridDim.x;
    F.gw = F.bx * NWAVES + F.wave; F.NGW = F.G * NWAVES;

#ifndef NO_P0
    LAUNDER(F); phase0(F);
#endif
    grid.sync();
#pragma unroll 1
    for (int l = 0; l < 2; ++l) {
#ifndef NO_P1
        LAUNDER(F); phase1(F, l);
#endif
        grid.sync();
#ifndef NO_P2
        {
            pg8::Gemm g{(const pg8::bf16_t*)(F.ws + WS_XN), (const pg8::bf16_t*)(F.ws + WS_WIN) + (size_t)l * NINP * DM, MT, NINP, DM};
            pg8::StaticOrder S; S.init(MT, NINP, F.G, F.bx);
            pg8::EpiBf16 E{(pg8::bf16_t*)(F.ws + WS_P), NINP, nullptr, 0, 0, 1.f};
            pg8::gemm_phase<pg8::EpiBf16, pg8::StaticOrder, true, true>(F.lds, g, S, E);
        }
#endif
        grid.sync();
#ifndef NO_P3A
        LAUNDER(F); phase3a(F, l);
#endif
        grid.sync();
#ifndef NO_P3B
        LAUNDER(F);
        if (F.bx < 128) {
#ifndef NO_SCAN
 scan_role(F);
#endif
 } else {
#ifndef NO_ATTN
 attn_role(F, l);
#endif
 }
#endif
        grid.sync();
#ifndef NO_P4
        LAUNDER(F); phase4(F, l);
#endif
        grid.sync();
#ifndef NO_P5
        {
            const int rows = l == 0 ? MT : ML;
            pg8::Gemm g{(const pg8::bf16_t*)(F.ws + WS_OC), (const pg8::bf16_t*)(F.ws + WS_WOUT) + (size_t)l * DM * DM, rows, DM, DM};
            pg8::StaticOrder S; S.init(rows, DM, F.G, F.bx);
            pg8::EpiF32 E{(float*)(F.ws + WS_P), DM};
            pg8::gemm_phase<pg8::EpiF32, pg8::StaticOrder, true, true>(F.lds, g, S, E);
        }
#endif
        grid.sync();
    }
#ifndef NO_P6
    LAUNDER(F); phase6(F);
#endif
}

extern "C" void kernel_launch(void* const* d_in, const int* in_sizes, int n_in, void* d_out, int out_size, void* d_ws, size_t ws_size, hipStream_t stream) {
    static int grid = 0;
    if (grid == 0) {
        if (n_in != 28 || out_size != ML * DM || ws_size < WS_END) { fprintf(stderr, "kernel_launch: unexpected shapes: n_in %d out %d ws %zu (need %zu)\n", n_in, out_size, ws_size, (size_t)WS_END); grid = -1; return; }
        int dev = 0, cus = 0, per_cu = 0;
        if (hipGetDevice(&dev) != hipSuccess || hipDeviceGetAttribute(&cus, hipDeviceAttributeMultiprocessorCount, dev) != hipSuccess) { grid = -1; return; }
        if (hipFuncSetAttribute((const void*)fwd_kernel, hipFuncAttributeMaxDynamicSharedMemorySize, LDS_BYTES) != hipSuccess) { fprintf(stderr, "kernel_launch: hipFuncSetAttribute failed\n"); grid = -1; return; }
        if (hipOccupancyMaxActiveBlocksPerMultiprocessor(&per_cu, (const void*)fwd_kernel, NTHREADS, LDS_BYTES) != hipSuccess || per_cu < 1) { fprintf(stderr, "kernel_launch: occupancy query says %d blocks per CU\n", per_cu); grid = -1; return; }
        (void)hipGetLastError();
        grid = cus;
        if (grid != 256) { fprintf(stderr, "kernel_launch: expected 256 CUs, got %d\n", cus); grid = -1; return; }
    }
    if (grid < 0) return;
    if (hipMemsetAsync((char*)d_ws + WS_CTL, 0, CTL_ZERO_BYTES, stream) != hipSuccess) { fprintf(stderr, "kernel_launch: memset failed\n"); return; }
    Params p{};
    for (int i = 0; i < 28; ++i) p.in[i] = (const float*)d_in[i];
    p.out = (float*)d_out; p.ws = (unsigned char*)d_ws;
    void* args[] = {&p};
    hipError_t e = hipLaunchCooperativeKernel((void*)fwd_kernel, dim3(grid), dim3(NTHREADS), args, LDS_BYTES, stream);
    if (e != hipSuccess) fprintf(stderr, "cooperative launch failed: %s (grid %d)\n", hipGetErrorString(e), grid);
}
```

```cpp
#include <hip/hip_runtime.h>
#include <hip/hip_cooperative_groups.h>
#include <cstdio>
#include <cstdint>
namespace cg = cooperative_groups;
namespace pg8 {
#define PG8_LAS __attribute__((address_space(3)))
typedef unsigned short bf16_t;
typedef short bf16x8 __attribute__((ext_vector_type(8)));
typedef float f32x4 __attribute__((ext_vector_type(4)));
typedef unsigned u32x4 __attribute__((ext_vector_type(4)));
constexpr int BM = 256, BK = 64, HALF = 128, HTB = HALF * BK * 2  , STAGE_BYTES = 8 * HTB, NXCD = 8, WGM = 8;

__host__ __device__ __forceinline__ int lds_byte(int r, int c) { const int st = (r >> 4) * 2 + (c >> 5), rr = r & 15, cc = c & 31, ob = rr * 64 + cc * 2; return st * 1024 + (ob ^ (((ob >> 9) & 1) << 5)); }
__host__ __device__ __forceinline__ void stage_rc(int b, int& R, int& C) { const int st = b / 1024, sb = b % 1024, swz = sb ^ (((sb >> 9) & 1) << 5); R = (st >> 1) * 16 + swz / 64; C = (st & 1) * 32 + (swz % 64) / 2; }
__host__ __device__ __forceinline__ int perm32(int rho) { const int n = rho >> 4, i = rho & 15; return 8 * (i >> 2) + 4 * n + (i & 3); }

struct Unit { int pm, pn; };
struct Gemm { const bf16_t* A; const bf16_t* Bt; int M, N, K; };

struct StaticOrder {
    int nM, nN, nwg, G, c;
    __host__ __device__ void init(int M, int N, int G_, int c_) { nM = M / BM; nN = N / BM; nwg = nM * nN; G = G_; c = c_; }
    __host__ __device__ bool next(int i, Unit& u) const {
        const long L = (long)i * G + c; if (L >= nwg) return false;
        int wgid = (int)L; { const int q = nwg / NXCD, r = nwg % NXCD, xcd = wgid % NXCD, off = wgid / NXCD; wgid = (xcd < r ? xcd * (q + 1) : r * (q + 1) + (xcd - r) * q) + off; }
        const int nig = WGM * nN, gid = wgid / nig, fm = gid * WGM, gsz = (nM - fm) < WGM ? (nM - fm) : WGM;
        u.pm = fm + ((wgid % nig) % gsz); u.pn = (wgid % nig) / gsz; return true;
    }
    __device__ __forceinline__ void a_ready(const Unit&) const {}
    __device__ __forceinline__ void done(const Unit&) const {}
};

__device__ __forceinline__ unsigned cvt_pk_bf16(float lo, float hi) { unsigned r; asm volatile("v_cvt_pk_bf16_f32 %0, %1, %2" : "=v"(r) : "v"(lo), "v"(hi)); return r; }
struct EpiBf16 {
    static constexpr bool PERM = true, AFTER_DRAIN = false;
    bf16_t* O; int ldc; const float* bias; int split_cols; size_t split_stride; float scale0;
    __device__ __forceinline__ void operator()(const f32x4 (&acc)[2][2][4][2], const Unit& u, int wr, int wc, int fr, int fq) const {
        const int row0 = u.pm * BM + wr * 64 + fr; int colt = u.pn * BM; bf16_t* base = O;
        float sc = 1.f; if (split_cols) { const int t = colt / split_cols; base += (size_t)t * split_stride; colt -= t * split_cols; if (t == 0) sc = scale0; }
        const int col0 = colt + wc * 32 + 8 * fq, bcol0 = u.pn * BM + wc * 32 + 8 * fq;
        f32x4 bv[2][2];
#pragma unroll
        for (int bj = 0; bj < 2; ++bj)
#pragma unroll
            for (int n = 0; n < 2; ++n) bv[bj][n] = bias ? *(const f32x4*)(bias + bcol0 + bj * HALF + 4 * n) : (f32x4){0.f, 0.f, 0.f, 0.f};
#pragma unroll
        for (int ai = 0; ai < 2; ++ai)
#pragma unroll
            for (int m = 0; m < 4; ++m) { bf16_t* rowp = base + (size_t)(row0 + ai * HALF + m * 16) * ldc + col0;
#pragma unroll
                for (int bj = 0; bj < 2; ++bj) { f32x4 v0 = acc[ai][bj][m][0] + bv[bj][0], v1 = acc[ai][bj][m][1] + bv[bj][1];
                    v0 = v0 * sc; v1 = v1 * sc; u32x4 w; w.x = cvt_pk_bf16(v0[0], v0[1]); w.y = cvt_pk_bf16(v0[2], v0[3]); w.z = cvt_pk_bf16(v1[0], v1[1]); w.w = cvt_pk_bf16(v1[2], v1[3]);
                    *(u32x4*)(rowp + bj * HALF) = w; } }
    }
};
struct EpiF32 {
    static constexpr bool PERM = false, AFTER_DRAIN = false;
    float* O; int ldc;
    __device__ __forceinline__ void operator()(const f32x4 (&acc)[2][2][4][2], const Unit& u, int wr, int wc, int fr, int fq) const {
        const int col0 = u.pn * BM + wc * 32 + 4 * fq;
#pragma unroll
        for (int ai = 0; ai < 2; ++ai)
#pragma unroll
            for (int m = 0; m < 4; ++m) { float* rowp = O + (size_t)(u.pm * BM + ai * HALF + wr * 64 + m * 16 + fr) * ldc + col0;
#pragma unroll
                for (int bj = 0; bj < 2; ++bj)
#pragma unroll
                    for (int n = 0; n < 2; ++n) *(f32x4*)(rowp + bj * HALF + n * 16) = acc[ai][bj][m][n]; }
    }
};
template <class Epi, class Sched, bool ALIGN_EPI = false, bool SP2 = false>
__device__ __forceinline__ void gemm_phase(PG8_LAS unsigned char* lds, const Gemm g, const Sched& S, const Epi& E) {
    int tid_ = threadIdx.x; asm volatile("" : "+v"(tid_));
    const int tid = tid_, wid = __builtin_amdgcn_readfirstlane(tid >> 6), lane = tid & 63, wr = wid >> 2, wc = wid & 3, fr = lane & 15, fq = lane >> 4;
    const int K = g.K, nt = K / BK;
    unsigned voffA[2], voffB[2];
#pragma unroll
    for (int i = 0; i < 2; ++i) { int R, C; stage_rc(tid * 16 + i * 8192, R, C); const int Rb = Epi::PERM ? ((R & ~31) + perm32(R & 31)) : R;
        voffA[i] = (unsigned)(R * K + C) * 2u; voffB[i] = (unsigned)(Rb * K + C) * 2u; }
    const size_t kstep = (size_t)(BK * 2);
    const size_t hstep = (size_t)HALF * K * 2;
    const size_t tstep = 2 * hstep;
    const unsigned ldsw = (unsigned)wid * 1024u;
    const int aoff = lds_byte(wr * 64 + fr, fq * 8), boff = lds_byte(wc * 32 + fr, fq * 8);
#define PG8_SA(b, h) (((b) * 2 + (h)) * HTB)
#define PG8_SB(b, h) ((4 + (b) * 2 + (h)) * HTB)
#define PG8_STAGE(bufoff, gbase, voff) do { _Pragma("unroll") for (int _i = 0; _i < 2; ++_i) \
        __builtin_amdgcn_global_load_lds((const unsigned*)((const char*)(gbase) + (voff)[_i]), (PG8_LAS unsigned*)(lds + (bufoff) + ldsw + _i * 8192), 16, 0, 0); } while (0)
#define PG8_LDA(dst, b, h) do { _Pragma("unroll") for (int m = 0; m < 4; ++m) _Pragma("unroll") for (int k = 0; k < 2; ++k) dst[m][k] = *(const PG8_LAS bf16x8*)(lds + PG8_SA(b, h) + aoff + m * 2048 + k * 1024); } while (0)
#define PG8_LDB(dst, b, h) do { _Pragma("unroll") for (int n = 0; n < 2; ++n) _Pragma("unroll") for (int k = 0; k < 2; ++k) dst[n][k] = *(const PG8_LAS bf16x8*)(lds + PG8_SB(b, h) + boff + n * 2048 + k * 1024); } while (0)
#define PG8_MMA(ai, bj, At, Bt) do { __builtin_amdgcn_s_setprio(1); _Pragma("unroll") for (int m = 0; m < 4; ++m) _Pragma("unroll") for (int n = 0; n < 2; ++n) _Pragma("unroll") for (int k = 0; k < 2; ++k) \
        acc[ai][bj][m][n] = __builtin_amdgcn_mfma_f32_16x16x32_bf16(Bt[n][k], At[m][k], acc[ai][bj][m][n], 0, 0, 0); __builtin_amdgcn_s_setprio(0); } while (0)
#define PG8_WAIT_V(n) asm volatile("s_waitcnt vmcnt(" #n ")" ::: "memory")
#define PG8_WAIT_L(n) asm volatile("s_waitcnt lgkmcnt(" #n ")" ::: "memory")
#define PG8_BAR __builtin_amdgcn_s_barrier()
#define PG8_SCHED __builtin_amdgcn_sched_barrier(0)
    Unit cur, nxt; int ui = 0;
    if (!S.next(0, cur)) return;
    f32x4 acc[2][2][4][2];
#pragma unroll
    for (int a = 0; a < 2; ++a)
#pragma unroll
        for (int b = 0; b < 2; ++b)
#pragma unroll
            for (int m = 0; m < 4; ++m)
#pragma unroll
                for (int n = 0; n < 2; ++n) acc[a][b][m][n] = (f32x4){0.f, 0.f, 0.f, 0.f};
    bf16x8 At[4][2], B0[2][2], B1[2][2];
    const char* cA = (const char*)g.A + (size_t)cur.pm * tstep; const char* cB = (const char*)g.Bt + (size_t)cur.pn * tstep;
    S.a_ready(cur);
    if constexpr (SP2) {
        PG8_STAGE(PG8_SB(0, 0), cB, voffB); PG8_STAGE(PG8_SB(0, 1), cB + hstep, voffB); PG8_STAGE(PG8_SA(0, 0), cA, voffA); PG8_STAGE(PG8_SA(0, 1), cA + hstep, voffA);
        if (wr == 1) PG8_BAR;
        PG8_WAIT_V(2); PG8_BAR;
        PG8_STAGE(PG8_SB(1, 0), cB + kstep, voffB); PG8_STAGE(PG8_SA(1, 0), cA + kstep, voffA); PG8_STAGE(PG8_SB(1, 1), cB + hstep + kstep, voffB);
        PG8_WAIT_V(6); PG8_BAR;
    } else {
        PG8_STAGE(PG8_SB(0, 0), cB, voffB); PG8_STAGE(PG8_SA(0, 0), cA, voffA); PG8_STAGE(PG8_SB(0, 1), cB + hstep, voffB); PG8_STAGE(PG8_SA(0, 1), cA + hstep, voffA);
        if (wr == 1) PG8_BAR;
        PG8_WAIT_V(4); PG8_BAR;
        PG8_STAGE(PG8_SB(1, 0), cB + kstep, voffB); PG8_STAGE(PG8_SA(1, 0), cA + kstep, voffA); PG8_STAGE(PG8_SB(1, 1), cB + hstep + kstep, voffB);
        PG8_WAIT_V(6); PG8_BAR;
    }
    for (;;) {
        const bool has_next = S.next(ui + 1, nxt);
        const char* nA = has_next ? (const char*)g.A + (size_t)nxt.pm * tstep : cA; const char* nB = has_next ? (const char*)g.Bt + (size_t)nxt.pn * tstep : cB;
        for (int t = 0; t < nt; t += 2) {
            const bool last = (t == nt - 2);
            const char* a1 = cA + (size_t)(t + 1) * kstep;
            const char* a2 = last ? nA : cA + (size_t)(t + 2) * kstep; const char* b2 = last ? nB : cB + (size_t)(t + 2) * kstep;
            const char* a3 = a2 + kstep; const char* b3 = b2 + kstep;
            if (last && has_next) S.a_ready(nxt);
            if constexpr (SP2) {
            PG8_LDB(B0, 0, 0); PG8_LDB(B1, 0, 1); PG8_SCHED; PG8_LDA(At, 0, 0); PG8_STAGE(PG8_SA(1, 1), a1 + hstep, voffA);
            PG8_WAIT_V(8); PG8_WAIT_L(0); PG8_BAR; PG8_MMA(0, 0, At, B0); PG8_MMA(0, 1, At, B1); PG8_BAR; PG8_SCHED;
            PG8_LDA(At, 0, 1); PG8_STAGE(PG8_SB(0, 0), b2, voffB); PG8_STAGE(PG8_SB(0, 1), b2 + hstep, voffB); PG8_STAGE(PG8_SA(0, 0), a2, voffA);
            PG8_WAIT_V(8); PG8_WAIT_L(0); PG8_BAR; PG8_MMA(1, 0, At, B0); PG8_MMA(1, 1, At, B1); PG8_BAR; PG8_SCHED;
            PG8_LDB(B0, 1, 0); PG8_LDB(B1, 1, 1); PG8_SCHED; PG8_LDA(At, 1, 0); PG8_STAGE(PG8_SA(0, 1), a2 + hstep, voffA);
            PG8_WAIT_V(8); PG8_WAIT_L(0); PG8_BAR; PG8_MMA(0, 0, At, B0); PG8_MMA(0, 1, At, B1); PG8_BAR; PG8_SCHED;
            PG8_LDA(At, 1, 1); PG8_STAGE(PG8_SB(1, 0), b3, voffB); PG8_STAGE(PG8_SB(1, 1), b3 + hstep, voffB); PG8_STAGE(PG8_SA(1, 0), a3, voffA);
            PG8_WAIT_V(8); PG8_WAIT_L(0); PG8_BAR; PG8_MMA(1, 0, At, B0); PG8_MMA(1, 1, At, B1); PG8_BAR; PG8_SCHED;
            } else {
            PG8_LDB(B0, 0, 0); PG8_SCHED; PG8_LDA(At, 0, 0); PG8_STAGE(PG8_SA(1, 1), a1 + hstep, voffA);
            PG8_WAIT_L(8); PG8_BAR; PG8_WAIT_L(0); PG8_MMA(0, 0, At, B0); PG8_BAR; PG8_SCHED;
            PG8_LDB(B1, 0, 1); PG8_STAGE(PG8_SB(0, 0), b2, voffB);
            PG8_BAR; PG8_WAIT_L(0); PG8_MMA(0, 1, At, B1); PG8_BAR;
            PG8_LDA(At, 0, 1); PG8_STAGE(PG8_SA(0, 0), a2, voffA);
            PG8_BAR; PG8_WAIT_L(0); PG8_MMA(1, 0, At, B0); PG8_BAR; PG8_SCHED;
            PG8_STAGE(PG8_SB(0, 1), b2 + hstep, voffB);
            PG8_WAIT_V(6); PG8_BAR; PG8_MMA(1, 1, At, B1); PG8_BAR;
            PG8_LDB(B0, 1, 0); PG8_SCHED; PG8_LDA(At, 1, 0); PG8_STAGE(PG8_SA(0, 1), a2 + hstep, voffA);
            PG8_WAIT_L(8); PG8_BAR; PG8_WAIT_L(0); PG8_MMA(0, 0, At, B0); PG8_BAR; PG8_SCHED;
            PG8_LDB(B1, 1, 1); PG8_STAGE(PG8_SB(1, 0), b3, voffB);
            PG8_BAR; PG8_WAIT_L(0); PG8_MMA(0, 1, At, B1); PG8_BAR;
            PG8_LDA(At, 1, 1); PG8_STAGE(PG8_SA(1, 0), a3, voffA);
            PG8_BAR; PG8_WAIT_L(0); PG8_MMA(1, 0, At, B0); PG8_BAR; PG8_SCHED;
            PG8_STAGE(PG8_SB(1, 1), b3 + hstep, voffB);
            PG8_WAIT_V(6); PG8_BAR; PG8_MMA(1, 1, At, B1); PG8_BAR;
            }
        }
        if constexpr (ALIGN_EPI) { if (wr == 0) PG8_BAR; }
        if constexpr (!Epi::AFTER_DRAIN) { E(acc, cur, wr, wc, fr, fq); S.done(cur); }
        if (!has_next) break;
#pragma unroll
        for (int a = 0; a < 2; ++a)
#pragma unroll
            for (int b = 0; b < 2; ++b)
#pragma unroll
                for (int m = 0; m < 4; ++m)
#pragma unroll
                    for (int n = 0; n < 2; ++n) acc[a][b][m][n] = (f32x4){0.f, 0.f, 0.f, 0.f};
        cur = nxt; cA = nA; cB = nB; ++ui;
        if constexpr (ALIGN_EPI) { if (wr == 1) PG8_BAR; }
    }
    PG8_WAIT_V(0);
    if constexpr (!ALIGN_EPI) { if (wr == 0) PG8_BAR; }
    PG8_BAR;
    if constexpr (Epi::AFTER_DRAIN) { E.fused(acc, cur, wr, wc, fr, fq, lds, wid, lane); S.done(cur); }
#undef PG8_SA
#undef PG8_SB
#undef PG8_STAGE
#undef PG8_LDA
#undef PG8_LDB
#undef PG8_MMA
#undef PG8_WAIT_V
#undef PG8_WAIT_L
#undef PG8_BAR
#undef PG8_SCHED
}
}

constexpr int NB = 2, TL = 4096, DM = 2048, CL = 256, NIN = 7872, NINP = 7936;
constexpr int ML = NB * TL, MC = NB * CL, MT = ML + MC;
constexpr int KEYS = CL + TL;
constexpr int NSTEP = KEYS;
constexpr int RECB = 896;
constexpr int A_U = 0, A_V = 512, A_G = 1024, B_Q = 1536, B_K = 2048, B_V = 2560, B_G = 3072, C_R = 3584, C_K = 4096, C_V = 4608, C_LF = 5120, C_LB = 5216, C_G = 5312,
              D_B = 5824, D_C = 6336, D_X = 6848, D_G = 7360;
constexpr float EPS = 1e-6f, GN_EPS = 64e-5f;
constexpr float QSCALE = 0.125f * 1.4426950408889634f;

constexpr size_t MiB = 1u << 20;
constexpr size_t WS_CTL = 0, CTL_ZERO_BYTES = 1 * MiB;
constexpr size_t CTL_MODACC = 65536;
constexpr size_t WS_ROPE = 1 * MiB - 16384;
constexpr size_t WS_WIN = 1 * MiB;
constexpr size_t WS_WOUT = 63 * MiB;
constexpr size_t WS_XN = 79 * MiB;
constexpr size_t WS_P = 113 * MiB;
constexpr size_t WS_QR = 245 * MiB;
constexpr size_t WS_QC = 253 * MiB;
constexpr size_t WS_KR = 254 * MiB;
constexpr size_t WS_VT = 263 * MiB;
constexpr size_t WS_OPS = 272 * MiB;
constexpr size_t WS_Y = 391 * MiB;
constexpr size_t WS_BON = 425 * MiB;
constexpr size_t WS_OC = 442 * MiB;
constexpr size_t WS_END = 476 * MiB;
static_assert(WS_WIN + (size_t)2 * NINP * DM * 2 <= WS_WOUT && WS_WOUT + (size_t)2 * DM * DM * 2 <= WS_XN && WS_XN + (size_t)MT * DM * 2 <= WS_P && WS_P + (size_t)MT * NINP * 2 <= WS_QR, "ws map 1");
static_assert(WS_QR + (size_t)16 * TL * 64 * 2 <= WS_QC && WS_QC + (size_t)16 * CL * 64 * 2 <= WS_KR && WS_KR + (size_t)16 * KEYS * 64 * 2 <= WS_VT && WS_VT + (size_t)8 * 128 * KEYS * 2 <= WS_OPS, "ws map 2");
static_assert(WS_OPS + (size_t)32 * NSTEP * RECB <= WS_Y && WS_Y + (size_t)2 * MT * 512 * 4 <= WS_BON && WS_BON + (size_t)MT * 512 * 4 <= WS_OC && WS_OC + (size_t)MT * DM * 2 <= WS_END, "ws map 3");
static_assert((size_t)MT * 1024 * 4 <= WS_P - WS_XN && (size_t)MT * DM * 4 <= WS_QR - WS_P, "overlays");

constexpr int LDS_BYTES = 147456;
constexpr int NWAVES = 8, NTHREADS = 512;

typedef unsigned short bf16;
typedef short bf16x8 __attribute__((ext_vector_type(8)));
typedef float f32x4 __attribute__((ext_vector_type(4)));
typedef float f32x2 __attribute__((ext_vector_type(2)));
typedef float f32x16 __attribute__((ext_vector_type(16)));
typedef unsigned u32x4 __attribute__((ext_vector_type(4)));
typedef unsigned u32x2 __attribute__((ext_vector_type(2)));
typedef __bf16 bf16x2_t __attribute__((ext_vector_type(2)));
#define LAS __attribute__((address_space(3)))

struct Params { const float* in[28]; float* out; unsigned char* ws; };

struct Ctx {
    const Params* prm; float* out; unsigned char* ws;
    LAS unsigned char* lds;
    int tid, lane, wave, bx, G, gw, NGW;
};

__device__ __forceinline__ unsigned cvtpk(float lo, float hi) { f32x2 v = {lo, hi}; bf16x2_t b = __builtin_convertvector(v, bf16x2_t); return __builtin_bit_cast(unsigned, b); }
__device__ __forceinline__ float bflo(unsigned u) { return __builtin_bit_cast(float, u << 16); }
__device__ __forceinline__ float bfhi(unsigned u) { return __builtin_bit_cast(float, u & 0xffff0000u); }
__device__ __forceinline__ void unpack8(const u32x4 v, float* f) { f[0] = bflo(v.x); f[1] = bfhi(v.x); f[2] = bflo(v.y); f[3] = bfhi(v.y); f[4] = bflo(v.z); f[5] = bfhi(v.z); f[6] = bflo(v.w); f[7] = bfhi(v.w); }
__device__ __forceinline__ u32x4 pack8(const float* f) { u32x4 r; r.x = cvtpk(f[0], f[1]); r.y = cvtpk(f[2], f[3]); r.z = cvtpk(f[4], f[5]); r.w = cvtpk(f[6], f[7]); return r; }
__device__ __forceinline__ float silu_f(float x) { return x / (1.f + __expf(-x)); }
__device__ __forceinline__ float wave_sum(float v) {
#pragma unroll
    for (int o = 1; o < 64; o <<= 1) v += __shfl_xor(v, o);
    return v;
}
template <int CTRL> __device__ __forceinline__ float dpp_f(float v) { return __builtin_bit_cast(float, __builtin_amdgcn_update_dpp(0, __builtin_bit_cast(int, v), CTRL, 0xf, 0xf, true)); }
__device__ __forceinline__ float red4(float v) { v += dpp_f<0xB1>(v); v += dpp_f<0x4E>(v); return v; }
__device__ __forceinline__ float red8(float v) { v = red4(v); v += dpp_f<0x141>(v); return v; }
__device__ __forceinline__ float red16(float v) { v = red8(v); v += dpp_f<0x140>(v); return v; }
#define LAUNDER(F) do { asm volatile("" : "+v"(F.tid), "+v"(F.lane)); asm volatile("" : "+s"(F.wave), "+s"(F.bx), "+s"(F.gw)); } while (0)
#define LDS_WAIT() asm volatile("s_waitcnt lgkmcnt(0)" ::: "memory")
#define WG_BAR() do { asm volatile("s_waitcnt lgkmcnt(0)" ::: "memory"); __builtin_amdgcn_s_barrier(); asm volatile("" ::: "memory"); } while (0)

__device__ __forceinline__ void p0_transpose_item(const float* W, int K, int N, bf16* WT, LAS float* scr, int item, int lane) {
    const int nblk = N / 32, kb = item / nblk, nb = item % nblk, k0 = 64 * kb, n0 = 32 * nb;
#pragma unroll 8
    for (int i = 0; i < 32; ++i) { const int kk = 2 * i + (lane >> 5); scr[kk * 33 + (lane & 31)] = W[(size_t)(k0 + kk) * N + n0 + (lane & 31)]; }
    LDS_WAIT();
    const int c = lane & 7;
#pragma unroll
    for (int j = 0; j < 4; ++j) { const int n = (lane >> 3) + 8 * j; const LAS float* s = scr + (8 * c) * 33 + n;
        u32x4 o; o.x = cvtpk(s[0 * 33], s[1 * 33]); o.y = cvtpk(s[2 * 33], s[3 * 33]); o.z = cvtpk(s[4 * 33], s[5 * 33]); o.w = cvtpk(s[6 * 33], s[7 * 33]);
        *(u32x4*)(WT + (size_t)(n0 + n) * K + k0 + 8 * c) = o; }
    LDS_WAIT();
}

__device__ __forceinline__ void phase0(Ctx& F) {
    LAS float* scr = (LAS float*)(F.lds + F.wave * 16384);
    const float* w_in = F.prm->in[8]; const float* w_out = F.prm->in[9];
    bf16* WIN = (bf16*)(F.ws + WS_WIN); bf16* WOUT = (bf16*)(F.ws + WS_WOUT);
    constexpr int I_IN = (DM / 64) * (NIN / 32), I_OUT = (DM / 64) * (DM / 32);
    constexpr int NITEMS = 2 * (I_IN + I_OUT);
    for (int it = F.gw; it < NITEMS; it += F.NGW) {
        int r = it;
        if (r < 2 * I_IN) { const int l = r / I_IN; r -= l * I_IN; p0_transpose_item(w_in + (size_t)l * DM * NIN, DM, NIN, WIN + (size_t)l * NINP * DM, scr, r, F.lane); }
        else { r -= 2 * I_IN; const int l = r / I_OUT; r -= l * I_OUT; p0_transpose_item(w_out + (size_t)l * DM * DM, DM, DM, WOUT + (size_t)l * DM * DM, scr, r, F.lane); }
    }
    const float* cvec = F.prm->in[1]; const float* cctx = F.prm->in[3]; const float* w_mod = F.prm->in[4];
    float* MODACC = (float*)(F.ws + WS_CTL + CTL_MODACC);
    constexpr int NMOD = 2 * 32 * 24;
    for (int it = F.gw; it < NMOD; it += F.NGW) {
        const int l = it / (32 * 24), rem = it % (32 * 24), ks = rem / 24, cb = rem % 24, k0 = ks * 64, n0 = cb * 256 + 4 * F.lane;
        scr[F.lane] = silu_f(cvec[k0 + F.lane]); scr[64 + F.lane] = silu_f(cvec[DM + k0 + F.lane]); scr[128 + F.lane] = silu_f(cctx[k0 + F.lane]);
        LDS_WAIT();
        f32x4 a0 = {0.f, 0.f, 0.f, 0.f}, a1 = a0, a2 = a0;
        const float* wp = w_mod + ((size_t)l * DM + k0) * 6144 + n0;
#pragma unroll 8
        for (int k = 0; k < 64; ++k) { const f32x4 w = *(const f32x4*)(wp + (size_t)k * 6144); a0 += w * scr[k]; a1 += w * scr[64 + k]; a2 += w * scr[128 + k]; }
        float* ma = MODACC + (size_t)(l * 3) * 6144 + n0;
#pragma unroll
        for (int e = 0; e < 4; ++e) { atomicAdd(ma + e, a0[e]); atomicAdd(ma + 6144 + e, a1[e]); atomicAdd(ma + 2 * 6144 + e, a2[e]); }
        LDS_WAIT();
    }
    if (F.bx == 0) {
        float* rope = (float*)(F.ws + WS_ROPE);
        for (int i = F.tid; i < 1024; i += NTHREADS) { const int pos = i >> 4, f = i & 15; const float inv = powf(10000.f, -(float)(2 * f) / 32.f); const float ang = (float)pos * inv;
            rope[i] = cosf(ang); rope[1024 + i] = sinf(ang); }
    }
}

__device__ __forceinline__ void ld_row(const float* p, int lane, f32x4* v) {
#pragma unroll
    for (int j = 0; j < 8; ++j) v[j] = *(const f32x4*)(p + 4 * lane + 256 * j);
}
__device__ __forceinline__ float sumsq8(const f32x4* v) { float s = 0.f;
#pragma unroll
    for (int j = 0; j < 8; ++j) s += (v[j].x * v[j].x + v[j].y * v[j].y) + (v[j].z * v[j].z + v[j].w * v[j].w);
    return s; }
__device__ __forceinline__ void ld_mod(const Ctx& F, int l, int r, int part, int lane, f32x4* v) {
    const float* ma = (const float*)(F.ws + WS_CTL + CTL_MODACC) + (size_t)(l * 3 + r) * 6144 + part * DM; const float* bm = F.prm->in[5] + (size_t)l * 6144 + part * DM;
#pragma unroll
    for (int j = 0; j < 8; ++j) v[j] = *(const f32x4*)(ma + 4 * lane + 256 * j) + *(const f32x4*)(bm + 4 * lane + 256 * j);
}
__device__ __forceinline__ void phase1(Ctx& F, int l) {
    const float* x = F.prm->in[0]; const float* ctx = F.prm->in[2]; const float* g_pre = F.prm->in[6] + (size_t)l * DM; const float* g_post0 = F.prm->in[7];
    const float* O = (const float*)(F.ws + WS_P); bf16* XN = (bf16*)(F.ws + WS_XN);
    for (int row = F.gw; row < MT; row += F.NGW) {
        const bool lat = row < ML; const int r = lat ? (row / TL) : 2;
        const float* src = lat ? x + (size_t)row * DM : ctx + (size_t)(row - ML) * DM;
        f32x4 xv[8]; ld_row(src, F.lane, xv);
        if (l == 1) {
            f32x4 ov[8], gt[8], gp[8]; ld_row(O + (size_t)row * DM, F.lane, ov); ld_mod(F, 0, r, 2, F.lane, gt); ld_row(g_post0, F.lane, gp);
            const float rs = 1.f / sqrtf(wave_sum(sumsq8(ov)) * (1.f / DM) + EPS);
#pragma unroll
            for (int j = 0; j < 8; ++j) xv[j] = xv[j] + gt[j] * (ov[j] * rs * gp[j]);
            if (lat) {
#pragma unroll
                for (int j = 0; j < 8; ++j) *(f32x4*)(F.out + (size_t)row * DM + 4 * F.lane + 256 * j) = xv[j];
            }
        }
        const float rs = 1.f / sqrtf(wave_sum(sumsq8(xv)) * (1.f / DM) + EPS);
        f32x4 sh[8], sc[8], g[8]; ld_mod(F, l, r, 0, F.lane, sh); ld_mod(F, l, r, 1, F.lane, sc); ld_row(g_pre, F.lane, g);
#pragma unroll
        for (int j = 0; j < 8; ++j) { const f32x4 h = (xv[j] * rs * g[j]) * (sc[j] + 1.f) + sh[j];
            u32x2 w; w.x = cvtpk(h.x, h.y); w.y = cvtpk(h.z, h.w); *(u32x2*)(XN + (size_t)row * DM + 4 * F.lane + 256 * j) = w; }
    }
}
__device__ __forceinline__ void phase6(Ctx& F) {
    const float* g_post1 = F.prm->in[7] + DM; const float* O = (const float*)(F.ws + WS_P);
    for (int row = F.gw; row < ML; row += F.NGW) {
        const int r = row / TL;
        f32x4 xv[8], ov[8], gt[8], gp[8]; ld_row(F.out + (size_t)row * DM, F.lane, xv); ld_row(O + (size_t)row * DM, F.lane, ov); ld_mod(F, 1, r, 2, F.lane, gt); ld_row(g_post1, F.lane, gp);
        const float rs = 1.f / sqrtf(wave_sum(sumsq8(ov)) * (1.f / DM) + EPS);
#pragma unroll
        for (int j = 0; j < 8; ++j) *(f32x4*)(F.out + (size_t)row * DM + 4 * F.lane + 256 * j) = xv[j] + gt[j] * (ov[j] * rs * gp[j]);
    }
}

__device__ __forceinline__ void sgu_item(Ctx& F, int l, int cb, int h) {
    const bf16* P = (const bf16*)(F.ws + WS_P); bf16* OC = (bf16*)(F.ws + WS_OC);
    const float* w_s = F.prm->in[10] + (size_t)(l * 4 + h) * 128 * 128; const float* b_s = F.prm->in[11] + (size_t)(l * 4 + h) * 128;
    const int row0 = cb < 64 ? (cb >> 5) * TL + (cb & 31) * 128 : ML + ((cb - 64) >> 1) * CL + ((cb - 64) & 1) * 128;
    LAS float* VN = (LAS float*)F.lds;
    LAS float* WT = (LAS float*)(F.lds + 65536);
    {
        const int row = F.tid >> 2, qt = F.tid & 3; const bf16* src = P + (size_t)(row0 + row) * NINP + A_V + h * 128 + qt * 32;
        float v[32];
#pragma unroll
        for (int i = 0; i < 4; ++i) unpack8(*(const u32x4*)(src + 8 * i), v + 8 * i);
        float s = 0.f;
#pragma unroll
        for (int i = 0; i < 32; ++i) s += v[i];
        const float mean = red4(s) * (1.f / 128.f); float q = 0.f;
#pragma unroll
        for (int i = 0; i < 32; ++i) { v[i] -= mean; q += v[i] * v[i]; }
        const float rstd = 1.f / sqrtf(red4(q) * (1.f / 128.f) + EPS);
#pragma unroll
        for (int i = 0; i < 8; ++i) *(LAS f32x4*)(VN + row * 128 + qt * 32 + 4 * i) = (f32x4){v[4 * i] * rstd, v[4 * i + 1] * rstd, v[4 * i + 2] * rstd, v[4 * i + 3] * rstd};
    }
    for (int idx = F.tid; idx < 4096; idx += NTHREADS) { const int p = idx >> 5, q4 = idx & 31; const f32x4 w = *(const f32x4*)(w_s + p * 128 + 4 * q4);
        WT[(4 * q4 + 0) * 128 + p] = w.x; WT[(4 * q4 + 1) * 128 + p] = w.y; WT[(4 * q4 + 2) * 128 + p] = w.z; WT[(4 * q4 + 3) * 128 + p] = w.w; }
    WG_BAR();
    const int pg = F.tid >> 5, dg = F.tid & 31;
    f32x4 acc[8];
#pragma unroll
    for (int i = 0; i < 8; ++i) acc[i] = (f32x4){0.f, 0.f, 0.f, 0.f};
#pragma unroll 4
    for (int q = 0; q < 128; ++q) {
        const f32x4 w0 = *(const LAS f32x4*)(WT + q * 128 + 8 * pg), w1 = *(const LAS f32x4*)(WT + q * 128 + 8 * pg + 4), vv = *(const LAS f32x4*)(VN + q * 128 + 4 * dg);
        acc[0] += vv * w0.x; acc[1] += vv * w0.y; acc[2] += vv * w0.z; acc[3] += vv * w0.w; acc[4] += vv * w1.x; acc[5] += vv * w1.y; acc[6] += vv * w1.z; acc[7] += vv * w1.w;
    }
#pragma unroll
    for (int i = 0; i < 8; ++i) { const int p = 8 * pg + i; const float bs = b_s[p]; const bf16* pr = P + (size_t)(row0 + p) * NINP + h * 128 + 4 * dg;
        const u32x2 uu = *(const u32x2*)(pr + A_U), gg = *(const u32x2*)(pr + A_G);
        const float o0 = bflo(uu.x) * (acc[i].x + bs) * silu_f(bflo(gg.x)), o1 = bfhi(uu.x) * (acc[i].y + bs) * silu_f(bfhi(gg.x));
        const float o2 = bflo(uu.y) * (acc[i].z + bs) * silu_f(bflo(gg.y)), o3 = bfhi(uu.y) * (acc[i].w + bs) * silu_f(bfhi(gg.y));
        u32x2 w; w.x = cvtpk(o0, o1); w.y = cvtpk(o2, o3); *(u32x2*)(OC + (size_t)(row0 + p) * DM + h * 128 + 4 * dg) = w; }
    WG_BAR();
}

__device__ __forceinline__ void conv_item(Ctx& F, int l, int item) {
    const bf16* P = (const bf16*)(F.ws + WS_P); bf16* OC = (bf16*)(F.ws + WS_OC); const float* cw = F.prm->in[27] + (size_t)l * 3 * 512;
    const int row = item * 16 + (F.tid >> 5), c0 = (F.tid & 31) * 16;
    int t, tlen; if (row < ML) { t = row & (TL - 1); tlen = TL; } else { t = (row - ML) & (CL - 1); tlen = CL; }
    const bf16* pr = P + (size_t)row * NINP;
    float z0[16], z1[16], z2[16], tmp[16];
#pragma unroll
    for (int i = 0; i < 2; ++i) {
        float a[8], b[8];
        unpack8(*(const u32x4*)(pr + D_C + c0 + 8 * i), a); unpack8(*(const u32x4*)(pr + D_X + c0 + 8 * i), b);
#pragma unroll
        for (int e = 0; e < 8; ++e) z1[8 * i + e] = a[e] * b[e];
        if (t > 0) { unpack8(*(const u32x4*)(pr - NINP + D_C + c0 + 8 * i), a); unpack8(*(const u32x4*)(pr - NINP + D_X + c0 + 8 * i), b);
#pragma unroll
            for (int e = 0; e < 8; ++e) z0[8 * i + e] = a[e] * b[e]; }
        else {
#pragma unroll
            for (int e = 0; e < 8; ++e) z0[8 * i + e] = 0.f; }
        if (t < tlen - 1) { unpack8(*(const u32x4*)(pr + NINP + D_C + c0 + 8 * i), a); unpack8(*(const u32x4*)(pr + NINP + D_X + c0 + 8 * i), b);
#pragma unroll
            for (int e = 0; e < 8; ++e) z2[8 * i + e] = a[e] * b[e]; }
        else {
#pragma unroll
            for (int e = 0; e < 8; ++e) z2[8 * i + e] = 0.f; }
    }
#pragma unroll
    for (int i = 0; i < 2; ++i) {
        float bg[8], gg[8]; unpack8(*(const u32x4*)(pr + D_B + c0 + 8 * i), bg); unpack8(*(const u32x4*)(pr + D_G + c0 + 8 * i), gg);
#pragma unroll
        for (int e = 0; e < 8; ++e) { const int c = c0 + 8 * i + e; const float y = cw[c] * z0[8 * i + e] + cw[512 + c] * z1[8 * i + e] + cw[1024 + c] * z2[8 * i + e]; tmp[e] = bg[e] * y * silu_f(gg[e]); }
        *(u32x4*)(OC + (size_t)row * DM + 1536 + c0 + 8 * i) = pack8(tmp);
    }
}

__device__ __forceinline__ void attnprep_item(Ctx& F, int l, int rb, int h) {
    const bf16* P = (const bf16*)(F.ws + WS_P); const float* rope = (const float*)(F.ws + WS_ROPE);
    bf16* QR = (bf16*)(F.ws + WS_QR); bf16* QC = (bf16*)(F.ws + WS_QC); bf16* KR = (bf16*)(F.ws + WS_KR); bf16* VT = (bf16*)(F.ws + WS_VT);
    const bool lat = rb < 128; const int b = lat ? (rb >> 6) : ((rb - 128) >> 2), t0 = lat ? (rb & 63) * 64 : ((rb - 128) & 3) * 64;
    const int row0 = lat ? b * TL + t0 : ML + b * CL + t0;
    {
        const int tk = F.tid >> 3, sub = F.tid & 7, isk = sub >> 2, hq = sub & 3, m = hq >> 1, half = hq & 1, t = t0 + tk;
        const bf16* src = P + (size_t)(row0 + tk) * NINP + (isk ? B_K : B_Q) + h * 128 + 32 * hq;
        float xx[32], oo[32];
#pragma unroll
        for (int i = 0; i < 4; ++i) unpack8(*(const u32x4*)(src + 8 * i), xx + 8 * i);
        if (lat) { const int pos = half ? (t & 63) : (t >> 6); const float* cs = rope + pos * 16; const float* sn = rope + 1024 + pos * 16;
#pragma unroll
            for (int i = 0; i < 16; ++i) { const float c = cs[i], s = sn[i]; oo[i] = xx[i] * c - xx[i + 16] * s; oo[i + 16] = xx[i + 16] * c + xx[i] * s; } }
        else {
#pragma unroll
            for (int i = 0; i < 32; ++i) oo[i] = xx[i]; }
        if (!isk) {
#pragma unroll
            for (int i = 0; i < 32; ++i) oo[i] *= QSCALE; }
        const int bhm = (b * 4 + h) * 2 + m;
        bf16* dst = isk ? KR + ((size_t)bhm * KEYS + (lat ? CL + t : t)) * 64 + 32 * half : (lat ? QR + ((size_t)bhm * TL + t) * 64 + 32 * half : QC + ((size_t)bhm * CL + t) * 64 + 32 * half);
        if (isk || lat || l == 0) {
#pragma unroll
            for (int i = 0; i < 4; ++i) *(u32x4*)(dst + 8 * i) = pack8(oo + 8 * i); }
    }
    LAS unsigned char* VL = F.lds;
#pragma unroll
    for (int pass = 0; pass < 2; ++pass) { const int idx = F.tid + 512 * pass, key = idx >> 4, c = idx & 15;
        *(LAS u32x4*)(VL + key * 272 + 16 * c) = *(const u32x4*)(P + (size_t)(row0 + key) * NINP + B_V + h * 128 + 8 * c); }
    WG_BAR();
    const int keybase = lat ? CL + t0 : t0;
#pragma unroll
    for (int pass = 0; pass < 2; ++pass) { const int idx = F.tid + 512 * pass, dv = idx >> 3, kc = idx & 7; unsigned short e[8];
#pragma unroll
        for (int i = 0; i < 8; ++i) e[i] = *(const LAS unsigned short*)(VL + (8 * kc + i) * 272 + 2 * dv);
        u32x4 o; o.x = e[0] | ((unsigned)e[1] << 16); o.y = e[2] | ((unsigned)e[3] << 16); o.z = e[4] | ((unsigned)e[5] << 16); o.w = e[6] | ((unsigned)e[7] << 16);
        *(u32x4*)(VT + ((size_t)(b * 4 + h) * 128 + dv) * KEYS + keybase + 8 * kc) = o; }
    WG_BAR();
}

__device__ __forceinline__ float softplus_f(float x) { return fmaxf(x, 0.f) + log1pf(__expf(-fabsf(x))); }
__device__ __forceinline__ void rwkvprep_item(Ctx& F, int l, int tb, int h) {
    const bf16* P = (const bf16*)(F.ws + WS_P); unsigned char* OPS = F.ws + WS_OPS; float* BON = (float*)(F.ws + WS_BON);
    const bool lat = tb < 128; const int b = lat ? (tb >> 6) : ((tb - 128) >> 2), t0 = lat ? (tb & 63) * 64 : ((tb - 128) & 3) * 64, tlen = lat ? TL : CL;
    const int row0 = lat ? b * TL + t0 : ML + b * CL + t0;
    LAS float* W2S = (LAS float*)F.lds;
    LAS float* A2S = (LAS float*)(F.lds + 16384);
    LAS float* TW = (LAS float*)(F.lds + 24576);
    LAS float* ZA = (LAS float*)(F.lds + 24576 + 16640);
    const int tk = F.tid >> 3, sub = F.tid & 7, t = t0 + tk, c0 = 8 * sub, gc0 = h * 64 + c0;
    const bf16* pr = P + (size_t)(row0 + tk) * NINP;
    float bon[8];
#pragma unroll
    for (int e = 0; e < 8; ++e) bon[e] = 0.f;
    for (int dir = 0; dir < 2; ++dir) {
        const int pd = l * 2 + dir;
        const float* mu = F.prm->in[17] + (size_t)pd * 1632; const float* w0 = F.prm->in[18] + (size_t)pd * 512; const float* w2 = F.prm->in[19] + (size_t)pd * 64 * 512;
        const float* a0 = F.prm->in[20] + (size_t)pd * 512; const float* a2 = F.prm->in[21] + (size_t)pd * 32 * 512; const float* k_k = F.prm->in[22] + (size_t)pd * 512;
        const float* k_a = F.prm->in[23] + (size_t)pd * 512; const float* r_k = F.prm->in[24] + (size_t)pd * 512;
        const bool hasprev = dir == 0 ? (t > 0) : (t < tlen - 1);
        const bf16* pp = dir == 0 ? pr - NINP : pr + NINP;
        const int CLX = dir == 0 ? C_LF : C_LB;
        {
            float f[8], pv[8];
            unpack8(*(const u32x4*)(pr + CLX + c0), f);
            if (hasprev) unpack8(*(const u32x4*)(pp + CLX + c0), pv); else {
#pragma unroll
                for (int e = 0; e < 8; ++e) pv[e] = 0.f; }
#pragma unroll
            for (int e = 0; e < 8; ++e) TW[tk * 65 + c0 + e] = tanhf(f[e] + (pv[e] - f[e]) * mu[1536 + c0 + e]);
            const u32x2 fa = *(const u32x2*)(pr + CLX + 64 + 4 * sub); u32x2 pa = {0u, 0u}; if (hasprev) pa = *(const u32x2*)(pp + CLX + 64 + 4 * sub);
            const float fz[4] = {bflo(fa.x), bfhi(fa.x), bflo(fa.y), bfhi(fa.y)}, pz[4] = {bflo(pa.x), bfhi(pa.x), bflo(pa.y), bfhi(pa.y)};
#pragma unroll
            for (int e = 0; e < 4; ++e) ZA[tk * 33 + 4 * sub + e] = fz[e] + (pz[e] - fz[e]) * mu[1600 + 4 * sub + e];
        }
#pragma unroll
        for (int i = 0; i < 2; ++i) { const int idx = F.tid + 512 * i, r = idx >> 4, c4 = idx & 15; *(LAS f32x4*)(W2S + r * 64 + 4 * c4) = *(const f32x4*)(w2 + (size_t)r * 512 + h * 64 + 4 * c4); }
        { const int r = F.tid >> 4, c4 = F.tid & 15; *(LAS f32x4*)(A2S + r * 64 + 4 * c4) = *(const f32x4*)(a2 + (size_t)r * 512 + h * 64 + 4 * c4); }
        WG_BAR();
        float wp[8], ap[8];
#pragma unroll
        for (int e = 0; e < 8; ++e) { wp[e] = w0[gc0 + e]; ap[e] = a0[gc0 + e]; }
#pragma unroll 4
        for (int i = 0; i < 64; ++i) { const float tw = TW[tk * 65 + i]; const f32x4 u0 = *(const LAS f32x4*)(W2S + i * 64 + c0), u1 = *(const LAS f32x4*)(W2S + i * 64 + c0 + 4);
            wp[0] += tw * u0.x; wp[1] += tw * u0.y; wp[2] += tw * u0.z; wp[3] += tw * u0.w; wp[4] += tw * u1.x; wp[5] += tw * u1.y; wp[6] += tw * u1.z; wp[7] += tw * u1.w; }
#pragma unroll 4
        for (int i = 0; i < 32; ++i) { const float za = ZA[tk * 33 + i]; const f32x4 u0 = *(const LAS f32x4*)(A2S + i * 64 + c0), u1 = *(const LAS f32x4*)(A2S + i * 64 + c0 + 4);
            ap[0] += za * u0.x; ap[1] += za * u0.y; ap[2] += za * u0.z; ap[3] += za * u0.w; ap[4] += za * u1.x; ap[5] += za * u1.y; ap[6] += za * u1.z; ap[7] += za * u1.w; }
        float fr[8], fk[8], fv[8], qr[8], qk[8], qv[8];
        unpack8(*(const u32x4*)(pr + C_R + gc0), fr); unpack8(*(const u32x4*)(pr + C_K + gc0), fk); unpack8(*(const u32x4*)(pr + C_V + gc0), fv);
        if (hasprev) { unpack8(*(const u32x4*)(pp + C_R + gc0), qr); unpack8(*(const u32x4*)(pp + C_K + gc0), qk); unpack8(*(const u32x4*)(pp + C_V + gc0), qv); }
        else {
#pragma unroll
            for (int e = 0; e < 8; ++e) { qr[e] = 0.f; qk[e] = 0.f; qv[e] = 0.f; } }
        float dec[8], nkk[8], bb[8], km[8], rr[8], vv[8]; float n2 = 0.f, bsum = 0.f;
#pragma unroll
        for (int e = 0; e < 8; ++e) {
            const int gc = gc0 + e;
            rr[e] = fr[e] + (qr[e] - fr[e]) * mu[gc]; const float kx = fk[e] + (qk[e] - fk[e]) * mu[512 + gc]; vv[e] = fv[e] + (qv[e] - fv[e]) * mu[1024 + gc];
            const float w = -softplus_f(-wp[e]) - 0.5f; dec[e] = __expf(-__expf(w));
            const float a = 1.f / (1.f + __expf(-ap[e]));
            const float kraw = kx * k_k[gc]; n2 += kraw * kraw; nkk[e] = kraw; bb[e] = a;
            km[e] = kx * (1.f + (a - 1.f) * k_a[gc]);
            bsum += rr[e] * km[e] * r_k[gc];
        }
        n2 = red8(n2); bsum = red8(bsum);
        const float inv = 1.f / fmaxf(sqrtf(n2), 1e-12f);
#pragma unroll
        for (int e = 0; e < 8; ++e) { const float kk = nkk[e] * inv; nkk[e] = -kk; bb[e] = kk * bb[e]; bon[e] += bsum * vv[e]; }
        const int step = dir == 0 ? (lat ? CL + t : t) : (lat ? CL + (TL - 1 - t) : (CL - 1 - t));
        unsigned char* rec = OPS + ((size_t)((dir * 2 + b) * 8 + h) * NSTEP + step) * RECB;
        *(f32x4*)(rec + 4 * c0) = (f32x4){dec[0], dec[1], dec[2], dec[3]}; *(f32x4*)(rec + 4 * c0 + 16) = (f32x4){dec[4], dec[5], dec[6], dec[7]};
        *(u32x4*)(rec + 256 + 0 * 128 + 2 * c0) = pack8(nkk); *(u32x4*)(rec + 256 + 1 * 128 + 2 * c0) = pack8(bb); *(u32x4*)(rec + 256 + 2 * 128 + 2 * c0) = pack8(km);
        *(u32x4*)(rec + 256 + 3 * 128 + 2 * c0) = pack8(rr); *(u32x4*)(rec + 256 + 4 * 128 + 2 * c0) = pack8(vv);
        WG_BAR();
    }
    float* bo = BON + (size_t)(row0 + tk) * 512 + gc0;
    *(f32x4*)bo = (f32x4){bon[0], bon[1], bon[2], bon[3]}; *(f32x4*)(bo + 4) = (f32x4){bon[4], bon[5], bon[6], bon[7]};
}

__device__ __forceinline__ void phase3a(Ctx& F, int l) {
    const int nsgu = (l == 0 ? 68 : 64) * 4, nrw = 136 * 8, nap = 136 * 4, ncv = (l == 0 ? MT : ML) / 16;
    const int total = nsgu + nrw + nap + ncv;
    for (int it = F.bx; it < total; it += F.G) {
        int r = it;
        if (r < nsgu) { sgu_item(F, l, r >> 2, r & 3); continue; } r -= nsgu;
        if (r < nrw) { rwkvprep_item(F, l, r >> 3, r & 7); continue; } r -= nrw;
        if (r < nap) { attnprep_item(F, l, r >> 2, r & 3); continue; } r -= nap;
        conv_item(F, l, r);
    }
}

struct ScanOps { f32x2 dec0, dec1, nk0, nk1, bb0, bb1, km0, km1, rr0, rr1; float vv; };
__device__ __forceinline__ void scan_role(Ctx& F) {
    const int scan = F.bx >> 2, quarter = F.bx & 3, dir = scan >> 4, b = (scan >> 3) & 1, h = scan & 7;
    const unsigned char* rec = F.ws + WS_OPS + (size_t)scan * NSTEP * RECB;
    float* Y = (float*)(F.ws + WS_Y) + (size_t)dir * MT * 512 + h * 64;
    constexpr int CH = 32, NCH = NSTEP / CH, CHB = CH * 1536, CHG = CH * RECB;
    const bool scanner = F.wave < 4;
    const int lt = F.tid - 256;
    u32x4 st[7];
    auto ld_chunk = [&](int c) {
#pragma unroll
        for (int k = 0; k < 7; ++k) st[k] = *(const u32x4*)(rec + (size_t)c * CHG + (size_t)(lt + 256 * k) * 16);
    };
    auto wr_chunk = [&](int c) {
        LAS unsigned char* buf = F.lds + (c & 1) * CHB;
#pragma unroll
        for (int k = 0; k < 7; ++k) { const int p = lt + 256 * k, s = p / 56, q = p % 56;
            if (q < 16) *(LAS u32x4*)(buf + s * 1536 + 16 * q) = st[k];
            else { float f[8]; unpack8(st[k], f); LAS float* d = (LAS float*)(buf + s * 1536 + 256 + 32 * (q - 16)); *(LAS f32x4*)d = (f32x4){f[0], f[1], f[2], f[3]}; *(LAS f32x4*)(d + 4) = (f32x4){f[4], f[5], f[6], f[7]}; } }
    };
    const int srow = quarter * 16 + (F.wave & 3) * 4 + (F.lane >> 4), jj = F.lane & 15;
    f32x2 Sa = {0.f, 0.f}, Sb = {0.f, 0.f};
    float yk = 0.f;
    if (!scanner) { ld_chunk(0); wr_chunk(0); ld_chunk(1); }
    WG_BAR();
#define SC_LOAD(o, s_) do { const LAS unsigned char* bs_ = lbase + (s_) * 1536; \
        const f32x4 t0_ = *(const LAS f32x4*)(bs_), t1_ = *(const LAS f32x4*)(bs_ + 256), t2_ = *(const LAS f32x4*)(bs_ + 512), t3_ = *(const LAS f32x4*)(bs_ + 768), t4_ = *(const LAS f32x4*)(bs_ + 1024); \
        o.vv = *(const LAS float*)(vbase + (s_) * 1536); \
        o.dec0 = (f32x2){t0_.x, t0_.y}; o.dec1 = (f32x2){t0_.z, t0_.w}; o.nk0 = (f32x2){t1_.x, t1_.y}; o.nk1 = (f32x2){t1_.z, t1_.w}; o.bb0 = (f32x2){t2_.x, t2_.y}; o.bb1 = (f32x2){t2_.z, t2_.w}; \
        o.km0 = (f32x2){t3_.x, t3_.y}; o.km1 = (f32x2){t3_.z, t3_.w}; o.rr0 = (f32x2){t4_.x, t4_.y}; o.rr1 = (f32x2){t4_.z, t4_.w}; } while (0)
#define SC_STEP(o, s_) do { \
        f32x2 p_ = Sa * o.nk0; p_ = Sb * o.nk1 + p_; \
        const f32x2 ua_ = Sa * o.dec0 + o.km0 * o.vv, ub_ = Sb * o.dec1 + o.km1 * o.vv; \
        const float sa_ = red16(p_.x + p_.y); \
        Sa = o.bb0 * sa_ + ua_; Sb = o.bb1 * sa_ + ub_; \
        f32x2 q_ = Sa * o.rr0; q_ = Sb * o.rr1 + q_; \
        const float y_ = red16(q_.x + q_.y); \
        yk = (jj == ((s_) & 15)) ? y_ : yk; } while (0)
    for (int c = 0; c < NCH; ++c) {
        if (scanner) {
            const LAS unsigned char* lbase = F.lds + (c & 1) * CHB + 16 * jj;
            const LAS unsigned char* vbase = F.lds + (c & 1) * CHB + 1280 + 4 * srow;
            const int i0 = c * CH;
            ScanOps A, B;
            SC_LOAD(A, 0);
#pragma unroll
            for (int s = 0; s < CH; s += 2) {
                SC_LOAD(B, s + 1);
                SC_STEP(A, s);
                if (s + 2 < CH) SC_LOAD(A, s + 2);
                SC_STEP(B, s + 1);
                if ((s & 15) == 14) {
                    const int i = i0 + (s & 16) + jj;
                    const int row = i < CL ? (ML + b * CL + (dir ? CL - 1 - i : i)) : (b * TL + (dir ? TL - 1 - (i - CL) : (i - CL)));
                    Y[(size_t)row * 512 + srow] = yk;
                }
            }
        } else {
            if (c + 1 < NCH) wr_chunk(c + 1);
            if (c + 2 < NCH) ld_chunk(c + 2);
        }
        WG_BAR();
    }
#undef SC_LOAD
#undef SC_STEP
}

__device__ __forceinline__ void attn_unit(Ctx& F, const bf16* Qp, const bf16* Kp, const bf16* Vtp, int nkt, float* Op) {
    constexpr int KB = 9216, TB = 27648;
    const int j = F.lane & 31, hh = F.lane >> 5;
    bf16x8 qf[4];
#pragma unroll
    for (int ks = 0; ks < 4; ++ks) qf[ks] = *(const bf16x8*)(Qp + (size_t)(F.wave * 32 + j) * 64 + ks * 16 + hh * 8);
    const int kkey = F.tid >> 3, kch = F.tid & 7;
    const bf16* ksrc = Kp + (size_t)kkey * 64 + kch * 8;
    const bf16* vsrc0 = Vtp + (size_t)(F.tid >> 3) * KEYS + kch * 8; const bf16* vsrc1 = vsrc0 + (size_t)64 * KEYS;
    const int kdst = kkey * 144 + kch * 16, vdst0 = KB + (F.tid >> 3) * 144 + kch * 16, vdst1 = vdst0 + 64 * 144;
    u32x4 rk, rv0, rv1;
    rk = *(const u32x4*)ksrc; rv0 = *(const u32x4*)vsrc0; rv1 = *(const u32x4*)vsrc1;
    *(LAS u32x4*)(F.lds + kdst) = rk; *(LAS u32x4*)(F.lds + vdst0) = rv0; *(LAS u32x4*)(F.lds + vdst1) = rv1;
    WG_BAR();
    const int sw = (j & ~12) | ((j & 4) << 1) | ((j & 8) >> 1);
    const int ka0 = sw * 144 + hh * 16, ka1 = (32 + sw) * 144 + hh * 16, va = KB + j * 144 + hh * 16;
    f32x16 acc[4];
#pragma unroll
    for (int i = 0; i < 4; ++i)
#pragma unroll
        for (int r = 0; r < 16; ++r) acc[i][r] = 0.f;
    float m_run = -1e30f, l_run = 0.f;
    for (int kt = 0; kt < nkt; ++kt) {
        const LAS unsigned char* buf = F.lds + (kt & 1) * TB;
        if (kt + 1 < nkt) { rk = *(const u32x4*)(ksrc + (size_t)(kt + 1) * 64 * 64); rv0 = *(const u32x4*)(vsrc0 + (kt + 1) * 64); rv1 = *(const u32x4*)(vsrc1 + (kt + 1) * 64); }
        f32x16 s0, s1;
#pragma unroll
        for (int r = 0; r < 16; ++r) { s0[r] = 0.f; s1[r] = 0.f; }
#pragma unroll
        for (int ks = 0; ks < 4; ++ks) {
            const bf16x8 a0 = *(const LAS bf16x8*)(buf + ka0 + ks * 32), a1 = *(const LAS bf16x8*)(buf + ka1 + ks * 32);
            s0 = __builtin_amdgcn_mfma_f32_32x32x16_bf16(a0, qf[ks], s0, 0, 0, 0);
            s1 = __builtin_amdgcn_mfma_f32_32x32x16_bf16(a1, qf[ks], s1, 0, 0, 0);
        }
        float mx = fmaxf(s0[0], s1[0]);
#pragma unroll
        for (int r = 1; r < 16; ++r) mx = fmaxf(mx, fmaxf(s0[r], s1[r]));
        mx = fmaxf(mx, __shfl_xor(mx, 32));
        const float m_new = fmaxf(m_run, mx), alpha = __builtin_amdgcn_exp2f(m_run - m_new);
        m_run = m_new;
        float ls = 0.f;
#pragma unroll
        for (int r = 0; r < 16; ++r) { s0[r] = __builtin_amdgcn_exp2f(s0[r] - m_new); s1[r] = __builtin_amdgcn_exp2f(s1[r] - m_new); ls += s0[r] + s1[r]; }
        l_run = l_run * alpha + ls;
#pragma unroll
        for (int i = 0; i < 4; ++i)
#pragma unroll
            for (int r = 0; r < 16; ++r) acc[i][r] *= alpha;
        bf16x8 pf[4];
        { u32x4 w;
          w.x = cvtpk(s0[0], s0[1]); w.y = cvtpk(s0[2], s0[3]); w.z = cvtpk(s0[4], s0[5]); w.w = cvtpk(s0[6], s0[7]); pf[0] = __builtin_bit_cast(bf16x8, w);
          w.x = cvtpk(s0[8], s0[9]); w.y = cvtpk(s0[10], s0[11]); w.z = cvtpk(s0[12], s0[13]); w.w = cvtpk(s0[14], s0[15]); pf[1] = __builtin_bit_cast(bf16x8, w);
          w.x = cvtpk(s1[0], s1[1]); w.y = cvtpk(s1[2], s1[3]); w.z = cvtpk(s1[4], s1[5]); w.w = cvtpk(s1[6], s1[7]); pf[2] = __builtin_bit_cast(bf16x8, w);
          w.x = cvtpk(s1[8], s1[9]); w.y = cvtpk(s1[10], s1[11]); w.z = cvtpk(s1[12], s1[13]); w.w = cvtpk(s1[14], s1[15]); pf[3] = __builtin_bit_cast(bf16x8, w); }
#pragma unroll
        for (int blk = 0; blk < 4; ++blk)
#pragma unroll
            for (int kstep = 0; kstep < 4; ++kstep) {
                const bf16x8 a = *(const LAS bf16x8*)(buf + va + blk * 32 * 144 + kstep * 32);
                acc[blk] = __builtin_amdgcn_mfma_f32_32x32x16_bf16(a, pf[kstep], acc[blk], 0, 0, 0);
            }
        if (kt + 1 < nkt) { LAS unsigned char* nb = F.lds + ((kt + 1) & 1) * TB; *(LAS u32x4*)(nb + kdst) = rk; *(LAS u32x4*)(nb + vdst0) = rv0; *(LAS u32x4*)(nb + vdst1) = rv1; }
        WG_BAR();
    }
    const float inv = 1.f / (l_run + __shfl_xor(l_run, 32));
    float* orow = Op + (size_t)(F.wave * 32 + j) * 1024 + 4 * hh;
#pragma unroll
    for (int blk = 0; blk < 4; ++blk)
#pragma unroll
        for (int g = 0; g < 4; ++g) *(f32x4*)(orow + 32 * blk + 8 * g) = (f32x4){acc[blk][4 * g] * inv, acc[blk][4 * g + 1] * inv, acc[blk][4 * g + 2] * inv, acc[blk][4 * g + 3] * inv};
}

__device__ __forceinline__ void attn_role(Ctx& F, int l) {
    const int a = F.bx - 128, bh = a & 7, k = a >> 3, b = bh >> 2, h = bh & 3;
    const bf16* QR = (const bf16*)(F.ws + WS_QR); const bf16* QC = (const bf16*)(F.ws + WS_QC); const bf16* KR = (const bf16*)(F.ws + WS_KR); const bf16* VT = (const bf16*)(F.ws + WS_VT);
    float* OATT = (float*)(F.ws + WS_XN);
    const bf16* Vtp = VT + (size_t)bh * 128 * KEYS;
    for (int m = 0; m < 2; ++m) {
        const int bhm = bh * 2 + m;
        attn_unit(F, QR + ((size_t)bhm * TL + k * 256) * 64, KR + (size_t)bhm * KEYS * 64, Vtp, KEYS / 64, OATT + (size_t)(b * TL + k * 256) * 1024 + (h * 2 + m) * 128);
    }
    if (l == 0 && k < 2) {
        const int m = k, bhm = bh * 2 + m;
        attn_unit(F, QC + (size_t)bhm * CL * 64, KR + (size_t)bhm * KEYS * 64, Vtp, CL / 64, OATT + (size_t)(ML + b * CL) * 1024 + (h * 2 + m) * 128);
    }
}

__device__ __forceinline__ void phase4(Ctx& F, int l) {
    const bf16* P = (const bf16*)(F.ws + WS_P); bf16* OC = (bf16*)(F.ws + WS_OC); const float* OATT = (const float*)(F.ws + WS_XN);
    const float* Yf = (const float*)(F.ws + WS_Y); const float* Yb = Yf + (size_t)MT * 512; const float* BON = (const float*)(F.ws + WS_BON);
    const float lam_init = 0.8f - 0.6f * expf(-0.3f * (float)l);
    const float d1 = wave_sum(F.prm->in[12][l * 64 + F.lane] * F.prm->in[13][l * 64 + F.lane]), d2 = wave_sum(F.prm->in[14][l * 64 + F.lane] * F.prm->in[15][l * 64 + F.lane]);
    const float lam = expf(d1) - expf(d2) + lam_init;
    const float* subg = F.prm->in[16] + l * 128; const float* ln_w = F.prm->in[25] + l * 512; const float* ln_b = F.prm->in[26] + l * 512;
    const int nrows = l == 0 ? MT : ML;
    for (int row = F.gw; row < nrows; row += F.NGW) {
        {
            const int h = F.lane >> 4, dv0 = (F.lane & 15) * 8; const float* o1 = OATT + (size_t)row * 1024 + h * 256 + dv0; const float* o2 = o1 + 128;
            float o[8]; const f32x4 a0 = *(const f32x4*)o1, a1 = *(const f32x4*)(o1 + 4), b0 = *(const f32x4*)o2, b1 = *(const f32x4*)(o2 + 4);
            o[0] = a0.x - lam * b0.x; o[1] = a0.y - lam * b0.y; o[2] = a0.z - lam * b0.z; o[3] = a0.w - lam * b0.w; o[4] = a1.x - lam * b1.x; o[5] = a1.y - lam * b1.y; o[6] = a1.z - lam * b1.z; o[7] = a1.w - lam * b1.w;
            float ss = 0.f;
#pragma unroll
            for (int e = 0; e < 8; ++e) ss += o[e] * o[e];
            const float rs = (1.f - lam_init) / sqrtf(red16(ss) * (1.f / 128.f) + EPS);
            float gg[8]; unpack8(*(const u32x4*)(P + (size_t)row * NINP + B_G + h * 128 + dv0), gg);
#pragma unroll
            for (int e = 0; e < 8; ++e) o[e] = o[e] * rs * subg[dv0 + e] * silu_f(gg[e]);
            *(u32x4*)(OC + (size_t)row * DM + 512 + h * 128 + dv0) = pack8(o);
        }
        {
            const int c0 = F.lane * 8; const float* yf = Yf + (size_t)row * 512 + c0; const float* yb = Yb + (size_t)row * 512 + c0; const float* bo = BON + (size_t)row * 512 + c0;
            float y[8]; const f32x4 a0 = *(const f32x4*)yf, a1 = *(const f32x4*)(yf + 4), b0 = *(const f32x4*)yb, b1 = *(const f32x4*)(yb + 4);
            y[0] = a0.x + b0.x; y[1] = a0.y + b0.y; y[2] = a0.z + b0.z; y[3] = a0.w + b0.w; y[4] = a1.x + b1.x; y[5] = a1.y + b1.y; y[6] = a1.z + b1.z; y[7] = a1.w + b1.w;
            float s = 0.f;
#pragma unroll
            for (int e = 0; e < 8; ++e) s += y[e];
            const float mean = red8(s) * (1.f / 64.f); float q = 0.f;
#pragma unroll
            for (int e = 0; e < 8; ++e) { y[e] -= mean; q += y[e] * y[e]; }
            const float rstd = 1.f / sqrtf(red8(q) * (1.f / 64.f) + GN_EPS);
            float gg[8]; unpack8(*(const u32x4*)(P + (size_t)row * NINP + C_G + c0), gg);
            const f32x4 q0 = *(const f32x4*)bo, q1 = *(const f32x4*)(bo + 4); const float bn[8] = {q0.x, q0.y, q0.z, q0.w, q1.x, q1.y, q1.z, q1.w};
#pragma unroll
            for (int e = 0; e < 8; ++e) y[e] = (y[e] * rstd * ln_w[c0 + e] + ln_b[c0 + e] + bn[e]) * silu_f(gg[e]);
            *(u32x4*)(OC + (size_t)row * DM + 1024 + c0) = pack8(y);
        }
    }
}

#define XB_TMO      128
#define XB_XCNT(j)  (256  + 64 * (j))
#define XB_XSUB(j)  (1280 + 64 * (j))
#define XB_XGEN(j)  (2304 + 64 * (j))
#define XB_TOP      3328
#define XB_TOPGEN   3392
#define XCD_BAR_WORDS 3456
#define XB_SPIN_CAP (1u << 18)

__device__ __forceinline__ unsigned xb_ld(unsigned* p)              { return __hip_atomic_load(p, __ATOMIC_RELAXED, __HIP_MEMORY_SCOPE_AGENT); }
__device__ __forceinline__ unsigned xb_add(unsigned* p, unsigned v) { return __hip_atomic_fetch_add(p, v, __ATOMIC_RELAXED, __HIP_MEMORY_SCOPE_AGENT); }
__device__ __forceinline__ unsigned xb_xcc_id() { return (unsigned)__builtin_amdgcn_s_getreg((3 << 11) | 20) & 0xFu; }
#define XB_SPIN(cond, bar) do { unsigned _sp = 0; while (cond) { __builtin_amdgcn_s_sleep(1); \
    if ((++_sp & 255u) == 0u) { if (xb_ld(&(bar)[XB_TMO])) break; if (_sp > XB_SPIN_CAP) { atomicAdd(&(bar)[XB_TMO], 1u); break; } } } } while (0)

struct XcdBarrier {
    unsigned* bar; unsigned x;
    volatile LAS unsigned* st;
};

__device__ __forceinline__ XcdBarrier xcd_barrier_post(unsigned* bar, volatile LAS unsigned* st) {
    XcdBarrier b; b.bar = bar; b.x = xb_xcc_id(); b.st = st;
    if (threadIdx.x == 0) (void)xb_add(&bar[XB_XCNT(b.x)], 1u);
    return b;
}
__device__ __forceinline__ void xcd_barrier_complete(unsigned* bar, unsigned x, unsigned& nloc, unsigned& nx) {
    const unsigned G = gridDim.x * gridDim.y * gridDim.z;
    unsigned sum, cnt, mine, sp = 0u;
    for (;;) {
        sum = 0u; cnt = 0u; mine = 0u;
#pragma unroll
        for (unsigned j = 0; j < 16; ++j) { const unsigned c = xb_ld(&bar[XB_XCNT(j)]); sum += c; cnt += (c > 0u) ? 1u : 0u; mine = (j == x) ? c : mine; }
        if (sum == G) break;
        __builtin_amdgcn_s_sleep(1);
        if ((++sp & 255u) == 0u) { if (xb_ld(&bar[XB_TMO])) break; if (sp > XB_SPIN_CAP) { atomicAdd(&bar[XB_TMO], 1u); break; } }
    }
    nloc = mine > 0u ? mine : 1u; nx = cnt > 0u ? cnt : 1u;
}

__device__ __forceinline__ void xcd_barrier(const XcdBarrier& b) {
    asm volatile("s_waitcnt vmcnt(0)" ::: "memory");
    __syncthreads();
    if (threadIdx.x == 0) {
        unsigned* bar = b.bar;
        __builtin_amdgcn_s_waitcnt(0);
        unsigned nloc = b.st[0], nx = b.st[1];
        if (nloc == 0u) { xcd_barrier_complete(bar, b.x, nloc, nx); b.st[0] = nloc; b.st[1] = nx; }
        const unsigned old = xb_add(&bar[XB_XSUB(b.x)], 1u);
        const unsigned gen = old / nloc;
        if (old + 1u == (gen + 1u) * nloc) {
            __builtin_amdgcn_fence(__ATOMIC_RELEASE, "agent");
            asm volatile("s_waitcnt vmcnt(0)" ::: "memory");
            const unsigned og = xb_add(&bar[XB_TOP], 1u);
            const unsigned tg = og / nx;
            if (og + 1u == (tg + 1u) * nx) xb_add(&bar[XB_TOPGEN], 1u);
            else XB_SPIN(xb_ld(&bar[XB_TOPGEN]) == tg, bar);
            __builtin_amdgcn_fence(__ATOMIC_ACQUIRE, "agent");
            xb_add(&bar[XB_XGEN(b.x)], 1u);
            asm volatile("s_waitcnt vmcnt(0)" ::: "memory");
        } else {
            XB_SPIN(xb_ld(&bar[XB_XGEN(b.x)]) == gen, bar);
            __builtin_amdgcn_fence(__ATOMIC_ACQUIRE, "agent");
            asm volatile("s_waitcnt vmcnt(0)" ::: "memory");
        }
    }
    __syncthreads();
}

__global__ void __launch_bounds__(NTHREADS, 2) fwd_kernel(Params prm) {
    extern __shared__ __attribute__((aligned(16))) unsigned char lds_raw[];
    cg::grid_group grid = cg::this_grid();
    Ctx F;
    F.prm = &prm; F.out = prm.out; F.ws = prm.ws; F.lds = (LAS unsigned char*)lds_raw;
    F.tid = threadIdx.x; F.lane = F.tid & 63; F.wave = __builtin_amdgcn_readfirstlane(F.tid >> 6); F.bx = blockIdx.x; F.G = gridDim.x;
    F.gw = F.bx * NWAVES + F.wave; F.NGW = F.G * NWAVES;
    volatile LAS unsigned* MISC = (volatile LAS unsigned*)(F.lds + 131072 + 1024);
    if (F.tid < 4) MISC[F.tid] = 0u;
    __syncthreads();
    XcdBarrier bar = xcd_barrier_post((unsigned*)(F.ws + WS_CTL + 16384), MISC);
#define GRID_BAR() xcd_barrier(bar)

#ifndef NO_P0
    LAUNDER(F); phase0(F);
#endif
    grid.sync();
#pragma unroll 1
    for (int l = 0; l < 2; ++l) {
#ifndef NO_P1
        LAUNDER(F); phase1(F, l);
#endif
        GRID_BAR();
#ifndef NO_P2
        {
            pg8::Gemm g{(const pg8::bf16_t*)(F.ws + WS_XN), (const pg8::bf16_t*)(F.ws + WS_WIN) + (size_t)l * NINP * DM, MT, NINP, DM};
            pg8::StaticOrder S; S.init(MT, NINP, F.G, F.bx);
            pg8::EpiBf16 E{(pg8::bf16_t*)(F.ws + WS_P), NINP, nullptr, 0, 0, 1.f};
            pg8::gemm_phase<pg8::EpiBf16, pg8::StaticOrder, true, true>(F.lds, g, S, E);
        }
#endif
        GRID_BAR();
#ifndef NO_P3A
        LAUNDER(F); phase3a(F, l);
#endif
        GRID_BAR();
#ifndef NO_P3B
        LAUNDER(F);
        if (F.bx < 128) {
#ifndef NO_SCAN
 scan_role(F);
#endif
 } else {
#ifndef NO_ATTN
 attn_role(F, l);
#endif
 }
#endif
        GRID_BAR();
#ifndef NO_P4
        LAUNDER(F); phase4(F, l);
#endif
        GRID_BAR();
#ifndef NO_P5
        {
            const int rows = l == 0 ? MT : ML;
            pg8::Gemm g{(const pg8::bf16_t*)(F.ws + WS_OC), (const pg8::bf16_t*)(F.ws + WS_WOUT) + (size_t)l * DM * DM, rows, DM, DM};
            pg8::StaticOrder S; S.init(rows, DM, F.G, F.bx);
            pg8::EpiF32 E{(float*)(F.ws + WS_P), DM};
            pg8::gemm_phase<pg8::EpiF32, pg8::StaticOrder, true, true>(F.lds, g, S, E);
        }
#endif
        GRID_BAR();
    }
#ifndef NO_P6
    LAUNDER(F); phase6(F);
#endif
}

extern "C" void kernel_launch(void* const* d_in, const int* in_sizes, int n_in, void* d_out, int out_size, void* d_ws, size_t ws_size, hipStream_t stream) {
    static int grid = 0;
    if (grid == 0) {
        if (n_in != 28 || out_size != ML * DM || ws_size < WS_END) { fprintf(stderr, "kernel_launch: unexpected shapes: n_in %d out %d ws %zu (need %zu)\n", n_in, out_size, ws_size, (size_t)WS_END); grid = -1; return; }
        int dev = 0, cus = 0, per_cu = 0;
        if (hipGetDevice(&dev) != hipSuccess || hipDeviceGetAttribute(&cus, hipDeviceAttributeMultiprocessorCount, dev) != hipSuccess) { grid = -1; return; }
        if (hipFuncSetAttribute((const void*)fwd_kernel, hipFuncAttributeMaxDynamicSharedMemorySize, LDS_BYTES) != hipSuccess) { fprintf(stderr, "kernel_launch: hipFuncSetAttribute failed\n"); grid = -1; return; }
        if (hipOccupancyMaxActiveBlocksPerMultiprocessor(&per_cu, (const void*)fwd_kernel, NTHREADS, LDS_BYTES) != hipSuccess || per_cu < 1) { fprintf(stderr, "kernel_launch: occupancy query says %d blocks per CU\n", per_cu); grid = -1; return; }
        (void)hipGetLastError();
        grid = cus;
        if (grid != 256) { fprintf(stderr, "kernel_launch: expected 256 CUs, got %d\n", cus); grid = -1; return; }
    }
    if (grid < 0) return;
    if (hipMemsetAsync((char*)d_ws + WS_CTL, 0, CTL_ZERO_BYTES, stream) != hipSuccess) { fprintf(stderr, "kernel_launch: memset failed\n"); return; }
    Params p{};
    for (int i = 0; i < 28; ++i) p.in[i] = (const float*)d_in[i];
    p.out = (float*)d_out; p.ws = (unsigned char*)d_ws;
    void* args[] = {&p};
    hipError_t e = hipLaunchCooperativeKernel((void*)fwd_kernel, dim3(grid), dim3(NTHREADS), args, LDS_BYTES, stream);
    if (e != hipSuccess) fprintf(stderr, "cooperative launch failed: %s (grid %d)\n", hipGetErrorString(e), grid);
}
```

```cpp
#include <hip/hip_runtime.h>
#include <hip/hip_cooperative_groups.h>
#include <cstdio>
#include <cstdint>
namespace cg = cooperative_groups;
namespace pg8 {
#define PG8_LAS __attribute__((address_space(3)))
typedef unsigned short bf16_t;
typedef short bf16x8 __attribute__((ext_vector_type(8)));
typedef float f32x4 __attribute__((ext_vector_type(4)));
typedef unsigned u32x4 __attribute__((ext_vector_type(4)));
constexpr int BM = 256, BK = 64, HALF = 128, HTB = HALF * BK * 2  , STAGE_BYTES = 8 * HTB, NXCD = 8, WGM = 8;

__host__ __device__ __forceinline__ int lds_byte(int r, int c) { const int st = (r >> 4) * 2 + (c >> 5), rr = r & 15, cc = c & 31, ob = rr * 64 + cc * 2; return st * 1024 + (ob ^ (((ob >> 9) & 1) << 5)); }
__host__ __device__ __forceinline__ void stage_rc(int b, int& R, int& C) { const int st = b / 1024, sb = b % 1024, swz = sb ^ (((sb >> 9) & 1) << 5); R = (st >> 1) * 16 + swz / 64; C = (st & 1) * 32 + (swz % 64) / 2; }
__host__ __device__ __forceinline__ int perm32(int rho) { const int n = rho >> 4, i = rho & 15; return 8 * (i >> 2) + 4 * n + (i & 3); }

struct Unit { int pm, pn; };
struct Gemm { const bf16_t* A; const bf16_t* Bt; int M, N, K; };

struct StaticOrder {
    int nM, nN, nwg, G, c;
    __host__ __device__ void init(int M, int N, int G_, int c_) { nM = M / BM; nN = N / BM; nwg = nM * nN; G = G_; c = c_; }
    __host__ __device__ bool next(int i, Unit& u) const {
        const long L = (long)i * G + c; if (L >= nwg) return false;
        int wgid = (int)L; { const int q = nwg / NXCD, r = nwg % NXCD, xcd = wgid % NXCD, off = wgid / NXCD; wgid = (xcd < r ? xcd * (q + 1) : r * (q + 1) + (xcd - r) * q) + off; }
        const int nig = WGM * nN, gid = wgid / nig, fm = gid * WGM, gsz = (nM - fm) < WGM ? (nM - fm) : WGM;
        u.pm = fm + ((wgid % nig) % gsz); u.pn = (wgid % nig) / gsz; return true;
    }
    __device__ __forceinline__ void a_ready(const Unit&) const {}
    __device__ __forceinline__ void done(const Unit&) const {}
};

__device__ __forceinline__ unsigned cvt_pk_bf16(float lo, float hi) { unsigned r; asm volatile("v_cvt_pk_bf16_f32 %0, %1, %2" : "=v"(r) : "v"(lo), "v"(hi)); return r; }
struct EpiBf16 {
    static constexpr bool PERM = true, AFTER_DRAIN = false;
    bf16_t* O; int ldc; const float* bias; int split_cols; size_t split_stride; float scale0;
    __device__ __forceinline__ void operator()(const f32x4 (&acc)[2][2][4][2], const Unit& u, int wr, int wc, int fr, int fq) const {
        const int row0 = u.pm * BM + wr * 64 + fr; int colt = u.pn * BM; bf16_t* base = O;
        float sc = 1.f; if (split_cols) { const int t = colt / split_cols; base += (size_t)t * split_stride; colt -= t * split_cols; if (t == 0) sc = scale0; }
        const int col0 = colt + wc * 32 + 8 * fq, bcol0 = u.pn * BM + wc * 32 + 8 * fq;
        f32x4 bv[2][2];
#pragma unroll
        for (int bj = 0; bj < 2; ++bj)
#pragma unroll
            for (int n = 0; n < 2; ++n) bv[bj][n] = bias ? *(const f32x4*)(bias + bcol0 + bj * HALF + 4 * n) : (f32x4){0.f, 0.f, 0.f, 0.f};
#pragma unroll
        for (int ai = 0; ai < 2; ++ai)
#pragma unroll
            for (int m = 0; m < 4; ++m) { bf16_t* rowp = base + (size_t)(row0 + ai * HALF + m * 16) * ldc + col0;
#pragma unroll
                for (int bj = 0; bj < 2; ++bj) { f32x4 v0 = acc[ai][bj][m][0] + bv[bj][0], v1 = acc[ai][bj][m][1] + bv[bj][1];
                    v0 = v0 * sc; v1 = v1 * sc; u32x4 w; w.x = cvt_pk_bf16(v0[0], v0[1]); w.y = cvt_pk_bf16(v0[2], v0[3]); w.z = cvt_pk_bf16(v1[0], v1[1]); w.w = cvt_pk_bf16(v1[2], v1[3]);
                    *(u32x4*)(rowp + bj * HALF) = w; } }
    }
};
struct EpiF32 {
    static constexpr bool PERM = false, AFTER_DRAIN = false;
    float* O; int ldc;
    __device__ __forceinline__ void operator()(const f32x4 (&acc)[2][2][4][2], const Unit& u, int wr, int wc, int fr, int fq) const {
        const int col0 = u.pn * BM + wc * 32 + 4 * fq;
#pragma unroll
        for (int ai = 0; ai < 2; ++ai)
#pragma unroll
            for (int m = 0; m < 4; ++m) { float* rowp = O + (size_t)(u.pm * BM + ai * HALF + wr * 64 + m * 16 + fr) * ldc + col0;
#pragma unroll
                for (int bj = 0; bj < 2; ++bj)
#pragma unroll
                    for (int n = 0; n < 2; ++n) *(f32x4*)(rowp + bj * HALF + n * 16) = acc[ai][bj][m][n]; }
    }
};
template <class Epi, class Sched, bool ALIGN_EPI = false, bool SP2 = false>
__device__ __forceinline__ void gemm_phase(PG8_LAS unsigned char* lds, const Gemm g, const Sched& S, const Epi& E) {
    int tid_ = threadIdx.x; asm volatile("" : "+v"(tid_));
    const int tid = tid_, wid = __builtin_amdgcn_readfirstlane(tid >> 6), lane = tid & 63, wr = wid >> 2, wc = wid & 3, fr = lane & 15, fq = lane >> 4;
    const int K = g.K, nt = K / BK;
    unsigned voffA[2], voffB[2];
#pragma unroll
    for (int i = 0; i < 2; ++i) { int R, C; stage_rc(tid * 16 + i * 8192, R, C); const int Rb = Epi::PERM ? ((R & ~31) + perm32(R & 31)) : R;
        voffA[i] = (unsigned)(R * K + C) * 2u; voffB[i] = (unsigned)(Rb * K + C) * 2u; }
    const size_t kstep = (size_t)(BK * 2);
    const size_t hstep = (size_t)HALF * K * 2;
    const size_t tstep = 2 * hstep;
    const unsigned ldsw = (unsigned)wid * 1024u;
    const int aoff = lds_byte(wr * 64 + fr, fq * 8), boff = lds_byte(wc * 32 + fr, fq * 8);
#define PG8_SA(b, h) (((b) * 2 + (h)) * HTB)
#define PG8_SB(b, h) ((4 + (b) * 2 + (h)) * HTB)
#define PG8_STAGE(bufoff, gbase, voff) do { _Pragma("unroll") for (int _i = 0; _i < 2; ++_i) \
        __builtin_amdgcn_global_load_lds((const unsigned*)((const char*)(gbase) + (voff)[_i]), (PG8_LAS unsigned*)(lds + (bufoff) + ldsw + _i * 8192), 16, 0, 0); } while (0)
#define PG8_LDA(dst, b, h) do { _Pragma("unroll") for (int m = 0; m < 4; ++m) _Pragma("unroll") for (int k = 0; k < 2; ++k) dst[m][k] = *(const PG8_LAS bf16x8*)(lds + PG8_SA(b, h) + aoff + m * 2048 + k * 1024); } while (0)
#define PG8_LDB(dst, b, h) do { _Pragma("unroll") for (int n = 0; n < 2; ++n) _Pragma("unroll") for (int k = 0; k < 2; ++k) dst[n][k] = *(const PG8_LAS bf16x8*)(lds + PG8_SB(b, h) + boff + n * 2048 + k * 1024); } while (0)
#define PG8_MMA(ai, bj, At, Bt) do { __builtin_amdgcn_s_setprio(1); _Pragma("unroll") for (int m = 0; m < 4; ++m) _Pragma("unroll") for (int n = 0; n < 2; ++n) _Pragma("unroll") for (int k = 0; k < 2; ++k) \
        acc[ai][bj][m][n] = __builtin_amdgcn_mfma_f32_16x16x32_bf16(Bt[n][k], At[m][k], acc[ai][bj][m][n], 0, 0, 0); __builtin_amdgcn_s_setprio(0); } while (0)
#define PG8_WAIT_V(n) asm volatile("s_waitcnt vmcnt(" #n ")" ::: "memory")
#define PG8_WAIT_L(n) asm volatile("s_waitcnt lgkmcnt(" #n ")" ::: "memory")
#define PG8_BAR __builtin_amdgcn_s_barrier()
#define PG8_SCHED __builtin_amdgcn_sched_barrier(0)
    Unit cur, nxt; int ui = 0;
    if (!S.next(0, cur)) return;
    f32x4 acc[2][2][4][2];
#pragma unroll
    for (int a = 0; a < 2; ++a)
#pragma unroll
        for (int b = 0; b < 2; ++b)
#pragma unroll
            for (int m = 0; m < 4; ++m)
#pragma unroll
                for (int n = 0; n < 2; ++n) acc[a][b][m][n] = (f32x4){0.f, 0.f, 0.f, 0.f};
    bf16x8 At[4][2], B0[2][2], B1[2][2];
    const char* cA = (const char*)g.A + (size_t)cur.pm * tstep; const char* cB = (const char*)g.Bt + (size_t)cur.pn * tstep;
    S.a_ready(cur);
    if constexpr (SP2) {
        PG8_STAGE(PG8_SB(0, 0), cB, voffB); PG8_STAGE(PG8_SB(0, 1), cB + hstep, voffB); PG8_STAGE(PG8_SA(0, 0), cA, voffA); PG8_STAGE(PG8_SA(0, 1), cA + hstep, voffA);
        if (wr == 1) PG8_BAR;
        PG8_WAIT_V(2); PG8_BAR;
        PG8_STAGE(PG8_SB(1, 0), cB + kstep, voffB); PG8_STAGE(PG8_SA(1, 0), cA + kstep, voffA); PG8_STAGE(PG8_SB(1, 1), cB + hstep + kstep, voffB);
        PG8_WAIT_V(6); PG8_BAR;
    } else {
        PG8_STAGE(PG8_SB(0, 0), cB, voffB); PG8_STAGE(PG8_SA(0, 0), cA, voffA); PG8_STAGE(PG8_SB(0, 1), cB + hstep, voffB); PG8_STAGE(PG8_SA(0, 1), cA + hstep, voffA);
        if (wr == 1) PG8_BAR;
        PG8_WAIT_V(4); PG8_BAR;
        PG8_STAGE(PG8_SB(1, 0), cB + kstep, voffB); PG8_STAGE(PG8_SA(1, 0), cA + kstep, voffA); PG8_STAGE(PG8_SB(1, 1), cB + hstep + kstep, voffB);
        PG8_WAIT_V(6); PG8_BAR;
    }
    for (;;) {
        const bool has_next = S.next(ui + 1, nxt);
        const char* nA = has_next ? (const char*)g.A + (size_t)nxt.pm * tstep : cA; const char* nB = has_next ? (const char*)g.Bt + (size_t)nxt.pn * tstep : cB;
        for (int t = 0; t < nt; t += 2) {
            const bool last = (t == nt - 2);
            const char* a1 = cA + (size_t)(t + 1) * kstep;
            const char* a2 = last ? nA : cA + (size_t)(t + 2) * kstep; const char* b2 = last ? nB : cB + (size_t)(t + 2) * kstep;
            const char* a3 = a2 + kstep; const char* b3 = b2 + kstep;
            if (last && has_next) S.a_ready(nxt);
            if constexpr (SP2) {
            PG8_LDB(B0, 0, 0); PG8_LDB(B1, 0, 1); PG8_SCHED; PG8_LDA(At, 0, 0); PG8_STAGE(PG8_SA(1, 1), a1 + hstep, voffA);
            PG8_WAIT_V(8); PG8_WAIT_L(0); PG8_BAR; PG8_MMA(0, 0, At, B0); PG8_MMA(0, 1, At, B1); PG8_BAR; PG8_SCHED;
            PG8_LDA(At, 0, 1); PG8_STAGE(PG8_SB(0, 0), b2, voffB); PG8_STAGE(PG8_SB(0, 1), b2 + hstep, voffB); PG8_STAGE(PG8_SA(0, 0), a2, voffA);
            PG8_WAIT_V(8); PG8_WAIT_L(0); PG8_BAR; PG8_MMA(1, 0, At, B0); PG8_MMA(1, 1, At, B1); PG8_BAR; PG8_SCHED;
            PG8_LDB(B0, 1, 0); PG8_LDB(B1, 1, 1); PG8_SCHED; PG8_LDA(At, 1, 0); PG8_STAGE(PG8_SA(0, 1), a2 + hstep, voffA);
            PG8_WAIT_V(8); PG8_WAIT_L(0); PG8_BAR; PG8_MMA(0, 0, At, B0); PG8_MMA(0, 1, At, B1); PG8_BAR; PG8_SCHED;
            PG8_LDA(At, 1, 1); PG8_STAGE(PG8_SB(1, 0), b3, voffB); PG8_STAGE(PG8_SB(1, 1), b3 + hstep, voffB); PG8_STAGE(PG8_SA(1, 0), a3, voffA);
            PG8_WAIT_V(8); PG8_WAIT_L(0); PG8_BAR; PG8_MMA(1, 0, At, B0); PG8_MMA(1, 1, At, B1); PG8_BAR; PG8_SCHED;
            } else {
            PG8_LDB(B0, 0, 0); PG8_SCHED; PG8_LDA(At, 0, 0); PG8_STAGE(PG8_SA(1, 1), a1 + hstep, voffA);
            PG8_WAIT_L(8); PG8_BAR; PG8_WAIT_L(0); PG8_MMA(0, 0, At, B0); PG8_BAR; PG8_SCHED;
            PG8_LDB(B1, 0, 1); PG8_STAGE(PG8_SB(0, 0), b2, voffB);
            PG8_BAR; PG8_WAIT_L(0); PG8_MMA(0, 1, At, B1); PG8_BAR;
            PG8_LDA(At, 0, 1); PG8_STAGE(PG8_SA(0, 0), a2, voffA);
            PG8_BAR; PG8_WAIT_L(0); PG8_MMA(1, 0, At, B0); PG8_BAR; PG8_SCHED;
            PG8_STAGE(PG8_SB(0, 1), b2 + hstep, voffB);
            PG8_WAIT_V(6); PG8_BAR; PG8_MMA(1, 1, At, B1); PG8_BAR;
            PG8_LDB(B0, 1, 0); PG8_SCHED; PG8_LDA(At, 1, 0); PG8_STAGE(PG8_SA(0, 1), a2 + hstep, voffA);
            PG8_WAIT_L(8); PG8_BAR; PG8_WAIT_L(0); PG8_MMA(0, 0, At, B0); PG8_BAR; PG8_SCHED;
            PG8_LDB(B1, 1, 1); PG8_STAGE(PG8_SB(1, 0), b3, voffB);
            PG8_BAR; PG8_WAIT_L(0); PG8_MMA(0, 1, At, B1); PG8_BAR;
            PG8_LDA(At, 1, 1); PG8_STAGE(PG8_SA(1, 0), a3, voffA);
            PG8_BAR; PG8_WAIT_L(0); PG8_MMA(1, 0, At, B0); PG8_BAR; PG8_SCHED;
            PG8_STAGE(PG8_SB(1, 1), b3 + hstep, voffB);
            PG8_WAIT_V(6); PG8_BAR; PG8_MMA(1, 1, At, B1); PG8_BAR;
            }
        }
        if constexpr (ALIGN_EPI) { if (wr == 0) PG8_BAR; }
        if constexpr (!Epi::AFTER_DRAIN) { E(acc, cur, wr, wc, fr, fq); S.done(cur); }
        if (!has_next) break;
#pragma unroll
        for (int a = 0; a < 2; ++a)
#pragma unroll
            for (int b = 0; b < 2; ++b)
#pragma unroll
                for (int m = 0; m < 4; ++m)
#pragma unroll
                    for (int n = 0; n < 2; ++n) acc[a][b][m][n] = (f32x4){0.f, 0.f, 0.f, 0.f};
        cur = nxt; cA = nA; cB = nB; ++ui;
        if constexpr (ALIGN_EPI) { if (wr == 1) PG8_BAR; }
    }
    PG8_WAIT_V(0);
    if constexpr (!ALIGN_EPI) { if (wr == 0) PG8_BAR; }
    PG8_BAR;
    if constexpr (Epi::AFTER_DRAIN) { E.fused(acc, cur, wr, wc, fr, fq, lds, wid, lane); S.done(cur); }
#undef PG8_SA
#undef PG8_SB
#undef PG8_STAGE
#undef PG8_LDA
#undef PG8_LDB
#undef PG8_MMA
#undef PG8_WAIT_V
#undef PG8_WAIT_L
#undef PG8_BAR
#undef PG8_SCHED
}
}

constexpr int NB = 2, TL = 4096, DM = 2048, CL = 256, NIN = 7872, NINP = 7936;
constexpr int ML = NB * TL, MC = NB * CL, MT = ML + MC;
constexpr int KEYS = CL + TL;
constexpr int NSTEP = KEYS;
constexpr int A_U = 0, A_V = 512, A_G = 1024, B_Q = 1536, B_K = 2048, B_V = 2560, B_G = 3072, C_R = 3584, C_K = 4096, C_V = 4608, C_LF = 5120, C_LB = 5216, C_G = 5312,
              D_B = 5824, D_C = 6336, D_X = 6848, D_G = 7360;
constexpr float EPS = 1e-6f, GN_EPS = 64e-5f;
constexpr float QSCALE = 0.125f * 1.4426950408889634f;

constexpr size_t MiB = 1u << 20;
constexpr size_t WS_CTL = 0, CTL_ZERO_BYTES = 1 * MiB;
constexpr size_t CTL_MODACC = 65536;
constexpr size_t WS_ROPE = 1 * MiB - 16384;
constexpr size_t WS_WIN = 1 * MiB;
constexpr size_t WS_WOUT = 63 * MiB;
constexpr size_t WS_XN = 79 * MiB;
constexpr size_t WS_P = 113 * MiB;
constexpr size_t WS_QR = 245 * MiB;
constexpr size_t WS_QC = 253 * MiB;
constexpr size_t WS_KR = 254 * MiB;
constexpr size_t WS_VT = 263 * MiB;
constexpr size_t WS_CHK = 272 * MiB;
constexpr size_t WS_Y = 402 * MiB;
constexpr size_t WS_BON = 436 * MiB;
constexpr size_t WS_OC = 453 * MiB;
constexpr size_t WS_END = 487 * MiB;
static_assert(WS_WIN + (size_t)2 * NINP * DM * 2 <= WS_WOUT && WS_WOUT + (size_t)2 * DM * DM * 2 <= WS_XN && WS_XN + (size_t)MT * DM * 2 <= WS_P && WS_P + (size_t)MT * NINP * 2 <= WS_QR, "ws map 1");
static_assert(WS_QR + (size_t)16 * TL * 64 * 2 <= WS_QC && WS_QC + (size_t)16 * CL * 64 * 2 <= WS_KR && WS_KR + (size_t)16 * KEYS * 64 * 2 <= WS_VT && WS_VT + (size_t)8 * 128 * KEYS * 2 <= WS_CHK, "ws map 2");
static_assert(WS_Y + (size_t)2 * MT * 512 * 4 <= WS_BON && WS_BON + (size_t)2 * MT * 512 * 2 <= WS_OC && WS_OC + (size_t)MT * DM * 2 <= WS_END, "ws map 3");
static_assert((size_t)MT * 1024 * 4 <= WS_P - WS_XN && (size_t)MT * DM * 4 <= WS_QR - WS_P, "overlays");

constexpr int LDS_BYTES = 147456;
constexpr int NWAVES = 8, NTHREADS = 512;

typedef unsigned short bf16;
typedef short bf16x8 __attribute__((ext_vector_type(8)));
typedef float f32x4 __attribute__((ext_vector_type(4)));
typedef float f32x2 __attribute__((ext_vector_type(2)));
typedef float f32x16 __attribute__((ext_vector_type(16)));
typedef unsigned u32x4 __attribute__((ext_vector_type(4)));
typedef unsigned u32x2 __attribute__((ext_vector_type(2)));
typedef __bf16 bf16x2_t __attribute__((ext_vector_type(2)));
#define LAS __attribute__((address_space(3)))

struct Params { const float* in[28]; float* out; unsigned char* ws; };

struct Ctx {
    const Params* prm; float* out; unsigned char* ws;
    LAS unsigned char* lds;
    int tid, lane, wave, bx, G, gw, NGW;
};

__device__ __forceinline__ unsigned cvtpk(float lo, float hi) { f32x2 v = {lo, hi}; bf16x2_t b = __builtin_convertvector(v, bf16x2_t); return __builtin_bit_cast(unsigned, b); }
__device__ __forceinline__ float bflo(unsigned u) { return __builtin_bit_cast(float, u << 16); }
__device__ __forceinline__ float bfhi(unsigned u) { return __builtin_bit_cast(float, u & 0xffff0000u); }
__device__ __forceinline__ void unpack8(const u32x4 v, float* f) { f[0] = bflo(v.x); f[1] = bfhi(v.x); f[2] = bflo(v.y); f[3] = bfhi(v.y); f[4] = bflo(v.z); f[5] = bfhi(v.z); f[6] = bflo(v.w); f[7] = bfhi(v.w); }
__device__ __forceinline__ u32x4 pack8(const float* f) { u32x4 r; r.x = cvtpk(f[0], f[1]); r.y = cvtpk(f[2], f[3]); r.z = cvtpk(f[4], f[5]); r.w = cvtpk(f[6], f[7]); return r; }
__device__ __forceinline__ float silu_f(float x) { return x / (1.f + __expf(-x)); }
__device__ __forceinline__ float wave_sum(float v) {
#pragma unroll
    for (int o = 1; o < 64; o <<= 1) v += __shfl_xor(v, o);
    return v;
}
template <int CTRL> __device__ __forceinline__ float dpp_f(float v) { return __builtin_bit_cast(float, __builtin_amdgcn_update_dpp(0, __builtin_bit_cast(int, v), CTRL, 0xf, 0xf, true)); }
__device__ __forceinline__ float red4(float v) { v += dpp_f<0xB1>(v); v += dpp_f<0x4E>(v); return v; }
__device__ __forceinline__ float red8(float v) { v = red4(v); v += dpp_f<0x141>(v); return v; }
__device__ __forceinline__ float red16(float v) { v = red8(v); v += dpp_f<0x140>(v); return v; }
#define LAUNDER(F) do { asm volatile("" : "+v"(F.tid), "+v"(F.lane)); asm volatile("" : "+s"(F.wave), "+s"(F.bx), "+s"(F.gw)); } while (0)
#define LDS_WAIT() asm volatile("s_waitcnt lgkmcnt(0)" ::: "memory")
#define WG_BAR() do { asm volatile("s_waitcnt lgkmcnt(0)" ::: "memory"); __builtin_amdgcn_s_barrier(); asm volatile("" ::: "memory"); } while (0)

#ifndef R_P0T
#define R_P0T 1
#endif
__device__ __forceinline__ void p0_transpose_item(const float* W, int K, int N, bf16* WT, LAS float* scr, int item, int lane) {
    const int nblk = N / 32, kb = item / nblk, nb = item % nblk, k0 = 64 * kb, n0 = 32 * nb;
#pragma unroll 8
    for (int i = 0; i < 32; ++i) { const int kk = 2 * i + (lane >> 5); scr[kk * 33 + (lane & 31)] = W[(size_t)(k0 + kk) * N + n0 + (lane & 31)]; }
    LDS_WAIT();
    const int c = lane & 7;
#pragma unroll
    for (int j = 0; j < 4; ++j) { const int n = (lane >> 3) + 8 * j; const LAS float* s = scr + (8 * c) * 33 + n;
        u32x4 o; o.x = cvtpk(s[0 * 33], s[1 * 33]); o.y = cvtpk(s[2 * 33], s[3 * 33]); o.z = cvtpk(s[4 * 33], s[5 * 33]); o.w = cvtpk(s[6 * 33], s[7 * 33]);
        *(u32x4*)(WT + (size_t)(n0 + n) * K + k0 + 8 * c) = o; }
    LDS_WAIT();
}

__device__ __forceinline__ void phase0(Ctx& F) {
    LAS float* scr = (LAS float*)(F.lds + F.wave * 16384);
    const float* w_in = F.prm->in[8]; const float* w_out = F.prm->in[9];
    bf16* WIN = (bf16*)(F.ws + WS_WIN); bf16* WOUT = (bf16*)(F.ws + WS_WOUT);
    constexpr int I_IN = (DM / 64) * (NIN / 32), I_OUT = (DM / 64) * (DM / 32);
    constexpr int NITEMS = 2 * (I_IN + I_OUT);
    for (int q_ = 0; q_ < R_P0T; ++q_)
    for (int it = F.gw; it < NITEMS; it += F.NGW) {
        int r = it;
        if (r < 2 * I_IN) { const int l = r / I_IN; r -= l * I_IN; p0_transpose_item(w_in + (size_t)l * DM * NIN, DM, NIN, WIN + (size_t)l * NINP * DM, scr, r, F.lane); }
        else { r -= 2 * I_IN; const int l = r / I_OUT; r -= l * I_OUT; p0_transpose_item(w_out + (size_t)l * DM * DM, DM, DM, WOUT + (size_t)l * DM * DM, scr, r, F.lane); }
    }
    const float* cvec = F.prm->in[1]; const float* cctx = F.prm->in[3]; const float* w_mod = F.prm->in[4];
    float* MODACC = (float*)(F.ws + WS_CTL + CTL_MODACC);
    constexpr int NMOD = 2 * 32 * 24;
    for (int it = F.gw; it < NMOD; it += F.NGW) {
        const int l = it / (32 * 24), rem = it % (32 * 24), ks = rem / 24, cb = rem % 24, k0 = ks * 64, n0 = cb * 256 + 4 * F.lane;
        scr[F.lane] = silu_f(cvec[k0 + F.lane]); scr[64 + F.lane] = silu_f(cvec[DM + k0 + F.lane]); scr[128 + F.lane] = silu_f(cctx[k0 + F.lane]);
        LDS_WAIT();
        f32x4 a0 = {0.f, 0.f, 0.f, 0.f}, a1 = a0, a2 = a0;
        const float* wp = w_mod + ((size_t)l * DM + k0) * 6144 + n0;
#pragma unroll 8
        for (int k = 0; k < 64; ++k) { const f32x4 w = *(const f32x4*)(wp + (size_t)k * 6144); a0 += w * scr[k]; a1 += w * scr[64 + k]; a2 += w * scr[128 + k]; }
        float* ma = MODACC + (size_t)(l * 3) * 6144 + n0;
#pragma unroll
        for (int e = 0; e < 4; ++e) { atomicAdd(ma + e, a0[e]); atomicAdd(ma + 6144 + e, a1[e]); atomicAdd(ma + 2 * 6144 + e, a2[e]); }
        LDS_WAIT();
    }
    if (F.bx == 0) {
        float* rope = (float*)(F.ws + WS_ROPE);
        for (int i = F.tid; i < 1024; i += NTHREADS) { const int pos = i >> 4, f = i & 15; const float inv = powf(10000.f, -(float)(2 * f) / 32.f); const float ang = (float)pos * inv;
            rope[i] = cosf(ang); rope[1024 + i] = sinf(ang); }
    }
}

__device__ __forceinline__ void ld_row(const float* p, int lane, f32x4* v) {
#pragma unroll
    for (int j = 0; j < 8; ++j) v[j] = *(const f32x4*)(p + 4 * lane + 256 * j);
}
__device__ __forceinline__ float sumsq8(const f32x4* v) { float s = 0.f;
#pragma unroll
    for (int j = 0; j < 8; ++j) s += (v[j].x * v[j].x + v[j].y * v[j].y) + (v[j].z * v[j].z + v[j].w * v[j].w);
    return s; }
__device__ __forceinline__ void ld_mod(const Ctx& F, int l, int r, int part, int lane, f32x4* v) {
    const float* ma = (const float*)(F.ws + WS_CTL + CTL_MODACC) + (size_t)(l * 3 + r) * 6144 + part * DM; const float* bm = F.prm->in[5] + (size_t)l * 6144 + part * DM;
#pragma unroll
    for (int j = 0; j < 8; ++j) v[j] = *(const f32x4*)(ma + 4 * lane + 256 * j) + *(const f32x4*)(bm + 4 * lane + 256 * j);
}
__device__ __forceinline__ void phase1(Ctx& F, int l) {
    const float* x = F.prm->in[0]; const float* ctx = F.prm->in[2]; const float* g_pre = F.prm->in[6] + (size_t)l * DM; const float* g_post0 = F.prm->in[7];
    const float* O = (const float*)(F.ws + WS_P); bf16* XN = (bf16*)(F.ws + WS_XN);
    for (int row = F.gw; row < MT; row += F.NGW) {
        const bool lat = row < ML; const int r = lat ? (row / TL) : 2;
        const float* src = lat ? x + (size_t)row * DM : ctx + (size_t)(row - ML) * DM;
        f32x4 xv[8]; ld_row(src, F.lane, xv);
        if (l == 1) {
            f32x4 ov[8], gt[8], gp[8]; ld_row(O + (size_t)row * DM, F.lane, ov); ld_mod(F, 0, r, 2, F.lane, gt); ld_row(g_post0, F.lane, gp);
            const float rs = 1.f / sqrtf(wave_sum(sumsq8(ov)) * (1.f / DM) + EPS);
#pragma unroll
            for (int j = 0; j < 8; ++j) xv[j] = xv[j] + gt[j] * (ov[j] * rs * gp[j]);
            if (lat) {
#pragma unroll
                for (int j = 0; j < 8; ++j) *(f32x4*)(F.out + (size_t)row * DM + 4 * F.lane + 256 * j) = xv[j];
            }
        }
        const float rs = 1.f / sqrtf(wave_sum(sumsq8(xv)) * (1.f / DM) + EPS);
        f32x4 sh[8], sc[8], g[8]; ld_mod(F, l, r, 0, F.lane, sh); ld_mod(F, l, r, 1, F.lane, sc); ld_row(g_pre, F.lane, g);
#pragma unroll
        for (int j = 0; j < 8; ++j) { const f32x4 h = (xv[j] * rs * g[j]) * (sc[j] + 1.f) + sh[j];
            u32x2 w; w.x = cvtpk(h.x, h.y); w.y = cvtpk(h.z, h.w); *(u32x2*)(XN + (size_t)row * DM + 4 * F.lane + 256 * j) = w; }
    }
}
__device__ __forceinline__ void phase6(Ctx& F) {
    const float* g_post1 = F.prm->in[7] + DM; const float* O = (const float*)(F.ws + WS_P);
    for (int row = F.gw; row < ML; row += F.NGW) {
        const int r = row / TL;
        f32x4 xv[8], ov[8], gt[8], gp[8]; ld_row(F.out + (size_t)row * DM, F.lane, xv); ld_row(O + (size_t)row * DM, F.lane, ov); ld_mod(F, 1, r, 2, F.lane, gt); ld_row(g_post1, F.lane, gp);
        const float rs = 1.f / sqrtf(wave_sum(sumsq8(ov)) * (1.f / DM) + EPS);
#pragma unroll
        for (int j = 0; j < 8; ++j) *(f32x4*)(F.out + (size_t)row * DM + 4 * F.lane + 256 * j) = xv[j] + gt[j] * (ov[j] * rs * gp[j]);
    }
}

__device__ __forceinline__ void sgu_item(Ctx& F, int l, int cb, int h) {
    const bf16* P = (const bf16*)(F.ws + WS_P); bf16* OC = (bf16*)(F.ws + WS_OC);
    const float* w_s = F.prm->in[10] + (size_t)(l * 4 + h) * 128 * 128; const float* b_s = F.prm->in[11] + (size_t)(l * 4 + h) * 128;
    const int row0 = cb < 64 ? (cb >> 5) * TL + (cb & 31) * 128 : ML + ((cb - 64) >> 1) * CL + ((cb - 64) & 1) * 128;
    LAS float* VN = (LAS float*)F.lds;
    LAS float* WT = (LAS float*)(F.lds + 65536);
    {
        const int row = F.tid >> 2, qt = F.tid & 3; const bf16* src = P + (size_t)(row0 + row) * NINP + A_V + h * 128 + qt * 32;
        float v[32];
#pragma unroll
        for (int i = 0; i < 4; ++i) unpack8(*(const u32x4*)(src + 8 * i), v + 8 * i);
        float s = 0.f;
#pragma unroll
        for (int i = 0; i < 32; ++i) s += v[i];
        const float mean = red4(s) * (1.f / 128.f); float q = 0.f;
#pragma unroll
        for (int i = 0; i < 32; ++i) { v[i] -= mean; q += v[i] * v[i]; }
        const float rstd = 1.f / sqrtf(red4(q) * (1.f / 128.f) + EPS);
#pragma unroll
        for (int i = 0; i < 8; ++i) *(LAS f32x4*)(VN + row * 128 + qt * 32 + 4 * i) = (f32x4){v[4 * i] * rstd, v[4 * i + 1] * rstd, v[4 * i + 2] * rstd, v[4 * i + 3] * rstd};
    }
    for (int idx = F.tid; idx < 4096; idx += NTHREADS) { const int p = idx >> 5, q4 = idx & 31; const f32x4 w = *(const f32x4*)(w_s + p * 128 + 4 * q4);
        WT[(4 * q4 + 0) * 128 + p] = w.x; WT[(4 * q4 + 1) * 128 + p] = w.y; WT[(4 * q4 + 2) * 128 + p] = w.z; WT[(4 * q4 + 3) * 128 + p] = w.w; }
    WG_BAR();
    const int pg = F.tid >> 5, dg = F.tid & 31;
    f32x4 acc[8];
#pragma unroll
    for (int i = 0; i < 8; ++i) acc[i] = (f32x4){0.f, 0.f, 0.f, 0.f};
#pragma unroll 4
    for (int q = 0; q < 128; ++q) {
        const f32x4 w0 = *(const LAS f32x4*)(WT + q * 128 + 8 * pg), w1 = *(const LAS f32x4*)(WT + q * 128 + 8 * pg + 4), vv = *(const LAS f32x4*)(VN + q * 128 + 4 * dg);
        acc[0] += vv * w0.x; acc[1] += vv * w0.y; acc[2] += vv * w0.z; acc[3] += vv * w0.w; acc[4] += vv * w1.x; acc[5] += vv * w1.y; acc[6] += vv * w1.z; acc[7] += vv * w1.w;
    }
#pragma unroll
    for (int i = 0; i < 8; ++i) { const int p = 8 * pg + i; const float bs = b_s[p]; const bf16* pr = P + (size_t)(row0 + p) * NINP + h * 128 + 4 * dg;
        const u32x2 uu = *(const u32x2*)(pr + A_U), gg = *(const u32x2*)(pr + A_G);
        const float o0 = bflo(uu.x) * (acc[i].x + bs) * silu_f(bflo(gg.x)), o1 = bfhi(uu.x) * (acc[i].y + bs) * silu_f(bfhi(gg.x));
        const float o2 = bflo(uu.y) * (acc[i].z + bs) * silu_f(bflo(gg.y)), o3 = bfhi(uu.y) * (acc[i].w + bs) * silu_f(bfhi(gg.y));
        u32x2 w; w.x = cvtpk(o0, o1); w.y = cvtpk(o2, o3); *(u32x2*)(OC + (size_t)(row0 + p) * DM + h * 128 + 4 * dg) = w; }
    WG_BAR();
}

__device__ __forceinline__ void conv_item(Ctx& F, int l, int item) {
    const bf16* P = (const bf16*)(F.ws + WS_P); bf16* OC = (bf16*)(F.ws + WS_OC); const float* cw = F.prm->in[27] + (size_t)l * 3 * 512;
    const int row = item * 16 + (F.tid >> 5), c0 = (F.tid & 31) * 16;
    int t, tlen; if (row < ML) { t = row & (TL - 1); tlen = TL; } else { t = (row - ML) & (CL - 1); tlen = CL; }
    const bf16* pr = P + (size_t)row * NINP;
    float z0[16], z1[16], z2[16], tmp[16];
#pragma unroll
    for (int i = 0; i < 2; ++i) {
        float a[8], b[8];
        unpack8(*(const u32x4*)(pr + D_C + c0 + 8 * i), a); unpack8(*(const u32x4*)(pr + D_X + c0 + 8 * i), b);
#pragma unroll
        for (int e = 0; e < 8; ++e) z1[8 * i + e] = a[e] * b[e];
        if (t > 0) { unpack8(*(const u32x4*)(pr - NINP + D_C + c0 + 8 * i), a); unpack8(*(const u32x4*)(pr - NINP + D_X + c0 + 8 * i), b);
#pragma unroll
            for (int e = 0; e < 8; ++e) z0[8 * i + e] = a[e] * b[e]; }
        else {
#pragma unroll
            for (int e = 0; e < 8; ++e) z0[8 * i + e] = 0.f; }
        if (t < tlen - 1) { unpack8(*(const u32x4*)(pr + NINP + D_C + c0 + 8 * i), a); unpack8(*(const u32x4*)(pr + NINP + D_X + c0 + 8 * i), b);
#pragma unroll
            for (int e = 0; e < 8; ++e) z2[8 * i + e] = a[e] * b[e]; }
        else {
#pragma unroll
            for (int e = 0; e < 8; ++e) z2[8 * i + e] = 0.f; }
    }
#pragma unroll
    for (int i = 0; i < 2; ++i) {
        float bg[8], gg[8]; unpack8(*(const u32x4*)(pr + D_B + c0 + 8 * i), bg); unpack8(*(const u32x4*)(pr + D_G + c0 + 8 * i), gg);
#pragma unroll
        for (int e = 0; e < 8; ++e) { const int c = c0 + 8 * i + e; const float y = cw[c] * z0[8 * i + e] + cw[512 + c] * z1[8 * i + e] + cw[1024 + c] * z2[8 * i + e]; tmp[e] = bg[e] * y * silu_f(gg[e]); }
        *(u32x4*)(OC + (size_t)row * DM + 1536 + c0 + 8 * i) = pack8(tmp);
    }
}

__device__ __forceinline__ void attnprep_item(Ctx& F, int l, int rb, int h) {
    const bf16* P = (const bf16*)(F.ws + WS_P); const float* rope = (const float*)(F.ws + WS_ROPE);
    bf16* QR = (bf16*)(F.ws + WS_QR); bf16* QC = (bf16*)(F.ws + WS_QC); bf16* KR = (bf16*)(F.ws + WS_KR); bf16* VT = (bf16*)(F.ws + WS_VT);
    const bool lat = rb < 128; const int b = lat ? (rb >> 6) : ((rb - 128) >> 2), t0 = lat ? (rb & 63) * 64 : ((rb - 128) & 3) * 64;
    const int row0 = lat ? b * TL + t0 : ML + b * CL + t0;
    {
        const int tk = F.tid >> 3, sub = F.tid & 7, isk = sub >> 2, hq = sub & 3, m = hq >> 1, half = hq & 1, t = t0 + tk;
        const bf16* src = P + (size_t)(row0 + tk) * NINP + (isk ? B_K : B_Q) + h * 128 + 32 * hq;
        float xx[32], oo[32];
#pragma unroll
        for (int i = 0; i < 4; ++i) unpack8(*(const u32x4*)(src + 8 * i), xx + 8 * i);
        if (lat) { const int pos = half ? (t & 63) : (t >> 6); const float* cs = rope + pos * 16; const float* sn = rope + 1024 + pos * 16;
#pragma unroll
            for (int i = 0; i < 16; ++i) { const float c = cs[i], s = sn[i]; oo[i] = xx[i] * c - xx[i + 16] * s; oo[i + 16] = xx[i + 16] * c + xx[i] * s; } }
        else {
#pragma unroll
            for (int i = 0; i < 32; ++i) oo[i] = xx[i]; }
        if (!isk) {
#pragma unroll
            for (int i = 0; i < 32; ++i) oo[i] *= QSCALE; }
        const int bhm = (b * 4 + h) * 2 + m;
        bf16* dst = isk ? KR + ((size_t)bhm * KEYS + (lat ? CL + t : t)) * 64 + 32 * half : (lat ? QR + ((size_t)bhm * TL + t) * 64 + 32 * half : QC + ((size_t)bhm * CL + t) * 64 + 32 * half);
        if (isk || lat || l == 0) {
#pragma unroll
            for (int i = 0; i < 4; ++i) *(u32x4*)(dst + 8 * i) = pack8(oo + 8 * i); }
    }
    LAS unsigned char* VL = F.lds;
#pragma unroll
    for (int pass = 0; pass < 2; ++pass) { const int idx = F.tid + 512 * pass, key = idx >> 4, c = idx & 15;
        *(LAS u32x4*)(VL + key * 272 + 16 * c) = *(const u32x4*)(P + (size_t)(row0 + key) * NINP + B_V + h * 128 + 8 * c); }
    WG_BAR();
    const int keybase = lat ? CL + t0 : t0;
#pragma unroll
    for (int pass = 0; pass < 2; ++pass) { const int idx = F.tid + 512 * pass, dv = idx >> 3, kc = idx & 7; unsigned short e[8];
#pragma unroll
        for (int i = 0; i < 8; ++i) e[i] = *(const LAS unsigned short*)(VL + (8 * kc + i) * 272 + 2 * dv);
        u32x4 o; o.x = e[0] | ((unsigned)e[1] << 16); o.y = e[2] | ((unsigned)e[3] << 16); o.z = e[4] | ((unsigned)e[5] << 16); o.w = e[6] | ((unsigned)e[7] << 16);
        *(u32x4*)(VT + ((size_t)(b * 4 + h) * 128 + dv) * KEYS + keybase + 8 * kc) = o; }
    WG_BAR();
}

constexpr int NCHUNK = NSTEP / 64;
constexpr int CHKB = 62464;
constexpr int CK_W1F = 0, CK_RF = 8192, CK_BTF = 16384, CK_ARBF = 24576, CK_ARKF = 30720, CK_VF = 36864, CK_W2A = 45056, CK_GA = 53248, CK_CLV = 61440;
static_assert((size_t)32 * NCHUNK * CHKB <= WS_Y - WS_CHK, "chunk records");

__device__ __forceinline__ bf16x8 frag16(const LAS unsigned char* tile, int row, int k0) { return *(const LAS bf16x8*)(tile + row * 144 + k0 * 2); }
__device__ __forceinline__ bf16x8 fragP(const LAS unsigned char* tile, int row, int base, int hh) {
    const u32x2 lo = *(const LAS u32x2*)(tile + row * 144 + (base + 4 * hh) * 2), hi = *(const LAS u32x2*)(tile + row * 144 + (base + 8 + 4 * hh) * 2);
    const u32x4 w = {lo.x, lo.y, hi.x, hi.y}; return __builtin_bit_cast(bf16x8, w);
}
template <int S8> __device__ __forceinline__ bf16x8 pk8(const f32x16& a) {
    const u32x4 w = {cvtpk(a[S8], a[S8 + 1]), cvtpk(a[S8 + 2], a[S8 + 3]), cvtpk(a[S8 + 4], a[S8 + 5]), cvtpk(a[S8 + 6], a[S8 + 7])}; return __builtin_bit_cast(bf16x8, w);
}
__device__ __forceinline__ f32x16 zero16() { f32x16 z;
#pragma unroll
    for (int r = 0; r < 16; ++r) z[r] = 0.f;
    return z; }
__device__ __forceinline__ f32x16 tile_prod(const LAS unsigned char* At, int m0, const LAS unsigned char* Bt, int n0, int l31, int hh) {
    f32x16 d = zero16();
#pragma unroll
    for (int q = 0; q < 4; ++q) d = __builtin_amdgcn_mfma_f32_32x32x16_bf16(frag16(At, m0 + l31, 16 * q + 8 * hh), frag16(Bt, n0 + l31, 16 * q + 8 * hh), d, 0, 0, 0);
    return d;
}
#define MROW(reg, hh) (((reg) & 3) + 8 * ((reg) >> 2) + 4 * (hh))
__device__ __forceinline__ void st_acc32(unsigned char* p, const f32x16& d) {
    *(u32x4*)p = (u32x4){cvtpk(d[0], d[1]), cvtpk(d[2], d[3]), cvtpk(d[4], d[5]), cvtpk(d[6], d[7])};
    *(u32x4*)(p + 16) = (u32x4){cvtpk(d[8], d[9]), cvtpk(d[10], d[11]), cvtpk(d[12], d[13]), cvtpk(d[14], d[15])};
}
__device__ __forceinline__ f32x16 ld_acc32(const LAS unsigned char* p) {
    const u32x4 a = *(const LAS u32x4*)p, b = *(const LAS u32x4*)(p + 16); f32x16 d;
    d[0] = bflo(a.x); d[1] = bfhi(a.x); d[2] = bflo(a.y); d[3] = bfhi(a.y); d[4] = bflo(a.z); d[5] = bfhi(a.z); d[6] = bflo(a.w); d[7] = bfhi(a.w);
    d[8] = bflo(b.x); d[9] = bfhi(b.x); d[10] = bflo(b.y); d[11] = bfhi(b.y); d[12] = bflo(b.z); d[13] = bfhi(b.z); d[14] = bflo(b.w); d[15] = bfhi(b.w); return d;
}
__device__ __forceinline__ float softplus_f(float x) { return fmaxf(x, 0.f) + log1pf(__expf(-fabsf(x))); }
__device__ __forceinline__ int scan_row(int c, int i, int dir, int b) {
    const bool isctx = c < 4; const int bi = (isctx ? 64 * c : 64 * (c - 4)) + i;
    return isctx ? ML + b * CL + (dir ? CL - 1 - bi : bi) : b * TL + (dir ? TL - 1 - bi : bi);
}

__device__ __forceinline__ void rwkv1_item(Ctx& F, int l, int item) {
    const int scan = item / NCHUNK, c = item % NCHUNK, dir = scan >> 4, b = (scan >> 3) & 1, h = scan & 7;
    const bf16* P = (const bf16*)(F.ws + WS_P); unsigned char* rec = F.ws + WS_CHK + (size_t)item * CHKB;
    bf16* BON = (bf16*)(F.ws + WS_BON) + (size_t)dir * MT * 512;
    LAS unsigned char* TA = F.lds; LAS unsigned char* TB = F.lds + 9216; LAS unsigned char* TK = F.lds + 18432; LAS unsigned char* TR = F.lds + 27648;
    LAS unsigned char* TAT = F.lds + 36864; LAS unsigned char* TBT = F.lds + 46080; LAS unsigned char* TKT = F.lds + 55296; LAS unsigned char* TVT = F.lds + 64512;
    LAS unsigned char* TT = F.lds + 73728;
    LAS float* AAB = (LAS float*)(F.lds + 82944);
    LAS float* CLS = (LAS float*)(F.lds + 100352);
    LAS float* W2S = (LAS float*)F.lds;
    LAS float* A2S = (LAS float*)(F.lds + 16384);
    LAS float* TW = (LAS float*)(F.lds + 24576);
    LAS float* ZA = (LAS float*)(F.lds + 41216);
    const int i = F.tid >> 3, sub = F.tid & 7, c0 = 8 * sub, gc0 = h * 64 + c0;
    const bool isctx = c < 4; const int bi = (isctx ? 64 * c : 64 * (c - 4)) + i;
    const int row = scan_row(c, i, dir, b);
    const bool hasprev = bi > 0;
    const bf16* pr = P + (size_t)row * NINP; const bf16* pp = dir ? pr + NINP : pr - NINP;
    const int pd = l * 2 + dir;
    const float* mu = F.prm->in[17] + (size_t)pd * 1632; const float* w0 = F.prm->in[18] + (size_t)pd * 512; const float* w2 = F.prm->in[19] + (size_t)pd * 64 * 512;
    const float* a0 = F.prm->in[20] + (size_t)pd * 512; const float* a2 = F.prm->in[21] + (size_t)pd * 32 * 512; const float* k_k = F.prm->in[22] + (size_t)pd * 512;
    const float* k_a = F.prm->in[23] + (size_t)pd * 512; const float* r_k = F.prm->in[24] + (size_t)pd * 512;
    const int CLX = dir == 0 ? C_LF : C_LB;
    const u32x4 zz4 = {0u, 0u, 0u, 0u}; const u32x2 zz2 = {0u, 0u};
    const u32x4 g_l = *(const u32x4*)(pr + CLX + c0), g_r = *(const u32x4*)(pr + C_R + gc0), g_k = *(const u32x4*)(pr + C_K + gc0), g_v = *(const u32x4*)(pr + C_V + gc0);
    const u32x2 g_a = *(const u32x2*)(pr + CLX + 64 + 4 * sub);
    u32x4 p_l = zz4, p_r = zz4, p_k = zz4, p_v = zz4; u32x2 p_a = zz2;
    if (hasprev) { p_l = *(const u32x4*)(pp + CLX + c0); p_r = *(const u32x4*)(pp + C_R + gc0); p_k = *(const u32x4*)(pp + C_K + gc0); p_v = *(const u32x4*)(pp + C_V + gc0); p_a = *(const u32x2*)(pp + CLX + 64 + 4 * sub); }
    f32x4 wv0, wv1, av0;
    { const int r0 = F.tid >> 4, c4 = F.tid & 15; wv0 = *(const f32x4*)(w2 + (size_t)r0 * 512 + h * 64 + 4 * c4); wv1 = *(const f32x4*)(w2 + (size_t)(r0 + 32) * 512 + h * 64 + 4 * c4); av0 = *(const f32x4*)(a2 + (size_t)r0 * 512 + h * 64 + 4 * c4);
      *(LAS f32x4*)(W2S + r0 * 64 + 4 * c4) = wv0; *(LAS f32x4*)(W2S + (r0 + 32) * 64 + 4 * c4) = wv1; *(LAS f32x4*)(A2S + r0 * 64 + 4 * c4) = av0; }
    {   float f[8], pv[8]; unpack8(g_l, f); unpack8(p_l, pv);
#pragma unroll
        for (int e = 0; e < 8; ++e) { const float z = f[e] + (pv[e] - f[e]) * mu[1536 + c0 + e]; const float ez = __expf(-2.f * fabsf(z)); const float th = (1.f - ez) / (1.f + ez); TW[i * 65 + c0 + e] = z < 0.f ? -th : th; }
        const float fz[4] = {bflo(g_a.x), bfhi(g_a.x), bflo(g_a.y), bfhi(g_a.y)}, pz[4] = {bflo(p_a.x), bfhi(p_a.x), bflo(p_a.y), bfhi(p_a.y)};
#pragma unroll
        for (int e = 0; e < 4; ++e) ZA[i * 33 + 4 * sub + e] = fz[e] + (pz[e] - fz[e]) * mu[1600 + 4 * sub + e];
    }
    WG_BAR();
    float wp[8], ap[8];
#pragma unroll
    for (int e = 0; e < 8; ++e) { wp[e] = w0[gc0 + e]; ap[e] = a0[gc0 + e]; }
#pragma unroll 4
    for (int q = 0; q < 64; ++q) { const float tw = TW[i * 65 + q]; const f32x4 u0 = *(const LAS f32x4*)(W2S + q * 64 + c0), u1 = *(const LAS f32x4*)(W2S + q * 64 + c0 + 4);
        wp[0] += tw * u0.x; wp[1] += tw * u0.y; wp[2] += tw * u0.z; wp[3] += tw * u0.w; wp[4] += tw * u1.x; wp[5] += tw * u1.y; wp[6] += tw * u1.z; wp[7] += tw * u1.w; }
#pragma unroll 4
    for (int q = 0; q < 32; ++q) { const float za = ZA[i * 33 + q]; const f32x4 u0 = *(const LAS f32x4*)(A2S + q * 64 + c0), u1 = *(const LAS f32x4*)(A2S + q * 64 + c0 + 4);
        ap[0] += za * u0.x; ap[1] += za * u0.y; ap[2] += za * u0.z; ap[3] += za * u0.w; ap[4] += za * u1.x; ap[5] += za * u1.y; ap[6] += za * u1.z; ap[7] += za * u1.w; }
    float lw[8], kk[8], al[8], km[8], rr[8], vv[8];
    {   float fr[8], fk[8], fv[8], qr[8], qk[8], qv[8]; unpack8(g_r, fr); unpack8(g_k, fk); unpack8(g_v, fv); unpack8(p_r, qr); unpack8(p_k, qk); unpack8(p_v, qv);
        float n2 = 0.f, bsum = 0.f;
#pragma unroll
        for (int e = 0; e < 8; ++e) { const int gc = gc0 + e;
            rr[e] = fr[e] + (qr[e] - fr[e]) * mu[gc]; const float kx = fk[e] + (qk[e] - fk[e]) * mu[512 + gc]; vv[e] = fv[e] + (qv[e] - fv[e]) * mu[1024 + gc];
            const float w = -softplus_f(-wp[e]) - 0.5f; lw[e] = -__expf(w);
            al[e] = 1.f / (1.f + __expf(-ap[e]));
            kk[e] = kx * k_k[gc]; n2 += kk[e] * kk[e];
            km[e] = kx * (1.f + (al[e] - 1.f) * k_a[gc]);
            bsum += rr[e] * km[e] * r_k[gc]; }
        n2 = red8(n2); bsum = red8(bsum);
        const float inv = 1.f / fmaxf(sqrtf(n2), 1e-12f); float bon[8];
#pragma unroll
        for (int e = 0; e < 8; ++e) { kk[e] *= inv; bon[e] = bsum * vv[e]; }
        *(u32x4*)(BON + (size_t)row * 512 + gc0) = pack8(bon);
    }
    *(LAS f32x4*)(CLS + i * 64 + c0) = (f32x4){lw[0], lw[1], lw[2], lw[3]}; *(LAS f32x4*)(CLS + i * 64 + c0 + 4) = (f32x4){lw[4], lw[5], lw[6], lw[7]};
    WG_BAR();
    if (F.tid < 64) {
        float x[64];
#pragma unroll
        for (int q = 0; q < 64; ++q) x[q] = CLS[q * 64 + F.tid];
#pragma unroll
        for (int q = 1; q < 64; ++q) x[q] += x[q - 1];
#pragma unroll
        for (int q = 0; q < 64; ++q) CLS[q * 64 + F.tid] = x[q];
    }
    WG_BAR();
    {   float cl[8], cL[8];
        { const f32x4 a = *(const LAS f32x4*)(CLS + i * 64 + c0), bq = *(const LAS f32x4*)(CLS + i * 64 + c0 + 4), cc = *(const LAS f32x4*)(CLS + 63 * 64 + c0), dd = *(const LAS f32x4*)(CLS + 63 * 64 + c0 + 4);
          cl[0] = a.x; cl[1] = a.y; cl[2] = a.z; cl[3] = a.w; cl[4] = bq.x; cl[5] = bq.y; cl[6] = bq.z; cl[7] = bq.w; cL[0] = cc.x; cL[1] = cc.y; cL[2] = cc.z; cL[3] = cc.w; cL[4] = dd.x; cL[5] = dd.y; cL[6] = dd.z; cL[7] = dd.w; }
        float tA[8], tB[8], tK[8], tR[8], tBt[8], tKt[8];
#pragma unroll
        for (int e = 0; e < 8; ++e) { const float eA = __expf(cl[e] - lw[e]), eI = __expf(-cl[e]), eR = __expf(cl[e]), eT = __expf(cL[e] - cl[e]); const float ba = kk[e] * al[e];
            tA[e] = -kk[e] * eA; tB[e] = ba * eI; tK[e] = km[e] * eI; tR[e] = rr[e] * eR; tBt[e] = ba * eT; tKt[e] = km[e] * eT; }
        *(LAS u32x4*)(TA + i * 144 + 2 * c0) = pack8(tA); *(LAS u32x4*)(TB + i * 144 + 2 * c0) = pack8(tB); *(LAS u32x4*)(TK + i * 144 + 2 * c0) = pack8(tK); *(LAS u32x4*)(TR + i * 144 + 2 * c0) = pack8(tR);
        const u32x4 qa = pack8(tA), qb = pack8(tBt), qk = pack8(tKt), qv = pack8(vv);
        const unsigned wa[4] = {qa.x, qa.y, qa.z, qa.w}, wb[4] = {qb.x, qb.y, qb.z, qb.w}, wk[4] = {qk.x, qk.y, qk.z, qk.w}, wv[4] = {qv.x, qv.y, qv.z, qv.w};
#pragma unroll
        for (int e = 0; e < 8; ++e) { const int sh = (e & 1) * 16; const int o = (c0 + e) * 144 + 2 * i;
            *(LAS unsigned short*)(TAT + o) = (unsigned short)(wa[e >> 1] >> sh); *(LAS unsigned short*)(TBT + o) = (unsigned short)(wb[e >> 1] >> sh);
            *(LAS unsigned short*)(TKT + o) = (unsigned short)(wk[e >> 1] >> sh); *(LAS unsigned short*)(TVT + o) = (unsigned short)(wv[e >> 1] >> sh); }
    }
    WG_BAR();
    const int l31 = F.lane & 31, hh = F.lane >> 5;
    if (F.wave < 3) { const int it = F.wave > 0, jt = F.wave > 1; const f32x16 d = tile_prod(TA, 32 * it, TB, 32 * jt, l31, hh);
#pragma unroll
        for (int r = 0; r < 16; ++r) { const int ii = 32 * it + MROW(r, hh), j = 32 * jt + l31; AAB[ii * 68 + (j & 7) * 8 + (j >> 3)] = j < ii ? d[r] : 0.f; } }
    else if (F.wave == 3) {
#pragma unroll
        for (int r = 0; r < 16; ++r) AAB[(2 * r + hh) * 68 + (l31 & 7) * 8 + 4 + (l31 >> 3)] = 0.f; }
    else if (F.wave == 4) {
#pragma unroll
        for (int f = 0; f < 8; ++f) { const int it = f >> 2, kt = (f >> 1) & 1, s = f & 1; *(bf16x8*)(rec + CK_RF + (f * 64 + F.lane) * 16) = fragP(TR, 32 * it + l31, 32 * kt + 16 * s, hh); } }
    else if (F.wave == 5) {
#pragma unroll
        for (int f = 0; f < 8; ++f) { const int kt = f >> 2, jt = (f >> 1) & 1, s = f & 1; *(bf16x8*)(rec + CK_BTF + (f * 64 + F.lane) * 16) = fragP(TBT, 32 * kt + l31, 32 * jt + 16 * s, hh); } }
    else if (F.wave == 6) {
#pragma unroll
        for (int f = 0; f < 8; ++f) { const int vt = f >> 2, jt = (f >> 1) & 1, s = f & 1; *(bf16x8*)(rec + CK_VF + (f * 64 + F.lane) * 16) = fragP(TVT, 32 * vt + l31, 32 * jt + 16 * s, hh); } }
    else { *(float*)(rec + CK_CLV + 4 * F.lane) = __expf(CLS[63 * 64 + F.lane]); }
    WG_BAR();
    {   const int col = F.tid >> 3; int dg = col; float town[8];
#pragma unroll
        for (int q = 0; q < 8; ++q) town[q] = 0.f;
        const LAS float* arow = AAB + sub * 8; asm volatile("" : "+v"(arow));
        LAS unsigned char* ttw = TT + 2 * col; asm volatile("" : "+v"(ttw));
#pragma unroll
        for (int q = 0; q < 8; ++q)
#pragma unroll
            for (int r = 0; r < 8; ++r) { const int ii = 8 * q + r;
                const f32x4 a0 = *(const LAS f32x4*)(arow + ii * 68), a1 = *(const LAS f32x4*)(arow + ii * 68 + 4);
                float p = a0.x * town[0];
                if (q >= 1) p += a0.y * town[1]; if (q >= 2) p += a0.z * town[2]; if (q >= 3) p += a0.w * town[3];
                if (q >= 4) p += a1.x * town[4]; if (q >= 5) p += a1.y * town[5]; if (q >= 6) p += a1.z * town[6]; if (q >= 7) p += a1.w * town[7];
                p = red8(p);
                const float tv = p + ((dg == 0) ? 1.f : 0.f); dg -= 1; asm volatile("" : "+v"(dg));
                town[q] = (sub == r) ? tv : town[q];
                if (sub == r) *(LAS unsigned short*)(ttw + ii * 144) = (unsigned short)cvtpk(tv, 0.f);
            }
    }
    f32x16 X0 = zero16(), X1 = zero16();
    if (F.wave == 0) {
    } else if (F.wave <= 2) {
        const int vt = F.wave - 1;
        f32x16 a00 = tile_prod(TK, 0, TA, 0, l31, hh), a11 = tile_prod(TK, 32, TA, 32, l31, hh); const f32x16 a01 = tile_prod(TK, 0, TA, 32, l31, hh);
#pragma unroll
        for (int r = 0; r < 16; ++r) { const bool keep = MROW(r, hh) < l31; a00[r] = keep ? a00[r] : 0.f; a11[r] = keep ? a11[r] : 0.f; }
        X0 = __builtin_amdgcn_mfma_f32_32x32x16_bf16(pk8<0>(a00), fragP(TVT, 32 * vt + l31, 0, hh), X0, 0, 0, 0);
        X0 = __builtin_amdgcn_mfma_f32_32x32x16_bf16(pk8<8>(a00), fragP(TVT, 32 * vt + l31, 16, hh), X0, 0, 0, 0);
        X1 = __builtin_amdgcn_mfma_f32_32x32x16_bf16(pk8<0>(a01), fragP(TVT, 32 * vt + l31, 0, hh), X1, 0, 0, 0);
        X1 = __builtin_amdgcn_mfma_f32_32x32x16_bf16(pk8<8>(a01), fragP(TVT, 32 * vt + l31, 16, hh), X1, 0, 0, 0);
        X1 = __builtin_amdgcn_mfma_f32_32x32x16_bf16(pk8<0>(a11), fragP(TVT, 32 * vt + l31, 32, hh), X1, 0, 0, 0);
        X1 = __builtin_amdgcn_mfma_f32_32x32x16_bf16(pk8<8>(a11), fragP(TVT, 32 * vt + l31, 48, hh), X1, 0, 0, 0);
    } else if (F.wave <= 4) {
        const LAS unsigned char* Tm = F.wave == 3 ? TB : TK; unsigned char* dst = rec + (F.wave == 3 ? CK_ARBF : CK_ARKF);
#pragma unroll
        for (int blk = 0; blk < 3; ++blk) { const int it = blk > 0, jt = blk > 1; f32x16 d = tile_prod(Tm, 32 * jt, TR, 32 * it, l31, hh);
            if (it == jt) {
#pragma unroll
                for (int r = 0; r < 16; ++r) d[r] = MROW(r, hh) <= l31 ? d[r] : 0.f; }
            *(bf16x8*)(dst + ((blk * 2 + 0) * 64 + F.lane) * 16) = pk8<0>(d); *(bf16x8*)(dst + ((blk * 2 + 1) * 64 + F.lane) * 16) = pk8<8>(d); }
    } else if (F.wave <= 6) {
        const int kt = F.wave - 5;
#pragma unroll
        for (int vt = 0; vt < 2; ++vt) { const f32x16 d = tile_prod(TKT, 32 * kt, TVT, 32 * vt, l31, hh); st_acc32(rec + CK_GA + ((kt * 2 + vt) * 64 + F.lane) * 32, d); }
    }
    WG_BAR();
    if (F.wave == 1 || F.wave == 2) { const int vt = F.wave - 1;
        f32x16 w0a = zero16(), w1a = zero16();
        w0a = __builtin_amdgcn_mfma_f32_32x32x16_bf16(fragP(TT, l31, 0, hh), pk8<0>(X0), w0a, 0, 0, 0);
        w0a = __builtin_amdgcn_mfma_f32_32x32x16_bf16(fragP(TT, l31, 16, hh), pk8<8>(X0), w0a, 0, 0, 0);
        w1a = __builtin_amdgcn_mfma_f32_32x32x16_bf16(fragP(TT, 32 + l31, 0, hh), pk8<0>(X0), w1a, 0, 0, 0);
        w1a = __builtin_amdgcn_mfma_f32_32x32x16_bf16(fragP(TT, 32 + l31, 16, hh), pk8<8>(X0), w1a, 0, 0, 0);
        w1a = __builtin_amdgcn_mfma_f32_32x32x16_bf16(fragP(TT, 32 + l31, 32, hh), pk8<0>(X1), w1a, 0, 0, 0);
        w1a = __builtin_amdgcn_mfma_f32_32x32x16_bf16(fragP(TT, 32 + l31, 48, hh), pk8<8>(X1), w1a, 0, 0, 0);
        st_acc32(rec + CK_W2A + ((0 * 2 + vt) * 64 + F.lane) * 32, w0a); st_acc32(rec + CK_W2A + ((1 * 2 + vt) * 64 + F.lane) * 32, w1a);
    } else if (F.wave >= 3 && F.wave <= 6) { const int kt = (F.wave - 3) >> 1, it = (F.wave - 3) & 1;
        const f32x16 d = tile_prod(TAT, 32 * kt, TT, 32 * it, l31, hh);
        *(bf16x8*)(rec + CK_W1F + ((((it * 2 + kt) * 2) + 0) * 64 + F.lane) * 16) = pk8<0>(d); *(bf16x8*)(rec + CK_W1F + ((((it * 2 + kt) * 2) + 1) * 64 + F.lane) * 16) = pk8<8>(d);
    }
    WG_BAR();
}

__device__ __forceinline__ void rwkv2_role(Ctx& F) {
    const int scan = F.bx, dir = scan >> 4, b = (scan >> 3) & 1, h = scan & 7;
    const unsigned char* recs = F.ws + WS_CHK + (size_t)scan * NCHUNK * CHKB;
    float* Y = (float*)(F.ws + WS_Y) + (size_t)dir * MT * 512 + h * 64;
    const int l31 = F.lane & 31, hh = F.lane >> 5, vt = F.wave;
    const bool comp = F.wave < 2;
    auto dma = [&](int c) {
        for (int p = F.wave - 2; p < CHKB / 1024; p += 6)
            __builtin_amdgcn_global_load_lds((const unsigned*)(recs + (size_t)c * CHKB + p * 1024 + F.lane * 16), (LAS unsigned*)(F.lds + (c & 1) * CHKB + p * 1024), 16, 0, 0);
    };
    f32x16 S0 = zero16(), S1 = zero16();
    if (!comp) { dma(0); asm volatile("s_waitcnt vmcnt(0)" ::: "memory"); }
    WG_BAR();
    for (int c = 0; c < NCHUNK; ++c) {
        if (comp) {
            const LAS unsigned char* buf = F.lds + (c & 1) * CHKB; const LAS unsigned char* lf = buf + F.lane * 16;
#define FR(off, idx) (*(const LAS bf16x8*)(lf + (off) + (idx) * 1024))
            const bf16x8 sb00 = pk8<0>(S0), sb01 = pk8<8>(S0), sb10 = pk8<0>(S1), sb11 = pk8<8>(S1);
            f32x16 U0 = ld_acc32(buf + CK_W2A + ((0 * 2 + vt) * 64 + F.lane) * 32), U1 = ld_acc32(buf + CK_W2A + ((1 * 2 + vt) * 64 + F.lane) * 32);
            U0 = __builtin_amdgcn_mfma_f32_32x32x16_bf16(FR(CK_W1F, 0), sb00, U0, 0, 0, 0); U0 = __builtin_amdgcn_mfma_f32_32x32x16_bf16(FR(CK_W1F, 1), sb01, U0, 0, 0, 0);
            U0 = __builtin_amdgcn_mfma_f32_32x32x16_bf16(FR(CK_W1F, 2), sb10, U0, 0, 0, 0); U0 = __builtin_amdgcn_mfma_f32_32x32x16_bf16(FR(CK_W1F, 3), sb11, U0, 0, 0, 0);
            U1 = __builtin_amdgcn_mfma_f32_32x32x16_bf16(FR(CK_W1F, 4), sb00, U1, 0, 0, 0); U1 = __builtin_amdgcn_mfma_f32_32x32x16_bf16(FR(CK_W1F, 5), sb01, U1, 0, 0, 0);
            U1 = __builtin_amdgcn_mfma_f32_32x32x16_bf16(FR(CK_W1F, 6), sb10, U1, 0, 0, 0); U1 = __builtin_amdgcn_mfma_f32_32x32x16_bf16(FR(CK_W1F, 7), sb11, U1, 0, 0, 0);
            const bf16x8 ub00 = pk8<0>(U0), ub01 = pk8<8>(U0), ub10 = pk8<0>(U1), ub11 = pk8<8>(U1);
            f32x16 Y0 = zero16(), Y1 = zero16();
            Y0 = __builtin_amdgcn_mfma_f32_32x32x16_bf16(FR(CK_RF, 0), sb00, Y0, 0, 0, 0); Y0 = __builtin_amdgcn_mfma_f32_32x32x16_bf16(FR(CK_RF, 1), sb01, Y0, 0, 0, 0);
            Y0 = __builtin_amdgcn_mfma_f32_32x32x16_bf16(FR(CK_RF, 2), sb10, Y0, 0, 0, 0); Y0 = __builtin_amdgcn_mfma_f32_32x32x16_bf16(FR(CK_RF, 3), sb11, Y0, 0, 0, 0);
            Y1 = __builtin_amdgcn_mfma_f32_32x32x16_bf16(FR(CK_RF, 4), sb00, Y1, 0, 0, 0); Y1 = __builtin_amdgcn_mfma_f32_32x32x16_bf16(FR(CK_RF, 5), sb01, Y1, 0, 0, 0);
            Y1 = __builtin_amdgcn_mfma_f32_32x32x16_bf16(FR(CK_RF, 6), sb10, Y1, 0, 0, 0); Y1 = __builtin_amdgcn_mfma_f32_32x32x16_bf16(FR(CK_RF, 7), sb11, Y1, 0, 0, 0);
            Y0 = __builtin_amdgcn_mfma_f32_32x32x16_bf16(FR(CK_ARBF, 0), ub00, Y0, 0, 0, 0); Y0 = __builtin_amdgcn_mfma_f32_32x32x16_bf16(FR(CK_ARBF, 1), ub01, Y0, 0, 0, 0);
            Y1 = __builtin_amdgcn_mfma_f32_32x32x16_bf16(FR(CK_ARBF, 2), ub00, Y1, 0, 0, 0); Y1 = __builtin_amdgcn_mfma_f32_32x32x16_bf16(FR(CK_ARBF, 3), ub01, Y1, 0, 0, 0);
            Y1 = __builtin_amdgcn_mfma_f32_32x32x16_bf16(FR(CK_ARBF, 4), ub10, Y1, 0, 0, 0); Y1 = __builtin_amdgcn_mfma_f32_32x32x16_bf16(FR(CK_ARBF, 5), ub11, Y1, 0, 0, 0);
            { const bf16x8 v00 = FR(CK_VF, (vt * 2 + 0) * 2 + 0), v01 = FR(CK_VF, (vt * 2 + 0) * 2 + 1), v10 = FR(CK_VF, (vt * 2 + 1) * 2 + 0), v11 = FR(CK_VF, (vt * 2 + 1) * 2 + 1);
              Y0 = __builtin_amdgcn_mfma_f32_32x32x16_bf16(FR(CK_ARKF, 0), v00, Y0, 0, 0, 0); Y0 = __builtin_amdgcn_mfma_f32_32x32x16_bf16(FR(CK_ARKF, 1), v01, Y0, 0, 0, 0);
              Y1 = __builtin_amdgcn_mfma_f32_32x32x16_bf16(FR(CK_ARKF, 2), v00, Y1, 0, 0, 0); Y1 = __builtin_amdgcn_mfma_f32_32x32x16_bf16(FR(CK_ARKF, 3), v01, Y1, 0, 0, 0);
              Y1 = __builtin_amdgcn_mfma_f32_32x32x16_bf16(FR(CK_ARKF, 4), v10, Y1, 0, 0, 0); Y1 = __builtin_amdgcn_mfma_f32_32x32x16_bf16(FR(CK_ARKF, 5), v11, Y1, 0, 0, 0); }
            { const LAS float* clv = (const LAS float*)(buf + CK_CLV);
              const f32x16 g0 = ld_acc32(buf + CK_GA + ((0 * 2 + vt) * 64 + F.lane) * 32), g1 = ld_acc32(buf + CK_GA + ((1 * 2 + vt) * 64 + F.lane) * 32);
#pragma unroll
              for (int g = 0; g < 4; ++g) { const f32x4 ca = *(const LAS f32x4*)(clv + 8 * g + 4 * hh), cb = *(const LAS f32x4*)(clv + 32 + 8 * g + 4 * hh);
#pragma unroll
                  for (int e = 0; e < 4; ++e) { S0[4 * g + e] = S0[4 * g + e] * ca[e] + g0[4 * g + e]; S1[4 * g + e] = S1[4 * g + e] * cb[e] + g1[4 * g + e]; } } }
            S0 = __builtin_amdgcn_mfma_f32_32x32x16_bf16(FR(CK_BTF, 0), ub00, S0, 0, 0, 0); S0 = __builtin_amdgcn_mfma_f32_32x32x16_bf16(FR(CK_BTF, 1), ub01, S0, 0, 0, 0);
            S0 = __builtin_amdgcn_mfma_f32_32x32x16_bf16(FR(CK_BTF, 2), ub10, S0, 0, 0, 0); S0 = __builtin_amdgcn_mfma_f32_32x32x16_bf16(FR(CK_BTF, 3), ub11, S0, 0, 0, 0);
            S1 = __builtin_amdgcn_mfma_f32_32x32x16_bf16(FR(CK_BTF, 4), ub00, S1, 0, 0, 0); S1 = __builtin_amdgcn_mfma_f32_32x32x16_bf16(FR(CK_BTF, 5), ub01, S1, 0, 0, 0);
            S1 = __builtin_amdgcn_mfma_f32_32x32x16_bf16(FR(CK_BTF, 6), ub10, S1, 0, 0, 0); S1 = __builtin_amdgcn_mfma_f32_32x32x16_bf16(FR(CK_BTF, 7), ub11, S1, 0, 0, 0);
#undef FR
#pragma unroll
            for (int r = 0; r < 16; ++r) { const int i0 = MROW(r, hh);
                Y[(size_t)scan_row(c, i0, dir, b) * 512 + 32 * vt + l31] = Y0[r]; Y[(size_t)scan_row(c, 32 + i0, dir, b) * 512 + 32 * vt + l31] = Y1[r]; }
        } else {
            if (c + 1 < NCHUNK) dma(c + 1);
            asm volatile("s_waitcnt vmcnt(0)" ::: "memory");
        }
        WG_BAR();
    }
}

#ifndef R_SGU
#define R_SGU 1
#endif
#ifndef R_R1
#define R_R1 1
#endif
#ifndef R_R2
#define R_R2 1
#endif
#ifndef R_AP
#define R_AP 1
#endif
#ifndef R_CV
#define R_CV 1
#endif
__device__ __forceinline__ void phase3a(Ctx& F, int l) {
    for (int it = F.bx; it < 32 * NCHUNK; it += F.G) for (int q_ = 0; q_ < R_R1; ++q_) rwkv1_item(F, l, it);
}
__device__ __forceinline__ void phase3b(Ctx& F, int l) {
    if (F.bx < 32) { for (int q_ = 0; q_ < R_R2; ++q_) rwkv2_role(F); return; }
    const int nsgu = (l == 0 ? 68 : 64) * 4, nap = 136 * 4, ncv = (l == 0 ? MT : ML) / 16;
    const int total = nsgu + nap + ncv;
    for (int it = F.bx - 32; it < total; it += F.G - 32) {
        int r = it;
        if (r < nsgu) { for (int q_ = 0; q_ < R_SGU; ++q_) sgu_item(F, l, r >> 2, r & 3); continue; } r -= nsgu;
        if (r < nap) { for (int q_ = 0; q_ < R_AP; ++q_) attnprep_item(F, l, r >> 2, r & 3); continue; } r -= nap;
        for (int q_ = 0; q_ < R_CV; ++q_) conv_item(F, l, r);
    }
}

__device__ __forceinline__ void attn_unit(Ctx& F, const bf16* Qp, const bf16* Kp, const bf16* Vtp, int nkt, float* Op) {
    constexpr int KB = 9216, TB = 27648;
    const int j = F.lane & 31, hh = F.lane >> 5;
    bf16x8 qf[4];
#pragma unroll
    for (int ks = 0; ks < 4; ++ks) qf[ks] = *(const bf16x8*)(Qp + (size_t)(F.wave * 32 + j) * 64 + ks * 16 + hh * 8);
    const int kkey = F.tid >> 3, kch = F.tid & 7;
    const bf16* ksrc = Kp + (size_t)kkey * 64 + kch * 8;
    const bf16* vsrc0 = Vtp + (size_t)(F.tid >> 3) * KEYS + kch * 8; const bf16* vsrc1 = vsrc0 + (size_t)64 * KEYS;
    const int kdst = kkey * 144 + kch * 16, vdst0 = KB + (F.tid >> 3) * 144 + kch * 16, vdst1 = vdst0 + 64 * 144;
    u32x4 rk, rv0, rv1;
    rk = *(const u32x4*)ksrc; rv0 = *(const u32x4*)vsrc0; rv1 = *(const u32x4*)vsrc1;
    *(LAS u32x4*)(F.lds + kdst) = rk; *(LAS u32x4*)(F.lds + vdst0) = rv0; *(LAS u32x4*)(F.lds + vdst1) = rv1;
    WG_BAR();
    const int sw = (j & ~12) | ((j & 4) << 1) | ((j & 8) >> 1);
    const int ka0 = sw * 144 + hh * 16, ka1 = (32 + sw) * 144 + hh * 16, va = KB + j * 144 + hh * 16;
    f32x16 acc[4];
#pragma unroll
    for (int i = 0; i < 4; ++i)
#pragma unroll
        for (int r = 0; r < 16; ++r) acc[i][r] = 0.f;
    float m_run = -1e30f, l_run = 0.f;
    for (int kt = 0; kt < nkt; ++kt) {
        const LAS unsigned char* buf = F.lds + (kt & 1) * TB;
        if (kt + 1 < nkt) { rk = *(const u32x4*)(ksrc + (size_t)(kt + 1) * 64 * 64); rv0 = *(const u32x4*)(vsrc0 + (kt + 1) * 64); rv1 = *(const u32x4*)(vsrc1 + (kt + 1) * 64); }
        f32x16 s0, s1;
#pragma unroll
        for (int r = 0; r < 16; ++r) { s0[r] = 0.f; s1[r] = 0.f; }
#pragma unroll
        for (int ks = 0; ks < 4; ++ks) {
            const bf16x8 a0 = *(const LAS bf16x8*)(buf + ka0 + ks * 32), a1 = *(const LAS bf16x8*)(buf + ka1 + ks * 32);
            s0 = __builtin_amdgcn_mfma_f32_32x32x16_bf16(a0, qf[ks], s0, 0, 0, 0);
            s1 = __builtin_amdgcn_mfma_f32_32x32x16_bf16(a1, qf[ks], s1, 0, 0, 0);
        }
        float mx = fmaxf(s0[0], s1[0]);
#pragma unroll
        for (int r = 1; r < 16; ++r) mx = fmaxf(mx, fmaxf(s0[r], s1[r]));
        mx = fmaxf(mx, __shfl_xor(mx, 32));
        const float m_new = fmaxf(m_run, mx), alpha = __builtin_amdgcn_exp2f(m_run - m_new);
        m_run = m_new;
        float ls = 0.f;
#pragma unroll
        for (int r = 0; r < 16; ++r) { s0[r] = __builtin_amdgcn_exp2f(s0[r] - m_new); s1[r] = __builtin_amdgcn_exp2f(s1[r] - m_new); ls += s0[r] + s1[r]; }
        l_run = l_run * alpha + ls;
#pragma unroll
        for (int i = 0; i < 4; ++i)
#pragma unroll
            for (int r = 0; r < 16; ++r) acc[i][r] *= alpha;
        bf16x8 pf[4];
        { u32x4 w;
          w.x = cvtpk(s0[0], s0[1]); w.y = cvtpk(s0[2], s0[3]); w.z = cvtpk(s0[4], s0[5]); w.w = cvtpk(s0[6], s0[7]); pf[0] = __builtin_bit_cast(bf16x8, w);
          w.x = cvtpk(s0[8], s0[9]); w.y = cvtpk(s0[10], s0[11]); w.z = cvtpk(s0[12], s0[13]); w.w = cvtpk(s0[14], s0[15]); pf[1] = __builtin_bit_cast(bf16x8, w);
          w.x = cvtpk(s1[0], s1[1]); w.y = cvtpk(s1[2], s1[3]); w.z = cvtpk(s1[4], s1[5]); w.w = cvtpk(s1[6], s1[7]); pf[2] = __builtin_bit_cast(bf16x8, w);
          w.x = cvtpk(s1[8], s1[9]); w.y = cvtpk(s1[10], s1[11]); w.z = cvtpk(s1[12], s1[13]); w.w = cvtpk(s1[14], s1[15]); pf[3] = __builtin_bit_cast(bf16x8, w); }
#pragma unroll
        for (int blk = 0; blk < 4; ++blk)
#pragma unroll
            for (int kstep = 0; kstep < 4; ++kstep) {
                const bf16x8 a = *(const LAS bf16x8*)(buf + va + blk * 32 * 144 + kstep * 32);
                acc[blk] = __builtin_amdgcn_mfma_f32_32x32x16_bf16(a, pf[kstep], acc[blk], 0, 0, 0);
            }
        if (kt + 1 < nkt) { LAS unsigned char* nb = F.lds + ((kt + 1) & 1) * TB; *(LAS u32x4*)(nb + kdst) = rk; *(LAS u32x4*)(nb + vdst0) = rv0; *(LAS u32x4*)(nb + vdst1) = rv1; }
        WG_BAR();
    }
    const float inv = 1.f / (l_run + __shfl_xor(l_run, 32));
    float* orow = Op + (size_t)(F.wave * 32 + j) * 1024 + 4 * hh;
#pragma unroll
    for (int blk = 0; blk < 4; ++blk)
#pragma unroll
        for (int g = 0; g < 4; ++g) *(f32x4*)(orow + 32 * blk + 8 * g) = (f32x4){acc[blk][4 * g] * inv, acc[blk][4 * g + 1] * inv, acc[blk][4 * g + 2] * inv, acc[blk][4 * g + 3] * inv};
}

__device__ __forceinline__ void attn_role(Ctx& F, int l) {
    const int bh = F.bx & 7, m = (F.bx >> 3) & 1, k = F.bx >> 4, b = bh >> 2, h = bh & 3;
    const bf16* QR = (const bf16*)(F.ws + WS_QR); const bf16* QC = (const bf16*)(F.ws + WS_QC); const bf16* KR = (const bf16*)(F.ws + WS_KR); const bf16* VT = (const bf16*)(F.ws + WS_VT);
    float* OATT = (float*)(F.ws + WS_XN);
    const bf16* Vtp = VT + (size_t)bh * 128 * KEYS;
    { const int bhm = bh * 2 + m;
      attn_unit(F, QR + ((size_t)bhm * TL + k * 256) * 64, KR + (size_t)bhm * KEYS * 64, Vtp, KEYS / 64, OATT + (size_t)(b * TL + k * 256) * 1024 + (h * 2 + m) * 128); }
    if (l == 0 && F.bx < 16) {
        const int mc = F.bx >> 3, bhm = bh * 2 + mc;
        attn_unit(F, QC + (size_t)bhm * CL * 64, KR + (size_t)bhm * KEYS * 64, Vtp, CL / 64, OATT + (size_t)(ML + b * CL) * 1024 + (h * 2 + mc) * 128);
    }
}

__device__ __forceinline__ void phase4(Ctx& F, int l) {
    const bf16* P = (const bf16*)(F.ws + WS_P); bf16* OC = (bf16*)(F.ws + WS_OC); const float* OATT = (const float*)(F.ws + WS_XN);
    const float* Yf = (const float*)(F.ws + WS_Y); const float* Yb = Yf + (size_t)MT * 512; const bf16* BON = (const bf16*)(F.ws + WS_BON);
    const float lam_init = 0.8f - 0.6f * expf(-0.3f * (float)l);
    const float d1 = wave_sum(F.prm->in[12][l * 64 + F.lane] * F.prm->in[13][l * 64 + F.lane]), d2 = wave_sum(F.prm->in[14][l * 64 + F.lane] * F.prm->in[15][l * 64 + F.lane]);
    const float lam = expf(d1) - expf(d2) + lam_init;
    const float* subg = F.prm->in[16] + l * 128; const float* ln_w = F.prm->in[25] + l * 512; const float* ln_b = F.prm->in[26] + l * 512;
    const int nrows = l == 0 ? MT : ML;
    for (int row = F.gw; row < nrows; row += F.NGW) {
        {
            const int h = F.lane >> 4, dv0 = (F.lane & 15) * 8; const float* o1 = OATT + (size_t)row * 1024 + h * 256 + dv0; const float* o2 = o1 + 128;
            float o[8]; const f32x4 a0 = *(const f32x4*)o1, a1 = *(const f32x4*)(o1 + 4), b0 = *(const f32x4*)o2, b1 = *(const f32x4*)(o2 + 4);
            o[0] = a0.x - lam * b0.x; o[1] = a0.y - lam * b0.y; o[2] = a0.z - lam * b0.z; o[3] = a0.w - lam * b0.w; o[4] = a1.x - lam * b1.x; o[5] = a1.y - lam * b1.y; o[6] = a1.z - lam * b1.z; o[7] = a1.w - lam * b1.w;
            float ss = 0.f;
#pragma unroll
            for (int e = 0; e < 8; ++e) ss += o[e] * o[e];
            const float rs = (1.f - lam_init) / sqrtf(red16(ss) * (1.f / 128.f) + EPS);
            float gg[8]; unpack8(*(const u32x4*)(P + (size_t)row * NINP + B_G + h * 128 + dv0), gg);
#pragma unroll
            for (int e = 0; e < 8; ++e) o[e] = o[e] * rs * subg[dv0 + e] * silu_f(gg[e]);
            *(u32x4*)(OC + (size_t)row * DM + 512 + h * 128 + dv0) = pack8(o);
        }
        {
            const int c0 = F.lane * 8; const float* yf = Yf + (size_t)row * 512 + c0; const float* yb = Yb + (size_t)row * 512 + c0; const bf16* bo = BON + (size_t)row * 512 + c0;
            float y[8]; const f32x4 a0 = *(const f32x4*)yf, a1 = *(const f32x4*)(yf + 4), b0 = *(const f32x4*)yb, b1 = *(const f32x4*)(yb + 4);
            y[0] = a0.x + b0.x; y[1] = a0.y + b0.y; y[2] = a0.z + b0.z; y[3] = a0.w + b0.w; y[4] = a1.x + b1.x; y[5] = a1.y + b1.y; y[6] = a1.z + b1.z; y[7] = a1.w + b1.w;
            float s = 0.f;
#pragma unroll
            for (int e = 0; e < 8; ++e) s += y[e];
            const float mean = red8(s) * (1.f / 64.f); float q = 0.f;
#pragma unroll
            for (int e = 0; e < 8; ++e) { y[e] -= mean; q += y[e] * y[e]; }
            const float rstd = 1.f / sqrtf(red8(q) * (1.f / 64.f) + GN_EPS);
            float gg[8]; unpack8(*(const u32x4*)(P + (size_t)row * NINP + C_G + c0), gg);
            float bn[8], bn2[8]; unpack8(*(const u32x4*)bo, bn); unpack8(*(const u32x4*)(bo + (size_t)MT * 512), bn2);
#pragma unroll
            for (int e = 0; e < 8; ++e) bn[e] += bn2[e];
#pragma unroll
            for (int e = 0; e < 8; ++e) y[e] = (y[e] * rstd * ln_w[c0 + e] + ln_b[c0 + e] + bn[e]) * silu_f(gg[e]);
            *(u32x4*)(OC + (size_t)row * DM + 1024 + c0) = pack8(y);
        }
    }
}

#define XB_TMO      128
#define XB_XCNT(j)  (256  + 64 * (j))
#define XB_XSUB(j)  (1280 + 64 * (j))
#define XB_XGEN(j)  (2304 + 64 * (j))
#define XB_TOP      3328
#define XB_TOPGEN   3392
#define XCD_BAR_WORDS 3456
#define XB_SPIN_CAP (1u << 18)

__device__ __forceinline__ unsigned xb_ld(unsigned* p)              { return __hip_atomic_load(p, __ATOMIC_RELAXED, __HIP_MEMORY_SCOPE_AGENT); }
__device__ __forceinline__ unsigned xb_add(unsigned* p, unsigned v) { return __hip_atomic_fetch_add(p, v, __ATOMIC_RELAXED, __HIP_MEMORY_SCOPE_AGENT); }
__device__ __forceinline__ unsigned xb_xcc_id() { return (unsigned)__builtin_amdgcn_s_getreg((3 << 11) | 20) & 0xFu; }
#define XB_SPIN(cond, bar) do { unsigned _sp = 0; while (cond) { __builtin_amdgcn_s_sleep(1); \
    if ((++_sp & 255u) == 0u) { if (xb_ld(&(bar)[XB_TMO])) break; if (_sp > XB_SPIN_CAP) { atomicAdd(&(bar)[XB_TMO], 1u); break; } } } } while (0)

struct XcdBarrier {
    unsigned* bar; unsigned x;
    volatile LAS unsigned* st;
};

__device__ __forceinline__ XcdBarrier xcd_barrier_post(unsigned* bar, volatile LAS unsigned* st) {
    XcdBarrier b; b.bar = bar; b.x = xb_xcc_id(); b.st = st;
    if (threadIdx.x == 0) (void)xb_add(&bar[XB_XCNT(b.x)], 1u);
    return b;
}
__device__ __forceinline__ void xcd_barrier_complete(unsigned* bar, unsigned x, unsigned& nloc, unsigned& nx) {
    const unsigned G = gridDim.x * gridDim.y * gridDim.z;
    unsigned sum, cnt, mine, sp = 0u;
    for (;;) {
        sum = 0u; cnt = 0u; mine = 0u;
#pragma unroll
        for (unsigned j = 0; j < 16; ++j) { const unsigned c = xb_ld(&bar[XB_XCNT(j)]); sum += c; cnt += (c > 0u) ? 1u : 0u; mine = (j == x) ? c : mine; }
        if (sum == G) break;
        __builtin_amdgcn_s_sleep(1);
        if ((++sp & 255u) == 0u) { if (xb_ld(&bar[XB_TMO])) break; if (sp > XB_SPIN_CAP) { atomicAdd(&bar[XB_TMO], 1u); break; } }
    }
    nloc = mine > 0u ? mine : 1u; nx = cnt > 0u ? cnt : 1u;
}

__device__ __forceinline__ void xcd_barrier(const XcdBarrier& b) {
    asm volatile("s_waitcnt vmcnt(0)" ::: "memory");
    __syncthreads();
    if (threadIdx.x == 0) {
        unsigned* bar = b.bar;
        __builtin_amdgcn_s_waitcnt(0);
        unsigned nloc = b.st[0], nx = b.st[1];
        if (nloc == 0u) { xcd_barrier_complete(bar, b.x, nloc, nx); b.st[0] = nloc; b.st[1] = nx; }
        const unsigned old = xb_add(&bar[XB_XSUB(b.x)], 1u);
        const unsigned gen = old / nloc;
        if (old + 1u == (gen + 1u) * nloc) {
            __builtin_amdgcn_fence(__ATOMIC_RELEASE, "agent");
            asm volatile("s_waitcnt vmcnt(0)" ::: "memory");
            const unsigned og = xb_add(&bar[XB_TOP], 1u);
            const unsigned tg = og / nx;
            if (og + 1u == (tg + 1u) * nx) xb_add(&bar[XB_TOPGEN], 1u);
            else XB_SPIN(xb_ld(&bar[XB_TOPGEN]) == tg, bar);
            __builtin_amdgcn_fence(__ATOMIC_ACQUIRE, "agent");
            xb_add(&bar[XB_XGEN(b.x)], 1u);
            asm volatile("s_waitcnt vmcnt(0)" ::: "memory");
        } else {
            XB_SPIN(xb_ld(&bar[XB_XGEN(b.x)]) == gen, bar);
            __builtin_amdgcn_fence(__ATOMIC_ACQUIRE, "agent");
            asm volatile("s_waitcnt vmcnt(0)" ::: "memory");
        }
    }
    __syncthreads();
}

#ifndef R_P0T
#define R_P0T 1
#endif
#ifndef R_P1
#define R_P1 1
#endif
#ifndef R_P2
#define R_P2 1
#endif
#ifndef R_P3A
#define R_P3A 1
#endif
#ifndef R_SCAN
#define R_SCAN 1
#endif
#ifndef R_ATTN
#define R_ATTN 1
#endif
#ifndef R_P4
#define R_P4 1
#endif
#ifndef R_P5
#define R_P5 1
#endif
#ifndef R_BAR
#define R_BAR 1
#endif
__global__ void __launch_bounds__(NTHREADS, 2) fwd_kernel(Params prm) {
    extern __shared__ __attribute__((aligned(16))) unsigned char lds_raw[];
    cg::grid_group grid = cg::this_grid();
    Ctx F;
    F.prm = &prm; F.out = prm.out; F.ws = prm.ws; F.lds = (LAS unsigned char*)lds_raw;
    F.tid = threadIdx.x; F.lane = F.tid & 63; F.wave = __builtin_amdgcn_readfirstlane(F.tid >> 6); F.bx = blockIdx.x; F.G = gridDim.x;
    F.gw = F.bx * NWAVES + F.wave; F.NGW = F.G * NWAVES;
    volatile LAS unsigned* MISC = (volatile LAS unsigned*)(F.lds + 131072 + 1024);
    if (F.tid < 4) MISC[F.tid] = 0u;
    __syncthreads();
    XcdBarrier bar = xcd_barrier_post((unsigned*)(F.ws + WS_CTL + 16384), MISC);
#define GRID_BAR() do { for (int rb_ = 0; rb_ < R_BAR; ++rb_) xcd_barrier(bar); } while (0)

#ifndef NO_P0
    LAUNDER(F); phase0(F);
#endif
    grid.sync();
#pragma unroll 1
    for (int l = 0; l < 2; ++l) {
#ifndef NO_P1
        for (int rp_ = 0; rp_ < R_P1; ++rp_) { LAUNDER(F); phase1(F, l); }
#endif
        GRID_BAR();
#ifndef NO_P2
        for (int rp_ = 0; rp_ < R_P2; ++rp_) {
            pg8::Gemm g{(const pg8::bf16_t*)(F.ws + WS_XN), (const pg8::bf16_t*)(F.ws + WS_WIN) + (size_t)l * NINP * DM, MT, NINP, DM};
            pg8::StaticOrder S; S.init(MT, NINP, F.G, F.bx);
            pg8::EpiBf16 E{(pg8::bf16_t*)(F.ws + WS_P), NINP, nullptr, 0, 0, 1.f};
            pg8::gemm_phase<pg8::EpiBf16, pg8::StaticOrder, true, true>(F.lds, g, S, E);
        }
#endif
        GRID_BAR();
#ifndef NO_P3A
        { LAUNDER(F); phase3a(F, l); }
        GRID_BAR();
        { LAUNDER(F); phase3b(F, l); }
        GRID_BAR();
        for (int rp_ = 0; rp_ < R_ATTN; ++rp_) { LAUNDER(F); attn_role(F, l); }
        GRID_BAR();
        for (int rp_ = 0; rp_ < R_P4; ++rp_) { LAUNDER(F); phase4(F, l); }
#endif
        GRID_BAR();
#ifndef NO_P5
        for (int rp_ = 0; rp_ < R_P5; ++rp_) {
            const int rows = l == 0 ? MT : ML;
            pg8::Gemm g{(const pg8::bf16_t*)(F.ws + WS_OC), (const pg8::bf16_t*)(F.ws + WS_WOUT) + (size_t)l * DM * DM, rows, DM, DM};
            pg8::StaticOrder S; S.init(rows, DM, F.G, F.bx);
            pg8::EpiF32 E{(float*)(F.ws + WS_P), DM};
            pg8::gemm_phase<pg8::EpiF32, pg8::StaticOrder, true, true>(F.lds, g, S, E);
        }
#endif
        GRID_BAR();
    }
#ifndef NO_P6
    LAUNDER(F); phase6(F);
#endif
}

extern "C" void kernel_launch(void* const* d_in, const int* in_sizes, int n_in, void* d_out, int out_size, void* d_ws, size_t ws_size, hipStream_t stream) {
    static int grid = 0;
    if (grid == 0) {
        if (n_in != 28 || out_size != ML * DM || ws_size < WS_END) { fprintf(stderr, "kernel_launch: unexpected shapes: n_in %d out %d ws %zu (need %zu)\n", n_in, out_size, ws_size, (size_t)WS_END); grid = -1; return; }
        int dev = 0, cus = 0, per_cu = 0;
        if (hipGetDevice(&dev) != hipSuccess || hipDeviceGetAttribute(&cus, hipDeviceAttributeMultiprocessorCount, dev) != hipSuccess) { grid = -1; return; }
        if (hipFuncSetAttribute((const void*)fwd_kernel, hipFuncAttributeMaxDynamicSharedMemorySize, LDS_BYTES) != hipSuccess) { fprintf(stderr, "kernel_launch: hipFuncSetAttribute failed\n"); grid = -1; return; }
        if (hipOccupancyMaxActiveBlocksPerMultiprocessor(&per_cu, (const void*)fwd_kernel, NTHREADS, LDS_BYTES) != hipSuccess || per_cu < 1) { fprintf(stderr, "kernel_launch: occupancy query says %d blocks per CU\n", per_cu); grid = -1; return; }
        (void)hipGetLastError();
        grid = cus;
        if (grid != 256) { fprintf(stderr, "kernel_launch: expected 256 CUs, got %d\n", cus); grid = -1; return; }
    }
    if (grid < 0) return;
    if (hipMemsetAsync((char*)d_ws + WS_CTL, 0, CTL_ZERO_BYTES, stream) != hipSuccess) { fprintf(stderr, "kernel_launch: memset failed\n"); return; }
    Params p{};
    for (int i = 0; i < 28; ++i) p.in[i] = (const float*)d_in[i];
    p.out = (float*)d_out; p.ws = (unsigned char*)d_ws;
    void* args[] = {&p};
    hipError_t e = hipLaunchCooperativeKernel((void*)fwd_kernel, dim3(grid), dim3(NTHREADS), args, LDS_BYTES, stream);
    if (e != hipSuccess) fprintf(stderr, "cooperative launch failed: %s (grid %d)\n", hipGetErrorString(e), grid);
}
```

```cpp
#include <hip/hip_runtime.h>
#include <hip/hip_cooperative_groups.h>
#include <cstdio>
#include <cstdint>
namespace cg = cooperative_groups;
namespace pg8 {
#define PG8_LAS __attribute__((address_space(3)))
typedef unsigned short bf16_t;
typedef short bf16x8 __attribute__((ext_vector_type(8)));
typedef float f32x4 __attribute__((ext_vector_type(4)));
typedef unsigned u32x4 __attribute__((ext_vector_type(4)));
constexpr int BM = 256, BK = 64, HALF = 128, HTB = HALF * BK * 2  , STAGE_BYTES = 8 * HTB, NXCD = 8, WGM = 8;

__host__ __device__ __forceinline__ int lds_byte(int r, int c) { const int st = (r >> 4) * 2 + (c >> 5), rr = r & 15, cc = c & 31, ob = rr * 64 + cc * 2; return st * 1024 + (ob ^ (((ob >> 9) & 1) << 5)); }
__host__ __device__ __forceinline__ void stage_rc(int b, int& R, int& C) { const int st = b / 1024, sb = b % 1024, swz = sb ^ (((sb >> 9) & 1) << 5); R = (st >> 1) * 16 + swz / 64; C = (st & 1) * 32 + (swz % 64) / 2; }
__host__ __device__ __forceinline__ int perm32(int rho) { const int n = rho >> 4, i = rho & 15; return 8 * (i >> 2) + 4 * n + (i & 3); }

struct Unit { int pm, pn; };
struct Gemm { const bf16_t* A; const bf16_t* Bt; int M, N, K; };

struct StaticOrder {
    int nM, nN, nwg, G, c;
    __host__ __device__ void init(int M, int N, int G_, int c_) { nM = M / BM; nN = N / BM; nwg = nM * nN; G = G_; c = c_; }
    __host__ __device__ bool next(int i, Unit& u) const {
        const long L = (long)i * G + c; if (L >= nwg) return false;
        int wgid = (int)L; { const int q = nwg / NXCD, r = nwg % NXCD, xcd = wgid % NXCD, off = wgid / NXCD; wgid = (xcd < r ? xcd * (q + 1) : r * (q + 1) + (xcd - r) * q) + off; }
        const int nig = WGM * nN, gid = wgid / nig, fm = gid * WGM, gsz = (nM - fm) < WGM ? (nM - fm) : WGM;
        u.pm = fm + ((wgid % nig) % gsz); u.pn = (wgid % nig) / gsz; return true;
    }
    __device__ __forceinline__ void a_ready(const Unit&) const {}
    __device__ __forceinline__ void done(const Unit&) const {}
};


struct CtxSparseOrder {
    StaticOrder base; int nMl, nctx, G, c;
    __host__ __device__ void init(int Mlat, int Mctx, int N, int G_, int c_) { base.init(Mlat, N, G_, c_); nMl = Mlat / BM; nctx = (Mctx / BM) * 11; G = G_; c = c_; }
    __host__ __device__ bool next(int i, Unit& u) const {
        if (base.next(i, u)) return true;
        const long L = (long)i * G + c - base.nwg; if (L < 0 || L >= nctx) return false;
        const int k = (int)L % 11; u.pm = nMl + (int)L / 11; u.pn = k < 4 ? 8 + k : 10 + k; return true;
    }
    __device__ __forceinline__ void a_ready(const Unit&) const {}
    __device__ __forceinline__ void done(const Unit&) const {}
};

__device__ __forceinline__ unsigned cvt_pk_bf16(float lo, float hi) { unsigned r; asm volatile("v_cvt_pk_bf16_f32 %0, %1, %2" : "=v"(r) : "v"(lo), "v"(hi)); return r; }
struct EpiBf16 {
    static constexpr bool PERM = true, AFTER_DRAIN = false;
    bf16_t* O; int ldc; const float* bias; int split_cols; size_t split_stride; float scale0;
    __device__ __forceinline__ void operator()(const f32x4 (&acc)[2][2][4][2], const Unit& u, int wr, int wc, int fr, int fq) const {
        const int row0 = u.pm * BM + wr * 64 + fr; int colt = u.pn * BM; bf16_t* base = O;
        float sc = 1.f; if (split_cols) { const int t = colt / split_cols; base += (size_t)t * split_stride; colt -= t * split_cols; if (t == 0) sc = scale0; }
        const int col0 = colt + wc * 32 + 8 * fq, bcol0 = u.pn * BM + wc * 32 + 8 * fq;
        f32x4 bv[2][2];
#pragma unroll
        for (int bj = 0; bj < 2; ++bj)
#pragma unroll
            for (int n = 0; n < 2; ++n) bv[bj][n] = bias ? *(const f32x4*)(bias + bcol0 + bj * HALF + 4 * n) : (f32x4){0.f, 0.f, 0.f, 0.f};
#pragma unroll
        for (int ai = 0; ai < 2; ++ai)
#pragma unroll
            for (int m = 0; m < 4; ++m) { bf16_t* rowp = base + (size_t)(row0 + ai * HALF + m * 16) * ldc + col0;
#pragma unroll
                for (int bj = 0; bj < 2; ++bj) { f32x4 v0 = acc[ai][bj][m][0] + bv[bj][0], v1 = acc[ai][bj][m][1] + bv[bj][1];
                    v0 = v0 * sc; v1 = v1 * sc; u32x4 w; w.x = cvt_pk_bf16(v0[0], v0[1]); w.y = cvt_pk_bf16(v0[2], v0[3]); w.z = cvt_pk_bf16(v1[0], v1[1]); w.w = cvt_pk_bf16(v1[2], v1[3]);
                    *(u32x4*)(rowp + bj * HALF) = w; } }
    }
};
struct EpiF32 {
    static constexpr bool PERM = false, AFTER_DRAIN = false;
    float* O; int ldc;
    __device__ __forceinline__ void operator()(const f32x4 (&acc)[2][2][4][2], const Unit& u, int wr, int wc, int fr, int fq) const {
        const int col0 = u.pn * BM + wc * 32 + 4 * fq;
#pragma unroll
        for (int ai = 0; ai < 2; ++ai)
#pragma unroll
            for (int m = 0; m < 4; ++m) { float* rowp = O + (size_t)(u.pm * BM + ai * HALF + wr * 64 + m * 16 + fr) * ldc + col0;
#pragma unroll
                for (int bj = 0; bj < 2; ++bj)
#pragma unroll
                    for (int n = 0; n < 2; ++n) *(f32x4*)(rowp + bj * HALF + n * 16) = acc[ai][bj][m][n]; }
    }
};
template <class Epi, class Sched, bool ALIGN_EPI = false, bool SP2 = false>
__device__ __forceinline__ void gemm_phase(PG8_LAS unsigned char* lds, const Gemm g, const Sched& S, const Epi& E) {
    int tid_ = threadIdx.x; asm volatile("" : "+v"(tid_));
    const int tid = tid_, wid = __builtin_amdgcn_readfirstlane(tid >> 6), lane = tid & 63, wr = wid >> 2, wc = wid & 3, fr = lane & 15, fq = lane >> 4;
    const int K = g.K, nt = K / BK;
    unsigned voffA[2], voffB[2];
#pragma unroll
    for (int i = 0; i < 2; ++i) { int R, C; stage_rc(tid * 16 + i * 8192, R, C); const int Rb = Epi::PERM ? ((R & ~31) + perm32(R & 31)) : R;
        voffA[i] = (unsigned)(R * K + C) * 2u; voffB[i] = (unsigned)(Rb * K + C) * 2u; }
    const size_t kstep = (size_t)(BK * 2);
    const size_t hstep = (size_t)HALF * K * 2;
    const size_t tstep = 2 * hstep;
    const unsigned ldsw = (unsigned)wid * 1024u;
    const int aoff = lds_byte(wr * 64 + fr, fq * 8), boff = lds_byte(wc * 32 + fr, fq * 8);
#define PG8_SA(b, h) (((b) * 2 + (h)) * HTB)
#define PG8_SB(b, h) ((4 + (b) * 2 + (h)) * HTB)
#define PG8_STAGE(bufoff, gbase, voff) do { _Pragma("unroll") for (int _i = 0; _i < 2; ++_i) \
        __builtin_amdgcn_global_load_lds((const unsigned*)((const char*)(gbase) + (voff)[_i]), (PG8_LAS unsigned*)(lds + (bufoff) + ldsw + _i * 8192), 16, 0, 0); } while (0)
#define PG8_LDA(dst, b, h) do { _Pragma("unroll") for (int m = 0; m < 4; ++m) _Pragma("unroll") for (int k = 0; k < 2; ++k) dst[m][k] = *(const PG8_LAS bf16x8*)(lds + PG8_SA(b, h) + aoff + m * 2048 + k * 1024); } while (0)
#define PG8_LDB(dst, b, h) do { _Pragma("unroll") for (int n = 0; n < 2; ++n) _Pragma("unroll") for (int k = 0; k < 2; ++k) dst[n][k] = *(const PG8_LAS bf16x8*)(lds + PG8_SB(b, h) + boff + n * 2048 + k * 1024); } while (0)
#define PG8_MMA(ai, bj, At, Bt) do { __builtin_amdgcn_s_setprio(1); _Pragma("unroll") for (int m = 0; m < 4; ++m) _Pragma("unroll") for (int n = 0; n < 2; ++n) _Pragma("unroll") for (int k = 0; k < 2; ++k) \
        acc[ai][bj][m][n] = __builtin_amdgcn_mfma_f32_16x16x32_bf16(Bt[n][k], At[m][k], acc[ai][bj][m][n], 0, 0, 0); __builtin_amdgcn_s_setprio(0); } while (0)
#define PG8_WAIT_V(n) asm volatile("s_waitcnt vmcnt(" #n ")" ::: "memory")
#define PG8_WAIT_L(n) asm volatile("s_waitcnt lgkmcnt(" #n ")" ::: "memory")
#define PG8_BAR __builtin_amdgcn_s_barrier()
#define PG8_SCHED __builtin_amdgcn_sched_barrier(0)
    Unit cur, nxt; int ui = 0;
    if (!S.next(0, cur)) return;
    f32x4 acc[2][2][4][2];
#pragma unroll
    for (int a = 0; a < 2; ++a)
#pragma unroll
        for (int b = 0; b < 2; ++b)
#pragma unroll
            for (int m = 0; m < 4; ++m)
#pragma unroll
                for (int n = 0; n < 2; ++n) acc[a][b][m][n] = (f32x4){0.f, 0.f, 0.f, 0.f};
    bf16x8 At[4][2], B0[2][2], B1[2][2];
    const char* cA = (const char*)g.A + (size_t)cur.pm * tstep; const char* cB = (const char*)g.Bt + (size_t)cur.pn * tstep;
    S.a_ready(cur);
    if constexpr (SP2) {
        PG8_STAGE(PG8_SB(0, 0), cB, voffB); PG8_STAGE(PG8_SB(0, 1), cB + hstep, voffB); PG8_STAGE(PG8_SA(0, 0), cA, voffA); PG8_STAGE(PG8_SA(0, 1), cA + hstep, voffA);
        if (wr == 1) PG8_BAR;
        PG8_WAIT_V(2); PG8_BAR;
        PG8_STAGE(PG8_SB(1, 0), cB + kstep, voffB); PG8_STAGE(PG8_SA(1, 0), cA + kstep, voffA); PG8_STAGE(PG8_SB(1, 1), cB + hstep + kstep, voffB);
        PG8_WAIT_V(6); PG8_BAR;
    } else {
        PG8_STAGE(PG8_SB(0, 0), cB, voffB); PG8_STAGE(PG8_SA(0, 0), cA, voffA); PG8_STAGE(PG8_SB(0, 1), cB + hstep, voffB); PG8_STAGE(PG8_SA(0, 1), cA + hstep, voffA);
        if (wr == 1) PG8_BAR;
        PG8_WAIT_V(4); PG8_BAR;
        PG8_STAGE(PG8_SB(1, 0), cB + kstep, voffB); PG8_STAGE(PG8_SA(1, 0), cA + kstep, voffA); PG8_STAGE(PG8_SB(1, 1), cB + hstep + kstep, voffB);
        PG8_WAIT_V(6); PG8_BAR;
    }
    for (;;) {
        const bool has_next = S.next(ui + 1, nxt);
        const char* nA = has_next ? (const char*)g.A + (size_t)nxt.pm * tstep : cA; const char* nB = has_next ? (const char*)g.Bt + (size_t)nxt.pn * tstep : cB;
        for (int t = 0; t < nt; t += 2) {
            const bool last = (t == nt - 2);
            const char* a1 = cA + (size_t)(t + 1) * kstep;
            const char* a2 = last ? nA : cA + (size_t)(t + 2) * kstep; const char* b2 = last ? nB : cB + (size_t)(t + 2) * kstep;
            const char* a3 = a2 + kstep; const char* b3 = b2 + kstep;
            if (last && has_next) S.a_ready(nxt);
            if constexpr (SP2) {
            PG8_LDB(B0, 0, 0); PG8_LDB(B1, 0, 1); PG8_SCHED; PG8_LDA(At, 0, 0); PG8_STAGE(PG8_SA(1, 1), a1 + hstep, voffA);
            PG8_WAIT_V(8); PG8_WAIT_L(0); PG8_BAR; PG8_MMA(0, 0, At, B0); PG8_MMA(0, 1, At, B1); PG8_BAR; PG8_SCHED;
            PG8_LDA(At, 0, 1); PG8_STAGE(PG8_SB(0, 0), b2, voffB); PG8_STAGE(PG8_SB(0, 1), b2 + hstep, voffB); PG8_STAGE(PG8_SA(0, 0), a2, voffA);
            PG8_WAIT_V(8); PG8_WAIT_L(0); PG8_BAR; PG8_MMA(1, 0, At, B0); PG8_MMA(1, 1, At, B1); PG8_BAR; PG8_SCHED;
            PG8_LDB(B0, 1, 0); PG8_LDB(B1, 1, 1); PG8_SCHED; PG8_LDA(At, 1, 0); PG8_STAGE(PG8_SA(0, 1), a2 + hstep, voffA);
            PG8_WAIT_V(8); PG8_WAIT_L(0); PG8_BAR; PG8_MMA(0, 0, At, B0); PG8_MMA(0, 1, At, B1); PG8_BAR; PG8_SCHED;
            PG8_LDA(At, 1, 1); PG8_STAGE(PG8_SB(1, 0), b3, voffB); PG8_STAGE(PG8_SB(1, 1), b3 + hstep, voffB); PG8_STAGE(PG8_SA(1, 0), a3, voffA);
            PG8_WAIT_V(8); PG8_WAIT_L(0); PG8_BAR; PG8_MMA(1, 0, At, B0); PG8_MMA(1, 1, At, B1); PG8_BAR; PG8_SCHED;
            } else {
            PG8_LDB(B0, 0, 0); PG8_SCHED; PG8_LDA(At, 0, 0); PG8_STAGE(PG8_SA(1, 1), a1 + hstep, voffA);
            PG8_WAIT_L(8); PG8_BAR; PG8_WAIT_L(0); PG8_MMA(0, 0, At, B0); PG8_BAR; PG8_SCHED;
            PG8_LDB(B1, 0, 1); PG8_STAGE(PG8_SB(0, 0), b2, voffB);
            PG8_BAR; PG8_WAIT_L(0); PG8_MMA(0, 1, At, B1); PG8_BAR;
            PG8_LDA(At, 0, 1); PG8_STAGE(PG8_SA(0, 0), a2, voffA);
            PG8_BAR; PG8_WAIT_L(0); PG8_MMA(1, 0, At, B0); PG8_BAR; PG8_SCHED;
            PG8_STAGE(PG8_SB(0, 1), b2 + hstep, voffB);
            PG8_WAIT_V(6); PG8_BAR; PG8_MMA(1, 1, At, B1); PG8_BAR;
            PG8_LDB(B0, 1, 0); PG8_SCHED; PG8_LDA(At, 1, 0); PG8_STAGE(PG8_SA(0, 1), a2 + hstep, voffA);
            PG8_WAIT_L(8); PG8_BAR; PG8_WAIT_L(0); PG8_MMA(0, 0, At, B0); PG8_BAR; PG8_SCHED;
            PG8_LDB(B1, 1, 1); PG8_STAGE(PG8_SB(1, 0), b3, voffB);
            PG8_BAR; PG8_WAIT_L(0); PG8_MMA(0, 1, At, B1); PG8_BAR;
            PG8_LDA(At, 1, 1); PG8_STAGE(PG8_SA(1, 0), a3, voffA);
            PG8_BAR; PG8_WAIT_L(0); PG8_MMA(1, 0, At, B0); PG8_BAR; PG8_SCHED;
            PG8_STAGE(PG8_SB(1, 1), b3 + hstep, voffB);
            PG8_WAIT_V(6); PG8_BAR; PG8_MMA(1, 1, At, B1); PG8_BAR;
            }
        }
        if constexpr (ALIGN_EPI) { if (wr == 0) PG8_BAR; }
        if constexpr (!Epi::AFTER_DRAIN) { E(acc, cur, wr, wc, fr, fq); S.done(cur); }
        if (!has_next) break;
#pragma unroll
        for (int a = 0; a < 2; ++a)
#pragma unroll
            for (int b = 0; b < 2; ++b)
#pragma unroll
                for (int m = 0; m < 4; ++m)
#pragma unroll
                    for (int n = 0; n < 2; ++n) acc[a][b][m][n] = (f32x4){0.f, 0.f, 0.f, 0.f};
        cur = nxt; cA = nA; cB = nB; ++ui;
        if constexpr (ALIGN_EPI) { if (wr == 1) PG8_BAR; }
    }
    PG8_WAIT_V(0);
    if constexpr (!ALIGN_EPI) { if (wr == 0) PG8_BAR; }
    PG8_BAR;
    if constexpr (Epi::AFTER_DRAIN) { E.fused(acc, cur, wr, wc, fr, fq, lds, wid, lane); S.done(cur); }
#undef PG8_SA
#undef PG8_SB
#undef PG8_STAGE
#undef PG8_LDA
#undef PG8_LDB
#undef PG8_MMA
#undef PG8_WAIT_V
#undef PG8_WAIT_L
#undef PG8_BAR
#undef PG8_SCHED
}
}

constexpr int NB = 2, TL = 4096, DM = 2048, CL = 256, NIN = 7872, NINP = 7936;
constexpr int ML = NB * TL, MC = NB * CL, MT = ML + MC;
constexpr int KEYS = CL + TL;
constexpr int NSTEP = KEYS;
constexpr int A_U = 0, A_V = 512, A_G = 1024, B_Q = 1536, B_K = 2048, B_V = 2560, B_G = 3072, C_R = 3584, C_K = 4096, C_V = 4608, C_LF = 5120, C_LB = 5216, C_G = 5312,
              D_B = 5824, D_C = 6336, D_X = 6848, D_G = 7360;
constexpr float EPS = 1e-6f, GN_EPS = 64e-5f;
constexpr float QSCALE = 0.125f * 1.4426950408889634f;

constexpr size_t MiB = 1u << 20;
constexpr size_t WS_CTL = 0, CTL_ZERO_BYTES = 1 * MiB;
constexpr size_t CTL_MODACC = 65536;
constexpr size_t WS_ROPE = 1 * MiB - 16384;
constexpr size_t WS_WIN = 1 * MiB;
constexpr size_t WS_WOUT = 63 * MiB;
constexpr size_t WS_XN = 79 * MiB;
constexpr size_t WS_P = 113 * MiB;
constexpr size_t WS_QR = 245 * MiB;
constexpr size_t WS_QC = 253 * MiB;
constexpr size_t WS_KR = 254 * MiB;
constexpr size_t WS_VT = 263 * MiB;
constexpr size_t WS_CHK = 272 * MiB;
constexpr size_t WS_Y = 402 * MiB;
constexpr size_t WS_BON = 436 * MiB;
constexpr size_t WS_OC = 453 * MiB;
constexpr size_t WS_LW = 487 * MiB;
constexpr size_t WS_END = 488 * MiB;
static_assert(WS_WIN + (size_t)2 * NINP * DM * 2 <= WS_WOUT && WS_WOUT + (size_t)2 * DM * DM * 2 <= WS_XN && WS_XN + (size_t)MT * DM * 2 <= WS_P && WS_P + (size_t)MT * NINP * 2 <= WS_QR, "ws map 1");
static_assert(WS_QR + (size_t)16 * TL * 64 * 2 <= WS_QC && WS_QC + (size_t)16 * CL * 64 * 2 <= WS_KR && WS_KR + (size_t)16 * KEYS * 64 * 2 <= WS_VT && WS_VT + (size_t)8 * 128 * KEYS * 2 <= WS_CHK, "ws map 2");
static_assert(WS_Y + (size_t)2 * MT * 512 * 4 <= WS_BON && WS_BON + (size_t)2 * MT * 512 * 2 <= WS_OC && WS_OC + (size_t)MT * DM * 2 <= WS_END, "ws map 3");
static_assert((size_t)MT * 1024 * 4 <= WS_P - WS_XN && (size_t)MT * DM * 4 <= WS_QR - WS_P, "overlays");

constexpr int LDS_BYTES = 147456;
constexpr int NWAVES = 8, NTHREADS = 512;

typedef unsigned short bf16;
typedef short bf16x8 __attribute__((ext_vector_type(8)));
typedef float f32x4 __attribute__((ext_vector_type(4)));
typedef float f32x2 __attribute__((ext_vector_type(2)));
typedef float f32x16 __attribute__((ext_vector_type(16)));
typedef unsigned u32x4 __attribute__((ext_vector_type(4)));
typedef unsigned u32x2 __attribute__((ext_vector_type(2)));
typedef __bf16 bf16x2_t __attribute__((ext_vector_type(2)));
#define LAS __attribute__((address_space(3)))

struct Params { const float* in[28]; float* out; unsigned char* ws; };

struct Ctx {
    const Params* prm; float* out; unsigned char* ws;
    LAS unsigned char* lds;
    int tid, lane, wave, bx, G, gw, NGW;
};

__device__ __forceinline__ unsigned cvtpk(float lo, float hi) { f32x2 v = {lo, hi}; bf16x2_t b = __builtin_convertvector(v, bf16x2_t); return __builtin_bit_cast(unsigned, b); }
__device__ __forceinline__ float bflo(unsigned u) { return __builtin_bit_cast(float, u << 16); }
__device__ __forceinline__ float bfhi(unsigned u) { return __builtin_bit_cast(float, u & 0xffff0000u); }
__device__ __forceinline__ void unpack8(const u32x4 v, float* f) { f[0] = bflo(v.x); f[1] = bfhi(v.x); f[2] = bflo(v.y); f[3] = bfhi(v.y); f[4] = bflo(v.z); f[5] = bfhi(v.z); f[6] = bflo(v.w); f[7] = bfhi(v.w); }
__device__ __forceinline__ u32x4 pack8(const float* f) { u32x4 r; r.x = cvtpk(f[0], f[1]); r.y = cvtpk(f[2], f[3]); r.z = cvtpk(f[4], f[5]); r.w = cvtpk(f[6], f[7]); return r; }
__device__ __forceinline__ float silu_f(float x) { return x * __builtin_amdgcn_rcpf(1.f + __expf(-x)); }
__device__ __forceinline__ float wave_sum(float v) {
#pragma unroll
    for (int o = 1; o < 64; o <<= 1) v += __shfl_xor(v, o);
    return v;
}
template <int CTRL> __device__ __forceinline__ float dpp_f(float v) { return __builtin_bit_cast(float, __builtin_amdgcn_update_dpp(0, __builtin_bit_cast(int, v), CTRL, 0xf, 0xf, true)); }
__device__ __forceinline__ float red4(float v) { v += dpp_f<0xB1>(v); v += dpp_f<0x4E>(v); return v; }
__device__ __forceinline__ float red8(float v) { v = red4(v); v += dpp_f<0x141>(v); return v; }
__device__ __forceinline__ float red16(float v) { v = red8(v); v += dpp_f<0x140>(v); return v; }
#define LAUNDER(F) do { asm volatile("" : "+v"(F.tid), "+v"(F.lane)); asm volatile("" : "+s"(F.wave), "+s"(F.bx), "+s"(F.gw)); } while (0)
#define LDS_WAIT() asm volatile("s_waitcnt lgkmcnt(0)" ::: "memory")
#define WG_BAR() do { asm volatile("s_waitcnt lgkmcnt(0)" ::: "memory"); __builtin_amdgcn_s_barrier(); asm volatile("" ::: "memory"); } while (0)

#ifndef R_P0T
#define R_P0T 1
#endif
__device__ __forceinline__ void p0_transpose_item(const float* W, int K, int N, bf16* WT, LAS float* scr, int item, int lane) {
    const int nblk = N / 32, kb = item / nblk, nb = item % nblk, k0 = 64 * kb, n0 = 32 * nb;
#pragma unroll 8
    for (int i = 0; i < 32; ++i) { const int kk = 2 * i + (lane >> 5); scr[kk * 33 + (lane & 31)] = W[(size_t)(k0 + kk) * N + n0 + (lane & 31)]; }
    LDS_WAIT();
    const int c = lane & 7;
#pragma unroll
    for (int j = 0; j < 4; ++j) { const int n = (lane >> 3) + 8 * j; const LAS float* s = scr + (8 * c) * 33 + n;
        u32x4 o; o.x = cvtpk(s[0 * 33], s[1 * 33]); o.y = cvtpk(s[2 * 33], s[3 * 33]); o.z = cvtpk(s[4 * 33], s[5 * 33]); o.w = cvtpk(s[6 * 33], s[7 * 33]);
        *(u32x4*)(WT + (size_t)(n0 + n) * K + k0 + 8 * c) = o; }
    LDS_WAIT();
}

__device__ __forceinline__ void p0_weights(Ctx& F, int l, int widx, int nw) {
    LAS float* scr = (LAS float*)(F.lds + F.wave * 16384);
    const float* w_in = F.prm->in[8] + (size_t)l * DM * NIN; const float* w_out = F.prm->in[9] + (size_t)l * DM * DM;
    bf16* WIN = (bf16*)(F.ws + WS_WIN) + (size_t)l * NINP * DM; bf16* WOUT = (bf16*)(F.ws + WS_WOUT) + (size_t)l * DM * DM;
    constexpr int I_IN = (DM / 64) * (NIN / 32), I_OUT = (DM / 64) * (DM / 32);
    for (int it = widx; it < I_IN + I_OUT; it += nw) {
        if (it < I_IN) p0_transpose_item(w_in, DM, NIN, WIN, scr, it, F.lane);
        else p0_transpose_item(w_out, DM, DM, WOUT, scr, it - I_IN, F.lane);
    }
    const float* cvec = F.prm->in[1]; const float* cctx = F.prm->in[3]; const float* w_mod = F.prm->in[4];
    float* MODACC = (float*)(F.ws + WS_CTL + CTL_MODACC);
    for (int it = widx; it < 32 * 24; it += nw) {
        const int ks = it / 24, cb = it % 24, k0 = ks * 64, n0 = cb * 256 + 4 * F.lane;
        scr[F.lane] = silu_f(cvec[k0 + F.lane]); scr[64 + F.lane] = silu_f(cvec[DM + k0 + F.lane]); scr[128 + F.lane] = silu_f(cctx[k0 + F.lane]);
        LDS_WAIT();
        f32x4 a0 = {0.f, 0.f, 0.f, 0.f}, a1 = a0, a2 = a0;
        const float* wp = w_mod + ((size_t)l * DM + k0) * 6144 + n0;
#pragma unroll 8
        for (int k = 0; k < 64; ++k) { const f32x4 w = *(const f32x4*)(wp + (size_t)k * 6144); a0 += w * scr[k]; a1 += w * scr[64 + k]; a2 += w * scr[128 + k]; }
        float* ma = MODACC + (size_t)(l * 3) * 6144 + n0;
#pragma unroll
        for (int e = 0; e < 4; ++e) { atomicAdd(ma + e, a0[e]); atomicAdd(ma + 6144 + e, a1[e]); atomicAdd(ma + 2 * 6144 + e, a2[e]); }
        LDS_WAIT();
    }
}
__device__ __forceinline__ void phase0(Ctx& F) {
    p0_weights(F, 0, F.gw, F.NGW);
    {   const float* w2a = F.prm->in[19]; const float* a2a = F.prm->in[21]; bf16* LW = (bf16*)(F.ws + WS_LW);
        const int gt = F.bx * NTHREADS + F.tid, GT = F.G * NTHREADS;
        for (int idx = gt; idx < 4 * 512 * 64; idx += GT) { const int pd = idx / (512 * 64), rem = idx % (512 * 64), k = rem >> 9, chg = rem & 511, hq = chg >> 6, ch = chg & 63;
            const float v = w2a[((size_t)pd * 64 + k) * 512 + chg]; const unsigned hi = cvtpk(v, 0.f) & 0xffffu; const float lo = v - bflo(hi);
            bf16* base = LW + (size_t)(pd * 8 + hq) * 12288; base[ch * 64 + k] = (bf16)hi; base[4096 + ch * 64 + k] = (bf16)(cvtpk(lo, 0.f) & 0xffffu); }
        for (int idx = gt; idx < 4 * 512 * 32; idx += GT) { const int pd = idx / (512 * 32), rem = idx % (512 * 32), k = rem >> 9, chg = rem & 511, hq = chg >> 6, ch = chg & 63;
            const float v = a2a[((size_t)pd * 32 + k) * 512 + chg]; const unsigned hi = cvtpk(v, 0.f) & 0xffffu; const float lo = v - bflo(hi);
            bf16* base = LW + (size_t)(pd * 8 + hq) * 12288 + 8192; base[ch * 32 + k] = (bf16)hi; base[2048 + ch * 32 + k] = (bf16)(cvtpk(lo, 0.f) & 0xffffu); }
    }
    if (F.bx == 0) {
        float* rope = (float*)(F.ws + WS_ROPE);
        for (int i = F.tid; i < 1024; i += NTHREADS) { const int pos = i >> 4, f = i & 15; const float inv = powf(10000.f, -(float)(2 * f) / 32.f); const float ang = (float)pos * inv;
            rope[i] = cosf(ang); rope[1024 + i] = sinf(ang); }
    }
}

__device__ __forceinline__ void ld_row(const float* p, int lane, f32x4* v) {
#pragma unroll
    for (int j = 0; j < 8; ++j) v[j] = *(const f32x4*)(p + 4 * lane + 256 * j);
}
__device__ __forceinline__ float sumsq8(const f32x4* v) { float s = 0.f;
#pragma unroll
    for (int j = 0; j < 8; ++j) s += (v[j].x * v[j].x + v[j].y * v[j].y) + (v[j].z * v[j].z + v[j].w * v[j].w);
    return s; }
__device__ __forceinline__ void ld_mod(const Ctx& F, int l, int r, int part, int lane, f32x4* v) {
    const float* ma = (const float*)(F.ws + WS_CTL + CTL_MODACC) + (size_t)(l * 3 + r) * 6144 + part * DM; const float* bm = F.prm->in[5] + (size_t)l * 6144 + part * DM;
#pragma unroll
    for (int j = 0; j < 8; ++j) v[j] = *(const f32x4*)(ma + 4 * lane + 256 * j) + *(const f32x4*)(bm + 4 * lane + 256 * j);
}
__device__ __forceinline__ void phase1(Ctx& F, int l) {
    const float* x = F.prm->in[0]; const float* ctx = F.prm->in[2]; const float* g_pre = F.prm->in[6] + (size_t)l * DM; const float* g_post0 = F.prm->in[7];
    const float* O = (const float*)(F.ws + WS_P); bf16* XN = (bf16*)(F.ws + WS_XN);
    LAS float* MV = (LAS float*)F.lds;
    {   const float* ma = (const float*)(F.ws + WS_CTL + CTL_MODACC); const float* bm = F.prm->in[5];
        for (int idx = F.tid; idx < 3 * 512; idx += NTHREADS) { const int r = idx >> 9, n = (idx & 511) * 4;
            const f32x4 shv = *(const f32x4*)(ma + (size_t)(l * 3 + r) * 6144 + n) + *(const f32x4*)(bm + (size_t)l * 6144 + n);
            const f32x4 scv = *(const f32x4*)(ma + (size_t)(l * 3 + r) * 6144 + DM + n) + *(const f32x4*)(bm + (size_t)l * 6144 + DM + n);
            *(LAS f32x4*)(MV + (r * 3 + 0) * DM + n) = shv; *(LAS f32x4*)(MV + (r * 3 + 1) * DM + n) = (scv + 1.f) * *(const f32x4*)(g_pre + n);
            if (l == 1) { const f32x4 gt = *(const f32x4*)(ma + (size_t)r * 6144 + 2 * DM + n) + *(const f32x4*)(bm + 2 * DM + n); *(LAS f32x4*)(MV + (r * 3 + 2) * DM + n) = gt * *(const f32x4*)(g_post0 + n); } }
    }
    WG_BAR();
    for (int row = F.gw; row < MT; row += F.NGW) {
        const bool lat = row < ML; const int r = lat ? (row / TL) : 2;
        const LAS float* mv = MV + r * 3 * DM + 4 * F.lane;
        const float* src = lat ? x + (size_t)row * DM : ctx + (size_t)(row - ML) * DM;
        f32x4 xv[8]; ld_row(src, F.lane, xv);
        if (l == 1) {
            f32x4 ov[8]; ld_row(O + (size_t)row * DM, F.lane, ov);
            const float rs = 1.f / sqrtf(wave_sum(sumsq8(ov)) * (1.f / DM) + EPS);
#pragma unroll
            for (int j = 0; j < 8; ++j) xv[j] = xv[j] + *(const LAS f32x4*)(mv + 2 * DM + 256 * j) * (ov[j] * rs);
            if (lat) {
#pragma unroll
                for (int j = 0; j < 8; ++j) *(f32x4*)(F.out + (size_t)row * DM + 4 * F.lane + 256 * j) = xv[j];
            }
        }
        const float rs = 1.f / sqrtf(wave_sum(sumsq8(xv)) * (1.f / DM) + EPS);
#pragma unroll
        for (int j = 0; j < 8; ++j) { const f32x4 h = (xv[j] * rs) * *(const LAS f32x4*)(mv + DM + 256 * j) + *(const LAS f32x4*)(mv + 256 * j);
            u32x2 w; w.x = cvtpk(h.x, h.y); w.y = cvtpk(h.z, h.w); *(u32x2*)(XN + (size_t)row * DM + 4 * F.lane + 256 * j) = w; }
    }
    WG_BAR();
}
__device__ __forceinline__ void phase6(Ctx& F) {
    const float* g_post1 = F.prm->in[7] + DM; const float* O = (const float*)(F.ws + WS_P);
    for (int row = F.gw; row < ML; row += F.NGW) {
        const int r = row / TL;
        f32x4 xv[8], ov[8], gt[8], gp[8]; ld_row(F.out + (size_t)row * DM, F.lane, xv); ld_row(O + (size_t)row * DM, F.lane, ov); ld_mod(F, 1, r, 2, F.lane, gt); ld_row(g_post1, F.lane, gp);
        const float rs = 1.f / sqrtf(wave_sum(sumsq8(ov)) * (1.f / DM) + EPS);
#pragma unroll
        for (int j = 0; j < 8; ++j) *(f32x4*)(F.out + (size_t)row * DM + 4 * F.lane + 256 * j) = xv[j] + gt[j] * (ov[j] * rs * gp[j]);
    }
}

__device__ __forceinline__ void sgu_item(Ctx& F, int l, int cb, int h) {
    const bf16* P = (const bf16*)(F.ws + WS_P); bf16* OC = (bf16*)(F.ws + WS_OC);
    const float* w_s = F.prm->in[10] + (size_t)(l * 4 + h) * 128 * 128; const float* b_s = F.prm->in[11] + (size_t)(l * 4 + h) * 128;
    const int row0 = cb < 64 ? (cb >> 5) * TL + (cb & 31) * 128 : ML + ((cb - 64) >> 1) * CL + ((cb - 64) & 1) * 128;
    LAS float* VN = (LAS float*)F.lds;
    LAS float* WT = (LAS float*)(F.lds + 65536);
    {
        const int row = F.tid >> 2, qt = F.tid & 3; const bf16* src = P + (size_t)(row0 + row) * NINP + A_V + h * 128 + qt * 32;
        float v[32];
#pragma unroll
        for (int i = 0; i < 4; ++i) unpack8(*(const u32x4*)(src + 8 * i), v + 8 * i);
        float s = 0.f;
#pragma unroll
        for (int i = 0; i < 32; ++i) s += v[i];
        const float mean = red4(s) * (1.f / 128.f); float q = 0.f;
#pragma unroll
        for (int i = 0; i < 32; ++i) { v[i] -= mean; q += v[i] * v[i]; }
        const float rstd = 1.f / sqrtf(red4(q) * (1.f / 128.f) + EPS);
#pragma unroll
        for (int i = 0; i < 8; ++i) *(LAS f32x4*)(VN + row * 128 + qt * 32 + 4 * i) = (f32x4){v[4 * i] * rstd, v[4 * i + 1] * rstd, v[4 * i + 2] * rstd, v[4 * i + 3] * rstd};
    }
    for (int idx = F.tid; idx < 4096; idx += NTHREADS) { const int p = idx >> 5, q4 = idx & 31; const f32x4 w = *(const f32x4*)(w_s + p * 128 + 4 * q4);
        WT[(4 * q4 + 0) * 128 + p] = w.x; WT[(4 * q4 + 1) * 128 + p] = w.y; WT[(4 * q4 + 2) * 128 + p] = w.z; WT[(4 * q4 + 3) * 128 + p] = w.w; }
    WG_BAR();
    const int pg = F.tid >> 5, dg = F.tid & 31;
    f32x4 acc[8];
#pragma unroll
    for (int i = 0; i < 8; ++i) acc[i] = (f32x4){0.f, 0.f, 0.f, 0.f};
#pragma unroll 4
    for (int q = 0; q < 128; ++q) {
        const f32x4 w0 = *(const LAS f32x4*)(WT + q * 128 + 8 * pg), w1 = *(const LAS f32x4*)(WT + q * 128 + 8 * pg + 4), vv = *(const LAS f32x4*)(VN + q * 128 + 4 * dg);
        acc[0] += vv * w0.x; acc[1] += vv * w0.y; acc[2] += vv * w0.z; acc[3] += vv * w0.w; acc[4] += vv * w1.x; acc[5] += vv * w1.y; acc[6] += vv * w1.z; acc[7] += vv * w1.w;
    }
#pragma unroll
    for (int i = 0; i < 8; ++i) { const int p = 8 * pg + i; const float bs = b_s[p]; const bf16* pr = P + (size_t)(row0 + p) * NINP + h * 128 + 4 * dg;
        const u32x2 uu = *(const u32x2*)(pr + A_U), gg = *(const u32x2*)(pr + A_G);
        const float o0 = bflo(uu.x) * (acc[i].x + bs) * silu_f(bflo(gg.x)), o1 = bfhi(uu.x) * (acc[i].y + bs) * silu_f(bfhi(gg.x));
        const float o2 = bflo(uu.y) * (acc[i].z + bs) * silu_f(bflo(gg.y)), o3 = bfhi(uu.y) * (acc[i].w + bs) * silu_f(bfhi(gg.y));
        u32x2 w; w.x = cvtpk(o0, o1); w.y = cvtpk(o2, o3); *(u32x2*)(OC + (size_t)(row0 + p) * DM + h * 128 + 4 * dg) = w; }
    WG_BAR();
}

__device__ __forceinline__ void conv_item(Ctx& F, int l, int item) {
    const bf16* P = (const bf16*)(F.ws + WS_P); bf16* OC = (bf16*)(F.ws + WS_OC); const float* cw = F.prm->in[27] + (size_t)l * 3 * 512;
    const int row = item * 16 + (F.tid >> 5), c0 = (F.tid & 31) * 16;
    int t, tlen; if (row < ML) { t = row & (TL - 1); tlen = TL; } else { t = (row - ML) & (CL - 1); tlen = CL; }
    const bf16* pr = P + (size_t)row * NINP;
    float z0[16], z1[16], z2[16], tmp[16];
#pragma unroll
    for (int i = 0; i < 2; ++i) {
        float a[8], b[8];
        unpack8(*(const u32x4*)(pr + D_C + c0 + 8 * i), a); unpack8(*(const u32x4*)(pr + D_X + c0 + 8 * i), b);
#pragma unroll
        for (int e = 0; e < 8; ++e) z1[8 * i + e] = a[e] * b[e];
        if (t > 0) { unpack8(*(const u32x4*)(pr - NINP + D_C + c0 + 8 * i), a); unpack8(*(const u32x4*)(pr - NINP + D_X + c0 + 8 * i), b);
#pragma unroll
            for (int e = 0; e < 8; ++e) z0[8 * i + e] = a[e] * b[e]; }
        else {
#pragma unroll
            for (int e = 0; e < 8; ++e) z0[8 * i + e] = 0.f; }
        if (t < tlen - 1) { unpack8(*(const u32x4*)(pr + NINP + D_C + c0 + 8 * i), a); unpack8(*(const u32x4*)(pr + NINP + D_X + c0 + 8 * i), b);
#pragma unroll
            for (int e = 0; e < 8; ++e) z2[8 * i + e] = a[e] * b[e]; }
        else {
#pragma unroll
            for (int e = 0; e < 8; ++e) z2[8 * i + e] = 0.f; }
    }
#pragma unroll
    for (int i = 0; i < 2; ++i) {
        float bg[8], gg[8]; unpack8(*(const u32x4*)(pr + D_B + c0 + 8 * i), bg); unpack8(*(const u32x4*)(pr + D_G + c0 + 8 * i), gg);
#pragma unroll
        for (int e = 0; e < 8; ++e) { const int c = c0 + 8 * i + e; const float y = cw[c] * z0[8 * i + e] + cw[512 + c] * z1[8 * i + e] + cw[1024 + c] * z2[8 * i + e]; tmp[e] = bg[e] * y * silu_f(gg[e]); }
        *(u32x4*)(OC + (size_t)row * DM + 1536 + c0 + 8 * i) = pack8(tmp);
    }
}

__device__ __forceinline__ void attnprep_item(Ctx& F, int l, int rb, int h) {
    const bf16* P = (const bf16*)(F.ws + WS_P); const float* rope = (const float*)(F.ws + WS_ROPE);
    bf16* QR = (bf16*)(F.ws + WS_QR); bf16* QC = (bf16*)(F.ws + WS_QC); bf16* KR = (bf16*)(F.ws + WS_KR); bf16* VT = (bf16*)(F.ws + WS_VT);
    const bool lat = rb < 128; const int b = lat ? (rb >> 6) : ((rb - 128) >> 2), t0 = lat ? (rb & 63) * 64 : ((rb - 128) & 3) * 64;
    const int row0 = lat ? b * TL + t0 : ML + b * CL + t0;
    {
        const int tk = F.tid >> 3, sub = F.tid & 7, isk = sub >> 2, hq = sub & 3, m = hq >> 1, half = hq & 1, t = t0 + tk;
        const bf16* src = P + (size_t)(row0 + tk) * NINP + (isk ? B_K : B_Q) + h * 128 + 32 * hq;
        float xx[32], oo[32];
#pragma unroll
        for (int i = 0; i < 4; ++i) unpack8(*(const u32x4*)(src + 8 * i), xx + 8 * i);
        if (lat) { const int pos = half ? (t & 63) : (t >> 6); const float* cs = rope + pos * 16; const float* sn = rope + 1024 + pos * 16;
#pragma unroll
            for (int i = 0; i < 16; ++i) { const float c = cs[i], s = sn[i]; oo[i] = xx[i] * c - xx[i + 16] * s; oo[i + 16] = xx[i + 16] * c + xx[i] * s; } }
        else {
#pragma unroll
            for (int i = 0; i < 32; ++i) oo[i] = xx[i]; }
        if (!isk) {
#pragma unroll
            for (int i = 0; i < 32; ++i) oo[i] *= QSCALE; }
        const int bhm = (b * 4 + h) * 2 + m;
        bf16* dst = isk ? KR + ((size_t)bhm * KEYS + (lat ? CL + t : t)) * 64 + 32 * half : (lat ? QR + ((size_t)bhm * TL + t) * 64 + 32 * half : QC + ((size_t)bhm * CL + t) * 64 + 32 * half);
        if (isk || lat || l == 0) {
#pragma unroll
            for (int i = 0; i < 4; ++i) *(u32x4*)(dst + 8 * i) = pack8(oo + 8 * i); }
    }
    LAS unsigned char* VL = F.lds;
#pragma unroll
    for (int pass = 0; pass < 2; ++pass) { const int idx = F.tid + 512 * pass, key = idx >> 4, c = idx & 15;
        *(LAS u32x4*)(VL + key * 272 + 16 * c) = *(const u32x4*)(P + (size_t)(row0 + key) * NINP + B_V + h * 128 + 8 * c); }
    WG_BAR();
    const int keybase = lat ? CL + t0 : t0;
#pragma unroll
    for (int pass = 0; pass < 2; ++pass) { const int idx = F.tid + 512 * pass, dv = idx >> 3, kc = idx & 7; unsigned short e[8];
#pragma unroll
        for (int i = 0; i < 8; ++i) e[i] = *(const LAS unsigned short*)(VL + (8 * kc + i) * 272 + 2 * dv);
        u32x4 o; o.x = e[0] | ((unsigned)e[1] << 16); o.y = e[2] | ((unsigned)e[3] << 16); o.z = e[4] | ((unsigned)e[5] << 16); o.w = e[6] | ((unsigned)e[7] << 16);
        *(u32x4*)(VT + ((size_t)(b * 4 + h) * 128 + dv) * KEYS + keybase + 8 * kc) = o; }
    WG_BAR();
}

constexpr int NCHUNK = NSTEP / 64;
constexpr int CHKB = 62464;
constexpr int CK_W1F = 0, CK_RF = 8192, CK_BTF = 16384, CK_ARBF = 24576, CK_ARKF = 30720, CK_VF = 36864, CK_W2A = 45056, CK_GA = 53248, CK_CLV = 61440;
static_assert((size_t)32 * NCHUNK * CHKB <= WS_Y - WS_CHK, "chunk records");

__device__ __forceinline__ bf16x8 frag16(const LAS unsigned char* tile, int row, int k0) { return *(const LAS bf16x8*)(tile + row * 144 + k0 * 2); }
__device__ __forceinline__ bf16x8 fragP(const LAS unsigned char* tile, int row, int base, int hh) {
    const u32x2 lo = *(const LAS u32x2*)(tile + row * 144 + (base + 4 * hh) * 2), hi = *(const LAS u32x2*)(tile + row * 144 + (base + 8 + 4 * hh) * 2);
    const u32x4 w = {lo.x, lo.y, hi.x, hi.y}; return __builtin_bit_cast(bf16x8, w);
}
template <int S8> __device__ __forceinline__ bf16x8 pk8(const f32x16& a) {
    const u32x4 w = {cvtpk(a[S8], a[S8 + 1]), cvtpk(a[S8 + 2], a[S8 + 3]), cvtpk(a[S8 + 4], a[S8 + 5]), cvtpk(a[S8 + 6], a[S8 + 7])}; return __builtin_bit_cast(bf16x8, w);
}
__device__ __forceinline__ f32x16 zero16() { f32x16 z;
#pragma unroll
    for (int r = 0; r < 16; ++r) z[r] = 0.f;
    return z; }
__device__ __forceinline__ f32x16 tile_prod(const LAS unsigned char* At, int m0, const LAS unsigned char* Bt, int n0, int l31, int hh) {
    f32x16 d = zero16();
#pragma unroll
    for (int q = 0; q < 4; ++q) d = __builtin_amdgcn_mfma_f32_32x32x16_bf16(frag16(At, m0 + l31, 16 * q + 8 * hh), frag16(Bt, n0 + l31, 16 * q + 8 * hh), d, 0, 0, 0);
    return d;
}
#define MROW(reg, hh) (((reg) & 3) + 8 * ((reg) >> 2) + 4 * (hh))
__device__ __forceinline__ void st_acc32(unsigned char* p, const f32x16& d) {
    *(u32x4*)p = (u32x4){cvtpk(d[0], d[1]), cvtpk(d[2], d[3]), cvtpk(d[4], d[5]), cvtpk(d[6], d[7])};
    *(u32x4*)(p + 16) = (u32x4){cvtpk(d[8], d[9]), cvtpk(d[10], d[11]), cvtpk(d[12], d[13]), cvtpk(d[14], d[15])};
}
__device__ __forceinline__ f32x16 ld_acc32(const LAS unsigned char* p) {
    const u32x4 a = *(const LAS u32x4*)p, b = *(const LAS u32x4*)(p + 16); f32x16 d;
    d[0] = bflo(a.x); d[1] = bfhi(a.x); d[2] = bflo(a.y); d[3] = bfhi(a.y); d[4] = bflo(a.z); d[5] = bfhi(a.z); d[6] = bflo(a.w); d[7] = bfhi(a.w);
    d[8] = bflo(b.x); d[9] = bfhi(b.x); d[10] = bflo(b.y); d[11] = bfhi(b.y); d[12] = bflo(b.z); d[13] = bfhi(b.z); d[14] = bflo(b.w); d[15] = bfhi(b.w); return d;
}
__device__ __forceinline__ float softplus_f(float x) { return fmaxf(x, 0.f) + __logf(1.f + __expf(-fabsf(x))); }
__device__ __forceinline__ int scan_row(int c, int i, int dir, int b) {
    const bool isctx = c < 4; const int bi = (isctx ? 64 * c : 64 * (c - 4)) + i;
    return isctx ? ML + b * CL + (dir ? CL - 1 - bi : bi) : b * TL + (dir ? TL - 1 - bi : bi);
}

__device__ __forceinline__ void rwkv1_item(Ctx& F, int l, int item) {
    const int scan = item / NCHUNK, c = item % NCHUNK, dir = scan >> 4, b = (scan >> 3) & 1, h = scan & 7;
    const bf16* P = (const bf16*)(F.ws + WS_P); unsigned char* rec = F.ws + WS_CHK + (size_t)item * CHKB;
    bf16* BON = (bf16*)(F.ws + WS_BON) + (size_t)dir * MT * 512;
    LAS unsigned char* TA = F.lds; LAS unsigned char* TB = F.lds + 9216; LAS unsigned char* TK = F.lds + 18432; LAS unsigned char* TR = F.lds + 27648;
    LAS unsigned char* TAT = F.lds + 36864; LAS unsigned char* TBT = F.lds + 46080; LAS unsigned char* TKT = F.lds + 55296; LAS unsigned char* TVT = F.lds + 64512;
    LAS unsigned char* TT = F.lds + 73728;
    LAS float* AAB = (LAS float*)(F.lds + 82944);
    LAS float* CLS = (LAS float*)(F.lds + 100352);
    LAS unsigned char* LWH = F.lds;             LAS unsigned char* LWL = F.lds + 9216;
    LAS unsigned char* LAH = F.lds + 18432;     LAS unsigned char* LAL = F.lds + 23552;
    LAS unsigned char* XWH = F.lds + 28672;     LAS unsigned char* XWL = F.lds + 37888;
    LAS unsigned char* XAH = F.lds + 47104;     LAS unsigned char* XAL = F.lds + 52224;
    LAS float* OW = (LAS float*)(F.lds + 57344);
    LAS float* OA = (LAS float*)(F.lds + 74752);
    const int i = F.tid >> 3, sub = F.tid & 7, c0 = 8 * sub, gc0 = h * 64 + c0;
    const bool isctx = c < 4; const int bi = (isctx ? 64 * c : 64 * (c - 4)) + i;
    const int row = scan_row(c, i, dir, b);
    const bool hasprev = bi > 0;
    const bf16* pr = P + (size_t)row * NINP; const bf16* pp = dir ? pr + NINP : pr - NINP;
    const int pd = l * 2 + dir;
    const float* mu = F.prm->in[17] + (size_t)pd * 1632; const float* w0 = F.prm->in[18] + (size_t)pd * 512; const float* w2 = F.prm->in[19] + (size_t)pd * 64 * 512;
    const float* a0 = F.prm->in[20] + (size_t)pd * 512; const float* a2 = F.prm->in[21] + (size_t)pd * 32 * 512; const float* k_k = F.prm->in[22] + (size_t)pd * 512;
    const float* k_a = F.prm->in[23] + (size_t)pd * 512; const float* r_k = F.prm->in[24] + (size_t)pd * 512;
    const int CLX = dir == 0 ? C_LF : C_LB;
    const u32x4 zz4 = {0u, 0u, 0u, 0u}; const u32x2 zz2 = {0u, 0u};
    const u32x4 g_l = *(const u32x4*)(pr + CLX + c0), g_r = *(const u32x4*)(pr + C_R + gc0), g_k = *(const u32x4*)(pr + C_K + gc0), g_v = *(const u32x4*)(pr + C_V + gc0);
    const u32x2 g_a = *(const u32x2*)(pr + CLX + 64 + 4 * sub);
    u32x4 p_l = zz4, p_r = zz4, p_k = zz4, p_v = zz4; u32x2 p_a = zz2;
    if (hasprev) { p_l = *(const u32x4*)(pp + CLX + c0); p_r = *(const u32x4*)(pp + C_R + gc0); p_k = *(const u32x4*)(pp + C_K + gc0); p_v = *(const u32x4*)(pp + C_V + gc0); p_a = *(const u32x2*)(pp + CLX + 64 + 4 * sub); }
    {
        const unsigned char* lwg = F.ws + WS_LW + (size_t)(pd * 8 + h) * 24576;
        { const int p = F.tid, r = p >> 3, cq = p & 7; *(LAS u32x4*)(LWH + r * 144 + cq * 16) = *(const u32x4*)(lwg + p * 16); *(LAS u32x4*)(LWL + r * 144 + cq * 16) = *(const u32x4*)(lwg + 8192 + p * 16); }
        { const int p = F.tid & 255, r = p >> 2, cq = p & 3; LAS unsigned char* dst = (F.tid < 256 ? LAH : LAL); *(LAS u32x4*)(dst + r * 80 + cq * 16) = *(const u32x4*)(lwg + 16384 + (F.tid < 256 ? 0 : 4096) + p * 16); }
    }
    {   float f[8], pv[8], th[8], tl[8]; unpack8(g_l, f); unpack8(p_l, pv);
#pragma unroll
        for (int e = 0; e < 8; ++e) { const float z = f[e] + (pv[e] - f[e]) * mu[1536 + c0 + e]; const float ez = __expf(-2.f * fabsf(z)); const float t0 = (1.f - ez) * __builtin_amdgcn_rcpf(1.f + ez); const float tv = z < 0.f ? -t0 : t0;
            th[e] = bflo(cvtpk(tv, 0.f)); tl[e] = tv - th[e]; }
        *(LAS u32x4*)(XWH + i * 144 + 2 * c0) = pack8(th); *(LAS u32x4*)(XWL + i * 144 + 2 * c0) = pack8(tl);
        const float fz[4] = {bflo(g_a.x), bfhi(g_a.x), bflo(g_a.y), bfhi(g_a.y)}, pz[4] = {bflo(p_a.x), bfhi(p_a.x), bflo(p_a.y), bfhi(p_a.y)}; float zh[4], zl[4];
#pragma unroll
        for (int e = 0; e < 4; ++e) { const float z = fz[e] + (pz[e] - fz[e]) * mu[1600 + 4 * sub + e]; zh[e] = bflo(cvtpk(z, 0.f)); zl[e] = z - zh[e]; }
        *(LAS u32x2*)(XAH + i * 80 + 8 * sub) = (u32x2){cvtpk(zh[0], zh[1]), cvtpk(zh[2], zh[3])}; *(LAS u32x2*)(XAL + i * 80 + 8 * sub) = (u32x2){cvtpk(zl[0], zl[1]), cvtpk(zl[2], zl[3])};
    }
    WG_BAR();
    {
        const int l31 = F.lane & 31, hh = F.lane >> 5, mt = (F.wave >> 1) & 1, nt = F.wave & 1;
        f32x16 d = zero16();
        if (F.wave < 4) {
#pragma unroll
            for (int q = 0; q < 4; ++q) { const bf16x8 ah = frag16(XWH, 32 * mt + l31, 16 * q + 8 * hh), al_ = frag16(XWL, 32 * mt + l31, 16 * q + 8 * hh), bh = frag16(LWH, 32 * nt + l31, 16 * q + 8 * hh), bl = frag16(LWL, 32 * nt + l31, 16 * q + 8 * hh);
                d = __builtin_amdgcn_mfma_f32_32x32x16_bf16(ah, bh, d, 0, 0, 0); d = __builtin_amdgcn_mfma_f32_32x32x16_bf16(ah, bl, d, 0, 0, 0); d = __builtin_amdgcn_mfma_f32_32x32x16_bf16(al_, bh, d, 0, 0, 0); }
#pragma unroll
            for (int r = 0; r < 16; ++r) OW[(32 * mt + MROW(r, hh)) * 68 + 32 * nt + l31] = d[r];
        } else {
#pragma unroll
            for (int q = 0; q < 2; ++q) { const int ko = (16 * q + 8 * hh) * 2;
                const bf16x8 ah = *(const LAS bf16x8*)(XAH + (32 * mt + l31) * 80 + ko), al_ = *(const LAS bf16x8*)(XAL + (32 * mt + l31) * 80 + ko), bh = *(const LAS bf16x8*)(LAH + (32 * nt + l31) * 80 + ko), bl = *(const LAS bf16x8*)(LAL + (32 * nt + l31) * 80 + ko);
                d = __builtin_amdgcn_mfma_f32_32x32x16_bf16(ah, bh, d, 0, 0, 0); d = __builtin_amdgcn_mfma_f32_32x32x16_bf16(ah, bl, d, 0, 0, 0); d = __builtin_amdgcn_mfma_f32_32x32x16_bf16(al_, bh, d, 0, 0, 0); }
#pragma unroll
            for (int r = 0; r < 16; ++r) OA[(32 * mt + MROW(r, hh)) * 68 + 32 * nt + l31] = d[r];
        }
    }
    WG_BAR();
    float wp[8], ap[8];
    { const f32x4 a = *(const LAS f32x4*)(OW + i * 68 + c0), bq = *(const LAS f32x4*)(OW + i * 68 + c0 + 4), cq = *(const LAS f32x4*)(OA + i * 68 + c0), dq = *(const LAS f32x4*)(OA + i * 68 + c0 + 4);
      const float ow[8] = {a.x, a.y, a.z, a.w, bq.x, bq.y, bq.z, bq.w}, oa[8] = {cq.x, cq.y, cq.z, cq.w, dq.x, dq.y, dq.z, dq.w};
#pragma unroll
      for (int e = 0; e < 8; ++e) { wp[e] = w0[gc0 + e] + ow[e]; ap[e] = a0[gc0 + e] + oa[e]; } }
    float lw[8], kk[8], al[8], km[8], rr[8], vv[8];
    {   float fr[8], fk[8], fv[8], qr[8], qk[8], qv[8]; unpack8(g_r, fr); unpack8(g_k, fk); unpack8(g_v, fv); unpack8(p_r, qr); unpack8(p_k, qk); unpack8(p_v, qv);
        float n2 = 0.f, bsum = 0.f;
#pragma unroll
        for (int e = 0; e < 8; ++e) { const int gc = gc0 + e;
            rr[e] = fr[e] + (qr[e] - fr[e]) * mu[gc]; const float kx = fk[e] + (qk[e] - fk[e]) * mu[512 + gc]; vv[e] = fv[e] + (qv[e] - fv[e]) * mu[1024 + gc];
            const float w = -softplus_f(-wp[e]) - 0.5f; lw[e] = -__expf(w);
            al[e] = __builtin_amdgcn_rcpf(1.f + __expf(-ap[e]));
            kk[e] = kx * k_k[gc]; n2 += kk[e] * kk[e];
            km[e] = kx * (1.f + (al[e] - 1.f) * k_a[gc]);
            bsum += rr[e] * km[e] * r_k[gc]; }
        n2 = red8(n2); bsum = red8(bsum);
        const float inv = __builtin_amdgcn_rsqf(fmaxf(n2, 1e-24f)); float bon[8];
#pragma unroll
        for (int e = 0; e < 8; ++e) { kk[e] *= inv; bon[e] = bsum * vv[e]; }
        *(u32x4*)(BON + (size_t)row * 512 + gc0) = pack8(bon);
    }
    *(LAS f32x4*)(CLS + i * 64 + c0) = (f32x4){lw[0], lw[1], lw[2], lw[3]}; *(LAS f32x4*)(CLS + i * 64 + c0 + 4) = (f32x4){lw[4], lw[5], lw[6], lw[7]};
    WG_BAR();
    if (F.tid < 64) {
        float x[64];
#pragma unroll
        for (int q = 0; q < 64; ++q) x[q] = CLS[q * 64 + F.tid];
#pragma unroll
        for (int q = 1; q < 64; ++q) x[q] += x[q - 1];
#pragma unroll
        for (int q = 0; q < 64; ++q) CLS[q * 64 + F.tid] = x[q];
    }
    WG_BAR();
    {   float cl[8], cL[8];
        { const f32x4 a = *(const LAS f32x4*)(CLS + i * 64 + c0), bq = *(const LAS f32x4*)(CLS + i * 64 + c0 + 4), cc = *(const LAS f32x4*)(CLS + 63 * 64 + c0), dd = *(const LAS f32x4*)(CLS + 63 * 64 + c0 + 4);
          cl[0] = a.x; cl[1] = a.y; cl[2] = a.z; cl[3] = a.w; cl[4] = bq.x; cl[5] = bq.y; cl[6] = bq.z; cl[7] = bq.w; cL[0] = cc.x; cL[1] = cc.y; cL[2] = cc.z; cL[3] = cc.w; cL[4] = dd.x; cL[5] = dd.y; cL[6] = dd.z; cL[7] = dd.w; }
        float tA[8], tB[8], tK[8], tR[8], tBt[8], tKt[8];
#pragma unroll
        for (int e = 0; e < 8; ++e) { const float eA = __expf(cl[e] - lw[e]), eI = __expf(-cl[e]), eR = __expf(cl[e]), eT = __expf(cL[e] - cl[e]); const float ba = kk[e] * al[e];
            tA[e] = -kk[e] * eA; tB[e] = ba * eI; tK[e] = km[e] * eI; tR[e] = rr[e] * eR; tBt[e] = ba * eT; tKt[e] = km[e] * eT; }
        *(LAS u32x4*)(TA + i * 144 + 2 * c0) = pack8(tA); *(LAS u32x4*)(TB + i * 144 + 2 * c0) = pack8(tB); *(LAS u32x4*)(TK + i * 144 + 2 * c0) = pack8(tK); *(LAS u32x4*)(TR + i * 144 + 2 * c0) = pack8(tR);
        const u32x4 qa = pack8(tA), qb = pack8(tBt), qk = pack8(tKt), qv = pack8(vv);
        const unsigned wa[4] = {qa.x, qa.y, qa.z, qa.w}, wb[4] = {qb.x, qb.y, qb.z, qb.w}, wk[4] = {qk.x, qk.y, qk.z, qk.w}, wv[4] = {qv.x, qv.y, qv.z, qv.w};
#pragma unroll
        for (int e = 0; e < 8; ++e) { const int sh = (e & 1) * 16; const int o = (c0 + e) * 144 + 2 * i;
            *(LAS unsigned short*)(TAT + o) = (unsigned short)(wa[e >> 1] >> sh); *(LAS unsigned short*)(TBT + o) = (unsigned short)(wb[e >> 1] >> sh);
            *(LAS unsigned short*)(TKT + o) = (unsigned short)(wk[e >> 1] >> sh); *(LAS unsigned short*)(TVT + o) = (unsigned short)(wv[e >> 1] >> sh); }
    }
    WG_BAR();
    const int l31 = F.lane & 31, hh = F.lane >> 5;
    if (F.wave < 3) { const int it = F.wave > 0, jt = F.wave > 1; const f32x16 d = tile_prod(TA, 32 * it, TB, 32 * jt, l31, hh);
#pragma unroll
        for (int r = 0; r < 16; ++r) { const int ii = 32 * it + MROW(r, hh), j = 32 * jt + l31; AAB[ii * 68 + (j & 7) * 8 + (j >> 3)] = j < ii ? d[r] : 0.f; } }
    else if (F.wave == 3) {
#pragma unroll
        for (int r = 0; r < 16; ++r) AAB[(2 * r + hh) * 68 + (l31 & 7) * 8 + 4 + (l31 >> 3)] = 0.f; }
    else if (F.wave == 4) {
#pragma unroll
        for (int f = 0; f < 8; ++f) { const int it = f >> 2, kt = (f >> 1) & 1, s = f & 1; *(bf16x8*)(rec + CK_RF + (f * 64 + F.lane) * 16) = fragP(TR, 32 * it + l31, 32 * kt + 16 * s, hh); } }
    else if (F.wave == 5) {
#pragma unroll
        for (int f = 0; f < 8; ++f) { const int kt = f >> 2, jt = (f >> 1) & 1, s = f & 1; *(bf16x8*)(rec + CK_BTF + (f * 64 + F.lane) * 16) = fragP(TBT, 32 * kt + l31, 32 * jt + 16 * s, hh); } }
    else if (F.wave == 6) {
#pragma unroll
        for (int f = 0; f < 8; ++f) { const int vt = f >> 2, jt = (f >> 1) & 1, s = f & 1; *(bf16x8*)(rec + CK_VF + (f * 64 + F.lane) * 16) = fragP(TVT, 32 * vt + l31, 32 * jt + 16 * s, hh); } }
    else { *(float*)(rec + CK_CLV + 4 * F.lane) = __expf(CLS[63 * 64 + F.lane]); }
    WG_BAR();
    {   const int col = F.tid >> 3; int dg = col; float town[8];
#pragma unroll
        for (int q = 0; q < 8; ++q) town[q] = 0.f;
        const LAS float* arow = AAB + sub * 8; asm volatile("" : "+v"(arow));
        LAS unsigned char* ttw = TT + 2 * col; asm volatile("" : "+v"(ttw));
#pragma unroll
        for (int q = 0; q < 8; ++q)
#pragma unroll
            for (int r = 0; r < 8; ++r) { const int ii = 8 * q + r;
                const f32x4 a0 = *(const LAS f32x4*)(arow + ii * 68), a1 = *(const LAS f32x4*)(arow + ii * 68 + 4);
                float p = a0.x * town[0];
                if (q >= 1) p += a0.y * town[1]; if (q >= 2) p += a0.z * town[2]; if (q >= 3) p += a0.w * town[3];
                if (q >= 4) p += a1.x * town[4]; if (q >= 5) p += a1.y * town[5]; if (q >= 6) p += a1.z * town[6]; if (q >= 7) p += a1.w * town[7];
                p = red8(p);
                const float tv = p + ((dg == 0) ? 1.f : 0.f); dg -= 1; asm volatile("" : "+v"(dg));
                town[q] = (sub == r) ? tv : town[q];
            }
#pragma unroll
        for (int q = 0; q < 8; ++q) *(LAS unsigned short*)(ttw + (8 * q + sub) * 144) = (unsigned short)cvtpk(town[q], 0.f);
    }
    f32x16 X0 = zero16(), X1 = zero16();
    if (F.wave == 0) {
    } else if (F.wave <= 2) {
        const int vt = F.wave - 1;
        f32x16 a00 = tile_prod(TK, 0, TA, 0, l31, hh), a11 = tile_prod(TK, 32, TA, 32, l31, hh); const f32x16 a01 = tile_prod(TK, 0, TA, 32, l31, hh);
#pragma unroll
        for (int r = 0; r < 16; ++r) { const bool keep = MROW(r, hh) < l31; a00[r] = keep ? a00[r] : 0.f; a11[r] = keep ? a11[r] : 0.f; }
        X0 = __builtin_amdgcn_mfma_f32_32x32x16_bf16(pk8<0>(a00), fragP(TVT, 32 * vt + l31, 0, hh), X0, 0, 0, 0);
        X0 = __builtin_amdgcn_mfma_f32_32x32x16_bf16(pk8<8>(a00), fragP(TVT, 32 * vt + l31, 16, hh), X0, 0, 0, 0);
        X1 = __builtin_amdgcn_mfma_f32_32x32x16_bf16(pk8<0>(a01), fragP(TVT, 32 * vt + l31, 0, hh), X1, 0, 0, 0);
        X1 = __builtin_amdgcn_mfma_f32_32x32x16_bf16(pk8<8>(a01), fragP(TVT, 32 * vt + l31, 16, hh), X1, 0, 0, 0);
        X1 = __builtin_amdgcn_mfma_f32_32x32x16_bf16(pk8<0>(a11), fragP(TVT, 32 * vt + l31, 32, hh), X1, 0, 0, 0);
        X1 = __builtin_amdgcn_mfma_f32_32x32x16_bf16(pk8<8>(a11), fragP(TVT, 32 * vt + l31, 48, hh), X1, 0, 0, 0);
    } else if (F.wave <= 4) {
        const LAS unsigned char* Tm = F.wave == 3 ? TB : TK; unsigned char* dst = rec + (F.wave == 3 ? CK_ARBF : CK_ARKF);
#pragma unroll
        for (int blk = 0; blk < 3; ++blk) { const int it = blk > 0, jt = blk > 1; f32x16 d = tile_prod(Tm, 32 * jt, TR, 32 * it, l31, hh);
            if (it == jt) {
#pragma unroll
                for (int r = 0; r < 16; ++r) d[r] = MROW(r, hh) <= l31 ? d[r] : 0.f; }
            *(bf16x8*)(dst + ((blk * 2 + 0) * 64 + F.lane) * 16) = pk8<0>(d); *(bf16x8*)(dst + ((blk * 2 + 1) * 64 + F.lane) * 16) = pk8<8>(d); }
    } else if (F.wave <= 6) {
        const int kt = F.wave - 5;
#pragma unroll
        for (int vt = 0; vt < 2; ++vt) { const f32x16 d = tile_prod(TKT, 32 * kt, TVT, 32 * vt, l31, hh); st_acc32(rec + CK_GA + ((kt * 2 + vt) * 64 + F.lane) * 32, d); }
    }
    WG_BAR();
    if (F.wave == 1 || F.wave == 2) { const int vt = F.wave - 1;
        f32x16 w0a = zero16(), w1a = zero16();
        w0a = __builtin_amdgcn_mfma_f32_32x32x16_bf16(fragP(TT, l31, 0, hh), pk8<0>(X0), w0a, 0, 0, 0);
        w0a = __builtin_amdgcn_mfma_f32_32x32x16_bf16(fragP(TT, l31, 16, hh), pk8<8>(X0), w0a, 0, 0, 0);
        w1a = __builtin_amdgcn_mfma_f32_32x32x16_bf16(fragP(TT, 32 + l31, 0, hh), pk8<0>(X0), w1a, 0, 0, 0);
        w1a = __builtin_amdgcn_mfma_f32_32x32x16_bf16(fragP(TT, 32 + l31, 16, hh), pk8<8>(X0), w1a, 0, 0, 0);
        w1a = __builtin_amdgcn_mfma_f32_32x32x16_bf16(fragP(TT, 32 + l31, 32, hh), pk8<0>(X1), w1a, 0, 0, 0);
        w1a = __builtin_amdgcn_mfma_f32_32x32x16_bf16(fragP(TT, 32 + l31, 48, hh), pk8<8>(X1), w1a, 0, 0, 0);
        st_acc32(rec + CK_W2A + ((0 * 2 + vt) * 64 + F.lane) * 32, w0a); st_acc32(rec + CK_W2A + ((1 * 2 + vt) * 64 + F.lane) * 32, w1a);
    } else if (F.wave >= 3 && F.wave <= 6) { const int kt = (F.wave - 3) >> 1, it = (F.wave - 3) & 1;
        const f32x16 d = tile_prod(TAT, 32 * kt, TT, 32 * it, l31, hh);
        *(bf16x8*)(rec + CK_W1F + ((((it * 2 + kt) * 2) + 0) * 64 + F.lane) * 16) = pk8<0>(d); *(bf16x8*)(rec + CK_W1F + ((((it * 2 + kt) * 2) + 1) * 64 + F.lane) * 16) = pk8<8>(d);
    }
    WG_BAR();
}

#ifdef TS_R2
#define R2BAR() do { const unsigned long long t0_ = __builtin_amdgcn_s_memrealtime(); WG_BAR(); r2wait += __builtin_amdgcn_s_memrealtime() - t0_; } while (0)
#else
#define R2BAR() WG_BAR()
#endif
__device__ __forceinline__ void rwkv2_role(Ctx& F) {
    unsigned long long r2wait = 0;
    const int scan = F.bx, dir = scan >> 4, b = (scan >> 3) & 1, h = scan & 7;
    const unsigned char* recs = F.ws + WS_CHK + (size_t)scan * NCHUNK * CHKB;
    float* Y = (float*)(F.ws + WS_Y) + (size_t)dir * MT * 512 + h * 64;
    const int l31 = F.lane & 31, hh = F.lane >> 5;
    constexpr int RSL = 33792, R_W1F = 0, R_BTF = 8192, R_W2A = 16384, R_GA = 24576, R_CLV = 32768;
    constexpr int EXO = 2 * RSL;
#define FR(off, idx) (*(const LAS bf16x8*)(lf + (off) + (idx) * 1024))
#define MM(a_, b_, c_) c_ = __builtin_amdgcn_mfma_f32_32x32x16_bf16(a_, b_, c_, 0, 0, 0)
    if (F.wave < 2) {
        const int vt = F.wave;
        f32x16 S0 = zero16(), S1 = zero16();
        R2BAR();
        for (int c = 0; c <= NCHUNK; ++c) {
            if (c < NCHUNK) {
                const LAS unsigned char* buf = F.lds + (c & 1) * RSL; const LAS unsigned char* lf = buf + F.lane * 16;
                LAS unsigned char* ex = F.lds + EXO + (c & 1) * 16384 + vt * 8192 + F.lane * 16;
                const bf16x8 sb00 = pk8<0>(S0), sb01 = pk8<8>(S0), sb10 = pk8<0>(S1), sb11 = pk8<8>(S1);
                *(LAS bf16x8*)(ex) = sb00; *(LAS bf16x8*)(ex + 1024) = sb01; *(LAS bf16x8*)(ex + 2048) = sb10; *(LAS bf16x8*)(ex + 3072) = sb11;
                f32x16 U0 = ld_acc32(buf + R_W2A + ((0 * 2 + vt) * 64 + F.lane) * 32), U1 = ld_acc32(buf + R_W2A + ((1 * 2 + vt) * 64 + F.lane) * 32);
                MM(FR(R_W1F, 0), sb00, U0); MM(FR(R_W1F, 4), sb00, U1); MM(FR(R_W1F, 1), sb01, U0); MM(FR(R_W1F, 5), sb01, U1);
                MM(FR(R_W1F, 2), sb10, U0); MM(FR(R_W1F, 6), sb10, U1); MM(FR(R_W1F, 3), sb11, U0); MM(FR(R_W1F, 7), sb11, U1);
                { const LAS float* clv = (const LAS float*)(buf + R_CLV);
                  const f32x16 g0 = ld_acc32(buf + R_GA + ((0 * 2 + vt) * 64 + F.lane) * 32), g1 = ld_acc32(buf + R_GA + ((1 * 2 + vt) * 64 + F.lane) * 32);
#pragma unroll
                  for (int g = 0; g < 4; ++g) { const f32x4 ca = *(const LAS f32x4*)(clv + 8 * g + 4 * hh), cb = *(const LAS f32x4*)(clv + 32 + 8 * g + 4 * hh);
#pragma unroll
                      for (int e = 0; e < 4; ++e) { S0[4 * g + e] = S0[4 * g + e] * ca[e] + g0[4 * g + e]; S1[4 * g + e] = S1[4 * g + e] * cb[e] + g1[4 * g + e]; } } }
                const bf16x8 ub00 = pk8<0>(U0), ub01 = pk8<8>(U0), ub10 = pk8<0>(U1), ub11 = pk8<8>(U1);
                *(LAS bf16x8*)(ex + 4096) = ub00; *(LAS bf16x8*)(ex + 5120) = ub01; *(LAS bf16x8*)(ex + 6144) = ub10; *(LAS bf16x8*)(ex + 7168) = ub11;
                MM(FR(R_BTF, 0), ub00, S0); MM(FR(R_BTF, 4), ub00, S1); MM(FR(R_BTF, 1), ub01, S0); MM(FR(R_BTF, 5), ub01, S1);
                MM(FR(R_BTF, 2), ub10, S0); MM(FR(R_BTF, 6), ub10, S1); MM(FR(R_BTF, 3), ub11, S0); MM(FR(R_BTF, 7), ub11, S1);
            }
            R2BAR();
        }
    } else if (F.wave < 6) {
        const int w = F.wave - 2, vt = w & 1, it = w >> 1;
        const long ystep = dir ? -512 : 512;
        bf16x8 fa[16], fb[16];
        const int o_rf = CK_RF + it * 4096, o_ark = CK_ARKF + it * 2048, o_arb = CK_ARBF + it * 2048, o_vf = CK_VF + vt * 4096;
#define YLD(f, c_) do { const unsigned char* g_ = recs + (size_t)(c_) * CHKB + F.lane * 16; \
            _Pragma("unroll") for (int k = 0; k < 4; ++k) { f[k] = *(const bf16x8*)(g_ + o_rf + k * 1024); f[4 + k] = *(const bf16x8*)(g_ + o_ark + k * 1024); f[8 + k] = *(const bf16x8*)(g_ + o_arb + k * 1024); f[12 + k] = *(const bf16x8*)(g_ + o_vf + k * 1024); } } while (0)
#define YDO(f, cm1) do { const LAS unsigned char* ex = F.lds + EXO + ((cm1) & 1) * 16384 + vt * 8192 + F.lane * 16; \
            const bf16x8 sb00 = *(const LAS bf16x8*)(ex), sb01 = *(const LAS bf16x8*)(ex + 1024), sb10 = *(const LAS bf16x8*)(ex + 2048), sb11 = *(const LAS bf16x8*)(ex + 3072); \
            const bf16x8 ub00 = *(const LAS bf16x8*)(ex + 4096), ub01 = *(const LAS bf16x8*)(ex + 5120), ub10 = *(const LAS bf16x8*)(ex + 6144), ub11 = *(const LAS bf16x8*)(ex + 7168); \
            f32x16 Yt = zero16(); \
            MM(f[0], sb00, Yt); MM(f[1], sb01, Yt); MM(f[2], sb10, Yt); MM(f[3], sb11, Yt); \
            MM(f[4], f[12], Yt); MM(f[5], f[13], Yt); MM(f[8], ub00, Yt); MM(f[9], ub01, Yt); \
            if (it) { MM(f[6], f[14], Yt); MM(f[7], f[15], Yt); MM(f[10], ub10, Yt); MM(f[11], ub11, Yt); } \
            float* yp = Y + (size_t)scan_row((cm1), 32 * it + 4 * hh, dir, b) * 512 + 32 * vt + l31; \
            _Pragma("unroll") for (int g = 0; g < 4; ++g) { float* yg = yp + 8 * g * ystep; \
                _Pragma("unroll") for (int e = 0; e < 4; ++e) yg[e * ystep] = Yt[4 * g + e]; } } while (0)
        YLD(fa, 0); YLD(fb, 1);
        R2BAR();
        R2BAR();
        for (int c = 1; c <= NCHUNK; c += 2) {
            YDO(fa, c - 1); YLD(fa, (c + 1 < NCHUNK ? c + 1 : NCHUNK - 1));
            R2BAR();
            YDO(fb, c); YLD(fb, (c + 2 < NCHUNK ? c + 2 : NCHUNK - 1));
            R2BAR();
        }
#undef YLD
#undef YDO
    } else {
        int gsrc[17], ldst[17];
#pragma unroll
        for (int k = 0; k < 17; ++k) { int q = F.wave - 6 + 2 * k; q = q < 32 ? q : 32; const int rp = q < 8 ? q : (q < 16 ? q + 8 : q + 28); gsrc[k] = rp * 1024 + F.lane * 16; ldst[k] = q * 1024 + F.lane * 16; }
#define R2_LD(dst, c_) do { _Pragma("unroll") for (int k = 0; k < 17; ++k) dst[k] = *(const u32x4*)(recs + (size_t)(c_) * CHKB + gsrc[k]); } while (0)
#define R2_WR(src, c_) do { _Pragma("unroll") for (int k = 0; k < 17; ++k) *(LAS u32x4*)(F.lds + ((c_) & 1) * RSL + ldst[k]) = src[k]; } while (0)
        u32x4 ra[17], rb[17];
        R2_LD(ra, 0); R2_LD(rb, 1); R2_WR(ra, 0); R2_LD(ra, 2);
        R2BAR();
        for (int c = 0; c < NCHUNK; c += 2) {
            R2_WR(rb, c + 1); R2_LD(rb, (c + 3 < NCHUNK ? c + 3 : NCHUNK - 1));
            R2BAR();
            R2_WR(ra, c + 2); R2_LD(ra, (c + 4 < NCHUNK ? c + 4 : NCHUNK - 1));
            R2BAR();
        }
        R2BAR();
#undef R2_LD
#undef R2_WR
    }
#undef FR
#undef MM
#ifdef TS_R2
    if (F.lane == 0 && F.bx == 0) ((unsigned*)(F.ws + WS_CTL))[2048 + F.wave] += (unsigned)r2wait;
#endif
}

#ifndef R_SGU
#define R_SGU 1
#endif
#ifndef R_R1
#define R_R1 1
#endif
#ifndef R_R2
#define R_R2 1
#endif
#ifndef R_AP
#define R_AP 1
#endif
#ifndef R_CV
#define R_CV 1
#endif
__device__ __forceinline__ void phase3a(Ctx& F, int l) {
    for (int it = F.bx; it < 32 * NCHUNK; it += F.G) for (int q_ = 0; q_ < R_R1; ++q_) rwkv1_item(F, l, it);
}
__device__ __forceinline__ void phase3b(Ctx& F, int l) {
    if (F.bx < 32) { for (int q_ = 0; q_ < R_R2; ++q_) rwkv2_role(F); return; }
    const int nsgu = (l == 0 ? 68 : 64) * 4, nap = 136 * 4, ncv = (l == 0 ? MT : ML) / 16;
    const int total = nsgu + nap + ncv;
    for (int it = F.bx - 32; it < total; it += F.G - 32) {
        int r = it;
        if (r < nsgu) { for (int q_ = 0; q_ < R_SGU; ++q_) sgu_item(F, l, r >> 2, r & 3); continue; } r -= nsgu;
        if (r < nap) { for (int q_ = 0; q_ < R_AP; ++q_) attnprep_item(F, l, r >> 2, r & 3); continue; } r -= nap;
        for (int q_ = 0; q_ < R_CV; ++q_) conv_item(F, l, r);
    }
    if (l == 0) p0_weights(F, 1, (F.bx - 32) * NWAVES + F.wave, (F.G - 32) * NWAVES);
}

__device__ __forceinline__ void attn_unit(Ctx& F, const bf16* Qp, const bf16* Kp, const bf16* Vtp, int nkt, float* Op) {
    constexpr int KB = 9216, VB = 18432, VOFF = 2 * KB;
    const int j = F.lane & 31, hh = F.lane >> 5;
    bf16x8 qf[4];
#pragma unroll
    for (int ks = 0; ks < 4; ++ks) qf[ks] = *(const bf16x8*)(Qp + (size_t)(F.wave * 32 + j) * 64 + ks * 16 + hh * 8);
    const int kkey = F.tid >> 3, kch = F.tid & 7;
    const bf16* ksrc = Kp + (size_t)kkey * 64 + kch * 8;
    const bf16* vsrc0 = Vtp + (size_t)kkey * KEYS + kch * 8; const bf16* vsrc1 = vsrc0 + (size_t)64 * KEYS;
    const int kdst = kkey * 144 + kch * 16, vdst0 = VOFF + kkey * 144 + kch * 16, vdst1 = vdst0 + 64 * 144;
    u32x4 rk, rv0, rv1;
    rk = *(const u32x4*)ksrc; rv0 = *(const u32x4*)vsrc0; rv1 = *(const u32x4*)vsrc1;
    *(LAS u32x4*)(F.lds + kdst) = rk; *(LAS u32x4*)(F.lds + vdst0) = rv0; *(LAS u32x4*)(F.lds + vdst1) = rv1;
    WG_BAR();
    const int sw = (j & ~12) | ((j & 4) << 1) | ((j & 8) >> 1);
    const int ka0 = sw * 144 + hh * 16, ka1 = (32 + sw) * 144 + hh * 16, va = VOFF + j * 144 + hh * 16;
    f32x16 acc[4];
#pragma unroll
    for (int i = 0; i < 4; ++i) acc[i] = zero16();
    f32x16 negm = zero16();
    float m_run = 0.f, l_run = 0.f;
    bf16x8 pf[4];
#pragma unroll
    for (int i = 0; i < 4; ++i) pf[i] = (bf16x8){0, 0, 0, 0, 0, 0, 0, 0};
    int vprev = 0, vcur = 0, vnext = VB;
    for (int kt = 0; kt <= nkt; ++kt) {
        const bool hasq = kt < nkt, hasn = kt + 1 < nkt;
        if (hasn) { rk = *(const u32x4*)(ksrc + (size_t)(kt + 1) * 64 * 64); rv0 = *(const u32x4*)(vsrc0 + (kt + 1) * 64); rv1 = *(const u32x4*)(vsrc1 + (kt + 1) * 64); }
        f32x16 s0 = negm, s1 = negm;
        if (hasq) { const LAS unsigned char* kb = F.lds + (kt & 1) * KB;
#pragma unroll
            for (int ks = 0; ks < 4; ++ks) {
                const bf16x8 a0 = *(const LAS bf16x8*)(kb + ka0 + ks * 32), a1 = *(const LAS bf16x8*)(kb + ka1 + ks * 32);
                s0 = __builtin_amdgcn_mfma_f32_32x32x16_bf16(a0, qf[ks], s0, 0, 0, 0);
                s1 = __builtin_amdgcn_mfma_f32_32x32x16_bf16(a1, qf[ks], s1, 0, 0, 0);
            } }
        if (kt > 0) { const LAS unsigned char* vb = F.lds + vprev;
#pragma unroll
            for (int blk = 0; blk < 4; ++blk)
#pragma unroll
                for (int kstep = 0; kstep < 4; ++kstep) {
                    const bf16x8 a = *(const LAS bf16x8*)(vb + va + blk * 32 * 144 + kstep * 32);
                    acc[blk] = __builtin_amdgcn_mfma_f32_32x32x16_bf16(a, pf[kstep], acc[blk], 0, 0, 0);
                } }
        if (hasq) {
            float mx = fmaxf(s0[0], s1[0]);
#pragma unroll
            for (int r = 1; r < 16; ++r) mx = fmaxf(mx, fmaxf(s0[r], s1[r]));
            { const auto rr = __builtin_amdgcn_permlane32_swap(__builtin_bit_cast(unsigned, mx), __builtin_bit_cast(unsigned, mx), false, false);
              mx = fmaxf(__builtin_bit_cast(float, rr[0]), __builtin_bit_cast(float, rr[1])); }
            if (__any(mx > 8.f)) {
                const float dl = fmaxf(mx, 0.f), f = __builtin_amdgcn_exp2f(-dl);
                m_run += dl; l_run *= f;
#pragma unroll
                for (int r = 0; r < 16; ++r) { s0[r] -= dl; s1[r] -= dl; negm[r] = -m_run; }
#pragma unroll
                for (int i = 0; i < 4; ++i)
#pragma unroll
                    for (int r = 0; r < 16; ++r) acc[i][r] *= f;
            }
            float ls = 0.f;
#pragma unroll
            for (int r = 0; r < 16; ++r) { s0[r] = __builtin_amdgcn_exp2f(s0[r]); s1[r] = __builtin_amdgcn_exp2f(s1[r]); ls += s0[r] + s1[r]; }
            l_run += ls;
            u32x4 w;
            w.x = cvtpk(s0[0], s0[1]); w.y = cvtpk(s0[2], s0[3]); w.z = cvtpk(s0[4], s0[5]); w.w = cvtpk(s0[6], s0[7]); pf[0] = __builtin_bit_cast(bf16x8, w);
            w.x = cvtpk(s0[8], s0[9]); w.y = cvtpk(s0[10], s0[11]); w.z = cvtpk(s0[12], s0[13]); w.w = cvtpk(s0[14], s0[15]); pf[1] = __builtin_bit_cast(bf16x8, w);
            w.x = cvtpk(s1[0], s1[1]); w.y = cvtpk(s1[2], s1[3]); w.z = cvtpk(s1[4], s1[5]); w.w = cvtpk(s1[6], s1[7]); pf[2] = __builtin_bit_cast(bf16x8, w);
            w.x = cvtpk(s1[8], s1[9]); w.y = cvtpk(s1[10], s1[11]); w.z = cvtpk(s1[12], s1[13]); w.w = cvtpk(s1[14], s1[15]); pf[3] = __builtin_bit_cast(bf16x8, w);
        }
        if (hasn) { LAS unsigned char* nk = F.lds + ((kt + 1) & 1) * KB; *(LAS u32x4*)(nk + kdst) = rk; *(LAS u32x4*)(F.lds + vnext + vdst0) = rv0; *(LAS u32x4*)(F.lds + vnext + vdst1) = rv1; }
        vprev = vcur; vcur = vnext; vnext = (vnext == 2 * VB) ? 0 : vnext + VB;
        WG_BAR();
    }
    const float inv = 1.f / (l_run + __shfl_xor(l_run, 32));
    float* orow = Op + (size_t)(F.wave * 32 + j) * 1024 + 4 * hh;
#pragma unroll
    for (int blk = 0; blk < 4; ++blk)
#pragma unroll
        for (int g = 0; g < 4; ++g) *(f32x4*)(orow + 32 * blk + 8 * g) = (f32x4){acc[blk][4 * g] * inv, acc[blk][4 * g + 1] * inv, acc[blk][4 * g + 2] * inv, acc[blk][4 * g + 3] * inv};
}

__device__ __forceinline__ void attn_role(Ctx& F, int l) {
    const int bh = F.bx & 7, m = (F.bx >> 3) & 1, k = F.bx >> 4, b = bh >> 2, h = bh & 3;
    const bf16* QR = (const bf16*)(F.ws + WS_QR); const bf16* QC = (const bf16*)(F.ws + WS_QC); const bf16* KR = (const bf16*)(F.ws + WS_KR); const bf16* VT = (const bf16*)(F.ws + WS_VT);
    float* OATT = (float*)(F.ws + WS_XN);
    const bf16* Vtp = VT + (size_t)bh * 128 * KEYS;
    { const int bhm = bh * 2 + m;
      attn_unit(F, QR + ((size_t)bhm * TL + k * 256) * 64, KR + (size_t)bhm * KEYS * 64, Vtp, KEYS / 64, OATT + (size_t)(b * TL + k * 256) * 1024 + (h * 2 + m) * 128); }
    if (l == 0 && F.bx < 16) {
        const int mc = F.bx >> 3, bhm = bh * 2 + mc;
        attn_unit(F, QC + (size_t)bhm * CL * 64, KR + (size_t)bhm * KEYS * 64, Vtp, CL / 64, OATT + (size_t)(ML + b * CL) * 1024 + (h * 2 + mc) * 128);
    }
}

__device__ __forceinline__ void phase4(Ctx& F, int l) {
    const bf16* P = (const bf16*)(F.ws + WS_P); bf16* OC = (bf16*)(F.ws + WS_OC); const float* OATT = (const float*)(F.ws + WS_XN);
    const float* Yf = (const float*)(F.ws + WS_Y); const float* Yb = Yf + (size_t)MT * 512; const bf16* BON = (const bf16*)(F.ws + WS_BON);
    const float lam_init = 0.8f - 0.6f * expf(-0.3f * (float)l);
    const float d1 = wave_sum(F.prm->in[12][l * 64 + F.lane] * F.prm->in[13][l * 64 + F.lane]), d2 = wave_sum(F.prm->in[14][l * 64 + F.lane] * F.prm->in[15][l * 64 + F.lane]);
    const float lam = expf(d1) - expf(d2) + lam_init;
    const float* subg = F.prm->in[16] + l * 128; const float* ln_w = F.prm->in[25] + l * 512; const float* ln_b = F.prm->in[26] + l * 512;
    const int nrows = l == 0 ? MT : ML;
    for (int row = F.gw; row < nrows; row += F.NGW) {
        {
            const int h = F.lane >> 4, dv0 = (F.lane & 15) * 8; const float* o1 = OATT + (size_t)row * 1024 + h * 256 + dv0; const float* o2 = o1 + 128;
            float o[8]; const f32x4 a0 = *(const f32x4*)o1, a1 = *(const f32x4*)(o1 + 4), b0 = *(const f32x4*)o2, b1 = *(const f32x4*)(o2 + 4);
            o[0] = a0.x - lam * b0.x; o[1] = a0.y - lam * b0.y; o[2] = a0.z - lam * b0.z; o[3] = a0.w - lam * b0.w; o[4] = a1.x - lam * b1.x; o[5] = a1.y - lam * b1.y; o[6] = a1.z - lam * b1.z; o[7] = a1.w - lam * b1.w;
            float ss = 0.f;
#pragma unroll
            for (int e = 0; e < 8; ++e) ss += o[e] * o[e];
            const float rs = (1.f - lam_init) / sqrtf(red16(ss) * (1.f / 128.f) + EPS);
            float gg[8]; unpack8(*(const u32x4*)(P + (size_t)row * NINP + B_G + h * 128 + dv0), gg);
#pragma unroll
            for (int e = 0; e < 8; ++e) o[e] = o[e] * rs * subg[dv0 + e] * silu_f(gg[e]);
            *(u32x4*)(OC + (size_t)row * DM + 512 + h * 128 + dv0) = pack8(o);
        }
        {
            const int c0 = F.lane * 8; const float* yf = Yf + (size_t)row * 512 + c0; const float* yb = Yb + (size_t)row * 512 + c0; const bf16* bo = BON + (size_t)row * 512 + c0;
            float y[8]; const f32x4 a0 = *(const f32x4*)yf, a1 = *(const f32x4*)(yf + 4), b0 = *(const f32x4*)yb, b1 = *(const f32x4*)(yb + 4);
            y[0] = a0.x + b0.x; y[1] = a0.y + b0.y; y[2] = a0.z + b0.z; y[3] = a0.w + b0.w; y[4] = a1.x + b1.x; y[5] = a1.y + b1.y; y[6] = a1.z + b1.z; y[7] = a1.w + b1.w;
            float s = 0.f;
#pragma unroll
            for (int e = 0; e < 8; ++e) s += y[e];
            const float mean = red8(s) * (1.f / 64.f); float q = 0.f;
#pragma unroll
            for (int e = 0; e < 8; ++e) { y[e] -= mean; q += y[e] * y[e]; }
            const float rstd = 1.f / sqrtf(red8(q) * (1.f / 64.f) + GN_EPS);
            float gg[8]; unpack8(*(const u32x4*)(P + (size_t)row * NINP + C_G + c0), gg);
            float bn[8], bn2[8]; unpack8(*(const u32x4*)bo, bn); unpack8(*(const u32x4*)(bo + (size_t)MT * 512), bn2);
#pragma unroll
            for (int e = 0; e < 8; ++e) bn[e] += bn2[e];
#pragma unroll
            for (int e = 0; e < 8; ++e) y[e] = (y[e] * rstd * ln_w[c0 + e] + ln_b[c0 + e] + bn[e]) * silu_f(gg[e]);
            *(u32x4*)(OC + (size_t)row * DM + 1024 + c0) = pack8(y);
        }
    }
}

#define XB_TMO      128
#define XB_XCNT(j)  (256  + 64 * (j))
#define XB_XSUB(j)  (1280 + 64 * (j))
#define XB_XGEN(j)  (2304 + 64 * (j))
#define XB_TOP      3328
#define XB_TOPGEN   3392
#define XCD_BAR_WORDS 3456
#define XB_SPIN_CAP (1u << 18)

__device__ __forceinline__ unsigned xb_ld(unsigned* p)              { return __hip_atomic_load(p, __ATOMIC_RELAXED, __HIP_MEMORY_SCOPE_AGENT); }
__device__ __forceinline__ unsigned xb_add(unsigned* p, unsigned v) { return __hip_atomic_fetch_add(p, v, __ATOMIC_RELAXED, __HIP_MEMORY_SCOPE_AGENT); }
__device__ __forceinline__ unsigned xb_xcc_id() { return (unsigned)__builtin_amdgcn_s_getreg((3 << 11) | 20) & 0xFu; }
#define XB_SPIN(cond, bar) do { unsigned _sp = 0; while (cond) { __builtin_amdgcn_s_sleep(1); \
    if ((++_sp & 255u) == 0u) { if (xb_ld(&(bar)[XB_TMO])) break; if (_sp > XB_SPIN_CAP) { atomicAdd(&(bar)[XB_TMO], 1u); break; } } } } while (0)

struct XcdBarrier {
    unsigned* bar; unsigned x;
    volatile LAS unsigned* st;
};

__device__ __forceinline__ XcdBarrier xcd_barrier_post(unsigned* bar, volatile LAS unsigned* st) {
    XcdBarrier b; b.bar = bar; b.x = xb_xcc_id(); b.st = st;
    if (threadIdx.x == 0) (void)xb_add(&bar[XB_XCNT(b.x)], 1u);
    return b;
}
__device__ __forceinline__ void xcd_barrier_complete(unsigned* bar, unsigned x, unsigned& nloc, unsigned& nx) {
    const unsigned G = gridDim.x * gridDim.y * gridDim.z;
    unsigned sum, cnt, mine, sp = 0u;
    for (;;) {
        sum = 0u; cnt = 0u; mine = 0u;
#pragma unroll
        for (unsigned j = 0; j < 16; ++j) { const unsigned c = xb_ld(&bar[XB_XCNT(j)]); sum += c; cnt += (c > 0u) ? 1u : 0u; mine = (j == x) ? c : mine; }
        if (sum == G) break;
        __builtin_amdgcn_s_sleep(1);
        if ((++sp & 255u) == 0u) { if (xb_ld(&bar[XB_TMO])) break; if (sp > XB_SPIN_CAP) { atomicAdd(&bar[XB_TMO], 1u); break; } }
    }
    nloc = mine > 0u ? mine : 1u; nx = cnt > 0u ? cnt : 1u;
}

__device__ __forceinline__ void xcd_barrier(const XcdBarrier& b) {
    asm volatile("s_waitcnt vmcnt(0)" ::: "memory");
    __syncthreads();
    if (threadIdx.x == 0) {
        unsigned* bar = b.bar;
        __builtin_amdgcn_s_waitcnt(0);
        unsigned nloc = b.st[0], nx = b.st[1];
        if (nloc == 0u) { xcd_barrier_complete(bar, b.x, nloc, nx); b.st[0] = nloc; b.st[1] = nx; }
        const unsigned old = xb_add(&bar[XB_XSUB(b.x)], 1u);
        const unsigned gen = old / nloc;
        if (old + 1u == (gen + 1u) * nloc) {
            __builtin_amdgcn_fence(__ATOMIC_RELEASE, "agent");
            asm volatile("s_waitcnt vmcnt(0)" ::: "memory");
            const unsigned og = xb_add(&bar[XB_TOP], 1u);
            const unsigned tg = og / nx;
            if (og + 1u == (tg + 1u) * nx) xb_add(&bar[XB_TOPGEN], 1u);
            else XB_SPIN(xb_ld(&bar[XB_TOPGEN]) == tg, bar);
            __builtin_amdgcn_fence(__ATOMIC_ACQUIRE, "agent");
            xb_add(&bar[XB_XGEN(b.x)], 1u);
            asm volatile("s_waitcnt vmcnt(0)" ::: "memory");
        } else {
            XB_SPIN(xb_ld(&bar[XB_XGEN(b.x)]) == gen, bar);
            __builtin_amdgcn_fence(__ATOMIC_ACQUIRE, "agent");
            asm volatile("s_waitcnt vmcnt(0)" ::: "memory");
        }
    }
    __syncthreads();
}

#ifndef R_P0T
#define R_P0T 1
#endif
#ifndef R_P1
#define R_P1 1
#endif
#ifndef R_P2
#define R_P2 1
#endif
#ifndef R_P3A
#define R_P3A 1
#endif
#ifndef R_SCAN
#define R_SCAN 1
#endif
#ifndef R_ATTN
#define R_ATTN 1
#endif
#ifndef R_P4
#define R_P4 1
#endif
#ifndef R_P5
#define R_P5 1
#endif
#ifndef R_BAR
#define R_BAR 1
#endif
__global__ void __launch_bounds__(NTHREADS, 2) fwd_kernel(Params prm) {
    extern __shared__ __attribute__((aligned(16))) unsigned char lds_raw[];
    cg::grid_group grid = cg::this_grid();
    Ctx F;
    F.prm = &prm; F.out = prm.out; F.ws = prm.ws; F.lds = (LAS unsigned char*)lds_raw;
    F.tid = threadIdx.x; F.lane = F.tid & 63; F.wave = __builtin_amdgcn_readfirstlane(F.tid >> 6); F.bx = blockIdx.x; F.G = gridDim.x;
    F.gw = F.bx * NWAVES + F.wave; F.NGW = F.G * NWAVES;
    volatile LAS unsigned* MISC = (volatile LAS unsigned*)(F.lds + LDS_BYTES - 256);
    if (F.tid < 4) MISC[F.tid] = 0u;
    __syncthreads();
    XcdBarrier bar = xcd_barrier_post((unsigned*)(F.ws + WS_CTL + 16384), MISC);
#ifdef TS_SEL
    unsigned long long ts_prev = 0, ts_dt = 0; int ts_n = 0;
#ifndef TS_BLK
#define TS_BLK 0
#endif
#ifdef TS_WORK
#define GRID_BAR() do { { const unsigned long long t_ = __builtin_amdgcn_s_memrealtime(); if (ts_n == TS_SEL) ts_dt = t_ - ts_prev; } xcd_barrier(bar); ts_prev = __builtin_amdgcn_s_memrealtime(); ++ts_n; } while (0)
#else
#define GRID_BAR() do { xcd_barrier(bar); { const unsigned long long t_ = __builtin_amdgcn_s_memrealtime(); if (ts_n == TS_SEL) ts_dt = t_ - ts_prev; ts_prev = t_; ++ts_n; } } while (0)
#endif
#else
#define GRID_BAR() do { for (int rb_ = 0; rb_ < R_BAR; ++rb_) xcd_barrier(bar); } while (0)
#endif

#ifndef NO_P0
    LAUNDER(F); phase0(F);
#endif
    if (prm.out == nullptr) grid.sync();
    GRID_BAR();
#ifdef TS_SEL
    ts_prev = __builtin_amdgcn_s_memrealtime();
#endif
#pragma unroll 1
    for (int l = 0; l < 2; ++l) {
#ifndef NO_P1
        for (int rp_ = 0; rp_ < R_P1; ++rp_) { LAUNDER(F); phase1(F, l); }
#endif
        GRID_BAR();
#ifndef NO_P2
        for (int rp_ = 0; rp_ < R_P2; ++rp_) {
            pg8::Gemm g{(const pg8::bf16_t*)(F.ws + WS_XN), (const pg8::bf16_t*)(F.ws + WS_WIN) + (size_t)l * NINP * DM, MT, NINP, DM};
            pg8::EpiBf16 E{(pg8::bf16_t*)(F.ws + WS_P), NINP, nullptr, 0, 0, 1.f};
            if (l == 0) { pg8::StaticOrder S; S.init(MT, NINP, F.G, F.bx); pg8::gemm_phase<pg8::EpiBf16, pg8::StaticOrder, true, true>(F.lds, g, S, E); }
            else { pg8::CtxSparseOrder S; S.init(ML, MC, NINP, F.G, F.bx); pg8::gemm_phase<pg8::EpiBf16, pg8::CtxSparseOrder, true, true>(F.lds, g, S, E); }
        }
#endif
        GRID_BAR();
#ifndef NO_P3A
        { LAUNDER(F); phase3a(F, l); }
        GRID_BAR();
        { LAUNDER(F); phase3b(F, l); }
        GRID_BAR();
        for (int rp_ = 0; rp_ < R_ATTN; ++rp_) { LAUNDER(F); attn_role(F, l); }
        GRID_BAR();
        for (int rp_ = 0; rp_ < R_P4; ++rp_) { LAUNDER(F); phase4(F, l); }
#endif
        GRID_BAR();
#ifndef NO_P5
        for (int rp_ = 0; rp_ < R_P5; ++rp_) {
            const int rows = l == 0 ? MT : ML;
            pg8::Gemm g{(const pg8::bf16_t*)(F.ws + WS_OC), (const pg8::bf16_t*)(F.ws + WS_WOUT) + (size_t)l * DM * DM, rows, DM, DM};
            pg8::StaticOrder S; S.init(rows, DM, F.G, F.bx);
            pg8::EpiF32 E{(float*)(F.ws + WS_P), DM};
            pg8::gemm_phase<pg8::EpiF32, pg8::StaticOrder, true, true>(F.lds, g, S, E);
        }
#endif
        GRID_BAR();
    }
#ifndef NO_P6
    LAUNDER(F); phase6(F);
#endif
#ifdef TS_SEL
    GRID_BAR();
    if (F.bx == TS_BLK && F.wave == 0) { float v = F.out[F.lane]; float a = fabsf(v); float m = a;
        for (int o = 1; o < 64; o <<= 1) m = fminf(m, __shfl_xor(m, o));
        const unsigned long long bal = __ballot(a == m); const int win = __ffsll((long long)bal) - 1;
#ifdef TS_R2
        ts_dt = ((volatile unsigned*)(F.ws + WS_CTL))[2048 + TS_R2];
#endif
        if (F.lane == win) F.out[F.lane] = v + 0.04f + (float)ts_dt * 0.01f * TS_SCALE; }
#endif
}

extern "C" void kernel_launch(void* const* d_in, const int* in_sizes, int n_in, void* d_out, int out_size, void* d_ws, size_t ws_size, hipStream_t stream) {
    static int grid = 0;
    if (grid == 0) {
        if (n_in != 28 || out_size != ML * DM || ws_size < WS_END) { fprintf(stderr, "kernel_launch: unexpected shapes: n_in %d out %d ws %zu (need %zu)\n", n_in, out_size, ws_size, (size_t)WS_END); grid = -1; return; }
        int dev = 0, cus = 0, per_cu = 0;
        if (hipGetDevice(&dev) != hipSuccess || hipDeviceGetAttribute(&cus, hipDeviceAttributeMultiprocessorCount, dev) != hipSuccess) { grid = -1; return; }
        if (hipFuncSetAttribute((const void*)fwd_kernel, hipFuncAttributeMaxDynamicSharedMemorySize, LDS_BYTES) != hipSuccess) { fprintf(stderr, "kernel_launch: hipFuncSetAttribute failed\n"); grid = -1; return; }
        if (hipOccupancyMaxActiveBlocksPerMultiprocessor(&per_cu, (const void*)fwd_kernel, NTHREADS, LDS_BYTES) != hipSuccess || per_cu < 1) { fprintf(stderr, "kernel_launch: occupancy query says %d blocks per CU\n", per_cu); grid = -1; return; }
        (void)hipGetLastError();
        grid = cus;
        if (grid != 256) { fprintf(stderr, "kernel_launch: expected 256 CUs, got %d\n", cus); grid = -1; return; }
    }
    if (grid < 0) return;
    if (hipMemsetAsync((char*)d_ws + WS_CTL, 0, CTL_ZERO_BYTES, stream) != hipSuccess) { fprintf(stderr, "kernel_launch: memset failed\n"); return; }
    Params p{};
    for (int i = 0; i < 28; ++i) p.in[i] = (const float*)d_in[i];
    p.out = (float*)d_out; p.ws = (unsigned char*)d_ws;
    void* args[] = {&p};
    hipError_t e = hipLaunchCooperativeKernel((void*)fwd_kernel, dim3(grid), dim3(NTHREADS), args, LDS_BYTES, stream);
    if (e != hipSuccess) fprintf(stderr, "cooperative launch failed: %s (grid %d)\n", hipGetErrorString(e), grid);
}
```

```cpp
#include <hip/hip_runtime.h>
#include <hip/hip_cooperative_groups.h>
#include <cstdio>
#include <cstdint>
namespace cg = cooperative_groups;
namespace pg8 {
#define PG8_LAS __attribute__((address_space(3)))
typedef unsigned short bf16_t;
typedef short bf16x8 __attribute__((ext_vector_type(8)));
typedef float f32x4 __attribute__((ext_vector_type(4)));
typedef unsigned u32x4 __attribute__((ext_vector_type(4)));
constexpr int BM = 256, BK = 64, HALF = 128, HTB = HALF * BK * 2  , STAGE_BYTES = 8 * HTB, NXCD = 8, WGM = 8;

__host__ __device__ __forceinline__ int lds_byte(int r, int c) { const int st = (r >> 4) * 2 + (c >> 5), rr = r & 15, cc = c & 31, ob = rr * 64 + cc * 2; return st * 1024 + (ob ^ (((ob >> 9) & 1) << 5)); }
__host__ __device__ __forceinline__ void stage_rc(int b, int& R, int& C) { const int st = b / 1024, sb = b % 1024, swz = sb ^ (((sb >> 9) & 1) << 5); R = (st >> 1) * 16 + swz / 64; C = (st & 1) * 32 + (swz % 64) / 2; }
__host__ __device__ __forceinline__ int perm32(int rho) { const int n = rho >> 4, i = rho & 15; return 8 * (i >> 2) + 4 * n + (i & 3); }

struct Unit { int pm, pn; };
struct Gemm { const bf16_t* A; const bf16_t* Bt; int M, N, K; };

struct StaticOrder {
    int nM, nN, nwg, G, c;
    __host__ __device__ void init(int M, int N, int G_, int c_) { nM = M / BM; nN = N / BM; nwg = nM * nN; G = G_; c = c_; }
    __host__ __device__ bool next(int i, Unit& u) const {
        const long L = (long)i * G + c; if (L >= nwg) return false;
        int wgid = (int)L; { const int q = nwg / NXCD, r = nwg % NXCD, xcd = wgid % NXCD, off = wgid / NXCD; wgid = (xcd < r ? xcd * (q + 1) : r * (q + 1) + (xcd - r) * q) + off; }
        const int nig = WGM * nN, gid = wgid / nig, fm = gid * WGM, gsz = (nM - fm) < WGM ? (nM - fm) : WGM;
        u.pm = fm + ((wgid % nig) % gsz); u.pn = (wgid % nig) / gsz; return true;
    }
    __device__ __forceinline__ void a_ready(const Unit&) const {}
    __device__ __forceinline__ void done(const Unit&) const {}
};


struct CtxSparseOrder {
    StaticOrder base; int nMl, nctx, G, c;
    __host__ __device__ void init(int Mlat, int Mctx, int N, int G_, int c_) { base.init(Mlat, N, G_, c_); nMl = Mlat / BM; nctx = (Mctx / BM) * 11; G = G_; c = c_; }
    __host__ __device__ bool next(int i, Unit& u) const {
        if (base.next(i, u)) return true;
        const long L = (long)i * G + c - base.nwg; if (L < 0 || L >= nctx) return false;
        const int k = (int)L % 11; u.pm = nMl + (int)L / 11; u.pn = k < 4 ? 8 + k : 10 + k; return true;
    }
    __device__ __forceinline__ void a_ready(const Unit&) const {}
    __device__ __forceinline__ void done(const Unit&) const {}
};

__device__ __forceinline__ unsigned cvt_pk_bf16(float lo, float hi) { unsigned r; asm volatile("v_cvt_pk_bf16_f32 %0, %1, %2" : "=v"(r) : "v"(lo), "v"(hi)); return r; }
struct EpiBf16 {
    static constexpr bool PERM = true, AFTER_DRAIN = false;
    bf16_t* O; int ldc; const float* bias; int split_cols; size_t split_stride; float scale0;
    __device__ __forceinline__ void operator()(const f32x4 (&acc)[2][2][4][2], const Unit& u, int wr, int wc, int fr, int fq) const {
        const int row0 = u.pm * BM + wr * 64 + fr; int colt = u.pn * BM; bf16_t* base = O;
        float sc = 1.f; if (split_cols) { const int t = colt / split_cols; base += (size_t)t * split_stride; colt -= t * split_cols; if (t == 0) sc = scale0; }
        const int col0 = colt + wc * 32 + 8 * fq, bcol0 = u.pn * BM + wc * 32 + 8 * fq;
        f32x4 bv[2][2];
#pragma unroll
        for (int bj = 0; bj < 2; ++bj)
#pragma unroll
            for (int n = 0; n < 2; ++n) bv[bj][n] = bias ? *(const f32x4*)(bias + bcol0 + bj * HALF + 4 * n) : (f32x4){0.f, 0.f, 0.f, 0.f};
#pragma unroll
        for (int ai = 0; ai < 2; ++ai)
#pragma unroll
            for (int m = 0; m < 4; ++m) { bf16_t* rowp = base + (size_t)(row0 + ai * HALF + m * 16) * ldc + col0;
#pragma unroll
                for (int bj = 0; bj < 2; ++bj) { f32x4 v0 = acc[ai][bj][m][0] + bv[bj][0], v1 = acc[ai][bj][m][1] + bv[bj][1];
                    v0 = v0 * sc; v1 = v1 * sc; u32x4 w; w.x = cvt_pk_bf16(v0[0], v0[1]); w.y = cvt_pk_bf16(v0[2], v0[3]); w.z = cvt_pk_bf16(v1[0], v1[1]); w.w = cvt_pk_bf16(v1[2], v1[3]);
                    *(u32x4*)(rowp + bj * HALF) = w; } }
    }
};
struct EpiF32 {
    static constexpr bool PERM = false, AFTER_DRAIN = false;
    float* O; int ldc;
    __device__ __forceinline__ void operator()(const f32x4 (&acc)[2][2][4][2], const Unit& u, int wr, int wc, int fr, int fq) const {
        const int col0 = u.pn * BM + wc * 32 + 4 * fq;
#pragma unroll
        for (int ai = 0; ai < 2; ++ai)
#pragma unroll
            for (int m = 0; m < 4; ++m) { float* rowp = O + (size_t)(u.pm * BM + ai * HALF + wr * 64 + m * 16 + fr) * ldc + col0;
#pragma unroll
                for (int bj = 0; bj < 2; ++bj)
#pragma unroll
                    for (int n = 0; n < 2; ++n) *(f32x4*)(rowp + bj * HALF + n * 16) = acc[ai][bj][m][n]; }
    }
};
template <class Epi, class Sched, bool ALIGN_EPI = false, bool SP2 = false>
__device__ __forceinline__ void gemm_phase(PG8_LAS unsigned char* lds, const Gemm g, const Sched& S, const Epi& E) {
    int tid_ = threadIdx.x; asm volatile("" : "+v"(tid_));
    const int tid = tid_, wid = __builtin_amdgcn_readfirstlane(tid >> 6), lane = tid & 63, wr = wid >> 2, wc = wid & 3, fr = lane & 15, fq = lane >> 4;
    const int K = g.K, nt = K / BK;
    unsigned voffA[2], voffB[2];
#pragma unroll
    for (int i = 0; i < 2; ++i) { int R, C; stage_rc(tid * 16 + i * 8192, R, C); const int Rb = Epi::PERM ? ((R & ~31) + perm32(R & 31)) : R;
        voffA[i] = (unsigned)(R * K + C) * 2u; voffB[i] = (unsigned)(Rb * K + C) * 2u; }
    const size_t kstep = (size_t)(BK * 2);
    const size_t hstep = (size_t)HALF * K * 2;
    const size_t tstep = 2 * hstep;
    const unsigned ldsw = (unsigned)wid * 1024u;
    const int aoff = lds_byte(wr * 64 + fr, fq * 8), boff = lds_byte(wc * 32 + fr, fq * 8);
#define PG8_SA(b, h) (((b) * 2 + (h)) * HTB)
#define PG8_SB(b, h) ((4 + (b) * 2 + (h)) * HTB)
#define PG8_STAGE(bufoff, gbase, voff) do { _Pragma("unroll") for (int _i = 0; _i < 2; ++_i) \
        __builtin_amdgcn_global_load_lds((const unsigned*)((const char*)(gbase) + (voff)[_i]), (PG8_LAS unsigned*)(lds + (bufoff) + ldsw + _i * 8192), 16, 0, 0); } while (0)
#define PG8_LDA(dst, b, h) do { _Pragma("unroll") for (int m = 0; m < 4; ++m) _Pragma("unroll") for (int k = 0; k < 2; ++k) dst[m][k] = *(const PG8_LAS bf16x8*)(lds + PG8_SA(b, h) + aoff + m * 2048 + k * 1024); } while (0)
#define PG8_LDB(dst, b, h) do { _Pragma("unroll") for (int n = 0; n < 2; ++n) _Pragma("unroll") for (int k = 0; k < 2; ++k) dst[n][k] = *(const PG8_LAS bf16x8*)(lds + PG8_SB(b, h) + boff + n * 2048 + k * 1024); } while (0)
#define PG8_MMA(ai, bj, At, Bt) do { __builtin_amdgcn_s_setprio(1); _Pragma("unroll") for (int m = 0; m < 4; ++m) _Pragma("unroll") for (int n = 0; n < 2; ++n) _Pragma("unroll") for (int k = 0; k < 2; ++k) \
        acc[ai][bj][m][n] = __builtin_amdgcn_mfma_f32_16x16x32_bf16(Bt[n][k], At[m][k], acc[ai][bj][m][n], 0, 0, 0); __builtin_amdgcn_s_setprio(0); } while (0)
#define PG8_WAIT_V(n) asm volatile("s_waitcnt vmcnt(" #n ")" ::: "memory")
#define PG8_WAIT_L(n) asm volatile("s_waitcnt lgkmcnt(" #n ")" ::: "memory")
#define PG8_BAR __builtin_amdgcn_s_barrier()
#define PG8_SCHED __builtin_amdgcn_sched_barrier(0)
    Unit cur, nxt; int ui = 0;
    if (!S.next(0, cur)) return;
    f32x4 acc[2][2][4][2];
#pragma unroll
    for (int a = 0; a < 2; ++a)
#pragma unroll
        for (int b = 0; b < 2; ++b)
#pragma unroll
            for (int m = 0; m < 4; ++m)
#pragma unroll
                for (int n = 0; n < 2; ++n) acc[a][b][m][n] = (f32x4){0.f, 0.f, 0.f, 0.f};
    bf16x8 At[4][2], B0[2][2], B1[2][2];
    const char* cA = (const char*)g.A + (size_t)cur.pm * tstep; const char* cB = (const char*)g.Bt + (size_t)cur.pn * tstep;
    S.a_ready(cur);
    if constexpr (SP2) {
        PG8_STAGE(PG8_SB(0, 0), cB, voffB); PG8_STAGE(PG8_SB(0, 1), cB + hstep, voffB); PG8_STAGE(PG8_SA(0, 0), cA, voffA); PG8_STAGE(PG8_SA(0, 1), cA + hstep, voffA);
        if (wr == 1) PG8_BAR;
        PG8_WAIT_V(2); PG8_BAR;
        PG8_STAGE(PG8_SB(1, 0), cB + kstep, voffB); PG8_STAGE(PG8_SA(1, 0), cA + kstep, voffA); PG8_STAGE(PG8_SB(1, 1), cB + hstep + kstep, voffB);
        PG8_WAIT_V(6); PG8_BAR;
    } else {
        PG8_STAGE(PG8_SB(0, 0), cB, voffB); PG8_STAGE(PG8_SA(0, 0), cA, voffA); PG8_STAGE(PG8_SB(0, 1), cB + hstep, voffB); PG8_STAGE(PG8_SA(0, 1), cA + hstep, voffA);
        if (wr == 1) PG8_BAR;
        PG8_WAIT_V(4); PG8_BAR;
        PG8_STAGE(PG8_SB(1, 0), cB + kstep, voffB); PG8_STAGE(PG8_SA(1, 0), cA + kstep, voffA); PG8_STAGE(PG8_SB(1, 1), cB + hstep + kstep, voffB);
        PG8_WAIT_V(6); PG8_BAR;
    }
    for (;;) {
        const bool has_next = S.next(ui + 1, nxt);
        const char* nA = has_next ? (const char*)g.A + (size_t)nxt.pm * tstep : cA; const char* nB = has_next ? (const char*)g.Bt + (size_t)nxt.pn * tstep : cB;
        for (int t = 0; t < nt; t += 2) {
            const bool last = (t == nt - 2);
            const char* a1 = cA + (size_t)(t + 1) * kstep;
            const char* a2 = last ? nA : cA + (size_t)(t + 2) * kstep; const char* b2 = last ? nB : cB + (size_t)(t + 2) * kstep;
            const char* a3 = a2 + kstep; const char* b3 = b2 + kstep;
            if (last && has_next) S.a_ready(nxt);
            if constexpr (SP2) {
            PG8_LDB(B0, 0, 0); PG8_LDB(B1, 0, 1); PG8_SCHED; PG8_LDA(At, 0, 0); PG8_STAGE(PG8_SA(1, 1), a1 + hstep, voffA);
            PG8_WAIT_V(8); PG8_WAIT_L(0); PG8_BAR; PG8_MMA(0, 0, At, B0); PG8_MMA(0, 1, At, B1); PG8_BAR; PG8_SCHED;
            PG8_LDA(At, 0, 1); PG8_STAGE(PG8_SB(0, 0), b2, voffB); PG8_STAGE(PG8_SB(0, 1), b2 + hstep, voffB); PG8_STAGE(PG8_SA(0, 0), a2, voffA);
            PG8_WAIT_V(8); PG8_WAIT_L(0); PG8_BAR; PG8_MMA(1, 0, At, B0); PG8_MMA(1, 1, At, B1); PG8_BAR; PG8_SCHED;
            PG8_LDB(B0, 1, 0); PG8_LDB(B1, 1, 1); PG8_SCHED; PG8_LDA(At, 1, 0); PG8_STAGE(PG8_SA(0, 1), a2 + hstep, voffA);
            PG8_WAIT_V(8); PG8_WAIT_L(0); PG8_BAR; PG8_MMA(0, 0, At, B0); PG8_MMA(0, 1, At, B1); PG8_BAR; PG8_SCHED;
            PG8_LDA(At, 1, 1); PG8_STAGE(PG8_SB(1, 0), b3, voffB); PG8_STAGE(PG8_SB(1, 1), b3 + hstep, voffB); PG8_STAGE(PG8_SA(1, 0), a3, voffA);
            PG8_WAIT_V(8); PG8_WAIT_L(0); PG8_BAR; PG8_MMA(1, 0, At, B0); PG8_MMA(1, 1, At, B1); PG8_BAR; PG8_SCHED;
            } else {
            PG8_LDB(B0, 0, 0); PG8_SCHED; PG8_LDA(At, 0, 0); PG8_STAGE(PG8_SA(1, 1), a1 + hstep, voffA);
            PG8_WAIT_L(8); PG8_BAR; PG8_WAIT_L(0); PG8_MMA(0, 0, At, B0); PG8_BAR; PG8_SCHED;
            PG8_LDB(B1, 0, 1); PG8_STAGE(PG8_SB(0, 0), b2, voffB);
            PG8_BAR; PG8_WAIT_L(0); PG8_MMA(0, 1, At, B1); PG8_BAR;
            PG8_LDA(At, 0, 1); PG8_STAGE(PG8_SA(0, 0), a2, voffA);
            PG8_BAR; PG8_WAIT_L(0); PG8_MMA(1, 0, At, B0); PG8_BAR; PG8_SCHED;
            PG8_STAGE(PG8_SB(0, 1), b2 + hstep, voffB);
            PG8_WAIT_V(6); PG8_BAR; PG8_MMA(1, 1, At, B1); PG8_BAR;
            PG8_LDB(B0, 1, 0); PG8_SCHED; PG8_LDA(At, 1, 0); PG8_STAGE(PG8_SA(0, 1), a2 + hstep, voffA);
            PG8_WAIT_L(8); PG8_BAR; PG8_WAIT_L(0); PG8_MMA(0, 0, At, B0); PG8_BAR; PG8_SCHED;
            PG8_LDB(B1, 1, 1); PG8_STAGE(PG8_SB(1, 0), b3, voffB);
            PG8_BAR; PG8_WAIT_L(0); PG8_MMA(0, 1, At, B1); PG8_BAR;
            PG8_LDA(At, 1, 1); PG8_STAGE(PG8_SA(1, 0), a3, voffA);
            PG8_BAR; PG8_WAIT_L(0); PG8_MMA(1, 0, At, B0); PG8_BAR; PG8_SCHED;
            PG8_STAGE(PG8_SB(1, 1), b3 + hstep, voffB);
            PG8_WAIT_V(6); PG8_BAR; PG8_MMA(1, 1, At, B1); PG8_BAR;
            }
        }
        if constexpr (ALIGN_EPI) { if (wr == 0) PG8_BAR; }
        if constexpr (!Epi::AFTER_DRAIN) { E(acc, cur, wr, wc, fr, fq); S.done(cur); }
        if (!has_next) break;
#pragma unroll
        for (int a = 0; a < 2; ++a)
#pragma unroll
            for (int b = 0; b < 2; ++b)
#pragma unroll
                for (int m = 0; m < 4; ++m)
#pragma unroll
                    for (int n = 0; n < 2; ++n) acc[a][b][m][n] = (f32x4){0.f, 0.f, 0.f, 0.f};
        cur = nxt; cA = nA; cB = nB; ++ui;
        if constexpr (ALIGN_EPI) { if (wr == 1) PG8_BAR; }
    }
    PG8_WAIT_V(0);
    if constexpr (!ALIGN_EPI) { if (wr == 0) PG8_BAR; }
    PG8_BAR;
    if constexpr (Epi::AFTER_DRAIN) { E.fused(acc, cur, wr, wc, fr, fq, lds, wid, lane); S.done(cur); }
#undef PG8_SA
#undef PG8_SB
#undef PG8_STAGE
#undef PG8_LDA
#undef PG8_LDB
#undef PG8_MMA
#undef PG8_WAIT_V
#undef PG8_WAIT_L
#undef PG8_BAR
#undef PG8_SCHED
}
}

constexpr int NB = 2, TL = 4096, DM = 2048, CL = 256, NIN = 7872, NINP = 7936;
constexpr int ML = NB * TL, MC = NB * CL, MT = ML + MC;
constexpr int KEYS = CL + TL;
constexpr int NSTEP = KEYS;
constexpr int A_U = 0, A_V = 512, A_G = 1024, B_Q = 1536, B_K = 2048, B_V = 2560, B_G = 3072, C_R = 3584, C_K = 4096, C_V = 4608, C_LF = 5120, C_LB = 5216, C_G = 5312,
              D_B = 5824, D_C = 6336, D_X = 6848, D_G = 7360;
constexpr float EPS = 1e-6f, GN_EPS = 64e-5f;
constexpr float QSCALE = 0.125f * 1.4426950408889634f;

constexpr size_t MiB = 1u << 20;
constexpr size_t WS_CTL = 0, CTL_ZERO_BYTES = 1 * MiB;
constexpr size_t CTL_MODACC = 65536;
constexpr size_t WS_ROPE = 1 * MiB - 16384;
constexpr size_t WS_WIN = 1 * MiB;
constexpr size_t WS_WOUT = 63 * MiB;
constexpr size_t WS_XN = 79 * MiB;
constexpr size_t WS_P = 113 * MiB;
constexpr size_t WS_QR = 245 * MiB;
constexpr size_t WS_QC = 253 * MiB;
constexpr size_t WS_KR = 254 * MiB;
constexpr size_t WS_VT = 263 * MiB;
constexpr size_t WS_CHK = 272 * MiB;
constexpr size_t WS_Y = 402 * MiB;
constexpr size_t WS_BON = 436 * MiB;
constexpr size_t WS_OC = 453 * MiB;
constexpr size_t WS_LW = 487 * MiB;
constexpr size_t WS_SST = 488 * MiB;
constexpr size_t WS_END = 489 * MiB;
static_assert(WS_WIN + (size_t)2 * NINP * DM * 2 <= WS_WOUT && WS_WOUT + (size_t)2 * DM * DM * 2 <= WS_XN && WS_XN + (size_t)MT * DM * 2 <= WS_P && WS_P + (size_t)MT * NINP * 2 <= WS_QR, "ws map 1");
static_assert(WS_QR + (size_t)16 * TL * 64 * 2 <= WS_QC && WS_QC + (size_t)16 * CL * 64 * 2 <= WS_KR && WS_KR + (size_t)16 * KEYS * 64 * 2 <= WS_VT && WS_VT + (size_t)8 * 128 * KEYS * 2 <= WS_CHK, "ws map 2");
static_assert(WS_Y + (size_t)2 * MT * 512 * 4 <= WS_BON && WS_BON + (size_t)2 * MT * 512 * 2 <= WS_OC && WS_OC + (size_t)MT * DM * 2 <= WS_END, "ws map 3");
static_assert((size_t)MT * 1024 * 4 <= WS_P - WS_XN && (size_t)MT * DM * 4 <= WS_QR - WS_P, "overlays");

constexpr int LDS_BYTES = 147456;
constexpr int NWAVES = 8, NTHREADS = 512;

typedef unsigned short bf16;
typedef short bf16x8 __attribute__((ext_vector_type(8)));
typedef float f32x4 __attribute__((ext_vector_type(4)));
typedef float f32x2 __attribute__((ext_vector_type(2)));
typedef float f32x16 __attribute__((ext_vector_type(16)));
typedef unsigned u32x4 __attribute__((ext_vector_type(4)));
typedef unsigned u32x2 __attribute__((ext_vector_type(2)));
typedef __bf16 bf16x2_t __attribute__((ext_vector_type(2)));
#define LAS __attribute__((address_space(3)))

struct Params { const float* in[28]; float* out; unsigned char* ws; };

struct Ctx {
    const Params* prm; float* out; unsigned char* ws;
    LAS unsigned char* lds;
    int tid, lane, wave, bx, G, gw, NGW;
};

__device__ __forceinline__ unsigned cvtpk(float lo, float hi) { f32x2 v = {lo, hi}; bf16x2_t b = __builtin_convertvector(v, bf16x2_t); return __builtin_bit_cast(unsigned, b); }
__device__ __forceinline__ float bflo(unsigned u) { return __builtin_bit_cast(float, u << 16); }
__device__ __forceinline__ float bfhi(unsigned u) { return __builtin_bit_cast(float, u & 0xffff0000u); }
__device__ __forceinline__ void unpack8(const u32x4 v, float* f) { f[0] = bflo(v.x); f[1] = bfhi(v.x); f[2] = bflo(v.y); f[3] = bfhi(v.y); f[4] = bflo(v.z); f[5] = bfhi(v.z); f[6] = bflo(v.w); f[7] = bfhi(v.w); }
__device__ __forceinline__ u32x4 pack8(const float* f) { u32x4 r; r.x = cvtpk(f[0], f[1]); r.y = cvtpk(f[2], f[3]); r.z = cvtpk(f[4], f[5]); r.w = cvtpk(f[6], f[7]); return r; }
__device__ __forceinline__ float silu_f(float x) { return x * __builtin_amdgcn_rcpf(1.f + __expf(-x)); }
__device__ __forceinline__ float wave_sum(float v) {
#pragma unroll
    for (int o = 1; o < 64; o <<= 1) v += __shfl_xor(v, o);
    return v;
}
template <int CTRL> __device__ __forceinline__ float dpp_f(float v) { return __builtin_bit_cast(float, __builtin_amdgcn_update_dpp(0, __builtin_bit_cast(int, v), CTRL, 0xf, 0xf, true)); }
__device__ __forceinline__ float red4(float v) { v += dpp_f<0xB1>(v); v += dpp_f<0x4E>(v); return v; }
__device__ __forceinline__ float red8(float v) { v = red4(v); v += dpp_f<0x141>(v); return v; }
__device__ __forceinline__ float red16(float v) { v = red8(v); v += dpp_f<0x140>(v); return v; }
#define LAUNDER(F) do { asm volatile("" : "+v"(F.tid), "+v"(F.lane)); asm volatile("" : "+s"(F.wave), "+s"(F.bx), "+s"(F.gw)); } while (0)
__device__ __forceinline__ f32x16 zero16() { f32x16 z;
#pragma unroll
    for (int r = 0; r < 16; ++r) z[r] = 0.f;
    return z; }
#define MROW(reg, hh) (((reg) & 3) + 8 * ((reg) >> 2) + 4 * (hh))
#define LDS_WAIT() asm volatile("s_waitcnt lgkmcnt(0)" ::: "memory")
#define WG_BAR() do { asm volatile("s_waitcnt lgkmcnt(0)" ::: "memory"); __builtin_amdgcn_s_barrier(); asm volatile("" ::: "memory"); } while (0)

#ifndef R_P0T
#define R_P0T 1
#endif
__device__ __forceinline__ void p0_transpose_item(const float* W, int K, int N, bf16* WT, LAS float* scr, int item, int lane) {
    const int nblk = N / 32, kb = item / nblk, nb = item % nblk, k0 = 64 * kb, n0 = 32 * nb;
#pragma unroll 8
    for (int i = 0; i < 32; ++i) { const int kk = 2 * i + (lane >> 5); scr[kk * 33 + (lane & 31)] = W[(size_t)(k0 + kk) * N + n0 + (lane & 31)]; }
    LDS_WAIT();
    const int c = lane & 7;
#pragma unroll
    for (int j = 0; j < 4; ++j) { const int n = (lane >> 3) + 8 * j; const LAS float* s = scr + (8 * c) * 33 + n;
        u32x4 o; o.x = cvtpk(s[0 * 33], s[1 * 33]); o.y = cvtpk(s[2 * 33], s[3 * 33]); o.z = cvtpk(s[4 * 33], s[5 * 33]); o.w = cvtpk(s[6 * 33], s[7 * 33]);
        *(u32x4*)(WT + (size_t)(n0 + n) * K + k0 + 8 * c) = o; }
    LDS_WAIT();
}

__device__ __forceinline__ void p0_weights(Ctx& F, int l, int widx, int nw) {
    LAS float* scr = (LAS float*)(F.lds + F.wave * 16384);
    const float* w_in = F.prm->in[8] + (size_t)l * DM * NIN; const float* w_out = F.prm->in[9] + (size_t)l * DM * DM;
    bf16* WIN = (bf16*)(F.ws + WS_WIN) + (size_t)l * NINP * DM; bf16* WOUT = (bf16*)(F.ws + WS_WOUT) + (size_t)l * DM * DM;
    constexpr int I_IN = (DM / 64) * (NIN / 32), I_OUT = (DM / 64) * (DM / 32);
    for (int it = widx; it < I_IN + I_OUT; it += nw) {
        if (it < I_IN) p0_transpose_item(w_in, DM, NIN, WIN, scr, it, F.lane);
        else p0_transpose_item(w_out, DM, DM, WOUT, scr, it - I_IN, F.lane);
    }
    const float* cvec = F.prm->in[1]; const float* cctx = F.prm->in[3]; const float* w_mod = F.prm->in[4];
    float* MODACC = (float*)(F.ws + WS_CTL + CTL_MODACC);
    for (int it = widx; it < 32 * 24; it += nw) {
        const int ks = it / 24, cb = it % 24, k0 = ks * 64, n0 = cb * 256 + 4 * F.lane;
        scr[F.lane] = silu_f(cvec[k0 + F.lane]); scr[64 + F.lane] = silu_f(cvec[DM + k0 + F.lane]); scr[128 + F.lane] = silu_f(cctx[k0 + F.lane]);
        LDS_WAIT();
        f32x4 a0 = {0.f, 0.f, 0.f, 0.f}, a1 = a0, a2 = a0;
        const float* wp = w_mod + ((size_t)l * DM + k0) * 6144 + n0;
#pragma unroll 8
        for (int k = 0; k < 64; ++k) { const f32x4 w = *(const f32x4*)(wp + (size_t)k * 6144); a0 += w * scr[k]; a1 += w * scr[64 + k]; a2 += w * scr[128 + k]; }
        float* ma = MODACC + (size_t)(l * 3) * 6144 + n0;
#pragma unroll
        for (int e = 0; e < 4; ++e) { atomicAdd(ma + e, a0[e]); atomicAdd(ma + 6144 + e, a1[e]); atomicAdd(ma + 2 * 6144 + e, a2[e]); }
        LDS_WAIT();
    }
}
__device__ __forceinline__ void phase0(Ctx& F) {
    p0_weights(F, 0, F.gw, F.NGW); p0_weights(F, 1, F.gw, F.NGW);
    {   const float* w2a = F.prm->in[19]; const float* a2a = F.prm->in[21]; bf16* LW = (bf16*)(F.ws + WS_LW);
        const int gt = F.bx * NTHREADS + F.tid, GT = F.G * NTHREADS;
        for (int idx = gt; idx < 4 * 512 * 64; idx += GT) { const int pd = idx / (512 * 64), rem = idx % (512 * 64), k = rem >> 9, chg = rem & 511, hq = chg >> 6, ch = chg & 63;
            const float v = w2a[((size_t)pd * 64 + k) * 512 + chg]; const unsigned hi = cvtpk(v, 0.f) & 0xffffu; const float lo = v - bflo(hi);
            bf16* base = LW + (size_t)(pd * 8 + hq) * 12288; base[ch * 64 + k] = (bf16)hi; base[4096 + ch * 64 + k] = (bf16)(cvtpk(lo, 0.f) & 0xffffu); }
        for (int idx = gt; idx < 4 * 512 * 32; idx += GT) { const int pd = idx / (512 * 32), rem = idx % (512 * 32), k = rem >> 9, chg = rem & 511, hq = chg >> 6, ch = chg & 63;
            const float v = a2a[((size_t)pd * 32 + k) * 512 + chg]; const unsigned hi = cvtpk(v, 0.f) & 0xffffu; const float lo = v - bflo(hi);
            bf16* base = LW + (size_t)(pd * 8 + hq) * 12288 + 8192; base[ch * 32 + k] = (bf16)hi; base[2048 + ch * 32 + k] = (bf16)(cvtpk(lo, 0.f) & 0xffffu); }
    }
    if (F.bx == 0) {
        float* rope = (float*)(F.ws + WS_ROPE);
        for (int i = F.tid; i < 1024; i += NTHREADS) { const int pos = i >> 4, f = i & 15; const float inv = powf(10000.f, -(float)(2 * f) / 32.f); const float ang = (float)pos * inv;
            rope[i] = cosf(ang); rope[1024 + i] = sinf(ang); }
    }
}

__device__ __forceinline__ void ld_row(const float* p, int lane, f32x4* v) {
#pragma unroll
    for (int j = 0; j < 8; ++j) v[j] = *(const f32x4*)(p + 4 * lane + 256 * j);
}
__device__ __forceinline__ float sumsq8(const f32x4* v) { float s = 0.f;
#pragma unroll
    for (int j = 0; j < 8; ++j) s += (v[j].x * v[j].x + v[j].y * v[j].y) + (v[j].z * v[j].z + v[j].w * v[j].w);
    return s; }
__device__ __forceinline__ void ld_mod(const Ctx& F, int l, int r, int part, int lane, f32x4* v) {
    const float* ma = (const float*)(F.ws + WS_CTL + CTL_MODACC) + (size_t)(l * 3 + r) * 6144 + part * DM; const float* bm = F.prm->in[5] + (size_t)l * 6144 + part * DM;
#pragma unroll
    for (int j = 0; j < 8; ++j) v[j] = *(const f32x4*)(ma + 4 * lane + 256 * j) + *(const f32x4*)(bm + 4 * lane + 256 * j);
}
__device__ __forceinline__ void phase1(Ctx& F, int l) {
    const float* x = F.prm->in[0]; const float* ctx = F.prm->in[2]; const float* g_pre = F.prm->in[6] + (size_t)l * DM; const float* g_post0 = F.prm->in[7];
    const float* O = (const float*)(F.ws + WS_P); bf16* XN = (bf16*)(F.ws + WS_XN);
    LAS float* MV = (LAS float*)F.lds;
    {   const float* ma = (const float*)(F.ws + WS_CTL + CTL_MODACC); const float* bm = F.prm->in[5];
        for (int idx = F.tid; idx < 3 * 512; idx += NTHREADS) { const int r = idx >> 9, n = (idx & 511) * 4;
            const f32x4 shv = *(const f32x4*)(ma + (size_t)(l * 3 + r) * 6144 + n) + *(const f32x4*)(bm + (size_t)l * 6144 + n);
            const f32x4 scv = *(const f32x4*)(ma + (size_t)(l * 3 + r) * 6144 + DM + n) + *(const f32x4*)(bm + (size_t)l * 6144 + DM + n);
            *(LAS f32x4*)(MV + (r * 3 + 0) * DM + n) = shv; *(LAS f32x4*)(MV + (r * 3 + 1) * DM + n) = (scv + 1.f) * *(const f32x4*)(g_pre + n);
            if (l == 1) { const f32x4 gt = *(const f32x4*)(ma + (size_t)r * 6144 + 2 * DM + n) + *(const f32x4*)(bm + 2 * DM + n); *(LAS f32x4*)(MV + (r * 3 + 2) * DM + n) = gt * *(const f32x4*)(g_post0 + n); } }
    }
    WG_BAR();
    for (int row = F.gw; row < MT; row += F.NGW) {
        const bool lat = row < ML; const int r = lat ? (row / TL) : 2;
        const LAS float* mv = MV + r * 3 * DM + 4 * F.lane;
        const float* src = lat ? x + (size_t)row * DM : ctx + (size_t)(row - ML) * DM;
        f32x4 xv[8]; ld_row(src, F.lane, xv);
        if (l == 1) {
            f32x4 ov[8]; ld_row(O + (size_t)row * DM, F.lane, ov);
            const float rs = 1.f / sqrtf(wave_sum(sumsq8(ov)) * (1.f / DM) + EPS);
#pragma unroll
            for (int j = 0; j < 8; ++j) xv[j] = xv[j] + *(const LAS f32x4*)(mv + 2 * DM + 256 * j) * (ov[j] * rs);
            if (lat) {
#pragma unroll
                for (int j = 0; j < 8; ++j) *(f32x4*)(F.out + (size_t)row * DM + 4 * F.lane + 256 * j) = xv[j];
            }
        }
        const float rs = 1.f / sqrtf(wave_sum(sumsq8(xv)) * (1.f / DM) + EPS);
#pragma unroll
        for (int j = 0; j < 8; ++j) { const f32x4 h = (xv[j] * rs) * *(const LAS f32x4*)(mv + DM + 256 * j) + *(const LAS f32x4*)(mv + 256 * j);
            u32x2 w; w.x = cvtpk(h.x, h.y); w.y = cvtpk(h.z, h.w); *(u32x2*)(XN + (size_t)row * DM + 4 * F.lane + 256 * j) = w; }
    }
    WG_BAR();
}
__device__ __forceinline__ void phase6(Ctx& F) {
    const float* g_post1 = F.prm->in[7] + DM; const float* O = (const float*)(F.ws + WS_P);
    for (int row = F.gw; row < ML; row += F.NGW) {
        const int r = row / TL;
        f32x4 xv[8], ov[8], gt[8], gp[8]; ld_row(F.out + (size_t)row * DM, F.lane, xv); ld_row(O + (size_t)row * DM, F.lane, ov); ld_mod(F, 1, r, 2, F.lane, gt); ld_row(g_post1, F.lane, gp);
        const float rs = 1.f / sqrtf(wave_sum(sumsq8(ov)) * (1.f / DM) + EPS);
#pragma unroll
        for (int j = 0; j < 8; ++j) *(f32x4*)(F.out + (size_t)row * DM + 4 * F.lane + 256 * j) = xv[j] + gt[j] * (ov[j] * rs * gp[j]);
    }
}

__device__ __forceinline__ void sgu_item(Ctx& F, int l, int cb, int h) {
    const bf16* P = (const bf16*)(F.ws + WS_P); bf16* OC = (bf16*)(F.ws + WS_OC);
    const float* w_s = F.prm->in[10] + (size_t)(l * 4 + h) * 128 * 128; const float* b_s = F.prm->in[11] + (size_t)(l * 4 + h) * 128;
    const int row0 = cb < 64 ? (cb >> 5) * TL + (cb & 31) * 128 : ML + ((cb - 64) >> 1) * CL + ((cb - 64) & 1) * 128;
    LAS unsigned char* WB = F.lds;
    LAS unsigned char* VTB = F.lds + 34816;
    LAS float* MX = (LAS float*)(F.lds + 69632);
    {
        const int row = F.tid >> 2, qt = F.tid & 3; const bf16* src = P + (size_t)(row0 + row) * NINP + A_V + h * 128 + qt * 32;
        float v[32];
#pragma unroll
        for (int i = 0; i < 4; ++i) unpack8(*(const u32x4*)(src + 8 * i), v + 8 * i);
        float s_ = 0.f;
#pragma unroll
        for (int i = 0; i < 32; ++i) s_ += v[i];
        const float mean = red4(s_) * (1.f / 128.f); float q = 0.f;
#pragma unroll
        for (int i = 0; i < 32; ++i) { v[i] -= mean; q += v[i] * v[i]; }
        const float rstd = 1.f / sqrtf(red4(q) * (1.f / 128.f) + EPS);
#pragma unroll
        for (int i = 0; i < 32; i += 2) { const unsigned w = cvtpk(v[i] * rstd, v[i + 1] * rstd);
            *(LAS unsigned short*)(VTB + (qt * 32 + i) * 272 + 2 * row) = (unsigned short)w; *(LAS unsigned short*)(VTB + (qt * 32 + i + 1) * 272 + 2 * row) = (unsigned short)(w >> 16); }
    }
    for (int idx = F.tid; idx < 4096; idx += NTHREADS) { const int p = idx >> 5, q4 = idx & 31; const f32x4 w = *(const f32x4*)(w_s + p * 128 + 4 * q4);
        *(LAS u32x2*)(WB + p * 272 + 8 * q4) = (u32x2){cvtpk(w.x, w.y), cvtpk(w.z, w.w)}; }
    WG_BAR();
    {   const int l31 = F.lane & 31, hh = F.lane >> 5, mt = F.wave >> 1;
#pragma unroll
        for (int nn = 0; nn < 2; ++nn) { const int nt = (F.wave & 1) * 2 + nn; f32x16 d = zero16();
#pragma unroll
            for (int ks = 0; ks < 8; ++ks) d = __builtin_amdgcn_mfma_f32_32x32x16_bf16(*(const LAS bf16x8*)(WB + (32 * mt + l31) * 272 + (16 * ks + 8 * hh) * 2), *(const LAS bf16x8*)(VTB + (32 * nt + l31) * 272 + (16 * ks + 8 * hh) * 2), d, 0, 0, 0);
#pragma unroll
            for (int r = 0; r < 16; ++r) MX[(32 * mt + MROW(r, hh)) * 132 + 32 * nt + l31] = d[r]; }
    }
    WG_BAR();
    const int pg = F.tid >> 5, dg = F.tid & 31;
    f32x4 acc[8];
#pragma unroll
    for (int i = 0; i < 8; ++i) acc[i] = *(const LAS f32x4*)(MX + (8 * pg + i) * 132 + 4 * dg);
#pragma unroll
    for (int i = 0; i < 8; ++i) { const int p = 8 * pg + i; const float bs = b_s[p]; const bf16* pr = P + (size_t)(row0 + p) * NINP + h * 128 + 4 * dg;
        const u32x2 uu = *(const u32x2*)(pr + A_U), gg = *(const u32x2*)(pr + A_G);
        const float o0 = bflo(uu.x) * (acc[i].x + bs) * silu_f(bflo(gg.x)), o1 = bfhi(uu.x) * (acc[i].y + bs) * silu_f(bfhi(gg.x));
        const float o2 = bflo(uu.y) * (acc[i].z + bs) * silu_f(bflo(gg.y)), o3 = bfhi(uu.y) * (acc[i].w + bs) * silu_f(bfhi(gg.y));
        u32x2 w; w.x = cvtpk(o0, o1); w.y = cvtpk(o2, o3); *(u32x2*)(OC + (size_t)(row0 + p) * DM + h * 128 + 4 * dg) = w; }
    WG_BAR();
}

__device__ __forceinline__ void conv_item(Ctx& F, int l, int item) {
    const bf16* P = (const bf16*)(F.ws + WS_P); bf16* OC = (bf16*)(F.ws + WS_OC); const float* cw = F.prm->in[27] + (size_t)l * 3 * 512;
    const int row = item * 16 + (F.tid >> 5), c0 = (F.tid & 31) * 16;
    int t, tlen; if (row < ML) { t = row & (TL - 1); tlen = TL; } else { t = (row - ML) & (CL - 1); tlen = CL; }
    const bf16* pr = P + (size_t)row * NINP;
    float z0[16], z1[16], z2[16], tmp[16];
#pragma unroll
    for (int i = 0; i < 2; ++i) {
        float a[8], b[8];
        unpack8(*(const u32x4*)(pr + D_C + c0 + 8 * i), a); unpack8(*(const u32x4*)(pr + D_X + c0 + 8 * i), b);
#pragma unroll
        for (int e = 0; e < 8; ++e) z1[8 * i + e] = a[e] * b[e];
        if (t > 0) { unpack8(*(const u32x4*)(pr - NINP + D_C + c0 + 8 * i), a); unpack8(*(const u32x4*)(pr - NINP + D_X + c0 + 8 * i), b);
#pragma unroll
            for (int e = 0; e < 8; ++e) z0[8 * i + e] = a[e] * b[e]; }
        else {
#pragma unroll
            for (int e = 0; e < 8; ++e) z0[8 * i + e] = 0.f; }
        if (t < tlen - 1) { unpack8(*(const u32x4*)(pr + NINP + D_C + c0 + 8 * i), a); unpack8(*(const u32x4*)(pr + NINP + D_X + c0 + 8 * i), b);
#pragma unroll
            for (int e = 0; e < 8; ++e) z2[8 * i + e] = a[e] * b[e]; }
        else {
#pragma unroll
            for (int e = 0; e < 8; ++e) z2[8 * i + e] = 0.f; }
    }
#pragma unroll
    for (int i = 0; i < 2; ++i) {
        float bg[8], gg[8]; unpack8(*(const u32x4*)(pr + D_B + c0 + 8 * i), bg); unpack8(*(const u32x4*)(pr + D_G + c0 + 8 * i), gg);
#pragma unroll
        for (int e = 0; e < 8; ++e) { const int c = c0 + 8 * i + e; const float y = cw[c] * z0[8 * i + e] + cw[512 + c] * z1[8 * i + e] + cw[1024 + c] * z2[8 * i + e]; tmp[e] = bg[e] * y * silu_f(gg[e]); }
        *(u32x4*)(OC + (size_t)row * DM + 1536 + c0 + 8 * i) = pack8(tmp);
    }
}

__device__ __forceinline__ void attnprep_item(Ctx& F, int l, int rb, int h) {
    const bf16* P = (const bf16*)(F.ws + WS_P); const float* rope = (const float*)(F.ws + WS_ROPE);
    bf16* QR = (bf16*)(F.ws + WS_QR); bf16* QC = (bf16*)(F.ws + WS_QC); bf16* KR = (bf16*)(F.ws + WS_KR); bf16* VT = (bf16*)(F.ws + WS_VT);
    const bool lat = rb < 128; const int b = lat ? (rb >> 6) : ((rb - 128) >> 2), t0 = lat ? (rb & 63) * 64 : ((rb - 128) & 3) * 64;
    const int row0 = lat ? b * TL + t0 : ML + b * CL + t0;
    {
        const int tk = F.tid >> 3, sub = F.tid & 7, isk = sub >> 2, hq = sub & 3, m = hq >> 1, half = hq & 1, t = t0 + tk;
        const bf16* src = P + (size_t)(row0 + tk) * NINP + (isk ? B_K : B_Q) + h * 128 + 32 * hq;
        float xx[32], oo[32];
#pragma unroll
        for (int i = 0; i < 4; ++i) unpack8(*(const u32x4*)(src + 8 * i), xx + 8 * i);
        if (lat) { const int pos = half ? (t & 63) : (t >> 6); const float* cs = rope + pos * 16; const float* sn = rope + 1024 + pos * 16;
#pragma unroll
            for (int i = 0; i < 16; ++i) { const float c = cs[i], s = sn[i]; oo[i] = xx[i] * c - xx[i + 16] * s; oo[i + 16] = xx[i + 16] * c + xx[i] * s; } }
        else {
#pragma unroll
            for (int i = 0; i < 32; ++i) oo[i] = xx[i]; }
        if (!isk) {
#pragma unroll
            for (int i = 0; i < 32; ++i) oo[i] *= QSCALE; }
        const int bhm = (b * 4 + h) * 2 + m;
        bf16* dst = isk ? KR + ((size_t)bhm * KEYS + (lat ? CL + t : t)) * 64 + 32 * half : (lat ? QR + ((size_t)bhm * TL + t) * 64 + 32 * half : QC + ((size_t)bhm * CL + t) * 64 + 32 * half);
        if (isk || lat || l == 0) {
#pragma unroll
            for (int i = 0; i < 4; ++i) *(u32x4*)(dst + 8 * i) = pack8(oo + 8 * i); }
    }
    LAS unsigned char* VL = F.lds;
#pragma unroll
    for (int pass = 0; pass < 2; ++pass) { const int idx = F.tid + 512 * pass, key = idx >> 4, c = idx & 15;
        *(LAS u32x4*)(VL + key * 272 + 16 * c) = *(const u32x4*)(P + (size_t)(row0 + key) * NINP + B_V + h * 128 + 8 * c); }
    WG_BAR();
    const int keybase = lat ? CL + t0 : t0;
#pragma unroll
    for (int pass = 0; pass < 2; ++pass) { const int idx = F.tid + 512 * pass, dv = idx >> 3, kc = idx & 7; unsigned short e[8];
#pragma unroll
        for (int i = 0; i < 8; ++i) e[i] = *(const LAS unsigned short*)(VL + (8 * kc + i) * 272 + 2 * dv);
        u32x4 o; o.x = e[0] | ((unsigned)e[1] << 16); o.y = e[2] | ((unsigned)e[3] << 16); o.z = e[4] | ((unsigned)e[5] << 16); o.w = e[6] | ((unsigned)e[7] << 16);
        *(u32x4*)(VT + ((size_t)(b * 4 + h) * 128 + dv) * KEYS + keybase + 8 * kc) = o; }
    WG_BAR();
}

constexpr int NCHUNK = NSTEP / 64;
constexpr int CHKB = 62464;
constexpr int CK_W1F = 0, CK_RF = 8192, CK_BTF = 16384, CK_ARBF = 24576, CK_ARKF = 30720, CK_VF = 36864, CK_W2A = 45056, CK_GA = 53248, CK_CLV = 61440;
static_assert((size_t)32 * NCHUNK * CHKB <= WS_Y - WS_CHK, "chunk records");

__device__ __forceinline__ bf16x8 frag16(const LAS unsigned char* tile, int row, int k0) { return *(const LAS bf16x8*)(tile + row * 144 + k0 * 2); }
__device__ __forceinline__ bf16x8 fragP(const LAS unsigned char* tile, int row, int base, int hh) {
    const u32x2 lo = *(const LAS u32x2*)(tile + row * 144 + (base + 4 * hh) * 2), hi = *(const LAS u32x2*)(tile + row * 144 + (base + 8 + 4 * hh) * 2);
    const u32x4 w = {lo.x, lo.y, hi.x, hi.y}; return __builtin_bit_cast(bf16x8, w);
}
template <int S8> __device__ __forceinline__ bf16x8 pk8(const f32x16& a) {
    const u32x4 w = {cvtpk(a[S8], a[S8 + 1]), cvtpk(a[S8 + 2], a[S8 + 3]), cvtpk(a[S8 + 4], a[S8 + 5]), cvtpk(a[S8 + 6], a[S8 + 7])}; return __builtin_bit_cast(bf16x8, w);
}
__device__ __forceinline__ f32x16 tile_prod(const LAS unsigned char* At, int m0, const LAS unsigned char* Bt, int n0, int l31, int hh) {
    f32x16 d = zero16();
#pragma unroll
    for (int q = 0; q < 4; ++q) d = __builtin_amdgcn_mfma_f32_32x32x16_bf16(frag16(At, m0 + l31, 16 * q + 8 * hh), frag16(Bt, n0 + l31, 16 * q + 8 * hh), d, 0, 0, 0);
    return d;
}
__device__ __forceinline__ void st_acc32(unsigned char* p, const f32x16& d) {
    *(u32x4*)p = (u32x4){cvtpk(d[0], d[1]), cvtpk(d[2], d[3]), cvtpk(d[4], d[5]), cvtpk(d[6], d[7])};
    *(u32x4*)(p + 16) = (u32x4){cvtpk(d[8], d[9]), cvtpk(d[10], d[11]), cvtpk(d[12], d[13]), cvtpk(d[14], d[15])};
}
__device__ __forceinline__ f32x16 ld_acc32(const LAS unsigned char* p) {
    const u32x4 a = *(const LAS u32x4*)p, b = *(const LAS u32x4*)(p + 16); f32x16 d;
    d[0] = bflo(a.x); d[1] = bfhi(a.x); d[2] = bflo(a.y); d[3] = bfhi(a.y); d[4] = bflo(a.z); d[5] = bfhi(a.z); d[6] = bflo(a.w); d[7] = bfhi(a.w);
    d[8] = bflo(b.x); d[9] = bfhi(b.x); d[10] = bflo(b.y); d[11] = bfhi(b.y); d[12] = bflo(b.z); d[13] = bfhi(b.z); d[14] = bflo(b.w); d[15] = bfhi(b.w); return d;
}
__device__ __forceinline__ float softplus_f(float x) { return fmaxf(x, 0.f) + __logf(1.f + __expf(-fabsf(x))); }
__device__ __forceinline__ int scan_row(int c, int i, int dir, int b) {
    const bool isctx = c < 4; const int bi = (isctx ? 64 * c : 64 * (c - 4)) + i;
    return isctx ? ML + b * CL + (dir ? CL - 1 - bi : bi) : b * TL + (dir ? TL - 1 - bi : bi);
}

__device__ __forceinline__ void rwkv1_item(Ctx& F, int l, int item) {
    const int scan = item / NCHUNK, c = item % NCHUNK, dir = scan >> 4, b = (scan >> 3) & 1, h = scan & 7;
    const bf16* P = (const bf16*)(F.ws + WS_P); unsigned char* rec = F.ws + WS_CHK + (size_t)item * CHKB;
    bf16* BON = (bf16*)(F.ws + WS_BON) + (size_t)dir * MT * 512;
    LAS unsigned char* TA = F.lds; LAS unsigned char* TB = F.lds + 9216; LAS unsigned char* TK = F.lds + 18432; LAS unsigned char* TR = F.lds + 27648;
    LAS unsigned char* TAT = F.lds + 36864; LAS unsigned char* TBT = F.lds + 46080; LAS unsigned char* TKT = F.lds + 55296; LAS unsigned char* TVT = F.lds + 64512;
    LAS unsigned char* TT = F.lds + 73728;
    LAS float* AAB = (LAS float*)(F.lds + 82944);
    LAS float* CLS = (LAS float*)(F.lds + 100352);
    LAS unsigned char* LWH = F.lds;             LAS unsigned char* LWL = F.lds + 9216;
    LAS unsigned char* LAH = F.lds + 18432;     LAS unsigned char* LAL = F.lds + 23552;
    LAS unsigned char* XWH = F.lds + 28672;     LAS unsigned char* XWL = F.lds + 37888;
    LAS unsigned char* XAH = F.lds + 47104;     LAS unsigned char* XAL = F.lds + 52224;
    LAS float* OW = (LAS float*)(F.lds + 57344);
    LAS float* OA = (LAS float*)(F.lds + 74752);
    const int i = F.tid >> 3, sub = F.tid & 7, c0 = 8 * sub, gc0 = h * 64 + c0;
    const bool isctx = c < 4; const int bi = (isctx ? 64 * c : 64 * (c - 4)) + i;
    const int row = scan_row(c, i, dir, b);
    const bool hasprev = bi > 0;
    const bf16* pr = P + (size_t)row * NINP; const bf16* pp = dir ? pr + NINP : pr - NINP;
    const int pd = l * 2 + dir;
    const float* mu = F.prm->in[17] + (size_t)pd * 1632; const float* w0 = F.prm->in[18] + (size_t)pd * 512; const float* w2 = F.prm->in[19] + (size_t)pd * 64 * 512;
    const float* a0 = F.prm->in[20] + (size_t)pd * 512; const float* a2 = F.prm->in[21] + (size_t)pd * 32 * 512; const float* k_k = F.prm->in[22] + (size_t)pd * 512;
    const float* k_a = F.prm->in[23] + (size_t)pd * 512; const float* r_k = F.prm->in[24] + (size_t)pd * 512;
    const int CLX = dir == 0 ? C_LF : C_LB;
    const u32x4 zz4 = {0u, 0u, 0u, 0u}; const u32x2 zz2 = {0u, 0u};
    const u32x4 g_l = *(const u32x4*)(pr + CLX + c0), g_r = *(const u32x4*)(pr + C_R + gc0), g_k = *(const u32x4*)(pr + C_K + gc0), g_v = *(const u32x4*)(pr + C_V + gc0);
    const u32x2 g_a = *(const u32x2*)(pr + CLX + 64 + 4 * sub);
    u32x4 p_l = zz4, p_r = zz4, p_k = zz4, p_v = zz4; u32x2 p_a = zz2;
    if (hasprev) { p_l = *(const u32x4*)(pp + CLX + c0); p_r = *(const u32x4*)(pp + C_R + gc0); p_k = *(const u32x4*)(pp + C_K + gc0); p_v = *(const u32x4*)(pp + C_V + gc0); p_a = *(const u32x2*)(pp + CLX + 64 + 4 * sub); }
    {
        const unsigned char* lwg = F.ws + WS_LW + (size_t)(pd * 8 + h) * 24576;
        { const int p = F.tid, r = p >> 3, cq = p & 7; *(LAS u32x4*)(LWH + r * 144 + cq * 16) = *(const u32x4*)(lwg + p * 16); *(LAS u32x4*)(LWL + r * 144 + cq * 16) = *(const u32x4*)(lwg + 8192 + p * 16); }
        { const int p = F.tid & 255, r = p >> 2, cq = p & 3; LAS unsigned char* dst = (F.tid < 256 ? LAH : LAL); *(LAS u32x4*)(dst + r * 80 + cq * 16) = *(const u32x4*)(lwg + 16384 + (F.tid < 256 ? 0 : 4096) + p * 16); }
    }
    {   float f[8], pv[8], th[8], tl[8]; unpack8(g_l, f); unpack8(p_l, pv);
#pragma unroll
        for (int e = 0; e < 8; ++e) { const float z = f[e] + (pv[e] - f[e]) * mu[1536 + c0 + e]; const float ez = __expf(-2.f * fabsf(z)); const float t0 = (1.f - ez) * __builtin_amdgcn_rcpf(1.f + ez); const float tv = z < 0.f ? -t0 : t0;
            th[e] = bflo(cvtpk(tv, 0.f)); tl[e] = tv - th[e]; }
        *(LAS u32x4*)(XWH + i * 144 + 2 * c0) = pack8(th); *(LAS u32x4*)(XWL + i * 144 + 2 * c0) = pack8(tl);
        const float fz[4] = {bflo(g_a.x), bfhi(g_a.x), bflo(g_a.y), bfhi(g_a.y)}, pz[4] = {bflo(p_a.x), bfhi(p_a.x), bflo(p_a.y), bfhi(p_a.y)}; float zh[4], zl[4];
#pragma unroll
        for (int e = 0; e < 4; ++e) { const float z = fz[e] + (pz[e] - fz[e]) * mu[1600 + 4 * sub + e]; zh[e] = bflo(cvtpk(z, 0.f)); zl[e] = z - zh[e]; }
        *(LAS u32x2*)(XAH + i * 80 + 8 * sub) = (u32x2){cvtpk(zh[0], zh[1]), cvtpk(zh[2], zh[3])}; *(LAS u32x2*)(XAL + i * 80 + 8 * sub) = (u32x2){cvtpk(zl[0], zl[1]), cvtpk(zl[2], zl[3])};
    }
    WG_BAR();
    {
        const int l31 = F.lane & 31, hh = F.lane >> 5, mt = (F.wave >> 1) & 1, nt = F.wave & 1;
        f32x16 d = zero16();
        if (F.wave < 4) {
#pragma unroll
            for (int q = 0; q < 4; ++q) { const bf16x8 ah = frag16(XWH, 32 * mt + l31, 16 * q + 8 * hh), al_ = frag16(XWL, 32 * mt + l31, 16 * q + 8 * hh), bh = frag16(LWH, 32 * nt + l31, 16 * q + 8 * hh), bl = frag16(LWL, 32 * nt + l31, 16 * q + 8 * hh);
                d = __builtin_amdgcn_mfma_f32_32x32x16_bf16(ah, bh, d, 0, 0, 0); d = __builtin_amdgcn_mfma_f32_32x32x16_bf16(ah, bl, d, 0, 0, 0); d = __builtin_amdgcn_mfma_f32_32x32x16_bf16(al_, bh, d, 0, 0, 0); }
#pragma unroll
            for (int r = 0; r < 16; ++r) OW[(32 * mt + MROW(r, hh)) * 68 + 32 * nt + l31] = d[r];
        } else {
#pragma unroll
            for (int q = 0; q < 2; ++q) { const int ko = (16 * q + 8 * hh) * 2;
                const bf16x8 ah = *(const LAS bf16x8*)(XAH + (32 * mt + l31) * 80 + ko), al_ = *(const LAS bf16x8*)(XAL + (32 * mt + l31) * 80 + ko), bh = *(const LAS bf16x8*)(LAH + (32 * nt + l31) * 80 + ko), bl = *(const LAS bf16x8*)(LAL + (32 * nt + l31) * 80 + ko);
                d = __builtin_amdgcn_mfma_f32_32x32x16_bf16(ah, bh, d, 0, 0, 0); d = __builtin_amdgcn_mfma_f32_32x32x16_bf16(ah, bl, d, 0, 0, 0); d = __builtin_amdgcn_mfma_f32_32x32x16_bf16(al_, bh, d, 0, 0, 0); }
#pragma unroll
            for (int r = 0; r < 16; ++r) OA[(32 * mt + MROW(r, hh)) * 68 + 32 * nt + l31] = d[r];
        }
    }
    WG_BAR();
    float wp[8], ap[8];
    { const f32x4 a = *(const LAS f32x4*)(OW + i * 68 + c0), bq = *(const LAS f32x4*)(OW + i * 68 + c0 + 4), cq = *(const LAS f32x4*)(OA + i * 68 + c0), dq = *(const LAS f32x4*)(OA + i * 68 + c0 + 4);
      const float ow[8] = {a.x, a.y, a.z, a.w, bq.x, bq.y, bq.z, bq.w}, oa[8] = {cq.x, cq.y, cq.z, cq.w, dq.x, dq.y, dq.z, dq.w};
#pragma unroll
      for (int e = 0; e < 8; ++e) { wp[e] = w0[gc0 + e] + ow[e]; ap[e] = a0[gc0 + e] + oa[e]; } }
    float lw[8], kk[8], al[8], km[8], rr[8], vv[8];
    {   float fr[8], fk[8], fv[8], qr[8], qk[8], qv[8]; unpack8(g_r, fr); unpack8(g_k, fk); unpack8(g_v, fv); unpack8(p_r, qr); unpack8(p_k, qk); unpack8(p_v, qv);
        float n2 = 0.f, bsum = 0.f;
#pragma unroll
        for (int e = 0; e < 8; ++e) { const int gc = gc0 + e;
            rr[e] = fr[e] + (qr[e] - fr[e]) * mu[gc]; const float kx = fk[e] + (qk[e] - fk[e]) * mu[512 + gc]; vv[e] = fv[e] + (qv[e] - fv[e]) * mu[1024 + gc];
            const float w = -softplus_f(-wp[e]) - 0.5f; lw[e] = -__expf(w);
            al[e] = __builtin_amdgcn_rcpf(1.f + __expf(-ap[e]));
            kk[e] = kx * k_k[gc]; n2 += kk[e] * kk[e];
            km[e] = kx * (1.f + (al[e] - 1.f) * k_a[gc]);
            bsum += rr[e] * km[e] * r_k[gc]; }
        n2 = red8(n2); bsum = red8(bsum);
        const float inv = __builtin_amdgcn_rsqf(fmaxf(n2, 1e-24f)); float bon[8];
#pragma unroll
        for (int e = 0; e < 8; ++e) { kk[e] *= inv; bon[e] = bsum * vv[e]; }
        *(u32x4*)(BON + (size_t)row * 512 + gc0) = pack8(bon);
    }
    *(LAS f32x4*)(CLS + i * 64 + c0) = (f32x4){lw[0], lw[1], lw[2], lw[3]}; *(LAS f32x4*)(CLS + i * 64 + c0 + 4) = (f32x4){lw[4], lw[5], lw[6], lw[7]};
    WG_BAR();
    if (F.tid < 64) {
        float x[64];
#pragma unroll
        for (int q = 0; q < 64; ++q) x[q] = CLS[q * 64 + F.tid];
#pragma unroll
        for (int q = 1; q < 64; ++q) x[q] += x[q - 1];
#pragma unroll
        for (int q = 0; q < 64; ++q) CLS[q * 64 + F.tid] = x[q];
    }
    WG_BAR();
    {   float cl[8], cL[8];
        { const f32x4 a = *(const LAS f32x4*)(CLS + i * 64 + c0), bq = *(const LAS f32x4*)(CLS + i * 64 + c0 + 4), cc = *(const LAS f32x4*)(CLS + 63 * 64 + c0), dd = *(const LAS f32x4*)(CLS + 63 * 64 + c0 + 4);
          cl[0] = a.x; cl[1] = a.y; cl[2] = a.z; cl[3] = a.w; cl[4] = bq.x; cl[5] = bq.y; cl[6] = bq.z; cl[7] = bq.w; cL[0] = cc.x; cL[1] = cc.y; cL[2] = cc.z; cL[3] = cc.w; cL[4] = dd.x; cL[5] = dd.y; cL[6] = dd.z; cL[7] = dd.w; }
        float tA[8], tB[8], tK[8], tR[8], tBt[8], tKt[8];
#pragma unroll
        for (int e = 0; e < 8; ++e) { const float eA = __expf(cl[e] - lw[e]), eI = __expf(-cl[e]), eR = __expf(cl[e]), eT = __expf(cL[e] - cl[e]); const float ba = kk[e] * al[e];
            tA[e] = -kk[e] * eA; tB[e] = ba * eI; tK[e] = km[e] * eI; tR[e] = rr[e] * eR; tBt[e] = ba * eT; tKt[e] = km[e] * eT; }
        *(LAS u32x4*)(TA + i * 144 + 2 * c0) = pack8(tA); *(LAS u32x4*)(TB + i * 144 + 2 * c0) = pack8(tB); *(LAS u32x4*)(TK + i * 144 + 2 * c0) = pack8(tK); *(LAS u32x4*)(TR + i * 144 + 2 * c0) = pack8(tR);
        const u32x4 qa = pack8(tA), qb = pack8(tBt), qk = pack8(tKt), qv = pack8(vv);
        const unsigned wa[4] = {qa.x, qa.y, qa.z, qa.w}, wb[4] = {qb.x, qb.y, qb.z, qb.w}, wk[4] = {qk.x, qk.y, qk.z, qk.w}, wv[4] = {qv.x, qv.y, qv.z, qv.w};
#pragma unroll
        for (int e = 0; e < 8; ++e) { const int sh = (e & 1) * 16; const int o = (c0 + e) * 144 + 2 * i;
            *(LAS unsigned short*)(TAT + o) = (unsigned short)(wa[e >> 1] >> sh); *(LAS unsigned short*)(TBT + o) = (unsigned short)(wb[e >> 1] >> sh);
            *(LAS unsigned short*)(TKT + o) = (unsigned short)(wk[e >> 1] >> sh); *(LAS unsigned short*)(TVT + o) = (unsigned short)(wv[e >> 1] >> sh); }
    }
    WG_BAR();
    const int l31 = F.lane & 31, hh = F.lane >> 5;
    if (F.wave < 3) { const int it = F.wave > 0, jt = F.wave > 1; const f32x16 d = tile_prod(TA, 32 * it, TB, 32 * jt, l31, hh);
#pragma unroll
        for (int r = 0; r < 16; ++r) { const int ii = 32 * it + MROW(r, hh), j = 32 * jt + l31; AAB[ii * 68 + (j & 7) * 8 + (j >> 3)] = j < ii ? d[r] : 0.f; } }
    else if (F.wave == 3) {
#pragma unroll
        for (int r = 0; r < 16; ++r) AAB[(2 * r + hh) * 68 + (l31 & 7) * 8 + 4 + (l31 >> 3)] = 0.f; }
    else if (F.wave == 4) {
#pragma unroll
        for (int f = 0; f < 8; ++f) { const int it = f >> 2, kt = (f >> 1) & 1, s = f & 1; *(bf16x8*)(rec + CK_RF + (f * 64 + F.lane) * 16) = fragP(TR, 32 * it + l31, 32 * kt + 16 * s, hh); } }
    else if (F.wave == 5) {
#pragma unroll
        for (int f = 0; f < 8; ++f) { const int kt = f >> 2, jt = (f >> 1) & 1, s = f & 1; *(bf16x8*)(rec + CK_BTF + (f * 64 + F.lane) * 16) = fragP(TBT, 32 * kt + l31, 32 * jt + 16 * s, hh); } }
    else if (F.wave == 6) {
#pragma unroll
        for (int f = 0; f < 8; ++f) { const int vt = f >> 2, jt = (f >> 1) & 1, s = f & 1; *(bf16x8*)(rec + CK_VF + (f * 64 + F.lane) * 16) = fragP(TVT, 32 * vt + l31, 32 * jt + 16 * s, hh); } }
    else { *(float*)(rec + CK_CLV + 4 * F.lane) = __expf(CLS[63 * 64 + F.lane]); }
    WG_BAR();
    {   const int col = F.tid >> 3; int dg = col; float town[8];
#pragma unroll
        for (int q = 0; q < 8; ++q) town[q] = 0.f;
        const LAS float* arow = AAB + sub * 8; asm volatile("" : "+v"(arow));
        LAS unsigned char* ttw = TT + 2 * col; asm volatile("" : "+v"(ttw));
#pragma unroll
        for (int q = 0; q < 8; ++q)
#pragma unroll
            for (int r = 0; r < 8; ++r) { const int ii = 8 * q + r;
                const f32x4 a0 = *(const LAS f32x4*)(arow + ii * 68), a1 = *(const LAS f32x4*)(arow + ii * 68 + 4);
                float p = a0.x * town[0];
                if (q >= 1) p += a0.y * town[1]; if (q >= 2) p += a0.z * town[2]; if (q >= 3) p += a0.w * town[3];
                if (q >= 4) p += a1.x * town[4]; if (q >= 5) p += a1.y * town[5]; if (q >= 6) p += a1.z * town[6]; if (q >= 7) p += a1.w * town[7];
                p = red8(p);
                const float tv = p + ((dg == 0) ? 1.f : 0.f); dg -= 1; asm volatile("" : "+v"(dg));
                town[q] = (sub == r) ? tv : town[q];
            }
#pragma unroll
        for (int q = 0; q < 8; ++q) *(LAS unsigned short*)(ttw + (8 * q + sub) * 144) = (unsigned short)cvtpk(town[q], 0.f);
    }
    f32x16 X0 = zero16(), X1 = zero16();
    if (F.wave == 0) {
    } else if (F.wave <= 2) {
        const int vt = F.wave - 1;
        f32x16 a00 = tile_prod(TK, 0, TA, 0, l31, hh), a11 = tile_prod(TK, 32, TA, 32, l31, hh); const f32x16 a01 = tile_prod(TK, 0, TA, 32, l31, hh);
#pragma unroll
        for (int r = 0; r < 16; ++r) { const bool keep = MROW(r, hh) < l31; a00[r] = keep ? a00[r] : 0.f; a11[r] = keep ? a11[r] : 0.f; }
        X0 = __builtin_amdgcn_mfma_f32_32x32x16_bf16(pk8<0>(a00), fragP(TVT, 32 * vt + l31, 0, hh), X0, 0, 0, 0);
        X0 = __builtin_amdgcn_mfma_f32_32x32x16_bf16(pk8<8>(a00), fragP(TVT, 32 * vt + l31, 16, hh), X0, 0, 0, 0);
        X1 = __builtin_amdgcn_mfma_f32_32x32x16_bf16(pk8<0>(a01), fragP(TVT, 32 * vt + l31, 0, hh), X1, 0, 0, 0);
        X1 = __builtin_amdgcn_mfma_f32_32x32x16_bf16(pk8<8>(a01), fragP(TVT, 32 * vt + l31, 16, hh), X1, 0, 0, 0);
        X1 = __builtin_amdgcn_mfma_f32_32x32x16_bf16(pk8<0>(a11), fragP(TVT, 32 * vt + l31, 32, hh), X1, 0, 0, 0);
        X1 = __builtin_amdgcn_mfma_f32_32x32x16_bf16(pk8<8>(a11), fragP(TVT, 32 * vt + l31, 48, hh), X1, 0, 0, 0);
    } else if (F.wave <= 4) {
        const LAS unsigned char* Tm = F.wave == 3 ? TB : TK; unsigned char* dst = rec + (F.wave == 3 ? CK_ARBF : CK_ARKF);
#pragma unroll
        for (int blk = 0; blk < 3; ++blk) { const int it = blk > 0, jt = blk > 1; f32x16 d = tile_prod(Tm, 32 * jt, TR, 32 * it, l31, hh);
            if (it == jt) {
#pragma unroll
                for (int r = 0; r < 16; ++r) d[r] = MROW(r, hh) <= l31 ? d[r] : 0.f; }
            *(bf16x8*)(dst + ((blk * 2 + 0) * 64 + F.lane) * 16) = pk8<0>(d); *(bf16x8*)(dst + ((blk * 2 + 1) * 64 + F.lane) * 16) = pk8<8>(d); }
    } else if (F.wave <= 6) {
        const int kt = F.wave - 5;
#pragma unroll
        for (int vt = 0; vt < 2; ++vt) { const f32x16 d = tile_prod(TKT, 32 * kt, TVT, 32 * vt, l31, hh); st_acc32(rec + CK_GA + ((kt * 2 + vt) * 64 + F.lane) * 32, d); }
    }
    WG_BAR();
    if (F.wave == 1 || F.wave == 2) { const int vt = F.wave - 1;
        f32x16 w0a = zero16(), w1a = zero16();
        w0a = __builtin_amdgcn_mfma_f32_32x32x16_bf16(fragP(TT, l31, 0, hh), pk8<0>(X0), w0a, 0, 0, 0);
        w0a = __builtin_amdgcn_mfma_f32_32x32x16_bf16(fragP(TT, l31, 16, hh), pk8<8>(X0), w0a, 0, 0, 0);
        w1a = __builtin_amdgcn_mfma_f32_32x32x16_bf16(fragP(TT, 32 + l31, 0, hh), pk8<0>(X0), w1a, 0, 0, 0);
        w1a = __builtin_amdgcn_mfma_f32_32x32x16_bf16(fragP(TT, 32 + l31, 16, hh), pk8<8>(X0), w1a, 0, 0, 0);
        w1a = __builtin_amdgcn_mfma_f32_32x32x16_bf16(fragP(TT, 32 + l31, 32, hh), pk8<0>(X1), w1a, 0, 0, 0);
        w1a = __builtin_amdgcn_mfma_f32_32x32x16_bf16(fragP(TT, 32 + l31, 48, hh), pk8<8>(X1), w1a, 0, 0, 0);
        st_acc32(rec + CK_W2A + ((0 * 2 + vt) * 64 + F.lane) * 32, w0a); st_acc32(rec + CK_W2A + ((1 * 2 + vt) * 64 + F.lane) * 32, w1a);
    } else if (F.wave >= 3 && F.wave <= 6) { const int kt = (F.wave - 3) >> 1, it = (F.wave - 3) & 1;
        const f32x16 d = tile_prod(TAT, 32 * kt, TT, 32 * it, l31, hh);
        *(bf16x8*)(rec + CK_W1F + ((((it * 2 + kt) * 2) + 0) * 64 + F.lane) * 16) = pk8<0>(d); *(bf16x8*)(rec + CK_W1F + ((((it * 2 + kt) * 2) + 1) * 64 + F.lane) * 16) = pk8<8>(d);
    }
    WG_BAR();
}

#ifdef TS_R2
#define R2BAR() do { const unsigned long long t0_ = __builtin_amdgcn_s_memrealtime(); WG_BAR(); r2wait += __builtin_amdgcn_s_memrealtime() - t0_; } while (0)
#else
#define R2BAR() WG_BAR()
#endif
template <int NC> __device__ __forceinline__ void rwkv2_role(Ctx& F, int cb) {
    unsigned long long r2wait = 0;
    const int scan = F.bx, dir = scan >> 4, b = (scan >> 3) & 1, h = scan & 7;
    const unsigned char* recs = F.ws + WS_CHK + ((size_t)scan * NCHUNK + cb) * CHKB;
    static_assert(NC % 2 == 0, "the Y waves alternate two register sets");
    float* Y = (float*)(F.ws + WS_Y) + (size_t)dir * MT * 512 + h * 64;
    const int l31 = F.lane & 31, hh = F.lane >> 5;
    constexpr int RSL = 33792, R_W1F = 0, R_BTF = 8192, R_W2A = 16384, R_GA = 24576, R_CLV = 32768;
    constexpr int EXO = 3 * RSL;
#define FR(off, idx) (*(const LAS bf16x8*)(lf + (off) + (idx) * 1024))
#define MM(a_, b_, c_) c_ = __builtin_amdgcn_mfma_f32_32x32x16_bf16(a_, b_, c_, 0, 0, 0)
    if (F.wave < 2) {
        const int vt = F.wave;
        f32x16 S0 = zero16(), S1 = zero16();
        float* sst = (float*)(F.ws + WS_SST) + ((size_t)(scan * 2 + vt) * 2 * 64 + F.lane) * 16;
        if (cb > 0) {
#pragma unroll
            for (int g = 0; g < 4; ++g) { const f32x4 a_ = *(const f32x4*)(sst + 4 * g), b_ = *(const f32x4*)(sst + 1024 + 4 * g);
#pragma unroll
                for (int e = 0; e < 4; ++e) { S0[4 * g + e] = a_[e]; S1[4 * g + e] = b_[e]; } } }
        R2BAR();
        for (int c = 0; c <= NC; ++c) {
            if (c < NC) {
                const LAS unsigned char* buf = F.lds + (c % 3) * RSL; const LAS unsigned char* lf = buf + F.lane * 16;
                LAS unsigned char* ex = F.lds + EXO + (c & 1) * 16384 + vt * 8192 + F.lane * 16;
                const bf16x8 sb00 = pk8<0>(S0), sb01 = pk8<8>(S0), sb10 = pk8<0>(S1), sb11 = pk8<8>(S1);
                *(LAS bf16x8*)(ex) = sb00; *(LAS bf16x8*)(ex + 1024) = sb01; *(LAS bf16x8*)(ex + 2048) = sb10; *(LAS bf16x8*)(ex + 3072) = sb11;
                f32x16 U0 = ld_acc32(buf + R_W2A + ((0 * 2 + vt) * 64 + F.lane) * 32), U1 = ld_acc32(buf + R_W2A + ((1 * 2 + vt) * 64 + F.lane) * 32);
                MM(FR(R_W1F, 0), sb00, U0); MM(FR(R_W1F, 4), sb00, U1); MM(FR(R_W1F, 1), sb01, U0); MM(FR(R_W1F, 5), sb01, U1);
                MM(FR(R_W1F, 2), sb10, U0); MM(FR(R_W1F, 6), sb10, U1); MM(FR(R_W1F, 3), sb11, U0); MM(FR(R_W1F, 7), sb11, U1);
                { const LAS float* clv = (const LAS float*)(buf + R_CLV);
                  const f32x16 g0 = ld_acc32(buf + R_GA + ((0 * 2 + vt) * 64 + F.lane) * 32), g1 = ld_acc32(buf + R_GA + ((1 * 2 + vt) * 64 + F.lane) * 32);
#pragma unroll
                  for (int g = 0; g < 4; ++g) { const f32x4 ca = *(const LAS f32x4*)(clv + 8 * g + 4 * hh), cb = *(const LAS f32x4*)(clv + 32 + 8 * g + 4 * hh);
#pragma unroll
                      for (int e = 0; e < 4; ++e) { S0[4 * g + e] = S0[4 * g + e] * ca[e] + g0[4 * g + e]; S1[4 * g + e] = S1[4 * g + e] * cb[e] + g1[4 * g + e]; } } }
                const bf16x8 ub00 = pk8<0>(U0), ub01 = pk8<8>(U0), ub10 = pk8<0>(U1), ub11 = pk8<8>(U1);
                *(LAS bf16x8*)(ex + 4096) = ub00; *(LAS bf16x8*)(ex + 5120) = ub01; *(LAS bf16x8*)(ex + 6144) = ub10; *(LAS bf16x8*)(ex + 7168) = ub11;
                MM(FR(R_BTF, 0), ub00, S0); MM(FR(R_BTF, 4), ub00, S1); MM(FR(R_BTF, 1), ub01, S0); MM(FR(R_BTF, 5), ub01, S1);
                MM(FR(R_BTF, 2), ub10, S0); MM(FR(R_BTF, 6), ub10, S1); MM(FR(R_BTF, 3), ub11, S0); MM(FR(R_BTF, 7), ub11, S1);
            }
            R2BAR();
        }
        if (cb + NC < NCHUNK) {
#pragma unroll
            for (int g = 0; g < 4; ++g) { *(f32x4*)(sst + 4 * g) = (f32x4){S0[4 * g], S0[4 * g + 1], S0[4 * g + 2], S0[4 * g + 3]}; *(f32x4*)(sst + 1024 + 4 * g) = (f32x4){S1[4 * g], S1[4 * g + 1], S1[4 * g + 2], S1[4 * g + 3]}; } }
    } else if (F.wave < 6) {
        const int w = F.wave - 2, vt = w & 1, it = w >> 1;
        const long ystep = dir ? -512 : 512;
        bf16x8 fa[16], fb[16];
        const int o_rf = CK_RF + it * 4096, o_ark = CK_ARKF + it * 2048, o_arb = CK_ARBF + it * 2048, o_vf = CK_VF + vt * 4096;
#define YLD(f, c_) do { const unsigned char* g_ = recs + (size_t)(c_) * CHKB + F.lane * 16; \
            _Pragma("unroll") for (int k = 0; k < 4; ++k) { f[k] = *(const bf16x8*)(g_ + o_rf + k * 1024); f[4 + k] = *(const bf16x8*)(g_ + o_ark + k * 1024); f[8 + k] = *(const bf16x8*)(g_ + o_arb + k * 1024); f[12 + k] = *(const bf16x8*)(g_ + o_vf + k * 1024); } } while (0)
#define YDO(f, cm1) do { const LAS unsigned char* ex = F.lds + EXO + ((cm1) & 1) * 16384 + vt * 8192 + F.lane * 16; \
            const bf16x8 sb00 = *(const LAS bf16x8*)(ex), sb01 = *(const LAS bf16x8*)(ex + 1024), sb10 = *(const LAS bf16x8*)(ex + 2048), sb11 = *(const LAS bf16x8*)(ex + 3072); \
            const bf16x8 ub00 = *(const LAS bf16x8*)(ex + 4096), ub01 = *(const LAS bf16x8*)(ex + 5120), ub10 = *(const LAS bf16x8*)(ex + 6144), ub11 = *(const LAS bf16x8*)(ex + 7168); \
            f32x16 Yt = zero16(); \
            MM(f[0], sb00, Yt); MM(f[1], sb01, Yt); MM(f[2], sb10, Yt); MM(f[3], sb11, Yt); \
            MM(f[4], f[12], Yt); MM(f[5], f[13], Yt); MM(f[8], ub00, Yt); MM(f[9], ub01, Yt); \
            if (it) { MM(f[6], f[14], Yt); MM(f[7], f[15], Yt); MM(f[10], ub10, Yt); MM(f[11], ub11, Yt); } \
            float* yp = Y + (size_t)scan_row(cb + (cm1), 32 * it + 4 * hh, dir, b) * 512 + 32 * vt + l31; \
            _Pragma("unroll") for (int g = 0; g < 4; ++g) { float* yg = yp + 8 * g * ystep; \
                _Pragma("unroll") for (int e = 0; e < 4; ++e) yg[e * ystep] = Yt[4 * g + e]; } } while (0)
        YLD(fa, 0); YLD(fb, 1);
        R2BAR();
        R2BAR();
        for (int c = 1; c <= NC; c += 2) {
            YDO(fa, c - 1); YLD(fa, (c + 1 < NC ? c + 1 : NC - 1));
            R2BAR();
            YDO(fb, c); YLD(fb, (c + 2 < NC ? c + 2 : NC - 1));
            R2BAR();
        }
#undef YLD
#undef YDO
    } else {
        int gsrc[17], ldst[17];
#pragma unroll
        for (int k = 0; k < 17; ++k) { int q = F.wave - 6 + 2 * k; q = q < 32 ? q : 32; const int rp = q < 8 ? q : (q < 16 ? q + 8 : q + 28); gsrc[k] = rp * 1024 + F.lane * 16; ldst[k] = q * 1024; }
#define R2_DMA(c_) do { const int cc_ = (c_) < NC ? (c_) : NC - 1; const int sl_ = ((c_) % 3) * RSL; _Pragma("unroll") for (int k = 0; k < 17; ++k) \
            __builtin_amdgcn_global_load_lds((const unsigned*)(recs + (size_t)cc_ * CHKB + gsrc[k]), (LAS unsigned*)(F.lds + sl_ + ldst[k]), 16, 0, 0); } while (0)
        R2_DMA(0); R2_DMA(1);
        asm volatile("s_waitcnt vmcnt(17)" ::: "memory");
        R2BAR();
        for (int c = 0; c <= NC; ++c) {
            R2_DMA(c + 2);
            asm volatile("s_waitcnt vmcnt(17)" ::: "memory");
            R2BAR();
        }
        asm volatile("s_waitcnt vmcnt(0)" ::: "memory");
#define R2_LD(a, b)
#define R2_WR(a, b)
#undef R2_LD
#undef R2_WR
    }
#undef FR
#undef MM
#ifdef TS_R2
    if (F.lane == 0 && F.bx == 0) ((unsigned*)(F.ws + WS_CTL))[2048 + F.wave] += (unsigned)r2wait;
#endif
}

#ifndef R_SGU
#define R_SGU 1
#endif
#ifndef R_R1
#define R_R1 1
#endif
#ifndef R_R2
#define R_R2 1
#endif
#ifndef R_AP
#define R_AP 1
#endif
#ifndef R_CV
#define R_CV 1
#endif
constexpr int NCH1 = 34, NCH2 = NCHUNK - NCH1;
__device__ __forceinline__ void phase3a(Ctx& F, int l) {
    for (int q = F.bx; q < 32 * NCH1; q += F.G) rwkv1_item(F, l, (q / NCH1) * NCHUNK + q % NCH1);
}
__device__ __forceinline__ void phase3b1(Ctx& F, int l) {
    if (F.bx < 32) { rwkv2_role<NCH1>(F, 0); return; }
    for (int q = F.bx - 32; q < 32 * NCH2; q += F.G - 32) rwkv1_item(F, l, (q / NCH2) * NCHUNK + NCH1 + q % NCH2);
}
__device__ __forceinline__ void phase3b(Ctx& F, int l) {
    if (F.bx < 32) { rwkv2_role<NCH2>(F, NCH1); return; }
    const int nsgu = (l == 0 ? 68 : 64) * 4, nap = 136 * 4, ncv = (l == 0 ? MT : ML) / 16;
    const int total = nsgu + nap + ncv;
    for (int it = F.bx - 32; it < total; it += F.G - 32) {
        int r = it;
        if (r < nsgu) { for (int q_ = 0; q_ < R_SGU; ++q_) sgu_item(F, l, r >> 2, r & 3); continue; } r -= nsgu;
        if (r < nap) { for (int q_ = 0; q_ < R_AP; ++q_) attnprep_item(F, l, r >> 2, r & 3); continue; } r -= nap;
        for (int q_ = 0; q_ < R_CV; ++q_) conv_item(F, l, r);
    }
}

__device__ __forceinline__ void attn_unit(Ctx& F, const bf16* Qp, const bf16* Kp, const bf16* Vtp, int nkt, float* Op) {
    constexpr int KB = 9216, VB = 18432, VOFF = 2 * KB;
    const int j = F.lane & 31, hh = F.lane >> 5;
    bf16x8 qf[4];
#pragma unroll
    for (int ks = 0; ks < 4; ++ks) qf[ks] = *(const bf16x8*)(Qp + (size_t)(F.wave * 32 + j) * 64 + ks * 16 + hh * 8);
    const int kkey = F.tid >> 3, kch = F.tid & 7;
    const bf16* ksrc = Kp + (size_t)kkey * 64 + kch * 8;
    const bf16* vsrc0 = Vtp + (size_t)kkey * KEYS + kch * 8; const bf16* vsrc1 = vsrc0 + (size_t)64 * KEYS;
    const int kdst = kkey * 144 + kch * 16, vdst0 = VOFF + kkey * 144 + kch * 16, vdst1 = vdst0 + 64 * 144;
    u32x4 rk, rv0, rv1;
    rk = *(const u32x4*)ksrc; rv0 = *(const u32x4*)vsrc0; rv1 = *(const u32x4*)vsrc1;
    *(LAS u32x4*)(F.lds + kdst) = rk; *(LAS u32x4*)(F.lds + vdst0) = rv0; *(LAS u32x4*)(F.lds + vdst1) = rv1;
    WG_BAR();
    const int sw = (j & ~12) | ((j & 4) << 1) | ((j & 8) >> 1);
    const int ka0 = sw * 144 + hh * 16, ka1 = (32 + sw) * 144 + hh * 16, va = VOFF + j * 144 + hh * 16;
    f32x16 acc[4];
#pragma unroll
    for (int i = 0; i < 4; ++i) acc[i] = zero16();
    f32x16 negm = zero16();
    float m_run = 0.f, l_run = 0.f;
    bf16x8 pf[4];
#pragma unroll
    for (int i = 0; i < 4; ++i) pf[i] = (bf16x8){0, 0, 0, 0, 0, 0, 0, 0};
    int vprev = 0, vcur = 0, vnext = VB;
    for (int kt = 0; kt <= nkt; ++kt) {
        const bool hasq = kt < nkt, hasn = kt + 1 < nkt;
        if (hasn) { rk = *(const u32x4*)(ksrc + (size_t)(kt + 1) * 64 * 64); rv0 = *(const u32x4*)(vsrc0 + (kt + 1) * 64); rv1 = *(const u32x4*)(vsrc1 + (kt + 1) * 64); }
        f32x16 s0 = negm, s1 = negm;
        if (hasq) { const LAS unsigned char* kb = F.lds + (kt & 1) * KB;
#pragma unroll
            for (int ks = 0; ks < 4; ++ks) {
                const bf16x8 a0 = *(const LAS bf16x8*)(kb + ka0 + ks * 32), a1 = *(const LAS bf16x8*)(kb + ka1 + ks * 32);
                s0 = __builtin_amdgcn_mfma_f32_32x32x16_bf16(a0, qf[ks], s0, 0, 0, 0);
                s1 = __builtin_amdgcn_mfma_f32_32x32x16_bf16(a1, qf[ks], s1, 0, 0, 0);
            } }
        if (kt > 0) { const LAS unsigned char* vb = F.lds + vprev;
#pragma unroll
            for (int blk = 0; blk < 4; ++blk)
#pragma unroll
                for (int kstep = 0; kstep < 4; ++kstep) {
                    const bf16x8 a = *(const LAS bf16x8*)(vb + va + blk * 32 * 144 + kstep * 32);
                    acc[blk] = __builtin_amdgcn_mfma_f32_32x32x16_bf16(a, pf[kstep], acc[blk], 0, 0, 0);
                } }
        if (hasq) {
            float mx = fmaxf(s0[0], s1[0]);
#pragma unroll
            for (int r = 1; r < 16; ++r) mx = fmaxf(mx, fmaxf(s0[r], s1[r]));
            { const auto rr = __builtin_amdgcn_permlane32_swap(__builtin_bit_cast(unsigned, mx), __builtin_bit_cast(unsigned, mx), false, false);
              mx = fmaxf(__builtin_bit_cast(float, rr[0]), __builtin_bit_cast(float, rr[1])); }
            if (__any(mx > 8.f)) {
                const float dl = fmaxf(mx, 0.f), f = __builtin_amdgcn_exp2f(-dl);
                m_run += dl; l_run *= f;
#pragma unroll
                for (int r = 0; r < 16; ++r) { s0[r] -= dl; s1[r] -= dl; negm[r] = -m_run; }
#pragma unroll
                for (int i = 0; i < 4; ++i)
#pragma unroll
                    for (int r = 0; r < 16; ++r) acc[i][r] *= f;
            }
            float ls = 0.f;
#pragma unroll
            for (int r = 0; r < 16; ++r) { s0[r] = __builtin_amdgcn_exp2f(s0[r]); s1[r] = __builtin_amdgcn_exp2f(s1[r]); ls += s0[r] + s1[r]; }
            l_run += ls;
            u32x4 w;
            w.x = cvtpk(s0[0], s0[1]); w.y = cvtpk(s0[2], s0[3]); w.z = cvtpk(s0[4], s0[5]); w.w = cvtpk(s0[6], s0[7]); pf[0] = __builtin_bit_cast(bf16x8, w);
            w.x = cvtpk(s0[8], s0[9]); w.y = cvtpk(s0[10], s0[11]); w.z = cvtpk(s0[12], s0[13]); w.w = cvtpk(s0[14], s0[15]); pf[1] = __builtin_bit_cast(bf16x8, w);
            w.x = cvtpk(s1[0], s1[1]); w.y = cvtpk(s1[2], s1[3]); w.z = cvtpk(s1[4], s1[5]); w.w = cvtpk(s1[6], s1[7]); pf[2] = __builtin_bit_cast(bf16x8, w);
            w.x = cvtpk(s1[8], s1[9]); w.y = cvtpk(s1[10], s1[11]); w.z = cvtpk(s1[12], s1[13]); w.w = cvtpk(s1[14], s1[15]); pf[3] = __builtin_bit_cast(bf16x8, w);
        }
        if (hasn) { LAS unsigned char* nk = F.lds + ((kt + 1) & 1) * KB; *(LAS u32x4*)(nk + kdst) = rk; *(LAS u32x4*)(F.lds + vnext + vdst0) = rv0; *(LAS u32x4*)(F.lds + vnext + vdst1) = rv1; }
        vprev = vcur; vcur = vnext; vnext = (vnext == 2 * VB) ? 0 : vnext + VB;
        WG_BAR();
    }
    const float inv = 1.f / (l_run + __shfl_xor(l_run, 32));
    float* orow = Op + (size_t)(F.wave * 32 + j) * 1024 + 4 * hh;
#pragma unroll
    for (int blk = 0; blk < 4; ++blk)
#pragma unroll
        for (int g = 0; g < 4; ++g) *(f32x4*)(orow + 32 * blk + 8 * g) = (f32x4){acc[blk][4 * g] * inv, acc[blk][4 * g + 1] * inv, acc[blk][4 * g + 2] * inv, acc[blk][4 * g + 3] * inv};
}

__device__ __forceinline__ void attn_role(Ctx& F, int l) {
    const int bh = F.bx & 7, m = (F.bx >> 3) & 1, k = F.bx >> 4, b = bh >> 2, h = bh & 3;
    const bf16* QR = (const bf16*)(F.ws + WS_QR); const bf16* QC = (const bf16*)(F.ws + WS_QC); const bf16* KR = (const bf16*)(F.ws + WS_KR); const bf16* VT = (const bf16*)(F.ws + WS_VT);
    float* OATT = (float*)(F.ws + WS_XN);
    const bf16* Vtp = VT + (size_t)bh * 128 * KEYS;
    { const int bhm = bh * 2 + m;
      attn_unit(F, QR + ((size_t)bhm * TL + k * 256) * 64, KR + (size_t)bhm * KEYS * 64, Vtp, KEYS / 64, OATT + (size_t)(b * TL + k * 256) * 1024 + (h * 2 + m) * 128); }
    if (l == 0 && F.bx < 16) {
        const int mc = F.bx >> 3, bhm = bh * 2 + mc;
        attn_unit(F, QC + (size_t)bhm * CL * 64, KR + (size_t)bhm * KEYS * 64, Vtp, CL / 64, OATT + (size_t)(ML + b * CL) * 1024 + (h * 2 + mc) * 128);
    }
}

__device__ __forceinline__ void phase4(Ctx& F, int l) {
    const bf16* P = (const bf16*)(F.ws + WS_P); bf16* OC = (bf16*)(F.ws + WS_OC); const float* OATT = (const float*)(F.ws + WS_XN);
    const float* Yf = (const float*)(F.ws + WS_Y); const float* Yb = Yf + (size_t)MT * 512; const bf16* BON = (const bf16*)(F.ws + WS_BON);
    const float lam_init = 0.8f - 0.6f * expf(-0.3f * (float)l);
    const float d1 = wave_sum(F.prm->in[12][l * 64 + F.lane] * F.prm->in[13][l * 64 + F.lane]), d2 = wave_sum(F.prm->in[14][l * 64 + F.lane] * F.prm->in[15][l * 64 + F.lane]);
    const float lam = expf(d1) - expf(d2) + lam_init;
    const float* subg = F.prm->in[16] + l * 128; const float* ln_w = F.prm->in[25] + l * 512; const float* ln_b = F.prm->in[26] + l * 512;
    const int nrows = l == 0 ? MT : ML;
    for (int row = F.gw; row < nrows; row += F.NGW) {
        {
            const int h = F.lane >> 4, dv0 = (F.lane & 15) * 8; const float* o1 = OATT + (size_t)row * 1024 + h * 256 + dv0; const float* o2 = o1 + 128;
            float o[8]; const f32x4 a0 = *(const f32x4*)o1, a1 = *(const f32x4*)(o1 + 4), b0 = *(const f32x4*)o2, b1 = *(const f32x4*)(o2 + 4);
            o[0] = a0.x - lam * b0.x; o[1] = a0.y - lam * b0.y; o[2] = a0.z - lam * b0.z; o[3] = a0.w - lam * b0.w; o[4] = a1.x - lam * b1.x; o[5] = a1.y - lam * b1.y; o[6] = a1.z - lam * b1.z; o[7] = a1.w - lam * b1.w;
            float ss = 0.f;
#pragma unroll
            for (int e = 0; e < 8; ++e) ss += o[e] * o[e];
            const float rs = (1.f - lam_init) / sqrtf(red16(ss) * (1.f / 128.f) + EPS);
            float gg[8]; unpack8(*(const u32x4*)(P + (size_t)row * NINP + B_G + h * 128 + dv0), gg);
#pragma unroll
            for (int e = 0; e < 8; ++e) o[e] = o[e] * rs * subg[dv0 + e] * silu_f(gg[e]);
            *(u32x4*)(OC + (size_t)row * DM + 512 + h * 128 + dv0) = pack8(o);
        }
        {
            const int c0 = F.lane * 8; const float* yf = Yf + (size_t)row * 512 + c0; const float* yb = Yb + (size_t)row * 512 + c0; const bf16* bo = BON + (size_t)row * 512 + c0;
            float y[8]; const f32x4 a0 = *(const f32x4*)yf, a1 = *(const f32x4*)(yf + 4), b0 = *(const f32x4*)yb, b1 = *(const f32x4*)(yb + 4);
            y[0] = a0.x + b0.x; y[1] = a0.y + b0.y; y[2] = a0.z + b0.z; y[3] = a0.w + b0.w; y[4] = a1.x + b1.x; y[5] = a1.y + b1.y; y[6] = a1.z + b1.z; y[7] = a1.w + b1.w;
            float s = 0.f;
#pragma unroll
            for (int e = 0; e < 8; ++e) s += y[e];
            const float mean = red8(s) * (1.f / 64.f); float q = 0.f;
#pragma unroll
            for (int e = 0; e < 8; ++e) { y[e] -= mean; q += y[e] * y[e]; }
            const float rstd = 1.f / sqrtf(red8(q) * (1.f / 64.f) + GN_EPS);
            float gg[8]; unpack8(*(const u32x4*)(P + (size_t)row * NINP + C_G + c0), gg);
            float bn[8], bn2[8]; unpack8(*(const u32x4*)bo, bn); unpack8(*(const u32x4*)(bo + (size_t)MT * 512), bn2);
#pragma unroll
            for (int e = 0; e < 8; ++e) bn[e] += bn2[e];
#pragma unroll
            for (int e = 0; e < 8; ++e) y[e] = (y[e] * rstd * ln_w[c0 + e] + ln_b[c0 + e] + bn[e]) * silu_f(gg[e]);
            *(u32x4*)(OC + (size_t)row * DM + 1024 + c0) = pack8(y);
        }
    }
}

#define XB_TMO      128
#define XB_XCNT(j)  (256  + 64 * (j))
#define XB_XSUB(j)  (1280 + 64 * (j))
#define XB_XGEN(j)  (2304 + 64 * (j))
#define XB_TOP      3328
#define XB_TOPGEN   3392
#define XCD_BAR_WORDS 3456
#define XB_SPIN_CAP (1u << 18)

__device__ __forceinline__ unsigned xb_ld(unsigned* p)              { return __hip_atomic_load(p, __ATOMIC_RELAXED, __HIP_MEMORY_SCOPE_AGENT); }
__device__ __forceinline__ unsigned xb_add(unsigned* p, unsigned v) { return __hip_atomic_fetch_add(p, v, __ATOMIC_RELAXED, __HIP_MEMORY_SCOPE_AGENT); }
__device__ __forceinline__ unsigned xb_xcc_id() { return (unsigned)__builtin_amdgcn_s_getreg((3 << 11) | 20) & 0xFu; }
#define XB_SPIN(cond, bar) do { unsigned _sp = 0; while (cond) { __builtin_amdgcn_s_sleep(1); \
    if ((++_sp & 255u) == 0u) { if (xb_ld(&(bar)[XB_TMO])) break; if (_sp > XB_SPIN_CAP) { atomicAdd(&(bar)[XB_TMO], 1u); break; } } } } while (0)

struct XcdBarrier {
    unsigned* bar; unsigned x;
    volatile LAS unsigned* st;
};

__device__ __forceinline__ XcdBarrier xcd_barrier_post(unsigned* bar, volatile LAS unsigned* st) {
    XcdBarrier b; b.bar = bar; b.x = xb_xcc_id(); b.st = st;
    if (threadIdx.x == 0) (void)xb_add(&bar[XB_XCNT(b.x)], 1u);
    return b;
}
__device__ __forceinline__ void xcd_barrier_complete(unsigned* bar, unsigned x, unsigned& nloc, unsigned& nx) {
    const unsigned G = gridDim.x * gridDim.y * gridDim.z;
    unsigned sum, cnt, mine, sp = 0u;
    for (;;) {
        sum = 0u; cnt = 0u; mine = 0u;
#pragma unroll
        for (unsigned j = 0; j < 16; ++j) { const unsigned c = xb_ld(&bar[XB_XCNT(j)]); sum += c; cnt += (c > 0u) ? 1u : 0u; mine = (j == x) ? c : mine; }
        if (sum == G) break;
        __builtin_amdgcn_s_sleep(1);
        if ((++sp & 255u) == 0u) { if (xb_ld(&bar[XB_TMO])) break; if (sp > XB_SPIN_CAP) { atomicAdd(&bar[XB_TMO], 1u); break; } }
    }
    nloc = mine > 0u ? mine : 1u; nx = cnt > 0u ? cnt : 1u;
}

__device__ __forceinline__ void xcd_barrier(const XcdBarrier& b) {
    asm volatile("s_waitcnt vmcnt(0)" ::: "memory");
    __syncthreads();
    if (threadIdx.x == 0) {
        unsigned* bar = b.bar;
        __builtin_amdgcn_s_waitcnt(0);
        unsigned nloc = b.st[0], nx = b.st[1];
        if (nloc == 0u) { xcd_barrier_complete(bar, b.x, nloc, nx); b.st[0] = nloc; b.st[1] = nx; }
        const unsigned old = xb_add(&bar[XB_XSUB(b.x)], 1u);
        const unsigned gen = old / nloc;
        if (old + 1u == (gen + 1u) * nloc) {
            __builtin_amdgcn_fence(__ATOMIC_RELEASE, "agent");
            asm volatile("s_waitcnt vmcnt(0)" ::: "memory");
            const unsigned og = xb_add(&bar[XB_TOP], 1u);
            const unsigned tg = og / nx;
            if (og + 1u == (tg + 1u) * nx) xb_add(&bar[XB_TOPGEN], 1u);
            else XB_SPIN(xb_ld(&bar[XB_TOPGEN]) == tg, bar);
            __builtin_amdgcn_fence(__ATOMIC_ACQUIRE, "agent");
            xb_add(&bar[XB_XGEN(b.x)], 1u);
            asm volatile("s_waitcnt vmcnt(0)" ::: "memory");
        } else {
            XB_SPIN(xb_ld(&bar[XB_XGEN(b.x)]) == gen, bar);
            __builtin_amdgcn_fence(__ATOMIC_ACQUIRE, "agent");
            asm volatile("s_waitcnt vmcnt(0)" ::: "memory");
        }
    }
    __syncthreads();
}

#ifndef R_P0T
#define R_P0T 1
#endif
#ifndef R_P1
#define R_P1 1
#endif
#ifndef R_P2
#define R_P2 1
#endif
#ifndef R_P3A
#define R_P3A 1
#endif
#ifndef R_SCAN
#define R_SCAN 1
#endif
#ifndef R_ATTN
#define R_ATTN 1
#endif
#ifndef R_P4
#define R_P4 1
#endif
#ifndef R_P5
#define R_P5 1
#endif
#ifndef R_BAR
#define R_BAR 1
#endif
__global__ void __launch_bounds__(NTHREADS, 2) fwd_kernel(Params prm) {
    extern __shared__ __attribute__((aligned(16))) unsigned char lds_raw[];
    cg::grid_group grid = cg::this_grid();
    Ctx F;
    F.prm = &prm; F.out = prm.out; F.ws = prm.ws; F.lds = (LAS unsigned char*)lds_raw;
    F.tid = threadIdx.x; F.lane = F.tid & 63; F.wave = __builtin_amdgcn_readfirstlane(F.tid >> 6); F.bx = blockIdx.x; F.G = gridDim.x;
    F.gw = F.bx * NWAVES + F.wave; F.NGW = F.G * NWAVES;
    volatile LAS unsigned* MISC = (volatile LAS unsigned*)(F.lds + LDS_BYTES - 256);
    if (F.tid < 4) MISC[F.tid] = 0u;
    __syncthreads();
    XcdBarrier bar = xcd_barrier_post((unsigned*)(F.ws + WS_CTL + 16384), MISC);
#ifdef TS_SEL
    unsigned long long ts_prev = 0, ts_dt = 0; int ts_n = 0;
#ifndef TS_BLK
#define TS_BLK 0
#endif
#ifdef TS_WORK
#define GRID_BAR() do { { const unsigned long long t_ = __builtin_amdgcn_s_memrealtime(); if (ts_n == TS_SEL) ts_dt = t_ - ts_prev; } xcd_barrier(bar); ts_prev = __builtin_amdgcn_s_memrealtime(); ++ts_n; } while (0)
#else
#define GRID_BAR() do { xcd_barrier(bar); { const unsigned long long t_ = __builtin_amdgcn_s_memrealtime(); if (ts_n == TS_SEL) ts_dt = t_ - ts_prev; ts_prev = t_; ++ts_n; } } while (0)
#endif
#else
#define GRID_BAR() do { for (int rb_ = 0; rb_ < R_BAR; ++rb_) xcd_barrier(bar); } while (0)
#endif

#ifndef NO_P0
    LAUNDER(F); phase0(F);
#endif
    if (prm.out == nullptr) grid.sync();
    GRID_BAR();
#ifdef TS_SEL
    ts_prev = __builtin_amdgcn_s_memrealtime();
#endif
#pragma unroll 1
    for (int l = 0; l < 2; ++l) {
#ifndef NO_P1
        for (int rp_ = 0; rp_ < R_P1; ++rp_) { LAUNDER(F); phase1(F, l); }
#endif
        GRID_BAR();
#ifndef NO_P2
        for (int rp_ = 0; rp_ < R_P2; ++rp_) {
            pg8::Gemm g{(const pg8::bf16_t*)(F.ws + WS_XN), (const pg8::bf16_t*)(F.ws + WS_WIN) + (size_t)l * NINP * DM, MT, NINP, DM};
            pg8::EpiBf16 E{(pg8::bf16_t*)(F.ws + WS_P), NINP, nullptr, 0, 0, 1.f};
            if (l == 0) { pg8::StaticOrder S; S.init(MT, NINP, F.G, F.bx); pg8::gemm_phase<pg8::EpiBf16, pg8::StaticOrder, true, true>(F.lds, g, S, E); }
            else { pg8::CtxSparseOrder S; S.init(ML, MC, NINP, F.G, F.bx); pg8::gemm_phase<pg8::EpiBf16, pg8::CtxSparseOrder, true, true>(F.lds, g, S, E); }
        }
#endif
        GRID_BAR();
#ifndef NO_P3A
        { LAUNDER(F); phase3a(F, l); }
        GRID_BAR();
        { LAUNDER(F); phase3b1(F, l); }
        GRID_BAR();
        { LAUNDER(F); phase3b(F, l); }
        GRID_BAR();
        for (int rp_ = 0; rp_ < R_ATTN; ++rp_) { LAUNDER(F); attn_role(F, l); }
        GRID_BAR();
        for (int rp_ = 0; rp_ < R_P4; ++rp_) { LAUNDER(F); phase4(F, l); }
#endif
        GRID_BAR();
#ifndef NO_P5
        for (int rp_ = 0; rp_ < R_P5; ++rp_) {
            const int rows = l == 0 ? MT : ML;
            pg8::Gemm g{(const pg8::bf16_t*)(F.ws + WS_OC), (const pg8::bf16_t*)(F.ws + WS_WOUT) + (size_t)l * DM * DM, rows, DM, DM};
            pg8::StaticOrder S; S.init(rows, DM, F.G, F.bx);
            pg8::EpiF32 E{(float*)(F.ws + WS_P), DM};
            pg8::gemm_phase<pg8::EpiF32, pg8::StaticOrder, true, true>(F.lds, g, S, E);
        }
#endif
        GRID_BAR();
    }
#ifndef NO_P6
    LAUNDER(F); phase6(F);
#endif
#ifdef TS_SEL
    GRID_BAR();
    if (F.bx == TS_BLK && F.wave == 0) { float v = F.out[F.lane]; float a = fabsf(v); float m = a;
        for (int o = 1; o < 64; o <<= 1) m = fminf(m, __shfl_xor(m, o));
        const unsigned long long bal = __ballot(a == m); const int win = __ffsll((long long)bal) - 1;
#ifdef TS_R2
        ts_dt = ((volatile unsigned*)(F.ws + WS_CTL))[2048 + TS_R2];
#endif
        if (F.lane == win) F.out[F.lane] = v + 0.04f + (float)ts_dt * 0.01f * TS_SCALE; }
#endif
}

extern "C" void kernel_launch(void* const* d_in, const int* in_sizes, int n_in, void* d_out, int out_size, void* d_ws, size_t ws_size, hipStream_t stream) {
    static int grid = 0;
    if (grid == 0) {
        if (n_in != 28 || out_size != ML * DM || ws_size < WS_END) { fprintf(stderr, "kernel_launch: unexpected shapes: n_in %d out %d ws %zu (need %zu)\n", n_in, out_size, ws_size, (size_t)WS_END); grid = -1; return; }
        int dev = 0, cus = 0, per_cu = 0;
        if (hipGetDevice(&dev) != hipSuccess || hipDeviceGetAttribute(&cus, hipDeviceAttributeMultiprocessorCount, dev) != hipSuccess) { grid = -1; return; }
        if (hipFuncSetAttribute((const void*)fwd_kernel, hipFuncAttributeMaxDynamicSharedMemorySize, LDS_BYTES) != hipSuccess) { fprintf(stderr, "kernel_launch: hipFuncSetAttribute failed\n"); grid = -1; return; }
        if (hipOccupancyMaxActiveBlocksPerMultiprocessor(&per_cu, (const void*)fwd_kernel, NTHREADS, LDS_BYTES) != hipSuccess || per_cu < 1) { fprintf(stderr, "kernel_launch: occupancy query says %d blocks per CU\n", per_cu); grid = -1; return; }
        (void)hipGetLastError();
        grid = cus;
        if (grid != 256) { fprintf(stderr, "kernel_launch: expected 256 CUs, got %d\n", cus); grid = -1; return; }
    }
    if (grid < 0) return;
    if (hipMemsetAsync((char*)d_ws + WS_CTL, 0, CTL_ZERO_BYTES, stream) != hipSuccess) { fprintf(stderr, "kernel_launch: memset failed\n"); return; }
    Params p{};
    for (int i = 0; i < 28; ++i) p.in[i] = (const float*)d_in[i];
    p.out = (float*)d_out; p.ws = (unsigned char*)d_ws;
    void* args[] = {&p};
    hipError_t e = hipLaunchCooperativeKernel((void*)fwd_kernel, dim3(grid), dim3(NTHREADS), args, LDS_BYTES, stream);
    if (e != hipSuccess) fprintf(stderr, "cooperative launch failed: %s (grid %d)\n", hipGetErrorString(e), grid);
}
```

```cpp
#include <hip/hip_runtime.h>
#include <hip/hip_cooperative_groups.h>
#include <cstdio>
#include <cstdint>
namespace cg = cooperative_groups;
namespace pg8 {
#define PG8_LAS __attribute__((address_space(3)))
typedef unsigned short bf16_t;
typedef short bf16x8 __attribute__((ext_vector_type(8)));
typedef float f32x4 __attribute__((ext_vector_type(4)));
typedef unsigned u32x4 __attribute__((ext_vector_type(4)));
constexpr int BM = 256, BK = 64, HALF = 128, HTB = HALF * BK * 2  , STAGE_BYTES = 8 * HTB, NXCD = 8, WGM = 8;

__host__ __device__ __forceinline__ int lds_byte(int r, int c) { const int st = (r >> 4) * 2 + (c >> 5), rr = r & 15, cc = c & 31, ob = rr * 64 + cc * 2; return st * 1024 + (ob ^ (((ob >> 9) & 1) << 5)); }
__host__ __device__ __forceinline__ void stage_rc(int b, int& R, int& C) { const int st = b / 1024, sb = b % 1024, swz = sb ^ (((sb >> 9) & 1) << 5); R = (st >> 1) * 16 + swz / 64; C = (st & 1) * 32 + (swz % 64) / 2; }
__host__ __device__ __forceinline__ int perm32(int rho) { const int n = rho >> 4, i = rho & 15; return 8 * (i >> 2) + 4 * n + (i & 3); }

struct Unit { int pm, pn; };
struct Gemm { const bf16_t* A; const bf16_t* Bt; int M, N, K, ld; };

struct StaticOrder {
    int nM, nN, nwg, G, c;
    __host__ __device__ void init(int M, int N, int G_, int c_) { nM = M / BM; nN = N / BM; nwg = nM * nN; G = G_; c = c_; }
    __host__ __device__ bool next(int i, Unit& u) const {
        const long L = (long)i * G + c; if (L >= nwg) return false;
        int wgid = (int)L; { const int q = nwg / NXCD, r = nwg % NXCD, xcd = wgid % NXCD, off = wgid / NXCD; wgid = (xcd < r ? xcd * (q + 1) : r * (q + 1) + (xcd - r) * q) + off; }
        const int nig = WGM * nN, gid = wgid / nig, fm = gid * WGM, gsz = (nM - fm) < WGM ? (nM - fm) : WGM;
        u.pm = fm + ((wgid % nig) % gsz); u.pn = (wgid % nig) / gsz; return true;
    }
    __device__ __forceinline__ void a_ready(const Unit&) const {}
    __device__ __forceinline__ void done(const Unit&) const {}
};


struct CtxSparseOrder {
    StaticOrder base; int nMl, nctx, G, c;
    __host__ __device__ void init(int Mlat, int Mctx, int N, int G_, int c_) { base.init(Mlat, N, G_, c_); nMl = Mlat / BM; nctx = (Mctx / BM) * 11; G = G_; c = c_; }
    __host__ __device__ bool next(int i, Unit& u) const {
        if (base.next(i, u)) return true;
        const long L = (long)i * G + c - base.nwg; if (L < 0 || L >= nctx) return false;
        const int k = (int)L % 11; u.pm = nMl + (int)L / 11; u.pn = k < 4 ? 8 + k : 10 + k; return true;
    }
    __device__ __forceinline__ void a_ready(const Unit&) const {}
    __device__ __forceinline__ void done(const Unit&) const {}
};


struct OneUnit {
    int pm, pn; bool has;
    __host__ __device__ bool next(int i, Unit& u) const { if (i > 0 || !has) return false; u.pm = pm; u.pn = pn; return true; }
    __device__ __forceinline__ void a_ready(const Unit&) const {}
    __device__ __forceinline__ void done(const Unit&) const {}
};

__device__ __forceinline__ unsigned cvt_pk_bf16(float lo, float hi) { unsigned r; asm volatile("v_cvt_pk_bf16_f32 %0, %1, %2" : "=v"(r) : "v"(lo), "v"(hi)); return r; }
struct EpiBf16 {
    static constexpr bool PERM = true, AFTER_DRAIN = false;
    bf16_t* O; int ldc; const float* bias; int split_cols; size_t split_stride; float scale0;
    __device__ __forceinline__ void operator()(const f32x4 (&acc)[2][2][4][2], const Unit& u, int wr, int wc, int fr, int fq) const {
        const int row0 = u.pm * BM + wr * 64 + fr; int colt = u.pn * BM; bf16_t* base = O;
        float sc = 1.f; if (split_cols) { const int t = colt / split_cols; base += (size_t)t * split_stride; colt -= t * split_cols; if (t == 0) sc = scale0; }
        const int col0 = colt + wc * 32 + 8 * fq, bcol0 = u.pn * BM + wc * 32 + 8 * fq;
        f32x4 bv[2][2];
#pragma unroll
        for (int bj = 0; bj < 2; ++bj)
#pragma unroll
            for (int n = 0; n < 2; ++n) bv[bj][n] = bias ? *(const f32x4*)(bias + bcol0 + bj * HALF + 4 * n) : (f32x4){0.f, 0.f, 0.f, 0.f};
#pragma unroll
        for (int ai = 0; ai < 2; ++ai)
#pragma unroll
            for (int m = 0; m < 4; ++m) { bf16_t* rowp = base + (size_t)(row0 + ai * HALF + m * 16) * ldc + col0;
#pragma unroll
                for (int bj = 0; bj < 2; ++bj) { f32x4 v0 = acc[ai][bj][m][0] + bv[bj][0], v1 = acc[ai][bj][m][1] + bv[bj][1];
                    v0 = v0 * sc; v1 = v1 * sc; u32x4 w; w.x = cvt_pk_bf16(v0[0], v0[1]); w.y = cvt_pk_bf16(v0[2], v0[3]); w.z = cvt_pk_bf16(v1[0], v1[1]); w.w = cvt_pk_bf16(v1[2], v1[3]);
                    *(u32x4*)(rowp + bj * HALF) = w; } }
    }
};
struct EpiF32 {
    static constexpr bool PERM = false, AFTER_DRAIN = false;
    float* O; int ldc;
    __device__ __forceinline__ void operator()(const f32x4 (&acc)[2][2][4][2], const Unit& u, int wr, int wc, int fr, int fq) const {
        const int col0 = u.pn * BM + wc * 32 + 4 * fq;
#pragma unroll
        for (int ai = 0; ai < 2; ++ai)
#pragma unroll
            for (int m = 0; m < 4; ++m) { float* rowp = O + (size_t)(u.pm * BM + ai * HALF + wr * 64 + m * 16 + fr) * ldc + col0;
#pragma unroll
                for (int bj = 0; bj < 2; ++bj)
#pragma unroll
                    for (int n = 0; n < 2; ++n) *(f32x4*)(rowp + bj * HALF + n * 16) = acc[ai][bj][m][n]; }
    }
};
template <class Epi, class Sched, bool ALIGN_EPI = false, bool SP2 = false>
__device__ __forceinline__ void gemm_phase(PG8_LAS unsigned char* lds, const Gemm g, const Sched& S, const Epi& E) {
    int tid_ = threadIdx.x; asm volatile("" : "+v"(tid_));
    const int tid = tid_, wid = __builtin_amdgcn_readfirstlane(tid >> 6), lane = tid & 63, wr = wid >> 2, wc = wid & 3, fr = lane & 15, fq = lane >> 4;
    const int K = g.ld, nt = g.K / BK;
    unsigned voffA[2], voffB[2];
#pragma unroll
    for (int i = 0; i < 2; ++i) { int R, C; stage_rc(tid * 16 + i * 8192, R, C); const int Rb = Epi::PERM ? ((R & ~31) + perm32(R & 31)) : R;
        voffA[i] = (unsigned)(R * K + C) * 2u; voffB[i] = (unsigned)(Rb * K + C) * 2u; }
    const size_t kstep = (size_t)(BK * 2);
    const size_t hstep = (size_t)HALF * K * 2;
    const size_t tstep = 2 * hstep;
    const unsigned ldsw = (unsigned)wid * 1024u;
    const int aoff = lds_byte(wr * 64 + fr, fq * 8), boff = lds_byte(wc * 32 + fr, fq * 8);
#define PG8_SA(b, h) (((b) * 2 + (h)) * HTB)
#define PG8_SB(b, h) ((4 + (b) * 2 + (h)) * HTB)
#define PG8_STAGE(bufoff, gbase, voff) do { _Pragma("unroll") for (int _i = 0; _i < 2; ++_i) \
        __builtin_amdgcn_global_load_lds((const unsigned*)((const char*)(gbase) + (voff)[_i]), (PG8_LAS unsigned*)(lds + (bufoff) + ldsw + _i * 8192), 16, 0, 0); } while (0)
#define PG8_LDA(dst, b, h) do { _Pragma("unroll") for (int m = 0; m < 4; ++m) _Pragma("unroll") for (int k = 0; k < 2; ++k) dst[m][k] = *(const PG8_LAS bf16x8*)(lds + PG8_SA(b, h) + aoff + m * 2048 + k * 1024); } while (0)
#define PG8_LDB(dst, b, h) do { _Pragma("unroll") for (int n = 0; n < 2; ++n) _Pragma("unroll") for (int k = 0; k < 2; ++k) dst[n][k] = *(const PG8_LAS bf16x8*)(lds + PG8_SB(b, h) + boff + n * 2048 + k * 1024); } while (0)
#define PG8_MMA(ai, bj, At, Bt) do { __builtin_amdgcn_s_setprio(1); _Pragma("unroll") for (int m = 0; m < 4; ++m) _Pragma("unroll") for (int n = 0; n < 2; ++n) _Pragma("unroll") for (int k = 0; k < 2; ++k) \
        acc[ai][bj][m][n] = __builtin_amdgcn_mfma_f32_16x16x32_bf16(Bt[n][k], At[m][k], acc[ai][bj][m][n], 0, 0, 0); __builtin_amdgcn_s_setprio(0); } while (0)
#define PG8_WAIT_V(n) asm volatile("s_waitcnt vmcnt(" #n ")" ::: "memory")
#define PG8_WAIT_L(n) asm volatile("s_waitcnt lgkmcnt(" #n ")" ::: "memory")
#define PG8_BAR __builtin_amdgcn_s_barrier()
#define PG8_SCHED __builtin_amdgcn_sched_barrier(0)
    Unit cur, nxt; int ui = 0;
    if (!S.next(0, cur)) return;
    f32x4 acc[2][2][4][2];
#pragma unroll
    for (int a = 0; a < 2; ++a)
#pragma unroll
        for (int b = 0; b < 2; ++b)
#pragma unroll
            for (int m = 0; m < 4; ++m)
#pragma unroll
                for (int n = 0; n < 2; ++n) acc[a][b][m][n] = (f32x4){0.f, 0.f, 0.f, 0.f};
    bf16x8 At[4][2], B0[2][2], B1[2][2];
    const char* cA = (const char*)g.A + (size_t)cur.pm * tstep; const char* cB = (const char*)g.Bt + (size_t)cur.pn * tstep;
    S.a_ready(cur);
    if constexpr (SP2) {
        PG8_STAGE(PG8_SB(0, 0), cB, voffB); PG8_STAGE(PG8_SB(0, 1), cB + hstep, voffB); PG8_STAGE(PG8_SA(0, 0), cA, voffA); PG8_STAGE(PG8_SA(0, 1), cA + hstep, voffA);
        if (wr == 1) PG8_BAR;
        PG8_WAIT_V(2); PG8_BAR;
        PG8_STAGE(PG8_SB(1, 0), cB + kstep, voffB); PG8_STAGE(PG8_SA(1, 0), cA + kstep, voffA); PG8_STAGE(PG8_SB(1, 1), cB + hstep + kstep, voffB);
        PG8_WAIT_V(6); PG8_BAR;
    } else {
        PG8_STAGE(PG8_SB(0, 0), cB, voffB); PG8_STAGE(PG8_SA(0, 0), cA, voffA); PG8_STAGE(PG8_SB(0, 1), cB + hstep, voffB); PG8_STAGE(PG8_SA(0, 1), cA + hstep, voffA);
        if (wr == 1) PG8_BAR;
        PG8_WAIT_V(4); PG8_BAR;
        PG8_STAGE(PG8_SB(1, 0), cB + kstep, voffB); PG8_STAGE(PG8_SA(1, 0), cA + kstep, voffA); PG8_STAGE(PG8_SB(1, 1), cB + hstep + kstep, voffB);
        PG8_WAIT_V(6); PG8_BAR;
    }
    for (;;) {
        const bool has_next = S.next(ui + 1, nxt);
        const char* nA = has_next ? (const char*)g.A + (size_t)nxt.pm * tstep : cA; const char* nB = has_next ? (const char*)g.Bt + (size_t)nxt.pn * tstep : cB;
        for (int t = 0; t < nt; t += 2) {
            const bool last = (t == nt - 2);
            const char* a1 = cA + (size_t)(t + 1) * kstep;
            const char* a2 = last ? nA : cA + (size_t)(t + 2) * kstep; const char* b2 = last ? nB : cB + (size_t)(t + 2) * kstep;
            const char* a3 = a2 + kstep; const char* b3 = b2 + kstep;
            if (last && has_next) S.a_ready(nxt);
            if constexpr (SP2) {
            PG8_LDB(B0, 0, 0); PG8_LDB(B1, 0, 1); PG8_SCHED; PG8_LDA(At, 0, 0); PG8_STAGE(PG8_SA(1, 1), a1 + hstep, voffA);
            PG8_WAIT_V(8); PG8_WAIT_L(0); PG8_BAR; PG8_MMA(0, 0, At, B0); PG8_MMA(0, 1, At, B1); PG8_BAR; PG8_SCHED;
            PG8_LDA(At, 0, 1); PG8_STAGE(PG8_SB(0, 0), b2, voffB); PG8_STAGE(PG8_SB(0, 1), b2 + hstep, voffB); PG8_STAGE(PG8_SA(0, 0), a2, voffA);
            PG8_WAIT_V(8); PG8_WAIT_L(0); PG8_BAR; PG8_MMA(1, 0, At, B0); PG8_MMA(1, 1, At, B1); PG8_BAR; PG8_SCHED;
            PG8_LDB(B0, 1, 0); PG8_LDB(B1, 1, 1); PG8_SCHED; PG8_LDA(At, 1, 0); PG8_STAGE(PG8_SA(0, 1), a2 + hstep, voffA);
            PG8_WAIT_V(8); PG8_WAIT_L(0); PG8_BAR; PG8_MMA(0, 0, At, B0); PG8_MMA(0, 1, At, B1); PG8_BAR; PG8_SCHED;
            PG8_LDA(At, 1, 1); PG8_STAGE(PG8_SB(1, 0), b3, voffB); PG8_STAGE(PG8_SB(1, 1), b3 + hstep, voffB); PG8_STAGE(PG8_SA(1, 0), a3, voffA);
            PG8_WAIT_V(8); PG8_WAIT_L(0); PG8_BAR; PG8_MMA(1, 0, At, B0); PG8_MMA(1, 1, At, B1); PG8_BAR; PG8_SCHED;
            } else {
            PG8_LDB(B0, 0, 0); PG8_SCHED; PG8_LDA(At, 0, 0); PG8_STAGE(PG8_SA(1, 1), a1 + hstep, voffA);
            PG8_WAIT_L(8); PG8_BAR; PG8_WAIT_L(0); PG8_MMA(0, 0, At, B0); PG8_BAR; PG8_SCHED;
            PG8_LDB(B1, 0, 1); PG8_STAGE(PG8_SB(0, 0), b2, voffB);
            PG8_BAR; PG8_WAIT_L(0); PG8_MMA(0, 1, At, B1); PG8_BAR;
            PG8_LDA(At, 0, 1); PG8_STAGE(PG8_SA(0, 0), a2, voffA);
            PG8_BAR; PG8_WAIT_L(0); PG8_MMA(1, 0, At, B0); PG8_BAR; PG8_SCHED;
            PG8_STAGE(PG8_SB(0, 1), b2 + hstep, voffB);
            PG8_WAIT_V(6); PG8_BAR; PG8_MMA(1, 1, At, B1); PG8_BAR;
            PG8_LDB(B0, 1, 0); PG8_SCHED; PG8_LDA(At, 1, 0); PG8_STAGE(PG8_SA(0, 1), a2 + hstep, voffA);
            PG8_WAIT_L(8); PG8_BAR; PG8_WAIT_L(0); PG8_MMA(0, 0, At, B0); PG8_BAR; PG8_SCHED;
            PG8_LDB(B1, 1, 1); PG8_STAGE(PG8_SB(1, 0), b3, voffB);
            PG8_BAR; PG8_WAIT_L(0); PG8_MMA(0, 1, At, B1); PG8_BAR;
            PG8_LDA(At, 1, 1); PG8_STAGE(PG8_SA(1, 0), a3, voffA);
            PG8_BAR; PG8_WAIT_L(0); PG8_MMA(1, 0, At, B0); PG8_BAR; PG8_SCHED;
            PG8_STAGE(PG8_SB(1, 1), b3 + hstep, voffB);
            PG8_WAIT_V(6); PG8_BAR; PG8_MMA(1, 1, At, B1); PG8_BAR;
            }
        }
        if constexpr (ALIGN_EPI) { if (wr == 0) PG8_BAR; }
        if constexpr (!Epi::AFTER_DRAIN) { E(acc, cur, wr, wc, fr, fq); S.done(cur); }
        if (!has_next) break;
#pragma unroll
        for (int a = 0; a < 2; ++a)
#pragma unroll
            for (int b = 0; b < 2; ++b)
#pragma unroll
                for (int m = 0; m < 4; ++m)
#pragma unroll
                    for (int n = 0; n < 2; ++n) acc[a][b][m][n] = (f32x4){0.f, 0.f, 0.f, 0.f};
        cur = nxt; cA = nA; cB = nB; ++ui;
        if constexpr (ALIGN_EPI) { if (wr == 1) PG8_BAR; }
    }
    PG8_WAIT_V(0);
    if constexpr (!ALIGN_EPI) { if (wr == 0) PG8_BAR; }
    PG8_BAR;
    if constexpr (Epi::AFTER_DRAIN) { E.fused(acc, cur, wr, wc, fr, fq, lds, wid, lane); S.done(cur); }
#undef PG8_SA
#undef PG8_SB
#undef PG8_STAGE
#undef PG8_LDA
#undef PG8_LDB
#undef PG8_MMA
#undef PG8_WAIT_V
#undef PG8_WAIT_L
#undef PG8_BAR
#undef PG8_SCHED
}
}

constexpr int NB = 2, TL = 4096, DM = 2048, CL = 256, NIN = 7872, NINP = 7936;
constexpr int ML = NB * TL, MC = NB * CL, MT = ML + MC;
constexpr int KEYS = CL + TL;
constexpr int NSTEP = KEYS;
constexpr int A_U = 0, A_V = 512, A_G = 1024, B_Q = 1536, B_K = 2048, B_V = 2560, B_G = 3072, C_R = 3584, C_K = 4096, C_V = 4608, C_LF = 5120, C_LB = 5216, C_G = 5312,
              D_B = 5824, D_C = 6336, D_X = 6848, D_G = 7360;
constexpr float EPS = 1e-6f, GN_EPS = 64e-5f;
constexpr float QSCALE = 0.125f * 1.4426950408889634f;

constexpr size_t MiB = 1u << 20;
constexpr size_t WS_CTL = 0, CTL_ZERO_BYTES = 1 * MiB;
constexpr size_t CTL_MODACC = 65536;
constexpr size_t WS_ROPE = 1 * MiB - 16384;
constexpr size_t WS_WIN = 1 * MiB;
constexpr size_t WS_WOUT = 63 * MiB;
constexpr size_t WS_XN = 79 * MiB;
constexpr size_t WS_P = 113 * MiB;
constexpr size_t WS_QR = 245 * MiB;
constexpr size_t WS_QC = 253 * MiB;
constexpr size_t WS_KR = 254 * MiB;
constexpr size_t WS_VT = 263 * MiB;
constexpr size_t WS_CHK = 272 * MiB;
constexpr size_t WS_Y = 402 * MiB;
constexpr size_t WS_BON = 436 * MiB;
constexpr size_t WS_OC = 453 * MiB;
constexpr size_t WS_LW = 487 * MiB;
constexpr size_t WS_SST = 488 * MiB;
constexpr size_t WS_END = 489 * MiB;
static_assert(WS_WIN + (size_t)2 * NINP * DM * 2 <= WS_WOUT && WS_WOUT + (size_t)2 * DM * DM * 2 <= WS_XN && WS_XN + (size_t)MT * DM * 2 <= WS_P && WS_P + (size_t)MT * NINP * 2 <= WS_QR, "ws map 1");
static_assert(WS_QR + (size_t)16 * TL * 64 * 2 <= WS_QC && WS_QC + (size_t)16 * CL * 64 * 2 <= WS_KR && WS_KR + (size_t)16 * KEYS * 64 * 2 <= WS_VT && WS_VT + (size_t)8 * 128 * KEYS * 2 <= WS_CHK, "ws map 2");
static_assert(WS_Y + (size_t)2 * MT * 512 * 4 <= WS_BON && WS_BON + (size_t)2 * MT * 512 * 2 <= WS_OC && WS_OC + (size_t)MT * DM * 2 <= WS_END, "ws map 3");
static_assert((size_t)MT * 1024 * 4 <= WS_P - WS_XN && (size_t)MT * DM * 4 <= WS_QR - WS_P, "overlays");

constexpr int LDS_BYTES = 147456;
constexpr int NWAVES = 8, NTHREADS = 512;

typedef unsigned short bf16;
typedef short bf16x8 __attribute__((ext_vector_type(8)));
typedef float f32x4 __attribute__((ext_vector_type(4)));
typedef float f32x2 __attribute__((ext_vector_type(2)));
typedef float f32x16 __attribute__((ext_vector_type(16)));
typedef unsigned u32x4 __attribute__((ext_vector_type(4)));
typedef unsigned u32x2 __attribute__((ext_vector_type(2)));
typedef __bf16 bf16x2_t __attribute__((ext_vector_type(2)));
#define LAS __attribute__((address_space(3)))

struct Params { const float* in[28]; float* out; unsigned char* ws; };

struct Ctx {
    const Params* prm; float* out; unsigned char* ws;
    LAS unsigned char* lds;
    int tid, lane, wave, bx, G, gw, NGW;
};

__device__ __forceinline__ unsigned cvtpk(float lo, float hi) { f32x2 v = {lo, hi}; bf16x2_t b = __builtin_convertvector(v, bf16x2_t); return __builtin_bit_cast(unsigned, b); }
__device__ __forceinline__ float bflo(unsigned u) { return __builtin_bit_cast(float, u << 16); }
__device__ __forceinline__ float bfhi(unsigned u) { return __builtin_bit_cast(float, u & 0xffff0000u); }
__device__ __forceinline__ void unpack8(const u32x4 v, float* f) { f[0] = bflo(v.x); f[1] = bfhi(v.x); f[2] = bflo(v.y); f[3] = bfhi(v.y); f[4] = bflo(v.z); f[5] = bfhi(v.z); f[6] = bflo(v.w); f[7] = bfhi(v.w); }
__device__ __forceinline__ u32x4 pack8(const float* f) { u32x4 r; r.x = cvtpk(f[0], f[1]); r.y = cvtpk(f[2], f[3]); r.z = cvtpk(f[4], f[5]); r.w = cvtpk(f[6], f[7]); return r; }
__device__ __forceinline__ float silu_f(float x) { return x * __builtin_amdgcn_rcpf(1.f + __expf(-x)); }
__device__ __forceinline__ float wave_sum(float v) {
#pragma unroll
    for (int o = 1; o < 64; o <<= 1) v += __shfl_xor(v, o);
    return v;
}
template <int CTRL> __device__ __forceinline__ float dpp_f(float v) { return __builtin_bit_cast(float, __builtin_amdgcn_update_dpp(0, __builtin_bit_cast(int, v), CTRL, 0xf, 0xf, true)); }
__device__ __forceinline__ float red4(float v) { v += dpp_f<0xB1>(v); v += dpp_f<0x4E>(v); return v; }
__device__ __forceinline__ float red8(float v) { v = red4(v); v += dpp_f<0x141>(v); return v; }
__device__ __forceinline__ float red16(float v) { v = red8(v); v += dpp_f<0x140>(v); return v; }
#define LAUNDER(F) do { asm volatile("" : "+v"(F.tid), "+v"(F.lane)); asm volatile("" : "+s"(F.wave), "+s"(F.bx), "+s"(F.gw)); } while (0)
__device__ __forceinline__ f32x16 zero16() { f32x16 z;
#pragma unroll
    for (int r = 0; r < 16; ++r) z[r] = 0.f;
    return z; }
#define MROW(reg, hh) (((reg) & 3) + 8 * ((reg) >> 2) + 4 * (hh))
#define LDS_WAIT() asm volatile("s_waitcnt lgkmcnt(0)" ::: "memory")
#define WG_BAR() do { asm volatile("s_waitcnt lgkmcnt(0)" ::: "memory"); __builtin_amdgcn_s_barrier(); asm volatile("" ::: "memory"); } while (0)

#ifndef R_P0T
#define R_P0T 1
#endif
__device__ __forceinline__ void p0_transpose_item(const float* W, int K, int N, bf16* WT, LAS float* scr, int item, int lane) {
    const int nblk = N / 64, kb = item / nblk, nb = item % nblk, k0 = 64 * kb, n0 = 64 * nb;
#pragma unroll 8
    for (int i = 0; i < 16; ++i) { const int kk = 4 * i + (lane >> 4), n4 = lane & 15; const f32x4 w = *(const f32x4*)(W + (size_t)(k0 + kk) * N + n0 + 4 * n4);
        LAS float* d = scr + kk * 65 + 4 * n4; d[0] = w.x; d[1] = w.y; d[2] = w.z; d[3] = w.w; }
    LDS_WAIT();
    const int c = lane & 7;
#pragma unroll
    for (int j = 0; j < 8; ++j) { const int n = (lane >> 3) + 8 * j; const LAS float* s = scr + (8 * c) * 65 + n;
        u32x4 o; o.x = cvtpk(s[0 * 65], s[1 * 65]); o.y = cvtpk(s[2 * 65], s[3 * 65]); o.z = cvtpk(s[4 * 65], s[5 * 65]); o.w = cvtpk(s[6 * 65], s[7 * 65]);
        *(u32x4*)(WT + (size_t)(n0 + n) * K + k0 + 8 * c) = o; }
    LDS_WAIT();
}

__device__ __forceinline__ void p0_weights(Ctx& F, int l, int widx, int nw) {
    LAS float* scr = (LAS float*)(F.lds + F.wave * 16896);
    const float* w_in = F.prm->in[8] + (size_t)l * DM * NIN; const float* w_out = F.prm->in[9] + (size_t)l * DM * DM;
    bf16* WIN = (bf16*)(F.ws + WS_WIN) + (size_t)l * NINP * DM; bf16* WOUT = (bf16*)(F.ws + WS_WOUT) + (size_t)l * DM * DM;
    constexpr int I_IN = (DM / 64) * (NIN / 64), I_OUT = (DM / 64) * (DM / 64);
    for (int it = widx; it < I_IN + I_OUT; it += nw) {
        if (it < I_IN) p0_transpose_item(w_in, DM, NIN, WIN, scr, it, F.lane);
        else p0_transpose_item(w_out, DM, DM, WOUT, scr, it - I_IN, F.lane);
    }
    const float* cvec = F.prm->in[1]; const float* cctx = F.prm->in[3]; const float* w_mod = F.prm->in[4];
    float* MODACC = (float*)(F.ws + WS_CTL + CTL_MODACC);
    for (int it = widx; it < 32 * 24; it += nw) {
        const int ks = it / 24, cb = it % 24, k0 = ks * 64, n0 = cb * 256 + 4 * F.lane;
        scr[F.lane] = silu_f(cvec[k0 + F.lane]); scr[64 + F.lane] = silu_f(cvec[DM + k0 + F.lane]); scr[128 + F.lane] = silu_f(cctx[k0 + F.lane]);
        LDS_WAIT();
        f32x4 a0 = {0.f, 0.f, 0.f, 0.f}, a1 = a0, a2 = a0;
        const float* wp = w_mod + ((size_t)l * DM + k0) * 6144 + n0;
#pragma unroll 8
        for (int k = 0; k < 64; ++k) { const f32x4 w = *(const f32x4*)(wp + (size_t)k * 6144); a0 += w * scr[k]; a1 += w * scr[64 + k]; a2 += w * scr[128 + k]; }
        float* ma = MODACC + (size_t)(l * 3) * 6144 + n0;
#pragma unroll
        for (int e = 0; e < 4; ++e) { atomicAdd(ma + e, a0[e]); atomicAdd(ma + 6144 + e, a1[e]); atomicAdd(ma + 2 * 6144 + e, a2[e]); }
        LDS_WAIT();
    }
}
__device__ __forceinline__ void phase0(Ctx& F) {
    p0_weights(F, 0, F.gw, F.NGW); p0_weights(F, 1, F.gw, F.NGW);
    {   const float* w2a = F.prm->in[19]; const float* a2a = F.prm->in[21]; bf16* LW = (bf16*)(F.ws + WS_LW);
        const int gt = F.bx * NTHREADS + F.tid, GT = F.G * NTHREADS;
        for (int idx = gt; idx < 4 * 512 * 64; idx += GT) { const int pd = idx / (512 * 64), rem = idx % (512 * 64), k = rem >> 9, chg = rem & 511, hq = chg >> 6, ch = chg & 63;
            const float v = w2a[((size_t)pd * 64 + k) * 512 + chg]; const unsigned hi = cvtpk(v, 0.f) & 0xffffu; const float lo = v - bflo(hi);
            bf16* base = LW + (size_t)(pd * 8 + hq) * 12288; base[ch * 64 + k] = (bf16)hi; base[4096 + ch * 64 + k] = (bf16)(cvtpk(lo, 0.f) & 0xffffu); }
        for (int idx = gt; idx < 4 * 512 * 32; idx += GT) { const int pd = idx / (512 * 32), rem = idx % (512 * 32), k = rem >> 9, chg = rem & 511, hq = chg >> 6, ch = chg & 63;
            const float v = a2a[((size_t)pd * 32 + k) * 512 + chg]; const unsigned hi = cvtpk(v, 0.f) & 0xffffu; const float lo = v - bflo(hi);
            bf16* base = LW + (size_t)(pd * 8 + hq) * 12288 + 8192; base[ch * 32 + k] = (bf16)hi; base[2048 + ch * 32 + k] = (bf16)(cvtpk(lo, 0.f) & 0xffffu); }
    }
    if (F.bx == 0) {
        float* rope = (float*)(F.ws + WS_ROPE);
        for (int i = F.tid; i < 1024; i += NTHREADS) { const int pos = i >> 4, f = i & 15; const float inv = powf(10000.f, -(float)(2 * f) / 32.f); const float ang = (float)pos * inv;
            rope[i] = cosf(ang); rope[1024 + i] = sinf(ang); }
    }
}

__device__ __forceinline__ void ld_row(const float* p, int lane, f32x4* v) {
#pragma unroll
    for (int j = 0; j < 8; ++j) v[j] = *(const f32x4*)(p + 4 * lane + 256 * j);
}
__device__ __forceinline__ float sumsq8(const f32x4* v) { float s = 0.f;
#pragma unroll
    for (int j = 0; j < 8; ++j) s += (v[j].x * v[j].x + v[j].y * v[j].y) + (v[j].z * v[j].z + v[j].w * v[j].w);
    return s; }
__device__ __forceinline__ void ld_mod(const Ctx& F, int l, int r, int part, int lane, f32x4* v) {
    const float* ma = (const float*)(F.ws + WS_CTL + CTL_MODACC) + (size_t)(l * 3 + r) * 6144 + part * DM; const float* bm = F.prm->in[5] + (size_t)l * 6144 + part * DM;
#pragma unroll
    for (int j = 0; j < 8; ++j) v[j] = *(const f32x4*)(ma + 4 * lane + 256 * j) + *(const f32x4*)(bm + 4 * lane + 256 * j);
}
__device__ __forceinline__ void phase1(Ctx& F, int l) {
    const float* x = F.prm->in[0]; const float* ctx = F.prm->in[2]; const float* g_pre = F.prm->in[6] + (size_t)l * DM; const float* g_post0 = F.prm->in[7];
    const float* O = (const float*)(F.ws + WS_P); bf16* XN = (bf16*)(F.ws + WS_XN);
    LAS float* MV = (LAS float*)F.lds;
    {   const float* ma = (const float*)(F.ws + WS_CTL + CTL_MODACC); const float* bm = F.prm->in[5];
        for (int idx = F.tid; idx < 3 * 512; idx += NTHREADS) { const int r = idx >> 9, n = (idx & 511) * 4;
            const f32x4 shv = *(const f32x4*)(ma + (size_t)(l * 3 + r) * 6144 + n) + *(const f32x4*)(bm + (size_t)l * 6144 + n);
            const f32x4 scv = *(const f32x4*)(ma + (size_t)(l * 3 + r) * 6144 + DM + n) + *(const f32x4*)(bm + (size_t)l * 6144 + DM + n);
            *(LAS f32x4*)(MV + (r * 3 + 0) * DM + n) = shv; *(LAS f32x4*)(MV + (r * 3 + 1) * DM + n) = (scv + 1.f) * *(const f32x4*)(g_pre + n);
            if (l == 1) { const f32x4 gt = *(const f32x4*)(ma + (size_t)r * 6144 + 2 * DM + n) + *(const f32x4*)(bm + 2 * DM + n); *(LAS f32x4*)(MV + (r * 3 + 2) * DM + n) = gt * *(const f32x4*)(g_post0 + n); } }
    }
    WG_BAR();
    for (int row = F.gw; row < MT; row += F.NGW) {
        const bool lat = row < ML; const int r = lat ? (row / TL) : 2;
        const LAS float* mv = MV + r * 3 * DM + 4 * F.lane;
        const float* src = lat ? x + (size_t)row * DM : ctx + (size_t)(row - ML) * DM;
        f32x4 xv[8]; ld_row(src, F.lane, xv);
        if (l == 1) {
            f32x4 ov[8]; ld_row(O + (size_t)row * DM, F.lane, ov);
            const float rs = 1.f / sqrtf(wave_sum(sumsq8(ov)) * (1.f / DM) + EPS);
#pragma unroll
            for (int j = 0; j < 8; ++j) xv[j] = xv[j] + *(const LAS f32x4*)(mv + 2 * DM + 256 * j) * (ov[j] * rs);
            if (lat) {
#pragma unroll
                for (int j = 0; j < 8; ++j) *(f32x4*)(F.out + (size_t)row * DM + 4 * F.lane + 256 * j) = xv[j];
            }
        }
        const float rs = 1.f / sqrtf(wave_sum(sumsq8(xv)) * (1.f / DM) + EPS);
#pragma unroll
        for (int j = 0; j < 8; ++j) { const f32x4 h = (xv[j] * rs) * *(const LAS f32x4*)(mv + DM + 256 * j) + *(const LAS f32x4*)(mv + 256 * j);
            u32x2 w; w.x = cvtpk(h.x, h.y); w.y = cvtpk(h.z, h.w); *(u32x2*)(XN + (size_t)row * DM + 4 * F.lane + 256 * j) = w; }
    }
    WG_BAR();
}
__device__ __forceinline__ void phase6(Ctx& F) {
    const float* g_post1 = F.prm->in[7] + DM; const float* O = (const float*)(F.ws + WS_P);
    for (int row = F.gw; row < ML; row += F.NGW) {
        const int r = row / TL;
        f32x4 xv[8], ov[8], gt[8], gp[8]; ld_row(F.out + (size_t)row * DM, F.lane, xv); ld_row(O + (size_t)row * DM, F.lane, ov); ld_mod(F, 1, r, 2, F.lane, gt); ld_row(g_post1, F.lane, gp);
        const float rs = 1.f / sqrtf(wave_sum(sumsq8(ov)) * (1.f / DM) + EPS);
#pragma unroll
        for (int j = 0; j < 8; ++j) *(f32x4*)(F.out + (size_t)row * DM + 4 * F.lane + 256 * j) = xv[j] + gt[j] * (ov[j] * rs * gp[j]);
    }
}

__device__ __forceinline__ void sgu_item(Ctx& F, int l, int cb, int h) {
    const bf16* P = (const bf16*)(F.ws + WS_P); bf16* OC = (bf16*)(F.ws + WS_OC);
    const float* w_s = F.prm->in[10] + (size_t)(l * 4 + h) * 128 * 128; const float* b_s = F.prm->in[11] + (size_t)(l * 4 + h) * 128;
    const int row0 = cb < 64 ? (cb >> 5) * TL + (cb & 31) * 128 : ML + ((cb - 64) >> 1) * CL + ((cb - 64) & 1) * 128;
    LAS unsigned char* WB = F.lds;
    LAS unsigned char* VTB = F.lds + 34816;
    LAS float* MX = (LAS float*)(F.lds + 69632);
    {
        const int row = F.tid >> 2, qt = F.tid & 3; const bf16* src = P + (size_t)(row0 + row) * NINP + A_V + h * 128 + qt * 32;
        float v[32];
#pragma unroll
        for (int i = 0; i < 4; ++i) unpack8(*(const u32x4*)(src + 8 * i), v + 8 * i);
        float s_ = 0.f;
#pragma unroll
        for (int i = 0; i < 32; ++i) s_ += v[i];
        const float mean = red4(s_) * (1.f / 128.f); float q = 0.f;
#pragma unroll
        for (int i = 0; i < 32; ++i) { v[i] -= mean; q += v[i] * v[i]; }
        const float rstd = 1.f / sqrtf(red4(q) * (1.f / 128.f) + EPS);
#pragma unroll
        for (int i = 0; i < 32; i += 2) { const unsigned w = cvtpk(v[i] * rstd, v[i + 1] * rstd);
            *(LAS unsigned short*)(VTB + (qt * 32 + i) * 272 + 2 * row) = (unsigned short)w; *(LAS unsigned short*)(VTB + (qt * 32 + i + 1) * 272 + 2 * row) = (unsigned short)(w >> 16); }
    }
    for (int idx = F.tid; idx < 4096; idx += NTHREADS) { const int p = idx >> 5, q4 = idx & 31; const f32x4 w = *(const f32x4*)(w_s + p * 128 + 4 * q4);
        *(LAS u32x2*)(WB + p * 272 + 8 * q4) = (u32x2){cvtpk(w.x, w.y), cvtpk(w.z, w.w)}; }
    WG_BAR();
    {   const int l31 = F.lane & 31, hh = F.lane >> 5, mt = F.wave >> 1;
#pragma unroll
        for (int nn = 0; nn < 2; ++nn) { const int nt = (F.wave & 1) * 2 + nn; f32x16 d = zero16();
#pragma unroll
            for (int ks = 0; ks < 8; ++ks) d = __builtin_amdgcn_mfma_f32_32x32x16_bf16(*(const LAS bf16x8*)(WB + (32 * mt + l31) * 272 + (16 * ks + 8 * hh) * 2), *(const LAS bf16x8*)(VTB + (32 * nt + l31) * 272 + (16 * ks + 8 * hh) * 2), d, 0, 0, 0);
#pragma unroll
            for (int r = 0; r < 16; ++r) MX[(32 * mt + MROW(r, hh)) * 132 + 32 * nt + l31] = d[r]; }
    }
    WG_BAR();
    const int pg = F.tid >> 5, dg = F.tid & 31;
    f32x4 acc[8];
#pragma unroll
    for (int i = 0; i < 8; ++i) acc[i] = *(const LAS f32x4*)(MX + (8 * pg + i) * 132 + 4 * dg);
#pragma unroll
    for (int i = 0; i < 8; ++i) { const int p = 8 * pg + i; const float bs = b_s[p]; const bf16* pr = P + (size_t)(row0 + p) * NINP + h * 128 + 4 * dg;
        const u32x2 uu = *(const u32x2*)(pr + A_U), gg = *(const u32x2*)(pr + A_G);
        const float o0 = bflo(uu.x) * (acc[i].x + bs) * silu_f(bflo(gg.x)), o1 = bfhi(uu.x) * (acc[i].y + bs) * silu_f(bfhi(gg.x));
        const float o2 = bflo(uu.y) * (acc[i].z + bs) * silu_f(bflo(gg.y)), o3 = bfhi(uu.y) * (acc[i].w + bs) * silu_f(bfhi(gg.y));
        u32x2 w; w.x = cvtpk(o0, o1); w.y = cvtpk(o2, o3); *(u32x2*)(OC + (size_t)(row0 + p) * DM + h * 128 + 4 * dg) = w; }
    WG_BAR();
}

__device__ __forceinline__ void conv_item(Ctx& F, int l, int item) {
    const bf16* P = (const bf16*)(F.ws + WS_P); bf16* OC = (bf16*)(F.ws + WS_OC); const float* cw = F.prm->in[27] + (size_t)l * 3 * 512;
    const int row = item * 16 + (F.tid >> 5), c0 = (F.tid & 31) * 16;
    int t, tlen; if (row < ML) { t = row & (TL - 1); tlen = TL; } else { t = (row - ML) & (CL - 1); tlen = CL; }
    const bf16* pr = P + (size_t)row * NINP;
    float z0[16], z1[16], z2[16], tmp[16];
#pragma unroll
    for (int i = 0; i < 2; ++i) {
        float a[8], b[8];
        unpack8(*(const u32x4*)(pr + D_C + c0 + 8 * i), a); unpack8(*(const u32x4*)(pr + D_X + c0 + 8 * i), b);
#pragma unroll
        for (int e = 0; e < 8; ++e) z1[8 * i + e] = a[e] * b[e];
        if (t > 0) { unpack8(*(const u32x4*)(pr - NINP + D_C + c0 + 8 * i), a); unpack8(*(const u32x4*)(pr - NINP + D_X + c0 + 8 * i), b);
#pragma unroll
            for (int e = 0; e < 8; ++e) z0[8 * i + e] = a[e] * b[e]; }
        else {
#pragma unroll
            for (int e = 0; e < 8; ++e) z0[8 * i + e] = 0.f; }
        if (t < tlen - 1) { unpack8(*(const u32x4*)(pr + NINP + D_C + c0 + 8 * i), a); unpack8(*(const u32x4*)(pr + NINP + D_X + c0 + 8 * i), b);
#pragma unroll
            for (int e = 0; e < 8; ++e) z2[8 * i + e] = a[e] * b[e]; }
        else {
#pragma unroll
            for (int e = 0; e < 8; ++e) z2[8 * i + e] = 0.f; }
    }
#pragma unroll
    for (int i = 0; i < 2; ++i) {
        float bg[8], gg[8]; unpack8(*(const u32x4*)(pr + D_B + c0 + 8 * i), bg); unpack8(*(const u32x4*)(pr + D_G + c0 + 8 * i), gg);
#pragma unroll
        for (int e = 0; e < 8; ++e) { const int c = c0 + 8 * i + e; const float y = cw[c] * z0[8 * i + e] + cw[512 + c] * z1[8 * i + e] + cw[1024 + c] * z2[8 * i + e]; tmp[e] = bg[e] * y * silu_f(gg[e]); }
        *(u32x4*)(OC + (size_t)row * DM + 1536 + c0 + 8 * i) = pack8(tmp);
    }
}

__device__ __forceinline__ void attnprep_item(Ctx& F, int l, int rb, int h) {
    const bf16* P = (const bf16*)(F.ws + WS_P); const float* rope = (const float*)(F.ws + WS_ROPE);
    bf16* QR = (bf16*)(F.ws + WS_QR); bf16* QC = (bf16*)(F.ws + WS_QC); bf16* KR = (bf16*)(F.ws + WS_KR); bf16* VT = (bf16*)(F.ws + WS_VT);
    const bool lat = rb < 128; const int b = lat ? (rb >> 6) : ((rb - 128) >> 2), t0 = lat ? (rb & 63) * 64 : ((rb - 128) & 3) * 64;
    const int row0 = lat ? b * TL + t0 : ML + b * CL + t0;
    {
        const int tk = F.tid >> 3, sub = F.tid & 7, isk = sub >> 2, hq = sub & 3, m = hq >> 1, half = hq & 1, t = t0 + tk;
        const bf16* src = P + (size_t)(row0 + tk) * NINP + (isk ? B_K : B_Q) + h * 128 + 32 * hq;
        float xx[32], oo[32];
#pragma unroll
        for (int i = 0; i < 4; ++i) unpack8(*(const u32x4*)(src + 8 * i), xx + 8 * i);
        if (lat) { const int pos = half ? (t & 63) : (t >> 6); const float* cs = rope + pos * 16; const float* sn = rope + 1024 + pos * 16;
#pragma unroll
            for (int i = 0; i < 16; ++i) { const float c = cs[i], s = sn[i]; oo[i] = xx[i] * c - xx[i + 16] * s; oo[i + 16] = xx[i + 16] * c + xx[i] * s; } }
        else {
#pragma unroll
            for (int i = 0; i < 32; ++i) oo[i] = xx[i]; }
        if (!isk) {
#pragma unroll
            for (int i = 0; i < 32; ++i) oo[i] *= QSCALE; }
        const int bhm = (b * 4 + h) * 2 + m;
        bf16* dst = isk ? KR + ((size_t)bhm * KEYS + (lat ? CL + t : t)) * 64 + 32 * half : (lat ? QR + ((size_t)bhm * TL + t) * 64 + 32 * half : QC + ((size_t)bhm * CL + t) * 64 + 32 * half);
        if (isk || lat || l == 0) {
#pragma unroll
            for (int i = 0; i < 4; ++i) *(u32x4*)(dst + 8 * i) = pack8(oo + 8 * i); }
    }
    LAS unsigned char* VL = F.lds;
#pragma unroll
    for (int pass = 0; pass < 2; ++pass) { const int idx = F.tid + 512 * pass, key = idx >> 4, c = idx & 15;
        *(LAS u32x4*)(VL + key * 272 + 16 * c) = *(const u32x4*)(P + (size_t)(row0 + key) * NINP + B_V + h * 128 + 8 * c); }
    WG_BAR();
    const int keybase = lat ? CL + t0 : t0;
#pragma unroll
    for (int pass = 0; pass < 2; ++pass) { const int idx = F.tid + 512 * pass, dv = idx >> 3, kc = idx & 7; unsigned short e[8];
#pragma unroll
        for (int i = 0; i < 8; ++i) e[i] = *(const LAS unsigned short*)(VL + (8 * kc + i) * 272 + 2 * dv);
        u32x4 o; o.x = e[0] | ((unsigned)e[1] << 16); o.y = e[2] | ((unsigned)e[3] << 16); o.z = e[4] | ((unsigned)e[5] << 16); o.w = e[6] | ((unsigned)e[7] << 16);
        *(u32x4*)(VT + ((size_t)(b * 4 + h) * 128 + dv) * KEYS + keybase + 8 * kc) = o; }
    WG_BAR();
}

constexpr int NCHUNK = NSTEP / 64;
constexpr int CHKB = 62464;
constexpr int CK_W1F = 0, CK_RF = 8192, CK_BTF = 16384, CK_ARBF = 24576, CK_ARKF = 30720, CK_VF = 36864, CK_W2A = 45056, CK_GA = 53248, CK_CLV = 61440;
static_assert((size_t)32 * NCHUNK * CHKB <= WS_Y - WS_CHK, "chunk records");

__device__ __forceinline__ bf16x8 frag16(const LAS unsigned char* tile, int row, int k0) { return *(const LAS bf16x8*)(tile + row * 144 + k0 * 2); }
__device__ __forceinline__ bf16x8 fragP(const LAS unsigned char* tile, int row, int base, int hh) {
    const u32x2 lo = *(const LAS u32x2*)(tile + row * 144 + (base + 4 * hh) * 2), hi = *(const LAS u32x2*)(tile + row * 144 + (base + 8 + 4 * hh) * 2);
    const u32x4 w = {lo.x, lo.y, hi.x, hi.y}; return __builtin_bit_cast(bf16x8, w);
}
template <int S8> __device__ __forceinline__ bf16x8 pk8(const f32x16& a) {
    const u32x4 w = {cvtpk(a[S8], a[S8 + 1]), cvtpk(a[S8 + 2], a[S8 + 3]), cvtpk(a[S8 + 4], a[S8 + 5]), cvtpk(a[S8 + 6], a[S8 + 7])}; return __builtin_bit_cast(bf16x8, w);
}
__device__ __forceinline__ f32x16 tile_prod(const LAS unsigned char* At, int m0, const LAS unsigned char* Bt, int n0, int l31, int hh) {
    f32x16 d = zero16();
#pragma unroll
    for (int q = 0; q < 4; ++q) d = __builtin_amdgcn_mfma_f32_32x32x16_bf16(frag16(At, m0 + l31, 16 * q + 8 * hh), frag16(Bt, n0 + l31, 16 * q + 8 * hh), d, 0, 0, 0);
    return d;
}
__device__ __forceinline__ void st_acc32(unsigned char* p, const f32x16& d) {
    *(u32x4*)p = (u32x4){cvtpk(d[0], d[1]), cvtpk(d[2], d[3]), cvtpk(d[4], d[5]), cvtpk(d[6], d[7])};
    *(u32x4*)(p + 16) = (u32x4){cvtpk(d[8], d[9]), cvtpk(d[10], d[11]), cvtpk(d[12], d[13]), cvtpk(d[14], d[15])};
}
__device__ __forceinline__ f32x16 ld_acc32(const LAS unsigned char* p) {
    const u32x4 a = *(const LAS u32x4*)p, b = *(const LAS u32x4*)(p + 16); f32x16 d;
    d[0] = bflo(a.x); d[1] = bfhi(a.x); d[2] = bflo(a.y); d[3] = bfhi(a.y); d[4] = bflo(a.z); d[5] = bfhi(a.z); d[6] = bflo(a.w); d[7] = bfhi(a.w);
    d[8] = bflo(b.x); d[9] = bfhi(b.x); d[10] = bflo(b.y); d[11] = bfhi(b.y); d[12] = bflo(b.z); d[13] = bfhi(b.z); d[14] = bflo(b.w); d[15] = bfhi(b.w); return d;
}
__device__ __forceinline__ float softplus_f(float x) { return fmaxf(x, 0.f) + __logf(1.f + __expf(-fabsf(x))); }
__device__ __forceinline__ int scan_row(int c, int i, int dir, int b) {
    const bool isctx = c < 4; const int bi = (isctx ? 64 * c : 64 * (c - 4)) + i;
    return isctx ? ML + b * CL + (dir ? CL - 1 - bi : bi) : b * TL + (dir ? TL - 1 - bi : bi);
}

struct R1In { u32x4 g_l, g_r, g_k, g_v, p_l, p_r, p_k, p_v; u32x2 g_a, p_a; };
__device__ __forceinline__ void r1_load(Ctx& F, int item, R1In& in) {
    const int scan = item / NCHUNK, c = item % NCHUNK, dir = scan >> 4, b = (scan >> 3) & 1, h = scan & 7;
    const bf16* P = (const bf16*)(F.ws + WS_P);
    const int i = F.tid >> 3, sub = F.tid & 7, c0 = 8 * sub, gc0 = h * 64 + c0;
    const bool isctx = c < 4; const int bi = (isctx ? 64 * c : 64 * (c - 4)) + i;
    const int row = scan_row(c, i, dir, b);
    const bf16* pr = P + (size_t)row * NINP; const bf16* pp = (bi > 0) ? (dir ? pr + NINP : pr - NINP) : pr;
    const int CLX = dir == 0 ? C_LF : C_LB;
    in.g_l = *(const u32x4*)(pr + CLX + c0); in.g_r = *(const u32x4*)(pr + C_R + gc0); in.g_k = *(const u32x4*)(pr + C_K + gc0); in.g_v = *(const u32x4*)(pr + C_V + gc0); in.g_a = *(const u32x2*)(pr + CLX + 64 + 4 * sub);
    in.p_l = *(const u32x4*)(pp + CLX + c0); in.p_r = *(const u32x4*)(pp + C_R + gc0); in.p_k = *(const u32x4*)(pp + C_K + gc0); in.p_v = *(const u32x4*)(pp + C_V + gc0); in.p_a = *(const u32x2*)(pp + CLX + 64 + 4 * sub);
}
__device__ __forceinline__ void rwkv1_item(Ctx& F, int l, int item, R1In& in, int next_item) {
    const int scan = item / NCHUNK, c = item % NCHUNK, dir = scan >> 4, b = (scan >> 3) & 1, h = scan & 7;
    const bf16* P = (const bf16*)(F.ws + WS_P); unsigned char* rec = F.ws + WS_CHK + (size_t)item * CHKB;
    bf16* BON = (bf16*)(F.ws + WS_BON) + (size_t)dir * MT * 512;
    LAS unsigned char* TA = F.lds; LAS unsigned char* TB = F.lds + 9216; LAS unsigned char* TK = F.lds + 18432; LAS unsigned char* TR = F.lds + 27648;
    LAS unsigned char* TAT = F.lds + 36864; LAS unsigned char* TBT = F.lds + 46080; LAS unsigned char* TKT = F.lds + 55296; LAS unsigned char* TVT = F.lds + 64512;
    LAS unsigned char* TT = F.lds + 73728;
    LAS float* AAB = (LAS float*)(F.lds + 82944);
    LAS float* CLS = (LAS float*)(F.lds + 100352);
    LAS unsigned char* A21B = F.lds + 116736; LAS unsigned char* T11T = F.lds + 119296;
    LAS unsigned char* LWH = F.lds;             LAS unsigned char* LWL = F.lds + 9216;
    LAS unsigned char* LAH = F.lds + 18432;     LAS unsigned char* LAL = F.lds + 23552;
    LAS unsigned char* XWH = F.lds + 28672;     LAS unsigned char* XWL = F.lds + 37888;
    LAS unsigned char* XAH = F.lds + 47104;     LAS unsigned char* XAL = F.lds + 52224;
    LAS float* OW = (LAS float*)(F.lds + 57344);
    LAS float* OA = (LAS float*)(F.lds + 74752);
    const int i = F.tid >> 3, sub = F.tid & 7, c0 = 8 * sub, gc0 = h * 64 + c0;
    const bool isctx = c < 4; const int bi = (isctx ? 64 * c : 64 * (c - 4)) + i;
    const int row = scan_row(c, i, dir, b);
    const bool hasprev = bi > 0;
    const bf16* pr = P + (size_t)row * NINP; const bf16* pp = dir ? pr + NINP : pr - NINP;
    const int pd = l * 2 + dir;
    const float* mu = F.prm->in[17] + (size_t)pd * 1632; const float* w0 = F.prm->in[18] + (size_t)pd * 512; const float* w2 = F.prm->in[19] + (size_t)pd * 64 * 512;
    const float* a0 = F.prm->in[20] + (size_t)pd * 512; const float* a2 = F.prm->in[21] + (size_t)pd * 32 * 512; const float* k_k = F.prm->in[22] + (size_t)pd * 512;
    const float* k_a = F.prm->in[23] + (size_t)pd * 512; const float* r_k = F.prm->in[24] + (size_t)pd * 512;
    const int CLX = dir == 0 ? C_LF : C_LB;
    f32x4 pm_[16];
    { const float* pv_[8] = {mu + gc0, mu + 512 + gc0, mu + 1024 + gc0, w0 + gc0, a0 + gc0, k_k + gc0, k_a + gc0, r_k + gc0};
#pragma unroll
      for (int v = 0; v < 8; ++v) { pm_[2 * v] = *(const f32x4*)(pv_[v]); pm_[2 * v + 1] = *(const f32x4*)(pv_[v] + 4); } }
#define PM(v, e) (pm_[2 * (v) + ((e) >> 2)][(e) & 3])
    const u32x4 zz4 = {0u, 0u, 0u, 0u}; const u32x2 zz2 = {0u, 0u};
    const u32x4 g_l = in.g_l, g_r = in.g_r, g_k = in.g_k, g_v = in.g_v; const u32x2 g_a = in.g_a;
    const u32x4 p_l = hasprev ? in.p_l : zz4, p_r = hasprev ? in.p_r : zz4, p_k = hasprev ? in.p_k : zz4, p_v = hasprev ? in.p_v : zz4; const u32x2 p_a = hasprev ? in.p_a : zz2;
    {
        const unsigned char* lwg = F.ws + WS_LW + (size_t)(pd * 8 + h) * 24576;
        { const int p = F.tid, r = p >> 3, cq = p & 7; *(LAS u32x4*)(LWH + r * 144 + cq * 16) = *(const u32x4*)(lwg + p * 16); *(LAS u32x4*)(LWL + r * 144 + cq * 16) = *(const u32x4*)(lwg + 8192 + p * 16); }
        { const int p = F.tid & 255, r = p >> 2, cq = p & 3; LAS unsigned char* dst = (F.tid < 256 ? LAH : LAL); *(LAS u32x4*)(dst + r * 80 + cq * 16) = *(const u32x4*)(lwg + 16384 + (F.tid < 256 ? 0 : 4096) + p * 16); }
    }
    {   float f[8], pv[8], th[8], tl[8]; unpack8(g_l, f); unpack8(p_l, pv);
        const f32x4 mw0 = *(const f32x4*)(mu + 1536 + c0), mw1 = *(const f32x4*)(mu + 1536 + c0 + 4), ma0 = *(const f32x4*)(mu + 1600 + 4 * sub); const float muw[8] = {mw0.x, mw0.y, mw0.z, mw0.w, mw1.x, mw1.y, mw1.z, mw1.w}, mua[4] = {ma0.x, ma0.y, ma0.z, ma0.w};
#pragma unroll
        for (int e = 0; e < 8; ++e) { const float z = f[e] + (pv[e] - f[e]) * muw[e]; const float ez = __expf(-2.f * fabsf(z)); const float t0 = (1.f - ez) * __builtin_amdgcn_rcpf(1.f + ez); const float tv = z < 0.f ? -t0 : t0;
            th[e] = bflo(cvtpk(tv, 0.f)); tl[e] = tv - th[e]; }
        *(LAS u32x4*)(XWH + i * 144 + 2 * c0) = pack8(th); *(LAS u32x4*)(XWL + i * 144 + 2 * c0) = pack8(tl);
        const float fz[4] = {bflo(g_a.x), bfhi(g_a.x), bflo(g_a.y), bfhi(g_a.y)}, pz[4] = {bflo(p_a.x), bfhi(p_a.x), bflo(p_a.y), bfhi(p_a.y)}; float zh[4], zl[4];
#pragma unroll
        for (int e = 0; e < 4; ++e) { const float z = fz[e] + (pz[e] - fz[e]) * mua[e]; zh[e] = bflo(cvtpk(z, 0.f)); zl[e] = z - zh[e]; }
        *(LAS u32x2*)(XAH + i * 80 + 8 * sub) = (u32x2){cvtpk(zh[0], zh[1]), cvtpk(zh[2], zh[3])}; *(LAS u32x2*)(XAL + i * 80 + 8 * sub) = (u32x2){cvtpk(zl[0], zl[1]), cvtpk(zl[2], zl[3])};
    }
    WG_BAR();
    {
        const int l31 = F.lane & 31, hh = F.lane >> 5, mt = (F.wave >> 1) & 1, nt = F.wave & 1;
        f32x16 d = zero16();
        if (F.wave < 4) {
#pragma unroll
            for (int q = 0; q < 4; ++q) { const bf16x8 ah = frag16(XWH, 32 * mt + l31, 16 * q + 8 * hh), al_ = frag16(XWL, 32 * mt + l31, 16 * q + 8 * hh), bh = frag16(LWH, 32 * nt + l31, 16 * q + 8 * hh), bl = frag16(LWL, 32 * nt + l31, 16 * q + 8 * hh);
                d = __builtin_amdgcn_mfma_f32_32x32x16_bf16(ah, bh, d, 0, 0, 0); d = __builtin_amdgcn_mfma_f32_32x32x16_bf16(ah, bl, d, 0, 0, 0); d = __builtin_amdgcn_mfma_f32_32x32x16_bf16(al_, bh, d, 0, 0, 0); }
#pragma unroll
            for (int r = 0; r < 16; ++r) OW[(32 * mt + MROW(r, hh)) * 68 + 32 * nt + l31] = d[r];
        } else {
#pragma unroll
            for (int q = 0; q < 2; ++q) { const int ko = (16 * q + 8 * hh) * 2;
                const bf16x8 ah = *(const LAS bf16x8*)(XAH + (32 * mt + l31) * 80 + ko), al_ = *(const LAS bf16x8*)(XAL + (32 * mt + l31) * 80 + ko), bh = *(const LAS bf16x8*)(LAH + (32 * nt + l31) * 80 + ko), bl = *(const LAS bf16x8*)(LAL + (32 * nt + l31) * 80 + ko);
                d = __builtin_amdgcn_mfma_f32_32x32x16_bf16(ah, bh, d, 0, 0, 0); d = __builtin_amdgcn_mfma_f32_32x32x16_bf16(ah, bl, d, 0, 0, 0); d = __builtin_amdgcn_mfma_f32_32x32x16_bf16(al_, bh, d, 0, 0, 0); }
#pragma unroll
            for (int r = 0; r < 16; ++r) OA[(32 * mt + MROW(r, hh)) * 68 + 32 * nt + l31] = d[r];
        }
    }
    WG_BAR();
    float wp[8], ap[8];
    { const f32x4 a = *(const LAS f32x4*)(OW + i * 68 + c0), bq = *(const LAS f32x4*)(OW + i * 68 + c0 + 4), cq = *(const LAS f32x4*)(OA + i * 68 + c0), dq = *(const LAS f32x4*)(OA + i * 68 + c0 + 4);
      const float ow[8] = {a.x, a.y, a.z, a.w, bq.x, bq.y, bq.z, bq.w}, oa[8] = {cq.x, cq.y, cq.z, cq.w, dq.x, dq.y, dq.z, dq.w};
#pragma unroll
      for (int e = 0; e < 8; ++e) { wp[e] = PM(3, e) + ow[e]; ap[e] = PM(4, e) + oa[e]; } }
    float lw[8], kk[8], al[8], km[8], rr[8], vv[8];
    {   float fr[8], fk[8], fv[8], qr[8], qk[8], qv[8]; unpack8(g_r, fr); unpack8(g_k, fk); unpack8(g_v, fv); unpack8(p_r, qr); unpack8(p_k, qk); unpack8(p_v, qv);
        float n2 = 0.f, bsum = 0.f;
#pragma unroll
        for (int e = 0; e < 8; ++e) { const int gc = gc0 + e;
            rr[e] = fr[e] + (qr[e] - fr[e]) * PM(0, e); const float kx = fk[e] + (qk[e] - fk[e]) * PM(1, e); vv[e] = fv[e] + (qv[e] - fv[e]) * PM(2, e);
            const float w = -softplus_f(-wp[e]) - 0.5f; lw[e] = -__expf(w);
            al[e] = __builtin_amdgcn_rcpf(1.f + __expf(-ap[e]));
            kk[e] = kx * PM(5, e); n2 += kk[e] * kk[e];
            km[e] = kx * (1.f + (al[e] - 1.f) * PM(6, e));
            bsum += rr[e] * km[e] * PM(7, e); }
        n2 = red8(n2); bsum = red8(bsum);
        const float inv = __builtin_amdgcn_rsqf(fmaxf(n2, 1e-24f)); float bon[8];
#pragma unroll
        for (int e = 0; e < 8; ++e) { kk[e] *= inv; bon[e] = bsum * vv[e]; }
        *(u32x4*)(BON + (size_t)row * 512 + gc0) = pack8(bon);
    }
    *(LAS f32x4*)(CLS + i * 64 + c0) = (f32x4){lw[0], lw[1], lw[2], lw[3]}; *(LAS f32x4*)(CLS + i * 64 + c0 + 4) = (f32x4){lw[4], lw[5], lw[6], lw[7]};
    WG_BAR();
    if (F.tid < 64) {
        float x[64];
#pragma unroll
        for (int q = 0; q < 64; ++q) x[q] = CLS[q * 64 + F.tid];
#pragma unroll
        for (int q = 1; q < 64; ++q) x[q] += x[q - 1];
#pragma unroll
        for (int q = 0; q < 64; ++q) CLS[q * 64 + F.tid] = x[q];
    }
    WG_BAR();
    {   float cl[8], cL[8];
        { const f32x4 a = *(const LAS f32x4*)(CLS + i * 64 + c0), bq = *(const LAS f32x4*)(CLS + i * 64 + c0 + 4), cc = *(const LAS f32x4*)(CLS + 63 * 64 + c0), dd = *(const LAS f32x4*)(CLS + 63 * 64 + c0 + 4);
          cl[0] = a.x; cl[1] = a.y; cl[2] = a.z; cl[3] = a.w; cl[4] = bq.x; cl[5] = bq.y; cl[6] = bq.z; cl[7] = bq.w; cL[0] = cc.x; cL[1] = cc.y; cL[2] = cc.z; cL[3] = cc.w; cL[4] = dd.x; cL[5] = dd.y; cL[6] = dd.z; cL[7] = dd.w; }
        float tA[8], tB[8], tK[8], tR[8], tBt[8], tKt[8];
#pragma unroll
        for (int e = 0; e < 8; ++e) { const float eA = __expf(cl[e] - lw[e]), eI = __expf(-cl[e]), eR = __expf(cl[e]), eT = __expf(cL[e] - cl[e]); const float ba = kk[e] * al[e];
            tA[e] = -kk[e] * eA; tB[e] = ba * eI; tK[e] = km[e] * eI; tR[e] = rr[e] * eR; tBt[e] = ba * eT; tKt[e] = km[e] * eT; }
        *(LAS u32x4*)(TA + i * 144 + 2 * c0) = pack8(tA); *(LAS u32x4*)(TB + i * 144 + 2 * c0) = pack8(tB); *(LAS u32x4*)(TK + i * 144 + 2 * c0) = pack8(tK); *(LAS u32x4*)(TR + i * 144 + 2 * c0) = pack8(tR);
        const u32x4 qa = pack8(tA), qb = pack8(tBt), qk = pack8(tKt), qv = pack8(vv);
        const unsigned wa[4] = {qa.x, qa.y, qa.z, qa.w}, wb[4] = {qb.x, qb.y, qb.z, qb.w}, wk[4] = {qk.x, qk.y, qk.z, qk.w}, wv[4] = {qv.x, qv.y, qv.z, qv.w};
#pragma unroll
        for (int e0 = 0; e0 < 8; ++e0) { const int e = (e0 + sub) & 7;
            const unsigned ua = e < 2 ? wa[0] : e < 4 ? wa[1] : e < 6 ? wa[2] : wa[3], ub_ = e < 2 ? wb[0] : e < 4 ? wb[1] : e < 6 ? wb[2] : wb[3];
            const unsigned uk = e < 2 ? wk[0] : e < 4 ? wk[1] : e < 6 ? wk[2] : wk[3], uv = e < 2 ? wv[0] : e < 4 ? wv[1] : e < 6 ? wv[2] : wv[3];
            const int sh = (e & 1) * 16; const int o = (c0 + e) * 144 + 2 * i;
            *(LAS unsigned short*)(TAT + o) = (unsigned short)(ua >> sh); *(LAS unsigned short*)(TBT + o) = (unsigned short)(ub_ >> sh);
            *(LAS unsigned short*)(TKT + o) = (unsigned short)(uk >> sh); *(LAS unsigned short*)(TVT + o) = (unsigned short)(uv >> sh); }
    }
    WG_BAR();
    const int l31 = F.lane & 31, hh = F.lane >> 5;
    if (F.wave < 3) { const int it = F.wave > 0, jt = F.wave > 1; const f32x16 d = tile_prod(TA, 32 * it, TB, 32 * jt, l31, hh);
#pragma unroll
        for (int r = 0; r < 16; ++r) { const int ii = 32 * it + MROW(r, hh), j = 32 * jt + l31; AAB[ii * 68 + (j & 7) * 8 + (j >> 3)] = j < ii ? d[r] : 0.f; }
        if (F.wave == 1) {
#pragma unroll
            for (int r = 0; r < 16; r += 2) { const unsigned w = cvtpk(d[r], d[r + 1]); *(LAS unsigned short*)(A21B + MROW(r, hh) * 80 + 2 * l31) = (unsigned short)w; *(LAS unsigned short*)(A21B + MROW(r + 1, hh) * 80 + 2 * l31) = (unsigned short)(w >> 16); } } }
    else if (F.wave == 3) {
#pragma unroll
        for (int r = 0; r < 16; ++r) AAB[(2 * r + hh) * 68 + (l31 & 7) * 8 + 4 + (l31 >> 3)] = 0.f; }
    else if (F.wave == 4) {
#pragma unroll
        for (int f = 0; f < 8; ++f) { const int it = f >> 2, kt = (f >> 1) & 1, s = f & 1; *(bf16x8*)(rec + CK_RF + (f * 64 + F.lane) * 16) = fragP(TR, 32 * it + l31, 32 * kt + 16 * s, hh); } }
    else if (F.wave == 5) {
#pragma unroll
        for (int f = 0; f < 8; ++f) { const int kt = f >> 2, jt = (f >> 1) & 1, s = f & 1; *(bf16x8*)(rec + CK_BTF + (f * 64 + F.lane) * 16) = fragP(TBT, 32 * kt + l31, 32 * jt + 16 * s, hh); } }
    else if (F.wave == 6) {
#pragma unroll
        for (int f = 0; f < 8; ++f) { const int vt = f >> 2, jt = (f >> 1) & 1, s = f & 1; *(bf16x8*)(rec + CK_VF + (f * 64 + F.lane) * 16) = fragP(TVT, 32 * vt + l31, 32 * jt + 16 * s, hh); } }
    else { *(float*)(rec + CK_CLV + 4 * F.lane) = __expf(CLS[63 * 64 + F.lane]); }
    WG_BAR();
    {   const int blk = F.tid >> 8, col = (F.tid >> 3) & 31; int dg = col; float town[4];
#pragma unroll
        for (int q = 0; q < 4; ++q) town[q] = 0.f;
        const LAS float* arow = AAB + blk * 32 * 68 + sub * 8 + blk * 4; asm volatile("" : "+v"(arow));
        f32x4 na0 = *(const LAS f32x4*)(arow);
#pragma unroll
        for (int q = 0; q < 4; ++q)
#pragma unroll
            for (int r = 0; r < 8; ++r) { const int ii = 8 * q + r;
                const f32x4 a0 = na0;
                if (ii + 1 < 32) na0 = *(const LAS f32x4*)(arow + (ii + 1) * 68);
                float p = a0.x * town[0];
                if (q >= 1) p += a0.y * town[1]; if (q >= 2) p += a0.z * town[2]; if (q >= 3) p += a0.w * town[3];
                p = red8(p);
                const float tv = p + ((dg == 0) ? 1.f : 0.f); dg -= 1; asm volatile("" : "+v"(dg));
                town[q] = (sub == r) ? tv : town[q];
            }
        LAS unsigned char* ttw = TT + (blk * 32) * 144 + 2 * (blk * 32 + col);
#pragma unroll
        for (int q = 0; q < 4; ++q) { const unsigned short tb = (unsigned short)cvtpk(town[q], 0.f); *(LAS unsigned short*)(ttw + (8 * q + sub) * 144) = tb;
            if (blk == 0) *(LAS unsigned short*)(T11T + col * 80 + 2 * (8 * q + sub)) = tb; }
        if (blk == 1) { const int t = F.tid - 256; *(LAS u32x2*)(TT + (t >> 3) * 144 + 64 + 8 * (t & 7)) = (u32x2){0u, 0u}; }
    }
    WG_BAR();
    if (F.wave == 0) {
        f32x16 m = zero16();
#pragma unroll
        for (int s2 = 0; s2 < 2; ++s2) m = __builtin_amdgcn_mfma_f32_32x32x16_bf16(*(const LAS bf16x8*)(A21B + l31 * 80 + (16 * s2 + 8 * hh) * 2), *(const LAS bf16x8*)(T11T + l31 * 80 + (16 * s2 + 8 * hh) * 2), m, 0, 0, 0);
        f32x16 t21 = zero16();
        t21 = __builtin_amdgcn_mfma_f32_32x32x16_bf16(fragP(TT, 32 + l31, 32, hh), pk8<0>(m), t21, 0, 0, 0);
        t21 = __builtin_amdgcn_mfma_f32_32x32x16_bf16(fragP(TT, 32 + l31, 48, hh), pk8<8>(m), t21, 0, 0, 0);
#pragma unroll
        for (int r = 0; r < 16; r += 2) { const unsigned w = cvtpk(t21[r], t21[r + 1]); *(LAS unsigned short*)(TT + (32 + MROW(r, hh)) * 144 + 2 * l31) = (unsigned short)w; *(LAS unsigned short*)(TT + (32 + MROW(r + 1, hh)) * 144 + 2 * l31) = (unsigned short)(w >> 16); }
    }
    f32x16 X0 = zero16(), X1 = zero16();
    if (F.wave == 0) {
    } else if (F.wave <= 2) {
        const int vt = F.wave - 1;
        f32x16 a00 = tile_prod(TK, 0, TA, 0, l31, hh), a11 = tile_prod(TK, 32, TA, 32, l31, hh); const f32x16 a01 = tile_prod(TK, 0, TA, 32, l31, hh);
#pragma unroll
        for (int r = 0; r < 16; ++r) { const bool keep = MROW(r, hh) < l31; a00[r] = keep ? a00[r] : 0.f; a11[r] = keep ? a11[r] : 0.f; }
        X0 = __builtin_amdgcn_mfma_f32_32x32x16_bf16(pk8<0>(a00), fragP(TVT, 32 * vt + l31, 0, hh), X0, 0, 0, 0);
        X0 = __builtin_amdgcn_mfma_f32_32x32x16_bf16(pk8<8>(a00), fragP(TVT, 32 * vt + l31, 16, hh), X0, 0, 0, 0);
        X1 = __builtin_amdgcn_mfma_f32_32x32x16_bf16(pk8<0>(a01), fragP(TVT, 32 * vt + l31, 0, hh), X1, 0, 0, 0);
        X1 = __builtin_amdgcn_mfma_f32_32x32x16_bf16(pk8<8>(a01), fragP(TVT, 32 * vt + l31, 16, hh), X1, 0, 0, 0);
        X1 = __builtin_amdgcn_mfma_f32_32x32x16_bf16(pk8<0>(a11), fragP(TVT, 32 * vt + l31, 32, hh), X1, 0, 0, 0);
        X1 = __builtin_amdgcn_mfma_f32_32x32x16_bf16(pk8<8>(a11), fragP(TVT, 32 * vt + l31, 48, hh), X1, 0, 0, 0);
    } else if (F.wave <= 4) {
        const LAS unsigned char* Tm = F.wave == 3 ? TB : TK; unsigned char* dst = rec + (F.wave == 3 ? CK_ARBF : CK_ARKF);
#pragma unroll
        for (int blk = 0; blk < 3; ++blk) { const int it = blk > 0, jt = blk > 1; f32x16 d = tile_prod(Tm, 32 * jt, TR, 32 * it, l31, hh);
            if (it == jt) {
#pragma unroll
                for (int r = 0; r < 16; ++r) d[r] = MROW(r, hh) <= l31 ? d[r] : 0.f; }
            *(bf16x8*)(dst + ((blk * 2 + 0) * 64 + F.lane) * 16) = pk8<0>(d); *(bf16x8*)(dst + ((blk * 2 + 1) * 64 + F.lane) * 16) = pk8<8>(d); }
    } else if (F.wave <= 6) {
        const int kt = F.wave - 5;
#pragma unroll
        for (int vt = 0; vt < 2; ++vt) { const f32x16 d = tile_prod(TKT, 32 * kt, TVT, 32 * vt, l31, hh); st_acc32(rec + CK_GA + ((kt * 2 + vt) * 64 + F.lane) * 32, d); }
    }
    WG_BAR();
    if (F.wave == 1 || F.wave == 2) { const int vt = F.wave - 1;
        f32x16 w0a = zero16(), w1a = zero16();
        w0a = __builtin_amdgcn_mfma_f32_32x32x16_bf16(fragP(TT, l31, 0, hh), pk8<0>(X0), w0a, 0, 0, 0);
        w0a = __builtin_amdgcn_mfma_f32_32x32x16_bf16(fragP(TT, l31, 16, hh), pk8<8>(X0), w0a, 0, 0, 0);
        w1a = __builtin_amdgcn_mfma_f32_32x32x16_bf16(fragP(TT, 32 + l31, 0, hh), pk8<0>(X0), w1a, 0, 0, 0);
        w1a = __builtin_amdgcn_mfma_f32_32x32x16_bf16(fragP(TT, 32 + l31, 16, hh), pk8<8>(X0), w1a, 0, 0, 0);
        w1a = __builtin_amdgcn_mfma_f32_32x32x16_bf16(fragP(TT, 32 + l31, 32, hh), pk8<0>(X1), w1a, 0, 0, 0);
        w1a = __builtin_amdgcn_mfma_f32_32x32x16_bf16(fragP(TT, 32 + l31, 48, hh), pk8<8>(X1), w1a, 0, 0, 0);
        st_acc32(rec + CK_W2A + ((0 * 2 + vt) * 64 + F.lane) * 32, w0a); st_acc32(rec + CK_W2A + ((1 * 2 + vt) * 64 + F.lane) * 32, w1a);
    } else if (F.wave >= 3 && F.wave <= 6) { const int kt = (F.wave - 3) >> 1, it = (F.wave - 3) & 1;
        const f32x16 d = tile_prod(TAT, 32 * kt, TT, 32 * it, l31, hh);
        *(bf16x8*)(rec + CK_W1F + ((((it * 2 + kt) * 2) + 0) * 64 + F.lane) * 16) = pk8<0>(d); *(bf16x8*)(rec + CK_W1F + ((((it * 2 + kt) * 2) + 1) * 64 + F.lane) * 16) = pk8<8>(d);
    }
    WG_BAR();
}

#ifdef TS_R2
#define R2BAR() do { const unsigned long long t0_ = __builtin_amdgcn_s_memrealtime(); WG_BAR(); r2wait += __builtin_amdgcn_s_memrealtime() - t0_; } while (0)
#else
#define R2BAR() WG_BAR()
#endif
template <int NC> __device__ __forceinline__ void rwkv2_role(Ctx& F, int cb) {
    unsigned long long r2wait = 0;
    const int scan = F.bx, dir = scan >> 4, b = (scan >> 3) & 1, h = scan & 7;
    const unsigned char* recs = F.ws + WS_CHK + ((size_t)scan * NCHUNK + cb) * CHKB;
    static_assert(NC % 2 == 0, "the Y waves alternate two register sets");
    float* Y = (float*)(F.ws + WS_Y) + (size_t)dir * MT * 512 + h * 64;
    const int l31 = F.lane & 31, hh = F.lane >> 5;
    constexpr int RSL = 33792, R_W1F = 0, R_BTF = 8192, R_W2A = 16384, R_GA = 24576, R_CLV = 32768;
    constexpr int EXO = 3 * RSL;
#define FR(off, idx) (*(const LAS bf16x8*)(lf + (off) + (idx) * 1024))
#define MM(a_, b_, c_) c_ = __builtin_amdgcn_mfma_f32_32x32x16_bf16(a_, b_, c_, 0, 0, 0)
    if (F.wave < 2) {
        const int vt = F.wave;
        f32x16 S0 = zero16(), S1 = zero16();
        float* sst = (float*)(F.ws + WS_SST) + ((size_t)(scan * 2 + vt) * 2 * 64 + F.lane) * 16;
        if (cb > 0) {
#pragma unroll
            for (int g = 0; g < 4; ++g) { const f32x4 a_ = *(const f32x4*)(sst + 4 * g), b_ = *(const f32x4*)(sst + 1024 + 4 * g);
#pragma unroll
                for (int e = 0; e < 4; ++e) { S0[4 * g + e] = a_[e]; S1[4 * g + e] = b_[e]; } } }
        R2BAR();
        for (int c = 0; c <= NC; ++c) {
            if (c < NC) {
                const LAS unsigned char* buf = F.lds + (c % 3) * RSL; const LAS unsigned char* lf = buf + F.lane * 16;
                LAS unsigned char* ex = F.lds + EXO + (c & 1) * 16384 + vt * 8192 + F.lane * 16;
                const bf16x8 sb00 = pk8<0>(S0), sb01 = pk8<8>(S0), sb10 = pk8<0>(S1), sb11 = pk8<8>(S1);
                *(LAS bf16x8*)(ex) = sb00; *(LAS bf16x8*)(ex + 1024) = sb01; *(LAS bf16x8*)(ex + 2048) = sb10; *(LAS bf16x8*)(ex + 3072) = sb11;
                f32x16 U0 = ld_acc32(buf + R_W2A + ((0 * 2 + vt) * 64 + F.lane) * 32), U1 = ld_acc32(buf + R_W2A + ((1 * 2 + vt) * 64 + F.lane) * 32);
                MM(FR(R_W1F, 0), sb00, U0); MM(FR(R_W1F, 4), sb00, U1); MM(FR(R_W1F, 1), sb01, U0); MM(FR(R_W1F, 5), sb01, U1);
                MM(FR(R_W1F, 2), sb10, U0); MM(FR(R_W1F, 6), sb10, U1); MM(FR(R_W1F, 3), sb11, U0); MM(FR(R_W1F, 7), sb11, U1);
                { const LAS float* clv = (const LAS float*)(buf + R_CLV);
                  const f32x16 g0 = ld_acc32(buf + R_GA + ((0 * 2 + vt) * 64 + F.lane) * 32), g1 = ld_acc32(buf + R_GA + ((1 * 2 + vt) * 64 + F.lane) * 32);
#pragma unroll
                  for (int g = 0; g < 4; ++g) { const f32x4 ca = *(const LAS f32x4*)(clv + 8 * g + 4 * hh), cb = *(const LAS f32x4*)(clv + 32 + 8 * g + 4 * hh);
#pragma unroll
                      for (int e = 0; e < 4; ++e) { S0[4 * g + e] = S0[4 * g + e] * ca[e] + g0[4 * g + e]; S1[4 * g + e] = S1[4 * g + e] * cb[e] + g1[4 * g + e]; } } }
                const bf16x8 ub00 = pk8<0>(U0), ub01 = pk8<8>(U0), ub10 = pk8<0>(U1), ub11 = pk8<8>(U1);
                *(LAS bf16x8*)(ex + 4096) = ub00; *(LAS bf16x8*)(ex + 5120) = ub01; *(LAS bf16x8*)(ex + 6144) = ub10; *(LAS bf16x8*)(ex + 7168) = ub11;
                MM(FR(R_BTF, 0), ub00, S0); MM(FR(R_BTF, 4), ub00, S1); MM(FR(R_BTF, 1), ub01, S0); MM(FR(R_BTF, 5), ub01, S1);
                MM(FR(R_BTF, 2), ub10, S0); MM(FR(R_BTF, 6), ub10, S1); MM(FR(R_BTF, 3), ub11, S0); MM(FR(R_BTF, 7), ub11, S1);
            }
            R2BAR();
        }
        if (cb + NC < NCHUNK) {
#pragma unroll
            for (int g = 0; g < 4; ++g) { *(f32x4*)(sst + 4 * g) = (f32x4){S0[4 * g], S0[4 * g + 1], S0[4 * g + 2], S0[4 * g + 3]}; *(f32x4*)(sst + 1024 + 4 * g) = (f32x4){S1[4 * g], S1[4 * g + 1], S1[4 * g + 2], S1[4 * g + 3]}; } }
    } else if (F.wave < 6) {
        const int w = F.wave - 2, vt = w & 1, it = w >> 1;
        const long ystep = dir ? -512 : 512;
        bf16x8 fa[16], fb[16];
        const int o_rf = CK_RF + it * 4096, o_ark = CK_ARKF + it * 2048, o_arb = CK_ARBF + it * 2048, o_vf = CK_VF + vt * 4096;
#define YLD(f, c_) do { const unsigned char* g_ = recs + (size_t)(c_) * CHKB + F.lane * 16; \
            _Pragma("unroll") for (int k = 0; k < 4; ++k) { f[k] = *(const bf16x8*)(g_ + o_rf + k * 1024); f[4 + k] = *(const bf16x8*)(g_ + o_ark + k * 1024); f[8 + k] = *(const bf16x8*)(g_ + o_arb + k * 1024); f[12 + k] = *(const bf16x8*)(g_ + o_vf + k * 1024); } } while (0)
#define YDO(f, cm1) do { const LAS unsigned char* ex = F.lds + EXO + ((cm1) & 1) * 16384 + vt * 8192 + F.lane * 16; \
            const bf16x8 sb00 = *(const LAS bf16x8*)(ex), sb01 = *(const LAS bf16x8*)(ex + 1024), sb10 = *(const LAS bf16x8*)(ex + 2048), sb11 = *(const LAS bf16x8*)(ex + 3072); \
            const bf16x8 ub00 = *(const LAS bf16x8*)(ex + 4096), ub01 = *(const LAS bf16x8*)(ex + 5120), ub10 = *(const LAS bf16x8*)(ex + 6144), ub11 = *(const LAS bf16x8*)(ex + 7168); \
            f32x16 Yt = zero16(); \
            MM(f[0], sb00, Yt); MM(f[1], sb01, Yt); MM(f[2], sb10, Yt); MM(f[3], sb11, Yt); \
            MM(f[4], f[12], Yt); MM(f[5], f[13], Yt); MM(f[8], ub00, Yt); MM(f[9], ub01, Yt); \
            if (it) { MM(f[6], f[14], Yt); MM(f[7], f[15], Yt); MM(f[10], ub10, Yt); MM(f[11], ub11, Yt); } \
            float* yp = Y + (size_t)scan_row(cb + (cm1), 32 * it + 4 * hh, dir, b) * 512 + 32 * vt + l31; \
            _Pragma("unroll") for (int g = 0; g < 4; ++g) { float* yg = yp + 8 * g * ystep; \
                _Pragma("unroll") for (int e = 0; e < 4; ++e) yg[e * ystep] = Yt[4 * g + e]; } } while (0)
        YLD(fa, 0); YLD(fb, 1);
        R2BAR();
        R2BAR();
        for (int c = 1; c <= NC; c += 2) {
            YDO(fa, c - 1); YLD(fa, (c + 1 < NC ? c + 1 : NC - 1));
            R2BAR();
            YDO(fb, c); YLD(fb, (c + 2 < NC ? c + 2 : NC - 1));
            R2BAR();
        }
#undef YLD
#undef YDO
    } else {
        int gsrc[17], ldst[17];
#pragma unroll
        for (int k = 0; k < 17; ++k) { int q = F.wave - 6 + 2 * k; q = q < 32 ? q : 32; const int rp = q < 8 ? q : (q < 16 ? q + 8 : q + 28); gsrc[k] = rp * 1024 + F.lane * 16; ldst[k] = q * 1024; }
#define R2_DMA(c_) do { const int cc_ = (c_) < NC ? (c_) : NC - 1; const int sl_ = ((c_) % 3) * RSL; _Pragma("unroll") for (int k = 0; k < 17; ++k) \
            __builtin_amdgcn_global_load_lds((const unsigned*)(recs + (size_t)cc_ * CHKB + gsrc[k]), (LAS unsigned*)(F.lds + sl_ + ldst[k]), 16, 0, 0); } while (0)
        R2_DMA(0); R2_DMA(1);
        asm volatile("s_waitcnt vmcnt(17)" ::: "memory");
        R2BAR();
        for (int c = 0; c <= NC; ++c) {
            R2_DMA(c + 2);
            asm volatile("s_waitcnt vmcnt(17)" ::: "memory");
            R2BAR();
        }
        asm volatile("s_waitcnt vmcnt(0)" ::: "memory");
#define R2_LD(a, b)
#define R2_WR(a, b)
#undef R2_LD
#undef R2_WR
    }
#undef FR
#undef MM
#ifdef TS_R2
    if (F.lane == 0 && F.bx == 0) ((unsigned*)(F.ws + WS_CTL))[2048 + F.wave] += (unsigned)r2wait;
#endif
}

#ifndef R_SGU
#define R_SGU 1
#endif
#ifndef R_R1
#define R_R1 1
#endif
#ifndef R_R2
#define R_R2 1
#endif
#ifndef R_AP
#define R_AP 1
#endif
#ifndef R_CV
#define R_CV 1
#endif
constexpr int NCH1 = 34, NCH2 = NCHUNK - NCH1;
__device__ __forceinline__ void r1_range(Ctx& F, int l, int c0, int nc, int w, int nw) {
    for (int q = w; q < 32 * nc; q += nw) { R1In in; const int item = (q / nc) * NCHUNK + c0 + q % nc; r1_load(F, item, in); rwkv1_item(F, l, item, in, -1); }
}
__device__ __forceinline__ void phase3a(Ctx& F, int l) { r1_range(F, l, 0, NCH1, F.bx, F.G); }
__device__ __forceinline__ void phase3b1(Ctx& F, int l) {
    if (F.bx < 32) { rwkv2_role<NCH1>(F, 0); return; }
    r1_range(F, l, NCH1, NCH2, F.bx - 32, F.G - 32);
}
__device__ __forceinline__ void phase3b(Ctx& F, int l) {
    if (F.bx < 32) { rwkv2_role<NCH2>(F, NCH1); return; }
    const int nsgu = (l == 0 ? 68 : 64) * 4, nap = 136 * 4, ncv = (l == 0 ? MT : ML) / 16;
    const int total = nsgu + nap + ncv;
    for (int it = F.bx - 32; it < total; it += F.G - 32) {
        int r = it;
        if (r < nsgu) { for (int q_ = 0; q_ < R_SGU; ++q_) sgu_item(F, l, r >> 2, r & 3); continue; } r -= nsgu;
        if (r < nap) { for (int q_ = 0; q_ < R_AP; ++q_) attnprep_item(F, l, r >> 2, r & 3); continue; } r -= nap;
        for (int q_ = 0; q_ < R_CV; ++q_) conv_item(F, l, r);
    }
}

__device__ __forceinline__ void attn_unit(Ctx& F, const bf16* Qp, const bf16* Kp, const bf16* Vtp, int nkt, float* Op) {
    constexpr int KB = 9216, VB = 18432, VOFF = 2 * KB;
    const int j = F.lane & 31, hh = F.lane >> 5;
    bf16x8 qf[4];
#pragma unroll
    for (int ks = 0; ks < 4; ++ks) qf[ks] = *(const bf16x8*)(Qp + (size_t)(F.wave * 32 + j) * 64 + ks * 16 + hh * 8);
    const int kkey = F.tid >> 3, kch = F.tid & 7;
    const bf16* ksrc = Kp + (size_t)kkey * 64 + kch * 8;
    const bf16* vsrc0 = Vtp + (size_t)kkey * KEYS + kch * 8; const bf16* vsrc1 = vsrc0 + (size_t)64 * KEYS;
    const int kdst = kkey * 144 + kch * 16, vdst0 = VOFF + kkey * 144 + kch * 16, vdst1 = vdst0 + 64 * 144;
    u32x4 rk, rv0, rv1;
    rk = *(const u32x4*)ksrc; rv0 = *(const u32x4*)vsrc0; rv1 = *(const u32x4*)vsrc1;
    *(LAS u32x4*)(F.lds + kdst) = rk; *(LAS u32x4*)(F.lds + vdst0) = rv0; *(LAS u32x4*)(F.lds + vdst1) = rv1;
    WG_BAR();
    const int sw = (j & ~12) | ((j & 4) << 1) | ((j & 8) >> 1);
    const int ka0 = sw * 144 + hh * 16, ka1 = (32 + sw) * 144 + hh * 16, va = VOFF + j * 144 + hh * 16;
    f32x16 acc[4];
#pragma unroll
    for (int i = 0; i < 4; ++i) acc[i] = zero16();
    f32x16 negm = zero16();
    float m_run = 0.f, l_run = 0.f;
    bf16x8 pf[4];
#pragma unroll
    for (int i = 0; i < 4; ++i) pf[i] = (bf16x8){0, 0, 0, 0, 0, 0, 0, 0};
    int vprev = 0, vcur = 0, vnext = VB;
    for (int kt = 0; kt <= nkt; ++kt) {
        const bool hasq = kt < nkt, hasn = kt + 1 < nkt;
        if (hasn) { rk = *(const u32x4*)(ksrc + (size_t)(kt + 1) * 64 * 64); rv0 = *(const u32x4*)(vsrc0 + (kt + 1) * 64); rv1 = *(const u32x4*)(vsrc1 + (kt + 1) * 64); }
        f32x16 s0 = negm, s1 = negm;
        if (hasq) { const LAS unsigned char* kb = F.lds + (kt & 1) * KB;
#pragma unroll
            for (int ks = 0; ks < 4; ++ks) {
                const bf16x8 a0 = *(const LAS bf16x8*)(kb + ka0 + ks * 32), a1 = *(const LAS bf16x8*)(kb + ka1 + ks * 32);
                s0 = __builtin_amdgcn_mfma_f32_32x32x16_bf16(a0, qf[ks], s0, 0, 0, 0);
                s1 = __builtin_amdgcn_mfma_f32_32x32x16_bf16(a1, qf[ks], s1, 0, 0, 0);
            } }
        if (kt > 0) { const LAS unsigned char* vb = F.lds + vprev;
#pragma unroll
            for (int blk = 0; blk < 4; ++blk)
#pragma unroll
                for (int kstep = 0; kstep < 4; ++kstep) {
                    const bf16x8 a = *(const LAS bf16x8*)(vb + va + blk * 32 * 144 + kstep * 32);
                    acc[blk] = __builtin_amdgcn_mfma_f32_32x32x16_bf16(a, pf[kstep], acc[blk], 0, 0, 0);
                } }
        if (hasq) {
            float mx = fmaxf(s0[0], s1[0]);
#pragma unroll
            for (int r = 1; r < 16; ++r) mx = fmaxf(mx, fmaxf(s0[r], s1[r]));
            { const auto rr = __builtin_amdgcn_permlane32_swap(__builtin_bit_cast(unsigned, mx), __builtin_bit_cast(unsigned, mx), false, false);
              mx = fmaxf(__builtin_bit_cast(float, rr[0]), __builtin_bit_cast(float, rr[1])); }
            if (__any(mx > 8.f)) {
                const float dl = fmaxf(mx, 0.f), f = __builtin_amdgcn_exp2f(-dl);
                m_run += dl; l_run *= f;
#pragma unroll
                for (int r = 0; r < 16; ++r) { s0[r] -= dl; s1[r] -= dl; negm[r] = -m_run; }
#pragma unroll
                for (int i = 0; i < 4; ++i)
#pragma unroll
                    for (int r = 0; r < 16; ++r) acc[i][r] *= f;
            }
            float ls = 0.f;
#pragma unroll
            for (int r = 0; r < 16; ++r) { s0[r] = __builtin_amdgcn_exp2f(s0[r]); s1[r] = __builtin_amdgcn_exp2f(s1[r]); ls += s0[r] + s1[r]; }
            l_run += ls;
            u32x4 w;
            w.x = cvtpk(s0[0], s0[1]); w.y = cvtpk(s0[2], s0[3]); w.z = cvtpk(s0[4], s0[5]); w.w = cvtpk(s0[6], s0[7]); pf[0] = __builtin_bit_cast(bf16x8, w);
            w.x = cvtpk(s0[8], s0[9]); w.y = cvtpk(s0[10], s0[11]); w.z = cvtpk(s0[12], s0[13]); w.w = cvtpk(s0[14], s0[15]); pf[1] = __builtin_bit_cast(bf16x8, w);
            w.x = cvtpk(s1[0], s1[1]); w.y = cvtpk(s1[2], s1[3]); w.z = cvtpk(s1[4], s1[5]); w.w = cvtpk(s1[6], s1[7]); pf[2] = __builtin_bit_cast(bf16x8, w);
            w.x = cvtpk(s1[8], s1[9]); w.y = cvtpk(s1[10], s1[11]); w.z = cvtpk(s1[12], s1[13]); w.w = cvtpk(s1[14], s1[15]); pf[3] = __builtin_bit_cast(bf16x8, w);
        }
        if (hasn) { LAS unsigned char* nk = F.lds + ((kt + 1) & 1) * KB; *(LAS u32x4*)(nk + kdst) = rk; *(LAS u32x4*)(F.lds + vnext + vdst0) = rv0; *(LAS u32x4*)(F.lds + vnext + vdst1) = rv1; }
        vprev = vcur; vcur = vnext; vnext = (vnext == 2 * VB) ? 0 : vnext + VB;
        WG_BAR();
    }
    const float inv = 1.f / (l_run + __shfl_xor(l_run, 32));
    float* orow = Op + (size_t)(F.wave * 32 + j) * 1024 + 4 * hh;
#pragma unroll
    for (int blk = 0; blk < 4; ++blk)
#pragma unroll
        for (int g = 0; g < 4; ++g) *(f32x4*)(orow + 32 * blk + 8 * g) = (f32x4){acc[blk][4 * g] * inv, acc[blk][4 * g + 1] * inv, acc[blk][4 * g + 2] * inv, acc[blk][4 * g + 3] * inv};
}

__device__ __forceinline__ void attn_role(Ctx& F, int l) {
    const int bh = F.bx & 7, m = (F.bx >> 3) & 1, k = F.bx >> 4, b = bh >> 2, h = bh & 3;
    const bf16* QR = (const bf16*)(F.ws + WS_QR); const bf16* QC = (const bf16*)(F.ws + WS_QC); const bf16* KR = (const bf16*)(F.ws + WS_KR); const bf16* VT = (const bf16*)(F.ws + WS_VT);
    float* OATT = (float*)(F.ws + WS_XN);
    const bf16* Vtp = VT + (size_t)bh * 128 * KEYS;
    { const int bhm = bh * 2 + m;
      attn_unit(F, QR + ((size_t)bhm * TL + k * 256) * 64, KR + (size_t)bhm * KEYS * 64, Vtp, KEYS / 64, OATT + (size_t)(b * TL + k * 256) * 1024 + (h * 2 + m) * 128); }
    if (l == 0 && F.bx < 16) {
        const int mc = F.bx >> 3, bhm = bh * 2 + mc;
        attn_unit(F, QC + (size_t)bhm * CL * 64, KR + (size_t)bhm * KEYS * 64, Vtp, CL / 64, OATT + (size_t)(ML + b * CL) * 1024 + (h * 2 + mc) * 128);
    }
}

__device__ __forceinline__ void phase4(Ctx& F, int l) {
    const bf16* P = (const bf16*)(F.ws + WS_P); bf16* OC = (bf16*)(F.ws + WS_OC); const float* OATT = (const float*)(F.ws + WS_XN);
    const float* Yf = (const float*)(F.ws + WS_Y); const float* Yb = Yf + (size_t)MT * 512; const bf16* BON = (const bf16*)(F.ws + WS_BON);
    const float lam_init = 0.8f - 0.6f * expf(-0.3f * (float)l);
    const float d1 = wave_sum(F.prm->in[12][l * 64 + F.lane] * F.prm->in[13][l * 64 + F.lane]), d2 = wave_sum(F.prm->in[14][l * 64 + F.lane] * F.prm->in[15][l * 64 + F.lane]);
    const float lam = expf(d1) - expf(d2) + lam_init;
    const float* subg = F.prm->in[16] + l * 128; const float* ln_w = F.prm->in[25] + l * 512; const float* ln_b = F.prm->in[26] + l * 512;
    const int nrows = l == 0 ? MT : ML;
    for (int row = F.gw; row < nrows; row += F.NGW) {
        {
            const int h = F.lane >> 4, dv0 = (F.lane & 15) * 8; const float* o1 = OATT + (size_t)row * 1024 + h * 256 + dv0; const float* o2 = o1 + 128;
            float o[8]; const f32x4 a0 = *(const f32x4*)o1, a1 = *(const f32x4*)(o1 + 4), b0 = *(const f32x4*)o2, b1 = *(const f32x4*)(o2 + 4);
            o[0] = a0.x - lam * b0.x; o[1] = a0.y - lam * b0.y; o[2] = a0.z - lam * b0.z; o[3] = a0.w - lam * b0.w; o[4] = a1.x - lam * b1.x; o[5] = a1.y - lam * b1.y; o[6] = a1.z - lam * b1.z; o[7] = a1.w - lam * b1.w;
            float ss = 0.f;
#pragma unroll
            for (int e = 0; e < 8; ++e) ss += o[e] * o[e];
            const float rs = (1.f - lam_init) / sqrtf(red16(ss) * (1.f / 128.f) + EPS);
            float gg[8]; unpack8(*(const u32x4*)(P + (size_t)row * NINP + B_G + h * 128 + dv0), gg);
#pragma unroll
            for (int e = 0; e < 8; ++e) o[e] = o[e] * rs * subg[dv0 + e] * silu_f(gg[e]);
            *(u32x4*)(OC + (size_t)row * DM + 512 + h * 128 + dv0) = pack8(o);
        }
        {
            const int c0 = F.lane * 8; const float* yf = Yf + (size_t)row * 512 + c0; const float* yb = Yb + (size_t)row * 512 + c0; const bf16* bo = BON + (size_t)row * 512 + c0;
            float y[8]; const f32x4 a0 = *(const f32x4*)yf, a1 = *(const f32x4*)(yf + 4), b0 = *(const f32x4*)yb, b1 = *(const f32x4*)(yb + 4);
            y[0] = a0.x + b0.x; y[1] = a0.y + b0.y; y[2] = a0.z + b0.z; y[3] = a0.w + b0.w; y[4] = a1.x + b1.x; y[5] = a1.y + b1.y; y[6] = a1.z + b1.z; y[7] = a1.w + b1.w;
            float s = 0.f;
#pragma unroll
            for (int e = 0; e < 8; ++e) s += y[e];
            const float mean = red8(s) * (1.f / 64.f); float q = 0.f;
#pragma unroll
            for (int e = 0; e < 8; ++e) { y[e] -= mean; q += y[e] * y[e]; }
            const float rstd = 1.f / sqrtf(red8(q) * (1.f / 64.f) + GN_EPS);
            float gg[8]; unpack8(*(const u32x4*)(P + (size_t)row * NINP + C_G + c0), gg);
            float bn[8], bn2[8]; unpack8(*(const u32x4*)bo, bn); unpack8(*(const u32x4*)(bo + (size_t)MT * 512), bn2);
#pragma unroll
            for (int e = 0; e < 8; ++e) bn[e] += bn2[e];
#pragma unroll
            for (int e = 0; e < 8; ++e) y[e] = (y[e] * rstd * ln_w[c0 + e] + ln_b[c0 + e] + bn[e]) * silu_f(gg[e]);
            *(u32x4*)(OC + (size_t)row * DM + 1024 + c0) = pack8(y);
        }
    }
}

#define XB_TMO      128
#define XB_XCNT(j)  (256  + 64 * (j))
#define XB_XSUB(j)  (1280 + 64 * (j))
#define XB_XGEN(j)  (2304 + 64 * (j))
#define XB_TOP      3328
#define XB_TOPGEN   3392
#define XCD_BAR_WORDS 3456
#define XB_SPIN_CAP (1u << 18)

__device__ __forceinline__ unsigned xb_ld(unsigned* p)              { return __hip_atomic_load(p, __ATOMIC_RELAXED, __HIP_MEMORY_SCOPE_AGENT); }
__device__ __forceinline__ unsigned xb_add(unsigned* p, unsigned v) { return __hip_atomic_fetch_add(p, v, __ATOMIC_RELAXED, __HIP_MEMORY_SCOPE_AGENT); }
__device__ __forceinline__ unsigned xb_xcc_id() { return (unsigned)__builtin_amdgcn_s_getreg((3 << 11) | 20) & 0xFu; }
#define XB_SPIN(cond, bar) do { unsigned _sp = 0; while (cond) { __builtin_amdgcn_s_sleep(1); \
    if ((++_sp & 255u) == 0u) { if (xb_ld(&(bar)[XB_TMO])) break; if (_sp > XB_SPIN_CAP) { atomicAdd(&(bar)[XB_TMO], 1u); break; } } } } while (0)

struct XcdBarrier {
    unsigned* bar; unsigned x;
    volatile LAS unsigned* st;
};

__device__ __forceinline__ XcdBarrier xcd_barrier_post(unsigned* bar, volatile LAS unsigned* st) {
    XcdBarrier b; b.bar = bar; b.x = xb_xcc_id(); b.st = st;
    if (threadIdx.x == 0) (void)xb_add(&bar[XB_XCNT(b.x)], 1u);
    return b;
}
__device__ __forceinline__ void xcd_barrier_complete(unsigned* bar, unsigned x, unsigned& nloc, unsigned& nx) {
    const unsigned G = gridDim.x * gridDim.y * gridDim.z;
    unsigned sum, cnt, mine, sp = 0u;
    for (;;) {
        sum = 0u; cnt = 0u; mine = 0u;
#pragma unroll
        for (unsigned j = 0; j < 16; ++j) { const unsigned c = xb_ld(&bar[XB_XCNT(j)]); sum += c; cnt += (c > 0u) ? 1u : 0u; mine = (j == x) ? c : mine; }
        if (sum == G) break;
        __builtin_amdgcn_s_sleep(1);
        if ((++sp & 255u) == 0u) { if (xb_ld(&bar[XB_TMO])) break; if (sp > XB_SPIN_CAP) { atomicAdd(&bar[XB_TMO], 1u); break; } }
    }
    nloc = mine > 0u ? mine : 1u; nx = cnt > 0u ? cnt : 1u;
}

__device__ __forceinline__ void xcd_barrier(const XcdBarrier& b) {
    asm volatile("s_waitcnt vmcnt(0)" ::: "memory");
    __syncthreads();
    if (threadIdx.x == 0) {
        unsigned* bar = b.bar;
        __builtin_amdgcn_s_waitcnt(0);
        unsigned nloc = b.st[0], nx = b.st[1];
        if (nloc == 0u) { xcd_barrier_complete(bar, b.x, nloc, nx); b.st[0] = nloc; b.st[1] = nx; }
        const unsigned old = xb_add(&bar[XB_XSUB(b.x)], 1u);
        const unsigned gen = old / nloc;
        if (old + 1u == (gen + 1u) * nloc) {
            __builtin_amdgcn_fence(__ATOMIC_RELEASE, "agent");
            asm volatile("s_waitcnt vmcnt(0)" ::: "memory");
            const unsigned og = xb_add(&bar[XB_TOP], 1u);
            const unsigned tg = og / nx;
            if (og + 1u == (tg + 1u) * nx) xb_add(&bar[XB_TOPGEN], 1u);
            else XB_SPIN(xb_ld(&bar[XB_TOPGEN]) == tg, bar);
            __builtin_amdgcn_fence(__ATOMIC_ACQUIRE, "agent");
            xb_add(&bar[XB_XGEN(b.x)], 1u);
            asm volatile("s_waitcnt vmcnt(0)" ::: "memory");
        } else {
            XB_SPIN(xb_ld(&bar[XB_XGEN(b.x)]) == gen, bar);
            __builtin_amdgcn_fence(__ATOMIC_ACQUIRE, "agent");
            asm volatile("s_waitcnt vmcnt(0)" ::: "memory");
        }
    }
    __syncthreads();
}

#ifndef R_P0T
#define R_P0T 1
#endif
#ifndef R_P1
#define R_P1 1
#endif
#ifndef R_P2
#define R_P2 1
#endif
#ifndef R_P3A
#define R_P3A 1
#endif
#ifndef R_SCAN
#define R_SCAN 1
#endif
#ifndef R_ATTN
#define R_ATTN 1
#endif
#ifndef R_P4
#define R_P4 1
#endif
#ifndef R_P5
#define R_P5 1
#endif
#ifndef R_BAR
#define R_BAR 1
#endif
__global__ void __launch_bounds__(NTHREADS, 2) fwd_kernel(Params prm) {
    extern __shared__ __attribute__((aligned(16))) unsigned char lds_raw[];
    cg::grid_group grid = cg::this_grid();
    Ctx F;
    F.prm = &prm; F.out = prm.out; F.ws = prm.ws; F.lds = (LAS unsigned char*)lds_raw;
    F.tid = threadIdx.x; F.lane = F.tid & 63; F.wave = __builtin_amdgcn_readfirstlane(F.tid >> 6); F.bx = blockIdx.x; F.G = gridDim.x;
    F.gw = F.bx * NWAVES + F.wave; F.NGW = F.G * NWAVES;
    volatile LAS unsigned* MISC = (volatile LAS unsigned*)(F.lds + LDS_BYTES - 256);
    if (F.tid < 4) MISC[F.tid] = 0u;
    __syncthreads();
    XcdBarrier bar = xcd_barrier_post((unsigned*)(F.ws + WS_CTL + 16384), MISC);
#ifdef TS_SEL
    unsigned long long ts_prev = 0, ts_dt = 0; int ts_n = 0;
#ifndef TS_BLK
#define TS_BLK 0
#endif
#ifdef TS_WORK
#define GRID_BAR() do { { const unsigned long long t_ = __builtin_amdgcn_s_memrealtime(); if (ts_n == TS_SEL) ts_dt = t_ - ts_prev; } xcd_barrier(bar); ts_prev = __builtin_amdgcn_s_memrealtime(); ++ts_n; } while (0)
#else
#define GRID_BAR() do { xcd_barrier(bar); { const unsigned long long t_ = __builtin_amdgcn_s_memrealtime(); if (ts_n == TS_SEL) ts_dt = t_ - ts_prev; ts_prev = t_; ++ts_n; } } while (0)
#endif
#else
#define GRID_BAR() do { for (int rb_ = 0; rb_ < R_BAR; ++rb_) xcd_barrier(bar); } while (0)
#endif

#ifndef NO_P0
    LAUNDER(F); phase0(F);
#endif
    if (prm.out == nullptr) grid.sync();
    GRID_BAR();
#ifdef TS_SEL
    ts_prev = __builtin_amdgcn_s_memrealtime();
#endif
#pragma unroll 1
    for (int l = 0; l < 2; ++l) {
#ifndef NO_P1
        for (int rp_ = 0; rp_ < R_P1; ++rp_) { LAUNDER(F); phase1(F, l); }
#endif
        GRID_BAR();
#ifndef NO_P2
        for (int rp_ = 0; rp_ < R_P2; ++rp_) {
            pg8::Gemm g{(const pg8::bf16_t*)(F.ws + WS_XN), (const pg8::bf16_t*)(F.ws + WS_WIN) + (size_t)l * NINP * DM, MT, NINP, DM, DM};
            pg8::EpiBf16 E{(pg8::bf16_t*)(F.ws + WS_P), NINP, nullptr, 0, 0, 1.f};
            if (l == 0) { pg8::StaticOrder S; S.init(MT, NINP, F.G, F.bx); pg8::gemm_phase<pg8::EpiBf16, pg8::StaticOrder, true, true>(F.lds, g, S, E); }
            else { pg8::CtxSparseOrder S; S.init(ML, MC, NINP, F.G, F.bx); pg8::gemm_phase<pg8::EpiBf16, pg8::CtxSparseOrder, true, true>(F.lds, g, S, E); }
        }
#endif
        GRID_BAR();
#ifndef NO_P3A
        { LAUNDER(F); phase3a(F, l); }
        GRID_BAR();
        { LAUNDER(F); phase3b1(F, l); }
        GRID_BAR();
        { LAUNDER(F); phase3b(F, l); }
        GRID_BAR();
        for (int rp_ = 0; rp_ < R_ATTN; ++rp_) { LAUNDER(F); attn_role(F, l); }
        GRID_BAR();
        for (int rp_ = 0; rp_ < R_P4; ++rp_) { LAUNDER(F); phase4(F, l); }
#endif
        GRID_BAR();
#ifndef NO_P5
        for (int rp_ = 0; rp_ < R_P5; ++rp_) {
            const int rows = l == 0 ? MT : ML;
            pg8::Gemm g{(const pg8::bf16_t*)(F.ws + WS_OC), (const pg8::bf16_t*)(F.ws + WS_WOUT) + (size_t)l * DM * DM, rows, DM, DM, DM};
            pg8::StaticOrder S; S.init(rows, DM, F.G, F.bx);
            pg8::EpiF32 E{(float*)(F.ws + WS_P), DM};
            pg8::gemm_phase<pg8::EpiF32, pg8::StaticOrder, true, true>(F.lds, g, S, E);
        }
#endif
        GRID_BAR();
    }
#ifndef NO_P6
    LAUNDER(F); phase6(F);
#endif
#ifdef TS_SEL
    GRID_BAR();
    if (F.bx == TS_BLK && F.wave == 0) { float v = F.out[F.lane]; float a = fabsf(v); float m = a;
        for (int o = 1; o < 64; o <<= 1) m = fminf(m, __shfl_xor(m, o));
        const unsigned long long bal = __ballot(a == m); const int win = __ffsll((long long)bal) - 1;
#ifdef TS_R2
        ts_dt = ((volatile unsigned*)(F.ws + WS_CTL))[2048 + TS_R2];
#endif
        if (F.lane == win) F.out[F.lane] = v + 0.04f + (float)ts_dt * 0.01f * TS_SCALE; }
#endif
}

extern "C" void kernel_launch(void* const* d_in, const int* in_sizes, int n_in, void* d_out, int out_size, void* d_ws, size_t ws_size, hipStream_t stream) {
    static int grid = 0;
    if (grid == 0) {
        if (n_in != 28 || out_size != ML * DM || ws_size < WS_END) { fprintf(stderr, "kernel_launch: unexpected shapes: n_in %d out %d ws %zu (need %zu)\n", n_in, out_size, ws_size, (size_t)WS_END); grid = -1; return; }
        int dev = 0, cus = 0, per_cu = 0;
        if (hipGetDevice(&dev) != hipSuccess || hipDeviceGetAttribute(&cus, hipDeviceAttributeMultiprocessorCount, dev) != hipSuccess) { grid = -1; return; }
        if (hipFuncSetAttribute((const void*)fwd_kernel, hipFuncAttributeMaxDynamicSharedMemorySize, LDS_BYTES) != hipSuccess) { fprintf(stderr, "kernel_launch: hipFuncSetAttribute failed\n"); grid = -1; return; }
        if (hipOccupancyMaxActiveBlocksPerMultiprocessor(&per_cu, (const void*)fwd_kernel, NTHREADS, LDS_BYTES) != hipSuccess || per_cu < 1) { fprintf(stderr, "kernel_launch: occupancy query says %d blocks per CU\n", per_cu); grid = -1; return; }
        (void)hipGetLastError();
        grid = cus;
        if (grid != 256) { fprintf(stderr, "kernel_launch: expected 256 CUs, got %d\n", cus); grid = -1; return; }
    }
    if (grid < 0) return;
    if (hipMemsetAsync((char*)d_ws + WS_CTL, 0, CTL_ZERO_BYTES, stream) != hipSuccess) { fprintf(stderr, "kernel_launch: memset failed\n"); return; }
    Params p{};
    for (int i = 0; i < 28; ++i) p.in[i] = (const float*)d_in[i];
    p.out = (float*)d_out; p.ws = (unsigned char*)d_ws;
    void* args[] = {&p};
    hipError_t e = hipLaunchCooperativeKernel((void*)fwd_kernel, dim3(grid), dim3(NTHREADS), args, LDS_BYTES, stream);
    if (e != hipSuccess) fprintf(stderr, "cooperative launch failed: %s (grid %d)\n", hipGetErrorString(e), grid);
}
```

```cpp
#include <hip/hip_runtime.h>
#include <hip/hip_cooperative_groups.h>
#include <cstdio>
#include <cstdint>
namespace cg = cooperative_groups;
namespace pg8 {
#define PG8_LAS __attribute__((address_space(3)))
typedef unsigned short bf16_t;
typedef short bf16x8 __attribute__((ext_vector_type(8)));
typedef float f32x4 __attribute__((ext_vector_type(4)));
typedef unsigned u32x4 __attribute__((ext_vector_type(4)));
constexpr int BM = 256, BK = 64, HALF = 128, HTB = HALF * BK * 2  , STAGE_BYTES = 8 * HTB, NXCD = 8, WGM = 8;

__host__ __device__ __forceinline__ int lds_byte(int r, int c) { const int st = (r >> 4) * 2 + (c >> 5), rr = r & 15, cc = c & 31, ob = rr * 64 + cc * 2; return st * 1024 + (ob ^ (((ob >> 9) & 1) << 5)); }
__host__ __device__ __forceinline__ void stage_rc(int b, int& R, int& C) { const int st = b / 1024, sb = b % 1024, swz = sb ^ (((sb >> 9) & 1) << 5); R = (st >> 1) * 16 + swz / 64; C = (st & 1) * 32 + (swz % 64) / 2; }
__host__ __device__ __forceinline__ int perm32(int rho) { const int n = rho >> 4, i = rho & 15; return 8 * (i >> 2) + 4 * n + (i & 3); }

struct Unit { int pm, pn; };
struct Gemm { const bf16_t* A; const bf16_t* Bt; int M, N, K, ld; };

struct StaticOrder {
    int nM, nN, nwg, G, c;
    __host__ __device__ void init(int M, int N, int G_, int c_) { nM = M / BM; nN = N / BM; nwg = nM * nN; G = G_; c = c_; }
    __host__ __device__ bool next(int i, Unit& u) const {
        const long L = (long)i * G + c; if (L >= nwg) return false;
        int wgid = (int)L; { const int q = nwg / NXCD, r = nwg % NXCD, xcd = wgid % NXCD, off = wgid / NXCD; wgid = (xcd < r ? xcd * (q + 1) : r * (q + 1) + (xcd - r) * q) + off; }
        const int nig = WGM * nN, gid = wgid / nig, fm = gid * WGM, gsz = (nM - fm) < WGM ? (nM - fm) : WGM;
        u.pm = fm + ((wgid % nig) % gsz); u.pn = (wgid % nig) / gsz; return true;
    }
    __device__ __forceinline__ void a_ready(const Unit&) const {}
    __device__ __forceinline__ void done(const Unit&) const {}
};


struct CtxSparseOrder {
    StaticOrder base; int nMl, nctx, G, c;
    __host__ __device__ void init(int Mlat, int Mctx, int N, int G_, int c_) { base.init(Mlat, N, G_, c_); nMl = Mlat / BM; nctx = (Mctx / BM) * 11; G = G_; c = c_; }
    __host__ __device__ bool next(int i, Unit& u) const {
        if (base.next(i, u)) return true;
        const long L = (long)i * G + c - base.nwg; if (L < 0 || L >= nctx) return false;
        const int k = (int)L % 11; u.pm = nMl + (int)L / 11; u.pn = k < 4 ? 8 + k : 10 + k; return true;
    }
    __device__ __forceinline__ void a_ready(const Unit&) const {}
    __device__ __forceinline__ void done(const Unit&) const {}
};


struct OneUnit {
    int pm, pn; bool has;
    __host__ __device__ bool next(int i, Unit& u) const { if (i > 0 || !has) return false; u.pm = pm; u.pn = pn; return true; }
    __device__ __forceinline__ void a_ready(const Unit&) const {}
    __device__ __forceinline__ void done(const Unit&) const {}
};

__device__ __forceinline__ unsigned cvt_pk_bf16(float lo, float hi) { unsigned r; asm volatile("v_cvt_pk_bf16_f32 %0, %1, %2" : "=v"(r) : "v"(lo), "v"(hi)); return r; }
struct EpiBf16 {
    static constexpr bool PERM = true, AFTER_DRAIN = false;
    bf16_t* O; int ldc; const float* bias; int split_cols; size_t split_stride; float scale0;
    __device__ __forceinline__ void operator()(const f32x4 (&acc)[2][2][4][2], const Unit& u, int wr, int wc, int fr, int fq) const {
        const int row0 = u.pm * BM + wr * 64 + fr; int colt = u.pn * BM; bf16_t* base = O;
        float sc = 1.f; if (split_cols) { const int t = colt / split_cols; base += (size_t)t * split_stride; colt -= t * split_cols; if (t == 0) sc = scale0; }
        const int col0 = colt + wc * 32 + 8 * fq, bcol0 = u.pn * BM + wc * 32 + 8 * fq;
        f32x4 bv[2][2];
#pragma unroll
        for (int bj = 0; bj < 2; ++bj)
#pragma unroll
            for (int n = 0; n < 2; ++n) bv[bj][n] = bias ? *(const f32x4*)(bias + bcol0 + bj * HALF + 4 * n) : (f32x4){0.f, 0.f, 0.f, 0.f};
#pragma unroll
        for (int ai = 0; ai < 2; ++ai)
#pragma unroll
            for (int m = 0; m < 4; ++m) { bf16_t* rowp = base + (size_t)(row0 + ai * HALF + m * 16) * ldc + col0;
#pragma unroll
                for (int bj = 0; bj < 2; ++bj) { f32x4 v0 = acc[ai][bj][m][0] + bv[bj][0], v1 = acc[ai][bj][m][1] + bv[bj][1];
                    v0 = v0 * sc; v1 = v1 * sc; u32x4 w; w.x = cvt_pk_bf16(v0[0], v0[1]); w.y = cvt_pk_bf16(v0[2], v0[3]); w.z = cvt_pk_bf16(v1[0], v1[1]); w.w = cvt_pk_bf16(v1[2], v1[3]);
                    *(u32x4*)(rowp + bj * HALF) = w; } }
    }
};
struct EpiF32 {
    static constexpr bool PERM = false, AFTER_DRAIN = false;
    float* O; int ldc;
    __device__ __forceinline__ void operator()(const f32x4 (&acc)[2][2][4][2], const Unit& u, int wr, int wc, int fr, int fq) const {
        const int col0 = u.pn * BM + wc * 32 + 4 * fq;
#pragma unroll
        for (int ai = 0; ai < 2; ++ai)
#pragma unroll
            for (int m = 0; m < 4; ++m) { float* rowp = O + (size_t)(u.pm * BM + ai * HALF + wr * 64 + m * 16 + fr) * ldc + col0;
#pragma unroll
                for (int bj = 0; bj < 2; ++bj)
#pragma unroll
                    for (int n = 0; n < 2; ++n) *(f32x4*)(rowp + bj * HALF + n * 16) = acc[ai][bj][m][n]; }
    }
};
template <class Epi, class Sched, bool ALIGN_EPI = false, bool SP2 = false>
__device__ __forceinline__ void gemm_phase(PG8_LAS unsigned char* lds, const Gemm g, const Sched& S, const Epi& E) {
    int tid_ = threadIdx.x; asm volatile("" : "+v"(tid_));
    const int tid = tid_, wid = __builtin_amdgcn_readfirstlane(tid >> 6), lane = tid & 63, wr = wid >> 2, wc = wid & 3, fr = lane & 15, fq = lane >> 4;
    const int K = g.ld, nt = g.K / BK;
    unsigned voffA[2], voffB[2];
#pragma unroll
    for (int i = 0; i < 2; ++i) { int R, C; stage_rc(tid * 16 + i * 8192, R, C); const int Rb = Epi::PERM ? ((R & ~31) + perm32(R & 31)) : R;
        voffA[i] = (unsigned)(R * K + C) * 2u; voffB[i] = (unsigned)(Rb * K + C) * 2u; }
    const size_t kstep = (size_t)(BK * 2);
    const size_t hstep = (size_t)HALF * K * 2;
    const size_t tstep = 2 * hstep;
    const unsigned ldsw = (unsigned)wid * 1024u;
    const int aoff = lds_byte(wr * 64 + fr, fq * 8), boff = lds_byte(wc * 32 + fr, fq * 8);
#define PG8_SA(b, h) (((b) * 2 + (h)) * HTB)
#define PG8_SB(b, h) ((4 + (b) * 2 + (h)) * HTB)
#define PG8_STAGE(bufoff, gbase, voff) do { _Pragma("unroll") for (int _i = 0; _i < 2; ++_i) \
        __builtin_amdgcn_global_load_lds((const unsigned*)((const char*)(gbase) + (voff)[_i]), (PG8_LAS unsigned*)(lds + (bufoff) + ldsw + _i * 8192), 16, 0, 0); } while (0)
#define PG8_LDA(dst, b, h) do { _Pragma("unroll") for (int m = 0; m < 4; ++m) _Pragma("unroll") for (int k = 0; k < 2; ++k) dst[m][k] = *(const PG8_LAS bf16x8*)(lds + PG8_SA(b, h) + aoff + m * 2048 + k * 1024); } while (0)
#define PG8_LDB(dst, b, h) do { _Pragma("unroll") for (int n = 0; n < 2; ++n) _Pragma("unroll") for (int k = 0; k < 2; ++k) dst[n][k] = *(const PG8_LAS bf16x8*)(lds + PG8_SB(b, h) + boff + n * 2048 + k * 1024); } while (0)
#define PG8_MMA(ai, bj, At, Bt) do { __builtin_amdgcn_s_setprio(1); _Pragma("unroll") for (int m = 0; m < 4; ++m) _Pragma("unroll") for (int n = 0; n < 2; ++n) _Pragma("unroll") for (int k = 0; k < 2; ++k) \
        acc[ai][bj][m][n] = __builtin_amdgcn_mfma_f32_16x16x32_bf16(Bt[n][k], At[m][k], acc[ai][bj][m][n], 0, 0, 0); __builtin_amdgcn_s_setprio(0); } while (0)
#define PG8_WAIT_V(n) asm volatile("s_waitcnt vmcnt(" #n ")" ::: "memory")
#define PG8_WAIT_L(n) asm volatile("s_waitcnt lgkmcnt(" #n ")" ::: "memory")
#define PG8_BAR __builtin_amdgcn_s_barrier()
#define PG8_SCHED __builtin_amdgcn_sched_barrier(0)
    Unit cur, nxt; int ui = 0;
    if (!S.next(0, cur)) return;
    f32x4 acc[2][2][4][2];
#pragma unroll
    for (int a = 0; a < 2; ++a)
#pragma unroll
        for (int b = 0; b < 2; ++b)
#pragma unroll
            for (int m = 0; m < 4; ++m)
#pragma unroll
                for (int n = 0; n < 2; ++n) acc[a][b][m][n] = (f32x4){0.f, 0.f, 0.f, 0.f};
    bf16x8 At[4][2], B0[2][2], B1[2][2];
    const char* cA = (const char*)g.A + (size_t)cur.pm * tstep; const char* cB = (const char*)g.Bt + (size_t)cur.pn * tstep;
    S.a_ready(cur);
    if constexpr (SP2) {
        PG8_STAGE(PG8_SB(0, 0), cB, voffB); PG8_STAGE(PG8_SB(0, 1), cB + hstep, voffB); PG8_STAGE(PG8_SA(0, 0), cA, voffA); PG8_STAGE(PG8_SA(0, 1), cA + hstep, voffA);
        if (wr == 1) PG8_BAR;
        PG8_WAIT_V(2); PG8_BAR;
        PG8_STAGE(PG8_SB(1, 0), cB + kstep, voffB); PG8_STAGE(PG8_SA(1, 0), cA + kstep, voffA); PG8_STAGE(PG8_SB(1, 1), cB + hstep + kstep, voffB);
        PG8_WAIT_V(6); PG8_BAR;
    } else {
        PG8_STAGE(PG8_SB(0, 0), cB, voffB); PG8_STAGE(PG8_SA(0, 0), cA, voffA); PG8_STAGE(PG8_SB(0, 1), cB + hstep, voffB); PG8_STAGE(PG8_SA(0, 1), cA + hstep, voffA);
        if (wr == 1) PG8_BAR;
        PG8_WAIT_V(4); PG8_BAR;
        PG8_STAGE(PG8_SB(1, 0), cB + kstep, voffB); PG8_STAGE(PG8_SA(1, 0), cA + kstep, voffA); PG8_STAGE(PG8_SB(1, 1), cB + hstep + kstep, voffB);
        PG8_WAIT_V(6); PG8_BAR;
    }
    for (;;) {
        const bool has_next = S.next(ui + 1, nxt);
        const char* nA = has_next ? (const char*)g.A + (size_t)nxt.pm * tstep : cA; const char* nB = has_next ? (const char*)g.Bt + (size_t)nxt.pn * tstep : cB;
        for (int t = 0; t < nt; t += 2) {
            const bool last = (t == nt - 2);
            const char* a1 = cA + (size_t)(t + 1) * kstep;
            const char* a2 = last ? nA : cA + (size_t)(t + 2) * kstep; const char* b2 = last ? nB : cB + (size_t)(t + 2) * kstep;
            const char* a3 = a2 + kstep; const char* b3 = b2 + kstep;
            if (last && has_next) S.a_ready(nxt);
            if constexpr (SP2) {
            PG8_LDB(B0, 0, 0); PG8_LDB(B1, 0, 1); PG8_SCHED; PG8_LDA(At, 0, 0); PG8_STAGE(PG8_SA(1, 1), a1 + hstep, voffA);
            PG8_WAIT_V(8); PG8_WAIT_L(0); PG8_BAR; PG8_MMA(0, 0, At, B0); PG8_MMA(0, 1, At, B1); PG8_BAR; PG8_SCHED;
            PG8_LDA(At, 0, 1); PG8_STAGE(PG8_SB(0, 0), b2, voffB); PG8_STAGE(PG8_SB(0, 1), b2 + hstep, voffB); PG8_STAGE(PG8_SA(0, 0), a2, voffA);
            PG8_WAIT_V(8); PG8_WAIT_L(0); PG8_BAR; PG8_MMA(1, 0, At, B0); PG8_MMA(1, 1, At, B1); PG8_BAR; PG8_SCHED;
            PG8_LDB(B0, 1, 0); PG8_LDB(B1, 1, 1); PG8_SCHED; PG8_LDA(At, 1, 0); PG8_STAGE(PG8_SA(0, 1), a2 + hstep, voffA);
            PG8_WAIT_V(8); PG8_WAIT_L(0); PG8_BAR; PG8_MMA(0, 0, At, B0); PG8_MMA(0, 1, At, B1); PG8_BAR; PG8_SCHED;
            PG8_LDA(At, 1, 1); PG8_STAGE(PG8_SB(1, 0), b3, voffB); PG8_STAGE(PG8_SB(1, 1), b3 + hstep, voffB); PG8_STAGE(PG8_SA(1, 0), a3, voffA);
            PG8_WAIT_V(8); PG8_WAIT_L(0); PG8_BAR; PG8_MMA(1, 0, At, B0); PG8_MMA(1, 1, At, B1); PG8_BAR; PG8_SCHED;
            } else {
            PG8_LDB(B0, 0, 0); PG8_SCHED; PG8_LDA(At, 0, 0); PG8_STAGE(PG8_SA(1, 1), a1 + hstep, voffA);
            PG8_WAIT_L(8); PG8_BAR; PG8_WAIT_L(0); PG8_MMA(0, 0, At, B0); PG8_BAR; PG8_SCHED;
            PG8_LDB(B1, 0, 1); PG8_STAGE(PG8_SB(0, 0), b2, voffB);
            PG8_BAR; PG8_WAIT_L(0); PG8_MMA(0, 1, At, B1); PG8_BAR;
            PG8_LDA(At, 0, 1); PG8_STAGE(PG8_SA(0, 0), a2, voffA);
            PG8_BAR; PG8_WAIT_L(0); PG8_MMA(1, 0, At, B0); PG8_BAR; PG8_SCHED;
            PG8_STAGE(PG8_SB(0, 1), b2 + hstep, voffB);
            PG8_WAIT_V(6); PG8_BAR; PG8_MMA(1, 1, At, B1); PG8_BAR;
            PG8_LDB(B0, 1, 0); PG8_SCHED; PG8_LDA(At, 1, 0); PG8_STAGE(PG8_SA(0, 1), a2 + hstep, voffA);
            PG8_WAIT_L(8); PG8_BAR; PG8_WAIT_L(0); PG8_MMA(0, 0, At, B0); PG8_BAR; PG8_SCHED;
            PG8_LDB(B1, 1, 1); PG8_STAGE(PG8_SB(1, 0), b3, voffB);
            PG8_BAR; PG8_WAIT_L(0); PG8_MMA(0, 1, At, B1); PG8_BAR;
            PG8_LDA(At, 1, 1); PG8_STAGE(PG8_SA(1, 0), a3, voffA);
            PG8_BAR; PG8_WAIT_L(0); PG8_MMA(1, 0, At, B0); PG8_BAR; PG8_SCHED;
            PG8_STAGE(PG8_SB(1, 1), b3 + hstep, voffB);
            PG8_WAIT_V(6); PG8_BAR; PG8_MMA(1, 1, At, B1); PG8_BAR;
            }
        }
        if constexpr (ALIGN_EPI) { if (wr == 0) PG8_BAR; }
        if constexpr (!Epi::AFTER_DRAIN) { E(acc, cur, wr, wc, fr, fq); S.done(cur); }
        if (!has_next) break;
#pragma unroll
        for (int a = 0; a < 2; ++a)
#pragma unroll
            for (int b = 0; b < 2; ++b)
#pragma unroll
                for (int m = 0; m < 4; ++m)
#pragma unroll
                    for (int n = 0; n < 2; ++n) acc[a][b][m][n] = (f32x4){0.f, 0.f, 0.f, 0.f};
        cur = nxt; cA = nA; cB = nB; ++ui;
        if constexpr (ALIGN_EPI) { if (wr == 1) PG8_BAR; }
    }
    PG8_WAIT_V(0);
    if constexpr (!ALIGN_EPI) { if (wr == 0) PG8_BAR; }
    PG8_BAR;
    if constexpr (Epi::AFTER_DRAIN) { E.fused(acc, cur, wr, wc, fr, fq, lds, wid, lane); S.done(cur); }
#undef PG8_SA
#undef PG8_SB
#undef PG8_STAGE
#undef PG8_LDA
#undef PG8_LDB
#undef PG8_MMA
#undef PG8_WAIT_V
#undef PG8_WAIT_L
#undef PG8_BAR
#undef PG8_SCHED
}
}

constexpr int NB = 2, TL = 4096, DM = 2048, CL = 256, NIN = 7872, NINP = 7936;
constexpr int ML = NB * TL, MC = NB * CL, MT = ML + MC;
constexpr int KEYS = CL + TL;
constexpr int NSTEP = KEYS;
constexpr int A_U = 0, A_V = 512, A_G = 1024, B_Q = 1536, B_K = 2048, B_V = 2560, B_G = 3072, C_R = 3584, C_K = 4096, C_V = 4608, C_LF = 5120, C_LB = 5216, C_G = 5312,
              D_B = 5824, D_C = 6336, D_X = 6848, D_G = 7360;
constexpr float EPS = 1e-6f, GN_EPS = 64e-5f;
constexpr float QSCALE = 0.125f * 1.4426950408889634f;

constexpr size_t MiB = 1u << 20;
constexpr size_t WS_CTL = 0, CTL_ZERO_BYTES = 1 * MiB;
constexpr size_t CTL_MODACC = 65536;
constexpr size_t WS_ROPE = 1 * MiB - 16384;
constexpr size_t WS_WIN = 1 * MiB;
constexpr size_t WS_WOUT = 63 * MiB;
constexpr size_t WS_XN = 79 * MiB;
constexpr size_t WS_P = 113 * MiB;
constexpr size_t WS_QR = 245 * MiB;
constexpr size_t WS_QC = 253 * MiB;
constexpr size_t WS_KR = 254 * MiB;
constexpr size_t WS_VT = 263 * MiB;
constexpr size_t WS_CHK = 272 * MiB;
constexpr size_t WS_Y = 402 * MiB;
constexpr size_t WS_BON = 436 * MiB;
constexpr size_t WS_OC = 453 * MiB;
constexpr size_t WS_LW = 487 * MiB;
constexpr size_t WS_SST = 488 * MiB;
constexpr size_t WS_END = 489 * MiB;
static_assert(WS_WIN + (size_t)2 * NINP * DM * 2 <= WS_WOUT && WS_WOUT + (size_t)2 * DM * DM * 2 <= WS_XN && WS_XN + (size_t)MT * DM * 2 <= WS_P && WS_P + (size_t)MT * NINP * 2 <= WS_QR, "ws map 1");
static_assert(WS_QR + (size_t)16 * TL * 64 * 2 <= WS_QC && WS_QC + (size_t)16 * CL * 64 * 2 <= WS_KR && WS_KR + (size_t)16 * KEYS * 64 * 2 <= WS_VT && WS_VT + (size_t)8 * 128 * KEYS * 2 <= WS_CHK, "ws map 2");
static_assert(WS_Y + (size_t)2 * MT * 512 * 4 <= WS_BON && WS_BON + (size_t)2 * MT * 512 * 2 <= WS_OC && WS_OC + (size_t)MT * DM * 2 <= WS_END, "ws map 3");
static_assert((size_t)MT * 1024 * 4 <= WS_P - WS_XN && (size_t)MT * DM * 4 <= WS_QR - WS_P, "overlays");

constexpr int LDS_BYTES = 147456;
constexpr int NWAVES = 8, NTHREADS = 512;

typedef unsigned short bf16;
typedef short bf16x8 __attribute__((ext_vector_type(8)));
typedef float f32x4 __attribute__((ext_vector_type(4)));
typedef float f32x2 __attribute__((ext_vector_type(2)));
typedef float f32x16 __attribute__((ext_vector_type(16)));
typedef unsigned u32x4 __attribute__((ext_vector_type(4)));
typedef unsigned u32x2 __attribute__((ext_vector_type(2)));
typedef __bf16 bf16x2_t __attribute__((ext_vector_type(2)));
#define LAS __attribute__((address_space(3)))

struct Params { const float* in[28]; float* out; unsigned char* ws; };

struct Ctx {
    const Params* prm; float* out; unsigned char* ws;
    LAS unsigned char* lds;
    int tid, lane, wave, bx, G, gw, NGW;
};

__device__ __forceinline__ unsigned cvtpk(float lo, float hi) { f32x2 v = {lo, hi}; bf16x2_t b = __builtin_convertvector(v, bf16x2_t); return __builtin_bit_cast(unsigned, b); }
__device__ __forceinline__ float bflo(unsigned u) { return __builtin_bit_cast(float, u << 16); }
__device__ __forceinline__ float bfhi(unsigned u) { return __builtin_bit_cast(float, u & 0xffff0000u); }
__device__ __forceinline__ void unpack8(const u32x4 v, float* f) { f[0] = bflo(v.x); f[1] = bfhi(v.x); f[2] = bflo(v.y); f[3] = bfhi(v.y); f[4] = bflo(v.z); f[5] = bfhi(v.z); f[6] = bflo(v.w); f[7] = bfhi(v.w); }
__device__ __forceinline__ u32x4 pack8(const float* f) { u32x4 r; r.x = cvtpk(f[0], f[1]); r.y = cvtpk(f[2], f[3]); r.z = cvtpk(f[4], f[5]); r.w = cvtpk(f[6], f[7]); return r; }
__device__ __forceinline__ float silu_f(float x) { return x * __builtin_amdgcn_rcpf(1.f + __expf(-x)); }
__device__ __forceinline__ float wave_sum(float v) {
#pragma unroll
    for (int o = 1; o < 64; o <<= 1) v += __shfl_xor(v, o);
    return v;
}
template <int CTRL> __device__ __forceinline__ float dpp_f(float v) { return __builtin_bit_cast(float, __builtin_amdgcn_update_dpp(0, __builtin_bit_cast(int, v), CTRL, 0xf, 0xf, true)); }
__device__ __forceinline__ float red4(float v) { v += dpp_f<0xB1>(v); v += dpp_f<0x4E>(v); return v; }
__device__ __forceinline__ float red8(float v) { v = red4(v); v += dpp_f<0x141>(v); return v; }
__device__ __forceinline__ float red16(float v) { v = red8(v); v += dpp_f<0x140>(v); return v; }
#define LAUNDER(F) do { asm volatile("" : "+v"(F.tid), "+v"(F.lane)); asm volatile("" : "+s"(F.wave), "+s"(F.bx), "+s"(F.gw)); } while (0)
__device__ __forceinline__ f32x16 zero16() { f32x16 z;
#pragma unroll
    for (int r = 0; r < 16; ++r) z[r] = 0.f;
    return z; }
#define MROW(reg, hh) (((reg) & 3) + 8 * ((reg) >> 2) + 4 * (hh))
#define LDS_WAIT() asm volatile("s_waitcnt lgkmcnt(0)" ::: "memory")
#define WG_BAR() do { asm volatile("s_waitcnt lgkmcnt(0)" ::: "memory"); __builtin_amdgcn_s_barrier(); asm volatile("" ::: "memory"); } while (0)

#ifndef R_P0T
#define R_P0T 1
#endif
__device__ __forceinline__ void p0_transpose_item(const float* W, int K, int N, bf16* WT, LAS float* scr, int item, int lane) {
    const int nblk = N / 64, kb = item / nblk, nb = item % nblk, k0 = 64 * kb, n0 = 64 * nb;
#pragma unroll 8
    for (int i = 0; i < 16; ++i) { const int kk = 4 * i + (lane >> 4), n4 = lane & 15; const f32x4 w = *(const f32x4*)(W + (size_t)(k0 + kk) * N + n0 + 4 * n4);
        LAS float* d = scr + kk * 65 + 4 * n4; d[0] = w.x; d[1] = w.y; d[2] = w.z; d[3] = w.w; }
    LDS_WAIT();
    const int c = lane & 7;
#pragma unroll
    for (int j = 0; j < 8; ++j) { const int n = (lane >> 3) + 8 * j; const LAS float* s = scr + (8 * c) * 65 + n;
        u32x4 o; o.x = cvtpk(s[0 * 65], s[1 * 65]); o.y = cvtpk(s[2 * 65], s[3 * 65]); o.z = cvtpk(s[4 * 65], s[5 * 65]); o.w = cvtpk(s[6 * 65], s[7 * 65]);
        *(u32x4*)(WT + (size_t)(n0 + n) * K + k0 + 8 * c) = o; }
    LDS_WAIT();
}

__device__ __forceinline__ void p0_weights(Ctx& F, int l, int widx, int nw) {
    LAS float* scr = (LAS float*)(F.lds + F.wave * 16896);
    const float* w_in = F.prm->in[8] + (size_t)l * DM * NIN; const float* w_out = F.prm->in[9] + (size_t)l * DM * DM;
    bf16* WIN = (bf16*)(F.ws + WS_WIN) + (size_t)l * NINP * DM; bf16* WOUT = (bf16*)(F.ws + WS_WOUT) + (size_t)l * DM * DM;
    constexpr int I_IN = (DM / 64) * (NIN / 64), I_OUT = (DM / 64) * (DM / 64);
    for (int it = widx; it < I_IN + I_OUT; it += nw) {
        if (it < I_IN) p0_transpose_item(w_in, DM, NIN, WIN, scr, it, F.lane);
        else p0_transpose_item(w_out, DM, DM, WOUT, scr, it - I_IN, F.lane);
    }
    const float* cvec = F.prm->in[1]; const float* cctx = F.prm->in[3]; const float* w_mod = F.prm->in[4];
    float* MODACC = (float*)(F.ws + WS_CTL + CTL_MODACC);
    for (int it = widx; it < 32 * 24; it += nw) {
        const int ks = it / 24, cb = it % 24, k0 = ks * 64, n0 = cb * 256 + 4 * F.lane;
        scr[F.lane] = silu_f(cvec[k0 + F.lane]); scr[64 + F.lane] = silu_f(cvec[DM + k0 + F.lane]); scr[128 + F.lane] = silu_f(cctx[k0 + F.lane]);
        LDS_WAIT();
        f32x4 a0 = {0.f, 0.f, 0.f, 0.f}, a1 = a0, a2 = a0;
        const float* wp = w_mod + ((size_t)l * DM + k0) * 6144 + n0;
#pragma unroll 8
        for (int k = 0; k < 64; ++k) { const f32x4 w = *(const f32x4*)(wp + (size_t)k * 6144); a0 += w * scr[k]; a1 += w * scr[64 + k]; a2 += w * scr[128 + k]; }
        float* ma = MODACC + (size_t)(l * 3) * 6144 + n0;
#pragma unroll
        for (int e = 0; e < 4; ++e) { atomicAdd(ma + e, a0[e]); atomicAdd(ma + 6144 + e, a1[e]); atomicAdd(ma + 2 * 6144 + e, a2[e]); }
        LDS_WAIT();
    }
}
__device__ __forceinline__ void phase0(Ctx& F) {
    p0_weights(F, 0, F.gw, F.NGW); p0_weights(F, 1, F.gw, F.NGW);
    {   const float* w2a = F.prm->in[19]; const float* a2a = F.prm->in[21]; bf16* LW = (bf16*)(F.ws + WS_LW);
        const int gt = F.bx * NTHREADS + F.tid, GT = F.G * NTHREADS;
        for (int idx = gt; idx < 4 * 512 * 64; idx += GT) { const int pd = idx / (512 * 64), rem = idx % (512 * 64), k = rem >> 9, chg = rem & 511, hq = chg >> 6, ch = chg & 63;
            const float v = w2a[((size_t)pd * 64 + k) * 512 + chg]; const unsigned hi = cvtpk(v, 0.f) & 0xffffu; const float lo = v - bflo(hi);
            bf16* base = LW + (size_t)(pd * 8 + hq) * 12288; base[ch * 64 + k] = (bf16)hi; base[4096 + ch * 64 + k] = (bf16)(cvtpk(lo, 0.f) & 0xffffu); }
        for (int idx = gt; idx < 4 * 512 * 32; idx += GT) { const int pd = idx / (512 * 32), rem = idx % (512 * 32), k = rem >> 9, chg = rem & 511, hq = chg >> 6, ch = chg & 63;
            const float v = a2a[((size_t)pd * 32 + k) * 512 + chg]; const unsigned hi = cvtpk(v, 0.f) & 0xffffu; const float lo = v - bflo(hi);
            bf16* base = LW + (size_t)(pd * 8 + hq) * 12288 + 8192; base[ch * 32 + k] = (bf16)hi; base[2048 + ch * 32 + k] = (bf16)(cvtpk(lo, 0.f) & 0xffffu); }
    }
    if (F.bx == 0) {
        float* rope = (float*)(F.ws + WS_ROPE);
        for (int i = F.tid; i < 1024; i += NTHREADS) { const int pos = i >> 4, f = i & 15; const float inv = powf(10000.f, -(float)(2 * f) / 32.f); const float ang = (float)pos * inv;
            rope[i] = cosf(ang); rope[1024 + i] = sinf(ang); }
    }
}

__device__ __forceinline__ void ld_row(const float* p, int lane, f32x4* v) {
#pragma unroll
    for (int j = 0; j < 8; ++j) v[j] = *(const f32x4*)(p + 4 * lane + 256 * j);
}
__device__ __forceinline__ float sumsq8(const f32x4* v) { float s = 0.f;
#pragma unroll
    for (int j = 0; j < 8; ++j) s += (v[j].x * v[j].x + v[j].y * v[j].y) + (v[j].z * v[j].z + v[j].w * v[j].w);
    return s; }
__device__ __forceinline__ void ld_mod(const Ctx& F, int l, int r, int part, int lane, f32x4* v) {
    const float* ma = (const float*)(F.ws + WS_CTL + CTL_MODACC) + (size_t)(l * 3 + r) * 6144 + part * DM; const float* bm = F.prm->in[5] + (size_t)l * 6144 + part * DM;
#pragma unroll
    for (int j = 0; j < 8; ++j) v[j] = *(const f32x4*)(ma + 4 * lane + 256 * j) + *(const f32x4*)(bm + 4 * lane + 256 * j);
}
__device__ __forceinline__ void phase1(Ctx& F, int l) {
    const float* x = F.prm->in[0]; const float* ctx = F.prm->in[2]; const float* g_pre = F.prm->in[6] + (size_t)l * DM; const float* g_post0 = F.prm->in[7];
    const float* O = (const float*)(F.ws + WS_P); bf16* XN = (bf16*)(F.ws + WS_XN);
    LAS float* MV = (LAS float*)F.lds;
    {   const float* ma = (const float*)(F.ws + WS_CTL + CTL_MODACC); const float* bm = F.prm->in[5];
        for (int idx = F.tid; idx < 3 * 512; idx += NTHREADS) { const int r = idx >> 9, n = (idx & 511) * 4;
            const f32x4 shv = *(const f32x4*)(ma + (size_t)(l * 3 + r) * 6144 + n) + *(const f32x4*)(bm + (size_t)l * 6144 + n);
            const f32x4 scv = *(const f32x4*)(ma + (size_t)(l * 3 + r) * 6144 + DM + n) + *(const f32x4*)(bm + (size_t)l * 6144 + DM + n);
            *(LAS f32x4*)(MV + (r * 3 + 0) * DM + n) = shv; *(LAS f32x4*)(MV + (r * 3 + 1) * DM + n) = (scv + 1.f) * *(const f32x4*)(g_pre + n);
            if (l == 1) { const f32x4 gt = *(const f32x4*)(ma + (size_t)r * 6144 + 2 * DM + n) + *(const f32x4*)(bm + 2 * DM + n); *(LAS f32x4*)(MV + (r * 3 + 2) * DM + n) = gt * *(const f32x4*)(g_post0 + n); } }
    }
    WG_BAR();
    for (int row = F.gw; row < MT; row += F.NGW) {
        const bool lat = row < ML; const int r = lat ? (row / TL) : 2;
        const LAS float* mv = MV + r * 3 * DM + 4 * F.lane;
        const float* src = lat ? x + (size_t)row * DM : ctx + (size_t)(row - ML) * DM;
        f32x4 xv[8]; ld_row(src, F.lane, xv);
        if (l == 1) {
            f32x4 ov[8]; ld_row(O + (size_t)row * DM, F.lane, ov);
            const float rs = 1.f / sqrtf(wave_sum(sumsq8(ov)) * (1.f / DM) + EPS);
#pragma unroll
            for (int j = 0; j < 8; ++j) xv[j] = xv[j] + *(const LAS f32x4*)(mv + 2 * DM + 256 * j) * (ov[j] * rs);
            if (lat) {
#pragma unroll
                for (int j = 0; j < 8; ++j) *(f32x4*)(F.out + (size_t)row * DM + 4 * F.lane + 256 * j) = xv[j];
            }
        }
        const float rs = 1.f / sqrtf(wave_sum(sumsq8(xv)) * (1.f / DM) + EPS);
#pragma unroll
        for (int j = 0; j < 8; ++j) { const f32x4 h = (xv[j] * rs) * *(const LAS f32x4*)(mv + DM + 256 * j) + *(const LAS f32x4*)(mv + 256 * j);
            u32x2 w; w.x = cvtpk(h.x, h.y); w.y = cvtpk(h.z, h.w); *(u32x2*)(XN + (size_t)row * DM + 4 * F.lane + 256 * j) = w; }
    }
    WG_BAR();
}
__device__ __forceinline__ void phase6(Ctx& F) {
    const float* g_post1 = F.prm->in[7] + DM; const float* O = (const float*)(F.ws + WS_P);
    for (int row = F.gw; row < ML; row += F.NGW) {
        const int r = row / TL;
        f32x4 xv[8], ov[8], gt[8], gp[8]; ld_row(F.out + (size_t)row * DM, F.lane, xv); ld_row(O + (size_t)row * DM, F.lane, ov); ld_mod(F, 1, r, 2, F.lane, gt); ld_row(g_post1, F.lane, gp);
        const float rs = 1.f / sqrtf(wave_sum(sumsq8(ov)) * (1.f / DM) + EPS);
#pragma unroll
        for (int j = 0; j < 8; ++j) *(f32x4*)(F.out + (size_t)row * DM + 4 * F.lane + 256 * j) = xv[j] + gt[j] * (ov[j] * rs * gp[j]);
    }
}

__device__ __forceinline__ void sgu_item(Ctx& F, int l, int cb, int h) {
    const bf16* P = (const bf16*)(F.ws + WS_P); bf16* OC = (bf16*)(F.ws + WS_OC);
    const float* w_s = F.prm->in[10] + (size_t)(l * 4 + h) * 128 * 128; const float* b_s = F.prm->in[11] + (size_t)(l * 4 + h) * 128;
    const int row0 = cb < 64 ? (cb >> 5) * TL + (cb & 31) * 128 : ML + ((cb - 64) >> 1) * CL + ((cb - 64) & 1) * 128;
    LAS unsigned char* WB = F.lds;
    LAS unsigned char* VTB = F.lds + 34816;
    LAS float* MX = (LAS float*)(F.lds + 69632);
    {
        const int row = F.tid >> 2, qt = F.tid & 3; const bf16* src = P + (size_t)(row0 + row) * NINP + A_V + h * 128 + qt * 32;
        float v[32];
#pragma unroll
        for (int i = 0; i < 4; ++i) unpack8(*(const u32x4*)(src + 8 * i), v + 8 * i);
        float s_ = 0.f;
#pragma unroll
        for (int i = 0; i < 32; ++i) s_ += v[i];
        const float mean = red4(s_) * (1.f / 128.f); float q = 0.f;
#pragma unroll
        for (int i = 0; i < 32; ++i) { v[i] -= mean; q += v[i] * v[i]; }
        const float rstd = 1.f / sqrtf(red4(q) * (1.f / 128.f) + EPS);
#pragma unroll
        for (int i = 0; i < 32; i += 2) { const unsigned w = cvtpk(v[i] * rstd, v[i + 1] * rstd);
            *(LAS unsigned short*)(VTB + (qt * 32 + i) * 272 + 2 * row) = (unsigned short)w; *(LAS unsigned short*)(VTB + (qt * 32 + i + 1) * 272 + 2 * row) = (unsigned short)(w >> 16); }
    }
    for (int idx = F.tid; idx < 4096; idx += NTHREADS) { const int p = idx >> 5, q4 = idx & 31; const f32x4 w = *(const f32x4*)(w_s + p * 128 + 4 * q4);
        *(LAS u32x2*)(WB + p * 272 + 8 * q4) = (u32x2){cvtpk(w.x, w.y), cvtpk(w.z, w.w)}; }
    WG_BAR();
    {   const int l31 = F.lane & 31, hh = F.lane >> 5, mt = F.wave >> 1;
#pragma unroll
        for (int nn = 0; nn < 2; ++nn) { const int nt = (F.wave & 1) * 2 + nn; f32x16 d = zero16();
#pragma unroll
            for (int ks = 0; ks < 8; ++ks) d = __builtin_amdgcn_mfma_f32_32x32x16_bf16(*(const LAS bf16x8*)(WB + (32 * mt + l31) * 272 + (16 * ks + 8 * hh) * 2), *(const LAS bf16x8*)(VTB + (32 * nt + l31) * 272 + (16 * ks + 8 * hh) * 2), d, 0, 0, 0);
#pragma unroll
            for (int r = 0; r < 16; ++r) MX[(32 * mt + MROW(r, hh)) * 132 + 32 * nt + l31] = d[r]; }
    }
    WG_BAR();
    const int pg = F.tid >> 5, dg = F.tid & 31;
    f32x4 acc[8];
#pragma unroll
    for (int i = 0; i < 8; ++i) acc[i] = *(const LAS f32x4*)(MX + (8 * pg + i) * 132 + 4 * dg);
#pragma unroll
    for (int i = 0; i < 8; ++i) { const int p = 8 * pg + i; const float bs = b_s[p]; const bf16* pr = P + (size_t)(row0 + p) * NINP + h * 128 + 4 * dg;
        const u32x2 uu = *(const u32x2*)(pr + A_U), gg = *(const u32x2*)(pr + A_G);
        const float o0 = bflo(uu.x) * (acc[i].x + bs) * silu_f(bflo(gg.x)), o1 = bfhi(uu.x) * (acc[i].y + bs) * silu_f(bfhi(gg.x));
        const float o2 = bflo(uu.y) * (acc[i].z + bs) * silu_f(bflo(gg.y)), o3 = bfhi(uu.y) * (acc[i].w + bs) * silu_f(bfhi(gg.y));
        u32x2 w; w.x = cvtpk(o0, o1); w.y = cvtpk(o2, o3); *(u32x2*)(OC + (size_t)(row0 + p) * DM + h * 128 + 4 * dg) = w; }
    WG_BAR();
}

__device__ __forceinline__ void conv_item(Ctx& F, int l, int item) {
    const bf16* P = (const bf16*)(F.ws + WS_P); bf16* OC = (bf16*)(F.ws + WS_OC); const float* cw = F.prm->in[27] + (size_t)l * 3 * 512;
    const int row = item * 16 + (F.tid >> 5), c0 = (F.tid & 31) * 16;
    int t, tlen; if (row < ML) { t = row & (TL - 1); tlen = TL; } else { t = (row - ML) & (CL - 1); tlen = CL; }
    const bf16* pr = P + (size_t)row * NINP;
    float z0[16], z1[16], z2[16], tmp[16];
#pragma unroll
    for (int i = 0; i < 2; ++i) {
        float a[8], b[8];
        unpack8(*(const u32x4*)(pr + D_C + c0 + 8 * i), a); unpack8(*(const u32x4*)(pr + D_X + c0 + 8 * i), b);
#pragma unroll
        for (int e = 0; e < 8; ++e) z1[8 * i + e] = a[e] * b[e];
        if (t > 0) { unpack8(*(const u32x4*)(pr - NINP + D_C + c0 + 8 * i), a); unpack8(*(const u32x4*)(pr - NINP + D_X + c0 + 8 * i), b);
#pragma unroll
            for (int e = 0; e < 8; ++e) z0[8 * i + e] = a[e] * b[e]; }
        else {
#pragma unroll
            for (int e = 0; e < 8; ++e) z0[8 * i + e] = 0.f; }
        if (t < tlen - 1) { unpack8(*(const u32x4*)(pr + NINP + D_C + c0 + 8 * i), a); unpack8(*(const u32x4*)(pr + NINP + D_X + c0 + 8 * i), b);
#pragma unroll
            for (int e = 0; e < 8; ++e) z2[8 * i + e] = a[e] * b[e]; }
        else {
#pragma unroll
            for (int e = 0; e < 8; ++e) z2[8 * i + e] = 0.f; }
    }
#pragma unroll
    for (int i = 0; i < 2; ++i) {
        float bg[8], gg[8]; unpack8(*(const u32x4*)(pr + D_B + c0 + 8 * i), bg); unpack8(*(const u32x4*)(pr + D_G + c0 + 8 * i), gg);
#pragma unroll
        for (int e = 0; e < 8; ++e) { const int c = c0 + 8 * i + e; const float y = cw[c] * z0[8 * i + e] + cw[512 + c] * z1[8 * i + e] + cw[1024 + c] * z2[8 * i + e]; tmp[e] = bg[e] * y * silu_f(gg[e]); }
        *(u32x4*)(OC + (size_t)row * DM + 1536 + c0 + 8 * i) = pack8(tmp);
    }
}

__device__ __forceinline__ void attnprep_item(Ctx& F, int l, int rb, int h) {
    const bf16* P = (const bf16*)(F.ws + WS_P); const float* rope = (const float*)(F.ws + WS_ROPE);
    bf16* QR = (bf16*)(F.ws + WS_QR); bf16* QC = (bf16*)(F.ws + WS_QC); bf16* KR = (bf16*)(F.ws + WS_KR); bf16* VT = (bf16*)(F.ws + WS_VT);
    const bool lat = rb < 128; const int b = lat ? (rb >> 6) : ((rb - 128) >> 2), t0 = lat ? (rb & 63) * 64 : ((rb - 128) & 3) * 64;
    const int row0 = lat ? b * TL + t0 : ML + b * CL + t0;
    {
        const int tk = F.tid >> 3, sub = F.tid & 7, isk = sub >> 2, hq = sub & 3, m = hq >> 1, half = hq & 1, t = t0 + tk;
        const bf16* src = P + (size_t)(row0 + tk) * NINP + (isk ? B_K : B_Q) + h * 128 + 32 * hq;
        float xx[32], oo[32];
#pragma unroll
        for (int i = 0; i < 4; ++i) unpack8(*(const u32x4*)(src + 8 * i), xx + 8 * i);
        if (lat) { const int pos = half ? (t & 63) : (t >> 6); const float* cs = rope + pos * 16; const float* sn = rope + 1024 + pos * 16;
#pragma unroll
            for (int i = 0; i < 16; ++i) { const float c = cs[i], s = sn[i]; oo[i] = xx[i] * c - xx[i + 16] * s; oo[i + 16] = xx[i + 16] * c + xx[i] * s; } }
        else {
#pragma unroll
            for (int i = 0; i < 32; ++i) oo[i] = xx[i]; }
        if (!isk) {
#pragma unroll
            for (int i = 0; i < 32; ++i) oo[i] *= QSCALE; }
        const int bhm = (b * 4 + h) * 2 + m;
        bf16* dst = isk ? KR + ((size_t)bhm * KEYS + (lat ? CL + t : t)) * 64 + 32 * half : (lat ? QR + ((size_t)bhm * TL + t) * 64 + 32 * half : QC + ((size_t)bhm * CL + t) * 64 + 32 * half);
        if (isk || lat || l == 0) {
#pragma unroll
            for (int i = 0; i < 4; ++i) *(u32x4*)(dst + 8 * i) = pack8(oo + 8 * i); }
    }
    LAS unsigned char* VL = F.lds;
#pragma unroll
    for (int pass = 0; pass < 2; ++pass) { const int idx = F.tid + 512 * pass, key = idx >> 4, c = idx & 15;
        *(LAS u32x4*)(VL + key * 272 + 16 * c) = *(const u32x4*)(P + (size_t)(row0 + key) * NINP + B_V + h * 128 + 8 * c); }
    WG_BAR();
    const int keybase = lat ? CL + t0 : t0;
#pragma unroll
    for (int pass = 0; pass < 2; ++pass) { const int idx = F.tid + 512 * pass, dv = idx >> 3, kc = idx & 7; unsigned short e[8];
#pragma unroll
        for (int i = 0; i < 8; ++i) e[i] = *(const LAS unsigned short*)(VL + (8 * kc + i) * 272 + 2 * dv);
        u32x4 o; o.x = e[0] | ((unsigned)e[1] << 16); o.y = e[2] | ((unsigned)e[3] << 16); o.z = e[4] | ((unsigned)e[5] << 16); o.w = e[6] | ((unsigned)e[7] << 16);
        *(u32x4*)(VT + ((size_t)(b * 4 + h) * 128 + dv) * KEYS + keybase + 8 * kc) = o; }
    WG_BAR();
}

constexpr int NCHUNK = NSTEP / 64;
constexpr int CHKB = 62464;
constexpr int CK_W1F = 0, CK_RF = 8192, CK_BTF = 16384, CK_ARBF = 24576, CK_YCA = 30720  , CK_VF = 36864  , CK_W2A = 45056, CK_GA = 53248, CK_CLV = 61440;
static_assert((size_t)32 * NCHUNK * CHKB <= WS_Y - WS_CHK, "chunk records");

__device__ __forceinline__ bf16x8 frag16(const LAS unsigned char* tile, int row, int k0) { return *(const LAS bf16x8*)(tile + row * 144 + k0 * 2); }
__device__ __forceinline__ bf16x8 fragP(const LAS unsigned char* tile, int row, int base, int hh) {
    const u32x2 lo = *(const LAS u32x2*)(tile + row * 144 + (base + 4 * hh) * 2), hi = *(const LAS u32x2*)(tile + row * 144 + (base + 8 + 4 * hh) * 2);
    const u32x4 w = {lo.x, lo.y, hi.x, hi.y}; return __builtin_bit_cast(bf16x8, w);
}
template <int S8> __device__ __forceinline__ bf16x8 pk8(const f32x16& a) {
    const u32x4 w = {cvtpk(a[S8], a[S8 + 1]), cvtpk(a[S8 + 2], a[S8 + 3]), cvtpk(a[S8 + 4], a[S8 + 5]), cvtpk(a[S8 + 6], a[S8 + 7])}; return __builtin_bit_cast(bf16x8, w);
}
__device__ __forceinline__ f32x16 tile_prod(const LAS unsigned char* At, int m0, const LAS unsigned char* Bt, int n0, int l31, int hh) {
    f32x16 d = zero16();
#pragma unroll
    for (int q = 0; q < 4; ++q) d = __builtin_amdgcn_mfma_f32_32x32x16_bf16(frag16(At, m0 + l31, 16 * q + 8 * hh), frag16(Bt, n0 + l31, 16 * q + 8 * hh), d, 0, 0, 0);
    return d;
}
__device__ __forceinline__ void st_acc32(unsigned char* p, const f32x16& d) {
    *(u32x4*)p = (u32x4){cvtpk(d[0], d[1]), cvtpk(d[2], d[3]), cvtpk(d[4], d[5]), cvtpk(d[6], d[7])};
    *(u32x4*)(p + 16) = (u32x4){cvtpk(d[8], d[9]), cvtpk(d[10], d[11]), cvtpk(d[12], d[13]), cvtpk(d[14], d[15])};
}
__device__ __forceinline__ f32x16 ld_acc32(const LAS unsigned char* p) {
    const u32x4 a = *(const LAS u32x4*)p, b = *(const LAS u32x4*)(p + 16); f32x16 d;
    d[0] = bflo(a.x); d[1] = bfhi(a.x); d[2] = bflo(a.y); d[3] = bfhi(a.y); d[4] = bflo(a.z); d[5] = bfhi(a.z); d[6] = bflo(a.w); d[7] = bfhi(a.w);
    d[8] = bflo(b.x); d[9] = bfhi(b.x); d[10] = bflo(b.y); d[11] = bfhi(b.y); d[12] = bflo(b.z); d[13] = bfhi(b.z); d[14] = bflo(b.w); d[15] = bfhi(b.w); return d;
}
__device__ __forceinline__ f32x16 acc_from(const u32x4 a, const u32x4 b) { f32x16 d;
    d[0] = bflo(a.x); d[1] = bfhi(a.x); d[2] = bflo(a.y); d[3] = bfhi(a.y); d[4] = bflo(a.z); d[5] = bfhi(a.z); d[6] = bflo(a.w); d[7] = bfhi(a.w);
    d[8] = bflo(b.x); d[9] = bfhi(b.x); d[10] = bflo(b.y); d[11] = bfhi(b.y); d[12] = bflo(b.z); d[13] = bfhi(b.z); d[14] = bflo(b.w); d[15] = bfhi(b.w); return d; }
__device__ __forceinline__ float softplus_f(float x) { return fmaxf(x, 0.f) + __logf(1.f + __expf(-fabsf(x))); }
__device__ __forceinline__ int scan_row(int c, int i, int dir, int b) {
    const bool isctx = c < 4; const int bi = (isctx ? 64 * c : 64 * (c - 4)) + i;
    return isctx ? ML + b * CL + (dir ? CL - 1 - bi : bi) : b * TL + (dir ? TL - 1 - bi : bi);
}

struct R1In { u32x4 g_l, g_r, g_k, g_v, p_l, p_r, p_k, p_v; u32x2 g_a, p_a; };
__device__ __forceinline__ void r1_load(Ctx& F, int item, R1In& in) {
    const int scan = item / NCHUNK, c = item % NCHUNK, dir = scan >> 4, b = (scan >> 3) & 1, h = scan & 7;
    const bf16* P = (const bf16*)(F.ws + WS_P);
    const int i = F.tid >> 3, sub = F.tid & 7, c0 = 8 * sub, gc0 = h * 64 + c0;
    const bool isctx = c < 4; const int bi = (isctx ? 64 * c : 64 * (c - 4)) + i;
    const int row = scan_row(c, i, dir, b);
    const bf16* pr = P + (size_t)row * NINP; const bf16* pp = (bi > 0) ? (dir ? pr + NINP : pr - NINP) : pr;
    const int CLX = dir == 0 ? C_LF : C_LB;
    in.g_l = *(const u32x4*)(pr + CLX + c0); in.g_r = *(const u32x4*)(pr + C_R + gc0); in.g_k = *(const u32x4*)(pr + C_K + gc0); in.g_v = *(const u32x4*)(pr + C_V + gc0); in.g_a = *(const u32x2*)(pr + CLX + 64 + 4 * sub);
    in.p_l = *(const u32x4*)(pp + CLX + c0); in.p_r = *(const u32x4*)(pp + C_R + gc0); in.p_k = *(const u32x4*)(pp + C_K + gc0); in.p_v = *(const u32x4*)(pp + C_V + gc0); in.p_a = *(const u32x2*)(pp + CLX + 64 + 4 * sub);
}
__device__ __forceinline__ void rwkv1_item(Ctx& F, int l, int item, R1In& in, int next_item) {
    const int scan = item / NCHUNK, c = item % NCHUNK, dir = scan >> 4, b = (scan >> 3) & 1, h = scan & 7;
    const bf16* P = (const bf16*)(F.ws + WS_P); unsigned char* rec = F.ws + WS_CHK + (size_t)item * CHKB;
    bf16* BON = (bf16*)(F.ws + WS_BON) + (size_t)dir * MT * 512;
    LAS unsigned char* TA = F.lds; LAS unsigned char* TB = F.lds + 9216; LAS unsigned char* TK = F.lds + 18432; LAS unsigned char* TR = F.lds + 27648;
    LAS unsigned char* TAT = F.lds + 36864; LAS unsigned char* TBT = F.lds + 46080; LAS unsigned char* TKT = F.lds + 55296; LAS unsigned char* TVT = F.lds + 64512;
    LAS unsigned char* TT = F.lds + 73728;
    LAS float* AAB = (LAS float*)(F.lds + 82944);
    LAS float* CLS = (LAS float*)(F.lds + 100352);
    LAS unsigned char* A21B = F.lds + 116736; LAS unsigned char* T11T = F.lds + 119296;
    LAS unsigned char* LWH = F.lds;             LAS unsigned char* LWL = F.lds + 9216;
    LAS unsigned char* LAH = F.lds + 18432;     LAS unsigned char* LAL = F.lds + 23552;
    LAS unsigned char* XWH = F.lds + 28672;     LAS unsigned char* XWL = F.lds + 37888;
    LAS unsigned char* XAH = F.lds + 47104;     LAS unsigned char* XAL = F.lds + 52224;
    LAS float* OW = (LAS float*)(F.lds + 57344);
    LAS float* OA = (LAS float*)(F.lds + 74752);
    const int i = F.tid >> 3, sub = F.tid & 7, c0 = 8 * sub, gc0 = h * 64 + c0;
    const bool isctx = c < 4; const int bi = (isctx ? 64 * c : 64 * (c - 4)) + i;
    const int row = scan_row(c, i, dir, b);
    const bool hasprev = bi > 0;
    const bf16* pr = P + (size_t)row * NINP; const bf16* pp = dir ? pr + NINP : pr - NINP;
    const int pd = l * 2 + dir;
    const float* mu = F.prm->in[17] + (size_t)pd * 1632; const float* w0 = F.prm->in[18] + (size_t)pd * 512; const float* w2 = F.prm->in[19] + (size_t)pd * 64 * 512;
    const float* a0 = F.prm->in[20] + (size_t)pd * 512; const float* a2 = F.prm->in[21] + (size_t)pd * 32 * 512; const float* k_k = F.prm->in[22] + (size_t)pd * 512;
    const float* k_a = F.prm->in[23] + (size_t)pd * 512; const float* r_k = F.prm->in[24] + (size_t)pd * 512;
    const int CLX = dir == 0 ? C_LF : C_LB;
    f32x4 pm_[16];
    { const float* pv_[8] = {mu + gc0, mu + 512 + gc0, mu + 1024 + gc0, w0 + gc0, a0 + gc0, k_k + gc0, k_a + gc0, r_k + gc0};
#pragma unroll
      for (int v = 0; v < 8; ++v) { pm_[2 * v] = *(const f32x4*)(pv_[v]); pm_[2 * v + 1] = *(const f32x4*)(pv_[v] + 4); } }
#define PM(v, e) (pm_[2 * (v) + ((e) >> 2)][(e) & 3])
    const u32x4 zz4 = {0u, 0u, 0u, 0u}; const u32x2 zz2 = {0u, 0u};
    const u32x4 g_l = in.g_l, g_r = in.g_r, g_k = in.g_k, g_v = in.g_v; const u32x2 g_a = in.g_a;
    const u32x4 p_l = hasprev ? in.p_l : zz4, p_r = hasprev ? in.p_r : zz4, p_k = hasprev ? in.p_k : zz4, p_v = hasprev ? in.p_v : zz4; const u32x2 p_a = hasprev ? in.p_a : zz2;
    {
        const unsigned char* lwg = F.ws + WS_LW + (size_t)(pd * 8 + h) * 24576;
        { const int p = F.tid, r = p >> 3, cq = p & 7; *(LAS u32x4*)(LWH + r * 144 + cq * 16) = *(const u32x4*)(lwg + p * 16); *(LAS u32x4*)(LWL + r * 144 + cq * 16) = *(const u32x4*)(lwg + 8192 + p * 16); }
        { const int p = F.tid & 255, r = p >> 2, cq = p & 3; LAS unsigned char* dst = (F.tid < 256 ? LAH : LAL); *(LAS u32x4*)(dst + r * 80 + cq * 16) = *(const u32x4*)(lwg + 16384 + (F.tid < 256 ? 0 : 4096) + p * 16); }
    }
    {   float f[8], pv[8], th[8], tl[8]; unpack8(g_l, f); unpack8(p_l, pv);
        const f32x4 mw0 = *(const f32x4*)(mu + 1536 + c0), mw1 = *(const f32x4*)(mu + 1536 + c0 + 4), ma0 = *(const f32x4*)(mu + 1600 + 4 * sub); const float muw[8] = {mw0.x, mw0.y, mw0.z, mw0.w, mw1.x, mw1.y, mw1.z, mw1.w}, mua[4] = {ma0.x, ma0.y, ma0.z, ma0.w};
#pragma unroll
        for (int e = 0; e < 8; ++e) { const float z = f[e] + (pv[e] - f[e]) * muw[e]; const float ez = __expf(-2.f * fabsf(z)); const float t0 = (1.f - ez) * __builtin_amdgcn_rcpf(1.f + ez); const float tv = z < 0.f ? -t0 : t0;
            th[e] = bflo(cvtpk(tv, 0.f)); tl[e] = tv - th[e]; }
        *(LAS u32x4*)(XWH + i * 144 + 2 * c0) = pack8(th); *(LAS u32x4*)(XWL + i * 144 + 2 * c0) = pack8(tl);
        const float fz[4] = {bflo(g_a.x), bfhi(g_a.x), bflo(g_a.y), bfhi(g_a.y)}, pz[4] = {bflo(p_a.x), bfhi(p_a.x), bflo(p_a.y), bfhi(p_a.y)}; float zh[4], zl[4];
#pragma unroll
        for (int e = 0; e < 4; ++e) { const float z = fz[e] + (pz[e] - fz[e]) * mua[e]; zh[e] = bflo(cvtpk(z, 0.f)); zl[e] = z - zh[e]; }
        *(LAS u32x2*)(XAH + i * 80 + 8 * sub) = (u32x2){cvtpk(zh[0], zh[1]), cvtpk(zh[2], zh[3])}; *(LAS u32x2*)(XAL + i * 80 + 8 * sub) = (u32x2){cvtpk(zl[0], zl[1]), cvtpk(zl[2], zl[3])};
    }
    WG_BAR();
    {
        const int l31 = F.lane & 31, hh = F.lane >> 5, mt = (F.wave >> 1) & 1, nt = F.wave & 1;
        f32x16 d = zero16();
        if (F.wave < 4) {
#pragma unroll
            for (int q = 0; q < 4; ++q) { const bf16x8 ah = frag16(XWH, 32 * mt + l31, 16 * q + 8 * hh), al_ = frag16(XWL, 32 * mt + l31, 16 * q + 8 * hh), bh = frag16(LWH, 32 * nt + l31, 16 * q + 8 * hh), bl = frag16(LWL, 32 * nt + l31, 16 * q + 8 * hh);
                d = __builtin_amdgcn_mfma_f32_32x32x16_bf16(ah, bh, d, 0, 0, 0); d = __builtin_amdgcn_mfma_f32_32x32x16_bf16(ah, bl, d, 0, 0, 0); d = __builtin_amdgcn_mfma_f32_32x32x16_bf16(al_, bh, d, 0, 0, 0); }
#pragma unroll
            for (int r = 0; r < 16; ++r) OW[(32 * mt + MROW(r, hh)) * 68 + 32 * nt + l31] = d[r];
        } else {
#pragma unroll
            for (int q = 0; q < 2; ++q) { const int ko = (16 * q + 8 * hh) * 2;
                const bf16x8 ah = *(const LAS bf16x8*)(XAH + (32 * mt + l31) * 80 + ko), al_ = *(const LAS bf16x8*)(XAL + (32 * mt + l31) * 80 + ko), bh = *(const LAS bf16x8*)(LAH + (32 * nt + l31) * 80 + ko), bl = *(const LAS bf16x8*)(LAL + (32 * nt + l31) * 80 + ko);
                d = __builtin_amdgcn_mfma_f32_32x32x16_bf16(ah, bh, d, 0, 0, 0); d = __builtin_amdgcn_mfma_f32_32x32x16_bf16(ah, bl, d, 0, 0, 0); d = __builtin_amdgcn_mfma_f32_32x32x16_bf16(al_, bh, d, 0, 0, 0); }
#pragma unroll
            for (int r = 0; r < 16; ++r) OA[(32 * mt + MROW(r, hh)) * 68 + 32 * nt + l31] = d[r];
        }
    }
    WG_BAR();
    float wp[8], ap[8];
    { const f32x4 a = *(const LAS f32x4*)(OW + i * 68 + c0), bq = *(const LAS f32x4*)(OW + i * 68 + c0 + 4), cq = *(const LAS f32x4*)(OA + i * 68 + c0), dq = *(const LAS f32x4*)(OA + i * 68 + c0 + 4);
      const float ow[8] = {a.x, a.y, a.z, a.w, bq.x, bq.y, bq.z, bq.w}, oa[8] = {cq.x, cq.y, cq.z, cq.w, dq.x, dq.y, dq.z, dq.w};
#pragma unroll
      for (int e = 0; e < 8; ++e) { wp[e] = PM(3, e) + ow[e]; ap[e] = PM(4, e) + oa[e]; } }
    float lw[8], kk[8], al[8], km[8], rr[8], vv[8];
    {   float fr[8], fk[8], fv[8], qr[8], qk[8], qv[8]; unpack8(g_r, fr); unpack8(g_k, fk); unpack8(g_v, fv); unpack8(p_r, qr); unpack8(p_k, qk); unpack8(p_v, qv);
        float n2 = 0.f, bsum = 0.f;
#pragma unroll
        for (int e = 0; e < 8; ++e) { const int gc = gc0 + e;
            rr[e] = fr[e] + (qr[e] - fr[e]) * PM(0, e); const float kx = fk[e] + (qk[e] - fk[e]) * PM(1, e); vv[e] = fv[e] + (qv[e] - fv[e]) * PM(2, e);
            const float w = -softplus_f(-wp[e]) - 0.5f; lw[e] = -__expf(w);
            al[e] = __builtin_amdgcn_rcpf(1.f + __expf(-ap[e]));
            kk[e] = kx * PM(5, e); n2 += kk[e] * kk[e];
            km[e] = kx * (1.f + (al[e] - 1.f) * PM(6, e));
            bsum += rr[e] * km[e] * PM(7, e); }
        n2 = red8(n2); bsum = red8(bsum);
        const float inv = __builtin_amdgcn_rsqf(fmaxf(n2, 1e-24f)); float bon[8];
#pragma unroll
        for (int e = 0; e < 8; ++e) { kk[e] *= inv; bon[e] = bsum * vv[e]; }
        *(u32x4*)(BON + (size_t)row * 512 + gc0) = pack8(bon);
    }
    *(LAS f32x4*)(CLS + i * 64 + c0) = (f32x4){lw[0], lw[1], lw[2], lw[3]}; *(LAS f32x4*)(CLS + i * 64 + c0 + 4) = (f32x4){lw[4], lw[5], lw[6], lw[7]};
    WG_BAR();
    if (F.tid < 64) {
        float x[64];
#pragma unroll
        for (int q = 0; q < 64; ++q) x[q] = CLS[q * 64 + F.tid];
#pragma unroll
        for (int q = 1; q < 64; ++q) x[q] += x[q - 1];
#pragma unroll
        for (int q = 0; q < 64; ++q) CLS[q * 64 + F.tid] = x[q];
    }
    WG_BAR();
    {   float cl[8], cL[8];
        { const f32x4 a = *(const LAS f32x4*)(CLS + i * 64 + c0), bq = *(const LAS f32x4*)(CLS + i * 64 + c0 + 4), cc = *(const LAS f32x4*)(CLS + 63 * 64 + c0), dd = *(const LAS f32x4*)(CLS + 63 * 64 + c0 + 4);
          cl[0] = a.x; cl[1] = a.y; cl[2] = a.z; cl[3] = a.w; cl[4] = bq.x; cl[5] = bq.y; cl[6] = bq.z; cl[7] = bq.w; cL[0] = cc.x; cL[1] = cc.y; cL[2] = cc.z; cL[3] = cc.w; cL[4] = dd.x; cL[5] = dd.y; cL[6] = dd.z; cL[7] = dd.w; }
        float tA[8], tB[8], tK[8], tR[8], tBt[8], tKt[8];
#pragma unroll
        for (int e = 0; e < 8; ++e) { const float eA = __expf(cl[e] - lw[e]), eI = __expf(-cl[e]), eR = __expf(cl[e]), eT = __expf(cL[e] - cl[e]); const float ba = kk[e] * al[e];
            tA[e] = -kk[e] * eA; tB[e] = ba * eI; tK[e] = km[e] * eI; tR[e] = rr[e] * eR; tBt[e] = ba * eT; tKt[e] = km[e] * eT; }
        *(LAS u32x4*)(TA + i * 144 + 2 * c0) = pack8(tA); *(LAS u32x4*)(TB + i * 144 + 2 * c0) = pack8(tB); *(LAS u32x4*)(TK + i * 144 + 2 * c0) = pack8(tK); *(LAS u32x4*)(TR + i * 144 + 2 * c0) = pack8(tR);
        const u32x4 qa = pack8(tA), qb = pack8(tBt), qk = pack8(tKt), qv = pack8(vv);
        const unsigned wa[4] = {qa.x, qa.y, qa.z, qa.w}, wb[4] = {qb.x, qb.y, qb.z, qb.w}, wk[4] = {qk.x, qk.y, qk.z, qk.w}, wv[4] = {qv.x, qv.y, qv.z, qv.w};
#pragma unroll
        for (int e0 = 0; e0 < 8; ++e0) { const int e = (e0 + sub) & 7;
            const unsigned ua = e < 2 ? wa[0] : e < 4 ? wa[1] : e < 6 ? wa[2] : wa[3], ub_ = e < 2 ? wb[0] : e < 4 ? wb[1] : e < 6 ? wb[2] : wb[3];
            const unsigned uk = e < 2 ? wk[0] : e < 4 ? wk[1] : e < 6 ? wk[2] : wk[3], uv = e < 2 ? wv[0] : e < 4 ? wv[1] : e < 6 ? wv[2] : wv[3];
            const int sh = (e & 1) * 16; const int o = (c0 + e) * 144 + 2 * i;
            *(LAS unsigned short*)(TAT + o) = (unsigned short)(ua >> sh); *(LAS unsigned short*)(TBT + o) = (unsigned short)(ub_ >> sh);
            *(LAS unsigned short*)(TKT + o) = (unsigned short)(uk >> sh); *(LAS unsigned short*)(TVT + o) = (unsigned short)(uv >> sh); }
    }
    WG_BAR();
    const int l31 = F.lane & 31, hh = F.lane >> 5;
    if (F.wave < 3) { const int it = F.wave > 0, jt = F.wave > 1; const f32x16 d = tile_prod(TA, 32 * it, TB, 32 * jt, l31, hh);
#pragma unroll
        for (int r = 0; r < 16; ++r) { const int ii = 32 * it + MROW(r, hh), j = 32 * jt + l31; AAB[ii * 68 + (j & 7) * 8 + (j >> 3)] = j < ii ? d[r] : 0.f; }
        if (F.wave == 1) {
#pragma unroll
            for (int r = 0; r < 16; r += 2) { const unsigned w = cvtpk(d[r], d[r + 1]); *(LAS unsigned short*)(A21B + MROW(r, hh) * 80 + 2 * l31) = (unsigned short)w; *(LAS unsigned short*)(A21B + MROW(r + 1, hh) * 80 + 2 * l31) = (unsigned short)(w >> 16); } } }
    else if (F.wave == 3) {
#pragma unroll
        for (int r = 0; r < 16; ++r) AAB[(2 * r + hh) * 68 + (l31 & 7) * 8 + 4 + (l31 >> 3)] = 0.f; }
    else if (F.wave == 4) {
#pragma unroll
        for (int f = 0; f < 8; ++f) { const int it = f >> 2, kt = (f >> 1) & 1, s = f & 1; *(bf16x8*)(rec + CK_RF + (f * 64 + F.lane) * 16) = fragP(TR, 32 * it + l31, 32 * kt + 16 * s, hh); } }
    else if (F.wave == 5) {
#pragma unroll
        for (int f = 0; f < 8; ++f) { const int kt = f >> 2, jt = (f >> 1) & 1, s = f & 1; *(bf16x8*)(rec + CK_BTF + (f * 64 + F.lane) * 16) = fragP(TBT, 32 * kt + l31, 32 * jt + 16 * s, hh); } }
    else if (F.wave == 7) { *(float*)(rec + CK_CLV + 4 * F.lane) = __expf(CLS[63 * 64 + F.lane]); }
    WG_BAR();
    {   const int blk = F.tid >> 8, col = (F.tid >> 3) & 31; int dg = col; float town[4];
#pragma unroll
        for (int q = 0; q < 4; ++q) town[q] = 0.f;
        const LAS float* arow = AAB + blk * 32 * 68 + sub * 8 + blk * 4; asm volatile("" : "+v"(arow));
        f32x4 na0 = *(const LAS f32x4*)(arow);
#pragma unroll
        for (int q = 0; q < 4; ++q)
#pragma unroll
            for (int r = 0; r < 8; ++r) { const int ii = 8 * q + r;
                const f32x4 a0 = na0;
                if (ii + 1 < 32) na0 = *(const LAS f32x4*)(arow + (ii + 1) * 68);
                float p = a0.x * town[0];
                if (q >= 1) p += a0.y * town[1]; if (q >= 2) p += a0.z * town[2]; if (q >= 3) p += a0.w * town[3];
                p = red8(p);
                const float tv = p + ((dg == 0) ? 1.f : 0.f); dg -= 1; asm volatile("" : "+v"(dg));
                town[q] = (sub == r) ? tv : town[q];
            }
        LAS unsigned char* ttw = TT + (blk * 32) * 144 + 2 * (blk * 32 + col);
#pragma unroll
        for (int q = 0; q < 4; ++q) { const unsigned short tb = (unsigned short)cvtpk(town[q], 0.f); *(LAS unsigned short*)(ttw + (8 * q + sub) * 144) = tb;
            if (blk == 0) *(LAS unsigned short*)(T11T + col * 80 + 2 * (8 * q + sub)) = tb; }
        if (blk == 1) { const int t = F.tid - 256; *(LAS u32x2*)(TT + (t >> 3) * 144 + 64 + 8 * (t & 7)) = (u32x2){0u, 0u}; }
    }
    WG_BAR();
    if (F.wave == 0) {
        f32x16 m = zero16();
#pragma unroll
        for (int s2 = 0; s2 < 2; ++s2) m = __builtin_amdgcn_mfma_f32_32x32x16_bf16(*(const LAS bf16x8*)(A21B + l31 * 80 + (16 * s2 + 8 * hh) * 2), *(const LAS bf16x8*)(T11T + l31 * 80 + (16 * s2 + 8 * hh) * 2), m, 0, 0, 0);
        f32x16 t21 = zero16();
        t21 = __builtin_amdgcn_mfma_f32_32x32x16_bf16(fragP(TT, 32 + l31, 32, hh), pk8<0>(m), t21, 0, 0, 0);
        t21 = __builtin_amdgcn_mfma_f32_32x32x16_bf16(fragP(TT, 32 + l31, 48, hh), pk8<8>(m), t21, 0, 0, 0);
#pragma unroll
        for (int r = 0; r < 16; r += 2) { const unsigned w = cvtpk(t21[r], t21[r + 1]); *(LAS unsigned short*)(TT + (32 + MROW(r, hh)) * 144 + 2 * l31) = (unsigned short)w; *(LAS unsigned short*)(TT + (32 + MROW(r + 1, hh)) * 144 + 2 * l31) = (unsigned short)(w >> 16); }
    }
    f32x16 X0 = zero16(), X1 = zero16();
    if (F.wave == 0) {
    } else if (F.wave <= 2) {
        const int vt = F.wave - 1;
        f32x16 a00 = tile_prod(TK, 0, TA, 0, l31, hh), a11 = tile_prod(TK, 32, TA, 32, l31, hh); const f32x16 a01 = tile_prod(TK, 0, TA, 32, l31, hh);
#pragma unroll
        for (int r = 0; r < 16; ++r) { const bool keep = MROW(r, hh) < l31; a00[r] = keep ? a00[r] : 0.f; a11[r] = keep ? a11[r] : 0.f; }
        X0 = __builtin_amdgcn_mfma_f32_32x32x16_bf16(pk8<0>(a00), fragP(TVT, 32 * vt + l31, 0, hh), X0, 0, 0, 0);
        X0 = __builtin_amdgcn_mfma_f32_32x32x16_bf16(pk8<8>(a00), fragP(TVT, 32 * vt + l31, 16, hh), X0, 0, 0, 0);
        X1 = __builtin_amdgcn_mfma_f32_32x32x16_bf16(pk8<0>(a01), fragP(TVT, 32 * vt + l31, 0, hh), X1, 0, 0, 0);
        X1 = __builtin_amdgcn_mfma_f32_32x32x16_bf16(pk8<8>(a01), fragP(TVT, 32 * vt + l31, 16, hh), X1, 0, 0, 0);
        X1 = __builtin_amdgcn_mfma_f32_32x32x16_bf16(pk8<0>(a11), fragP(TVT, 32 * vt + l31, 32, hh), X1, 0, 0, 0);
        X1 = __builtin_amdgcn_mfma_f32_32x32x16_bf16(pk8<8>(a11), fragP(TVT, 32 * vt + l31, 48, hh), X1, 0, 0, 0);
    } else if (F.wave == 3) {
#pragma unroll
        for (int blk = 0; blk < 3; ++blk) { const int it = blk > 0, jt = blk > 1; f32x16 d = tile_prod(TB, 32 * jt, TR, 32 * it, l31, hh);
            if (it == jt) {
#pragma unroll
                for (int r = 0; r < 16; ++r) d[r] = MROW(r, hh) <= l31 ? d[r] : 0.f; }
            *(bf16x8*)(rec + CK_ARBF + ((blk * 2 + 0) * 64 + F.lane) * 16) = pk8<0>(d); *(bf16x8*)(rec + CK_ARBF + ((blk * 2 + 1) * 64 + F.lane) * 16) = pk8<8>(d); }
    } else if (F.wave == 4) {
        f32x16 d00 = tile_prod(TK, 0, TR, 0, l31, hh), d11 = tile_prod(TK, 32, TR, 32, l31, hh); const f32x16 d10 = tile_prod(TK, 0, TR, 32, l31, hh);
#pragma unroll
        for (int r = 0; r < 16; ++r) { const bool keep = MROW(r, hh) <= l31; d00[r] = keep ? d00[r] : 0.f; d11[r] = keep ? d11[r] : 0.f; }
#pragma unroll
        for (int vt = 0; vt < 2; ++vt) { f32x16 y0 = zero16(), y1 = zero16();
            y0 = __builtin_amdgcn_mfma_f32_32x32x16_bf16(pk8<0>(d00), fragP(TVT, 32 * vt + l31, 0, hh), y0, 0, 0, 0);
            y0 = __builtin_amdgcn_mfma_f32_32x32x16_bf16(pk8<8>(d00), fragP(TVT, 32 * vt + l31, 16, hh), y0, 0, 0, 0);
            y1 = __builtin_amdgcn_mfma_f32_32x32x16_bf16(pk8<0>(d10), fragP(TVT, 32 * vt + l31, 0, hh), y1, 0, 0, 0);
            y1 = __builtin_amdgcn_mfma_f32_32x32x16_bf16(pk8<8>(d10), fragP(TVT, 32 * vt + l31, 16, hh), y1, 0, 0, 0);
            y1 = __builtin_amdgcn_mfma_f32_32x32x16_bf16(pk8<0>(d11), fragP(TVT, 32 * vt + l31, 32, hh), y1, 0, 0, 0);
            y1 = __builtin_amdgcn_mfma_f32_32x32x16_bf16(pk8<8>(d11), fragP(TVT, 32 * vt + l31, 48, hh), y1, 0, 0, 0);
            st_acc32(rec + CK_YCA + ((0 * 2 + vt) * 64 + F.lane) * 32, y0); st_acc32(rec + CK_YCA + ((1 * 2 + vt) * 64 + F.lane) * 32, y1); }
    } else if (F.wave <= 6) {
        const int kt = F.wave - 5;
#pragma unroll
        for (int vt = 0; vt < 2; ++vt) { const f32x16 d = tile_prod(TKT, 32 * kt, TVT, 32 * vt, l31, hh); st_acc32(rec + CK_GA + ((kt * 2 + vt) * 64 + F.lane) * 32, d); }
    }
    WG_BAR();
    if (F.wave == 1 || F.wave == 2) { const int vt = F.wave - 1;
        f32x16 w0a = zero16(), w1a = zero16();
        w0a = __builtin_amdgcn_mfma_f32_32x32x16_bf16(fragP(TT, l31, 0, hh), pk8<0>(X0), w0a, 0, 0, 0);
        w0a = __builtin_amdgcn_mfma_f32_32x32x16_bf16(fragP(TT, l31, 16, hh), pk8<8>(X0), w0a, 0, 0, 0);
        w1a = __builtin_amdgcn_mfma_f32_32x32x16_bf16(fragP(TT, 32 + l31, 0, hh), pk8<0>(X0), w1a, 0, 0, 0);
        w1a = __builtin_amdgcn_mfma_f32_32x32x16_bf16(fragP(TT, 32 + l31, 16, hh), pk8<8>(X0), w1a, 0, 0, 0);
        w1a = __builtin_amdgcn_mfma_f32_32x32x16_bf16(fragP(TT, 32 + l31, 32, hh), pk8<0>(X1), w1a, 0, 0, 0);
        w1a = __builtin_amdgcn_mfma_f32_32x32x16_bf16(fragP(TT, 32 + l31, 48, hh), pk8<8>(X1), w1a, 0, 0, 0);
        st_acc32(rec + CK_W2A + ((0 * 2 + vt) * 64 + F.lane) * 32, w0a); st_acc32(rec + CK_W2A + ((1 * 2 + vt) * 64 + F.lane) * 32, w1a);
    } else if (F.wave >= 3 && F.wave <= 6) { const int kt = (F.wave - 3) >> 1, it = (F.wave - 3) & 1;
        const f32x16 d = tile_prod(TAT, 32 * kt, TT, 32 * it, l31, hh);
        *(bf16x8*)(rec + CK_W1F + ((((it * 2 + kt) * 2) + 0) * 64 + F.lane) * 16) = pk8<0>(d); *(bf16x8*)(rec + CK_W1F + ((((it * 2 + kt) * 2) + 1) * 64 + F.lane) * 16) = pk8<8>(d);
    }
    WG_BAR();
}

#ifdef TS_R2
#define R2BAR() do { const unsigned long long t0_ = __builtin_amdgcn_s_memrealtime(); WG_BAR(); r2wait += __builtin_amdgcn_s_memrealtime() - t0_; } while (0)
#else
#define R2BAR() WG_BAR()
#endif
template <int NC> __device__ __forceinline__ void rwkv2_role(Ctx& F, int cb) {
    unsigned long long r2wait = 0;
    const int scan = F.bx, dir = scan >> 4, b = (scan >> 3) & 1, h = scan & 7;
    const unsigned char* recs = F.ws + WS_CHK + ((size_t)scan * NCHUNK + cb) * CHKB;
    static_assert(NC % 2 == 0, "the Y waves alternate two register sets");
    float* Y = (float*)(F.ws + WS_Y) + (size_t)dir * MT * 512 + h * 64;
    const int l31 = F.lane & 31, hh = F.lane >> 5;
    constexpr int RSL = 33792, R_W1F = 0, R_BTF = 8192, R_W2A = 16384, R_GA = 24576, R_CLV = 32768;
    constexpr int EXO = 3 * RSL;
#define FR(off, idx) (*(const LAS bf16x8*)(lf + (off) + (idx) * 1024))
#define MM(a_, b_, c_) c_ = __builtin_amdgcn_mfma_f32_32x32x16_bf16(a_, b_, c_, 0, 0, 0)
    if (F.wave < 2) {
        const int vt = F.wave;
        f32x16 S0 = zero16(), S1 = zero16();
        float* sst = (float*)(F.ws + WS_SST) + ((size_t)(scan * 2 + vt) * 2 * 64 + F.lane) * 16;
        if (cb > 0) {
#pragma unroll
            for (int g = 0; g < 4; ++g) { const f32x4 a_ = *(const f32x4*)(sst + 4 * g), b_ = *(const f32x4*)(sst + 1024 + 4 * g);
#pragma unroll
                for (int e = 0; e < 4; ++e) { S0[4 * g + e] = a_[e]; S1[4 * g + e] = b_[e]; } } }
        R2BAR();
        for (int c = 0; c <= NC; ++c) {
            if (c < NC) {
                const LAS unsigned char* buf = F.lds + (c % 3) * RSL; const LAS unsigned char* lf = buf + F.lane * 16;
                LAS unsigned char* ex = F.lds + EXO + (c & 1) * 16384 + vt * 8192 + F.lane * 16;
                const bf16x8 sb00 = pk8<0>(S0), sb01 = pk8<8>(S0), sb10 = pk8<0>(S1), sb11 = pk8<8>(S1);
                *(LAS bf16x8*)(ex) = sb00; *(LAS bf16x8*)(ex + 1024) = sb01; *(LAS bf16x8*)(ex + 2048) = sb10; *(LAS bf16x8*)(ex + 3072) = sb11;
                f32x16 U0 = ld_acc32(buf + R_W2A + ((0 * 2 + vt) * 64 + F.lane) * 32), U1 = ld_acc32(buf + R_W2A + ((1 * 2 + vt) * 64 + F.lane) * 32);
                MM(FR(R_W1F, 0), sb00, U0); MM(FR(R_W1F, 4), sb00, U1); MM(FR(R_W1F, 1), sb01, U0); MM(FR(R_W1F, 5), sb01, U1);
                MM(FR(R_W1F, 2), sb10, U0); MM(FR(R_W1F, 6), sb10, U1); MM(FR(R_W1F, 3), sb11, U0); MM(FR(R_W1F, 7), sb11, U1);
                { const LAS float* clv = (const LAS float*)(buf + R_CLV);
                  const f32x16 g0 = ld_acc32(buf + R_GA + ((0 * 2 + vt) * 64 + F.lane) * 32), g1 = ld_acc32(buf + R_GA + ((1 * 2 + vt) * 64 + F.lane) * 32);
#pragma unroll
                  for (int g = 0; g < 4; ++g) { const f32x4 ca = *(const LAS f32x4*)(clv + 8 * g + 4 * hh), cb = *(const LAS f32x4*)(clv + 32 + 8 * g + 4 * hh);
#pragma unroll
                      for (int e = 0; e < 4; ++e) { S0[4 * g + e] = S0[4 * g + e] * ca[e] + g0[4 * g + e]; S1[4 * g + e] = S1[4 * g + e] * cb[e] + g1[4 * g + e]; } } }
                const bf16x8 ub00 = pk8<0>(U0), ub01 = pk8<8>(U0), ub10 = pk8<0>(U1), ub11 = pk8<8>(U1);
                *(LAS bf16x8*)(ex + 4096) = ub00; *(LAS bf16x8*)(ex + 5120) = ub01; *(LAS bf16x8*)(ex + 6144) = ub10; *(LAS bf16x8*)(ex + 7168) = ub11;
                MM(FR(R_BTF, 0), ub00, S0); MM(FR(R_BTF, 4), ub00, S1); MM(FR(R_BTF, 1), ub01, S0); MM(FR(R_BTF, 5), ub01, S1);
                MM(FR(R_BTF, 2), ub10, S0); MM(FR(R_BTF, 6), ub10, S1); MM(FR(R_BTF, 3), ub11, S0); MM(FR(R_BTF, 7), ub11, S1);
            }
            R2BAR();
        }
        if (cb + NC < NCHUNK) {
#pragma unroll
            for (int g = 0; g < 4; ++g) { *(f32x4*)(sst + 4 * g) = (f32x4){S0[4 * g], S0[4 * g + 1], S0[4 * g + 2], S0[4 * g + 3]}; *(f32x4*)(sst + 1024 + 4 * g) = (f32x4){S1[4 * g], S1[4 * g + 1], S1[4 * g + 2], S1[4 * g + 3]}; } }
    } else if (F.wave < 6) {
        const int w = F.wave - 2, vt = w & 1, it = w >> 1;
        const long ystep = dir ? -512 : 512;
        bf16x8 fa[8], fb[8]; u32x4 ya[2], yb[2];
        const int o_rf = CK_RF + it * 4096, o_arb = CK_ARBF + it * 2048, o_yc = CK_YCA + ((it * 2 + vt) * 64) * 32;
#define YLD(f, y, c_) do { const unsigned char* g_ = recs + (size_t)(c_) * CHKB + F.lane * 16; \
            _Pragma("unroll") for (int k = 0; k < 4; ++k) { f[k] = *(const bf16x8*)(g_ + o_rf + k * 1024); f[4 + k] = *(const bf16x8*)(g_ + o_arb + k * 1024); } \
            y[0] = *(const u32x4*)(g_ + o_yc + F.lane * 16); y[1] = *(const u32x4*)(g_ + o_yc + F.lane * 16 + 16); } while (0)
#define YDO(f, y, cm1) do { const LAS unsigned char* ex = F.lds + EXO + ((cm1) & 1) * 16384 + vt * 8192 + F.lane * 16; \
            const bf16x8 sb00 = *(const LAS bf16x8*)(ex), sb01 = *(const LAS bf16x8*)(ex + 1024), sb10 = *(const LAS bf16x8*)(ex + 2048), sb11 = *(const LAS bf16x8*)(ex + 3072); \
            const bf16x8 ub00 = *(const LAS bf16x8*)(ex + 4096), ub01 = *(const LAS bf16x8*)(ex + 5120), ub10 = *(const LAS bf16x8*)(ex + 6144), ub11 = *(const LAS bf16x8*)(ex + 7168); \
            f32x16 Yt = acc_from(y[0], y[1]); \
            MM(f[0], sb00, Yt); MM(f[1], sb01, Yt); MM(f[2], sb10, Yt); MM(f[3], sb11, Yt); \
            MM(f[4], ub00, Yt); MM(f[5], ub01, Yt); \
            if (it) { MM(f[6], ub10, Yt); MM(f[7], ub11, Yt); } \
            float* yp = Y + (size_t)scan_row(cb + (cm1), 32 * it + 4 * hh, dir, b) * 512 + 32 * vt + l31; \
            _Pragma("unroll") for (int g = 0; g < 4; ++g) { float* yg = yp + 8 * g * ystep; \
                _Pragma("unroll") for (int e = 0; e < 4; ++e) yg[e * ystep] = Yt[4 * g + e]; } } while (0)
        YLD(fa, ya, 0); YLD(fb, yb, 1);
        R2BAR();
        R2BAR();
        for (int c = 1; c <= NC; c += 2) {
            YDO(fa, ya, c - 1); YLD(fa, ya, (c + 1 < NC ? c + 1 : NC - 1));
            R2BAR();
            YDO(fb, yb, c); YLD(fb, yb, (c + 2 < NC ? c + 2 : NC - 1));
            R2BAR();
        }
#undef YLD
#undef YDO
    } else {
        int gsrc[17], ldst[17];
#pragma unroll
        for (int k = 0; k < 17; ++k) { int q = F.wave - 6 + 2 * k; q = q < 32 ? q : 32; const int rp = q < 8 ? q : (q < 16 ? q + 8 : q + 28); gsrc[k] = rp * 1024 + F.lane * 16; ldst[k] = q * 1024; }
#define R2_DMA(c_) do { const int cc_ = (c_) < NC ? (c_) : NC - 1; const int sl_ = ((c_) % 3) * RSL; _Pragma("unroll") for (int k = 0; k < 17; ++k) \
            __builtin_amdgcn_global_load_lds((const unsigned*)(recs + (size_t)cc_ * CHKB + gsrc[k]), (LAS unsigned*)(F.lds + sl_ + ldst[k]), 16, 0, 0); } while (0)
        R2_DMA(0); R2_DMA(1);
        asm volatile("s_waitcnt vmcnt(17)" ::: "memory");
        R2BAR();
        for (int c = 0; c <= NC; ++c) {
            R2_DMA(c + 2);
            asm volatile("s_waitcnt vmcnt(17)" ::: "memory");
            R2BAR();
        }
        asm volatile("s_waitcnt vmcnt(0)" ::: "memory");
#define R2_LD(a, b)
#define R2_WR(a, b)
#undef R2_LD
#undef R2_WR
    }
#undef FR
#undef MM
#ifdef TS_R2
    if (F.lane == 0 && F.bx == 0) ((unsigned*)(F.ws + WS_CTL))[2048 + F.wave] += (unsigned)r2wait;
#endif
}

#ifndef R_SGU
#define R_SGU 1
#endif
#ifndef R_R1
#define R_R1 1
#endif
#ifndef R_R2
#define R_R2 1
#endif
#ifndef R_AP
#define R_AP 1
#endif
#ifndef R_CV
#define R_CV 1
#endif
constexpr int NCH1 = 34, NCH2 = NCHUNK - NCH1;
__device__ __forceinline__ void r1_range(Ctx& F, int l, int c0, int nc, int w, int nw) {
    for (int q = w; q < 32 * nc; q += nw) { R1In in; const int item = (q / nc) * NCHUNK + c0 + q % nc; r1_load(F, item, in); rwkv1_item(F, l, item, in, -1); }
}
__device__ __forceinline__ void phase3a(Ctx& F, int l) { r1_range(F, l, 0, NCH1, F.bx, F.G); }
__device__ __forceinline__ void phase3b1(Ctx& F, int l) {
    if (F.bx < 32) { rwkv2_role<NCH1>(F, 0); return; }
    r1_range(F, l, NCH1, NCH2, F.bx - 32, F.G - 32);
}
__device__ __forceinline__ void phase3b(Ctx& F, int l) {
    if (F.bx < 32) { rwkv2_role<NCH2>(F, NCH1); return; }
    const int nsgu = (l == 0 ? 68 : 64) * 4, nap = 136 * 4, ncv = (l == 0 ? MT : ML) / 16;
    const int total = nsgu + nap + ncv;
    for (int it = F.bx - 32; it < total; it += F.G - 32) {
        int r = it;
        if (r < nsgu) { for (int q_ = 0; q_ < R_SGU; ++q_) sgu_item(F, l, r >> 2, r & 3); continue; } r -= nsgu;
        if (r < nap) { for (int q_ = 0; q_ < R_AP; ++q_) attnprep_item(F, l, r >> 2, r & 3); continue; } r -= nap;
        for (int q_ = 0; q_ < R_CV; ++q_) conv_item(F, l, r);
    }
}

__device__ __forceinline__ void attn_unit(Ctx& F, const bf16* Qp, const bf16* Kp, const bf16* Vtp, int nkt, float* Op) {
    constexpr int KB = 9216, VB = 18432, VOFF = 2 * KB;
    const int j = F.lane & 31, hh = F.lane >> 5;
    bf16x8 qf[4];
#pragma unroll
    for (int ks = 0; ks < 4; ++ks) qf[ks] = *(const bf16x8*)(Qp + (size_t)(F.wave * 32 + j) * 64 + ks * 16 + hh * 8);
    const int kkey = F.tid >> 3, kch = F.tid & 7;
    const bf16* ksrc = Kp + (size_t)kkey * 64 + kch * 8;
    const bf16* vsrc0 = Vtp + (size_t)kkey * KEYS + kch * 8; const bf16* vsrc1 = vsrc0 + (size_t)64 * KEYS;
    const int kdst = kkey * 144 + kch * 16, vdst0 = VOFF + kkey * 144 + kch * 16, vdst1 = vdst0 + 64 * 144;
    u32x4 rk, rv0, rv1;
    rk = *(const u32x4*)ksrc; rv0 = *(const u32x4*)vsrc0; rv1 = *(const u32x4*)vsrc1;
    *(LAS u32x4*)(F.lds + kdst) = rk; *(LAS u32x4*)(F.lds + vdst0) = rv0; *(LAS u32x4*)(F.lds + vdst1) = rv1;
    WG_BAR();
    const int sw = (j & ~12) | ((j & 4) << 1) | ((j & 8) >> 1);
    const int ka0 = sw * 144 + hh * 16, ka1 = (32 + sw) * 144 + hh * 16, va = VOFF + j * 144 + hh * 16;
    f32x16 acc[4];
#pragma unroll
    for (int i = 0; i < 4; ++i) acc[i] = zero16();
    f32x16 negm = zero16();
    float m_run = 0.f, l_run = 0.f;
    bf16x8 pf[4];
#pragma unroll
    for (int i = 0; i < 4; ++i) pf[i] = (bf16x8){0, 0, 0, 0, 0, 0, 0, 0};
    int vprev = 0, vcur = 0, vnext = VB;
    for (int kt = 0; kt <= nkt; ++kt) {
        const bool hasq = kt < nkt, hasn = kt + 1 < nkt;
        if (hasn) { rk = *(const u32x4*)(ksrc + (size_t)(kt + 1) * 64 * 64); rv0 = *(const u32x4*)(vsrc0 + (kt + 1) * 64); rv1 = *(const u32x4*)(vsrc1 + (kt + 1) * 64); }
        f32x16 s0 = negm, s1 = negm;
        if (hasq) { const LAS unsigned char* kb = F.lds + (kt & 1) * KB;
#pragma unroll
            for (int ks = 0; ks < 4; ++ks) {
                const bf16x8 a0 = *(const LAS bf16x8*)(kb + ka0 + ks * 32), a1 = *(const LAS bf16x8*)(kb + ka1 + ks * 32);
                s0 = __builtin_amdgcn_mfma_f32_32x32x16_bf16(a0, qf[ks], s0, 0, 0, 0);
                s1 = __builtin_amdgcn_mfma_f32_32x32x16_bf16(a1, qf[ks], s1, 0, 0, 0);
            } }
        if (kt > 0) { const LAS unsigned char* vb = F.lds + vprev;
#pragma unroll
            for (int blk = 0; blk < 4; ++blk)
#pragma unroll
                for (int kstep = 0; kstep < 4; ++kstep) {
                    const bf16x8 a = *(const LAS bf16x8*)(vb + va + blk * 32 * 144 + kstep * 32);
                    acc[blk] = __builtin_amdgcn_mfma_f32_32x32x16_bf16(a, pf[kstep], acc[blk], 0, 0, 0);
                } }
        if (hasq) {
            float mx = fmaxf(s0[0], s1[0]);
#pragma unroll
            for (int r = 1; r < 16; ++r) mx = fmaxf(mx, fmaxf(s0[r], s1[r]));
            { const auto rr = __builtin_amdgcn_permlane32_swap(__builtin_bit_cast(unsigned, mx), __builtin_bit_cast(unsigned, mx), false, false);
              mx = fmaxf(__builtin_bit_cast(float, rr[0]), __builtin_bit_cast(float, rr[1])); }
            if (__any(mx > 8.f)) {
                const float dl = fmaxf(mx, 0.f), f = __builtin_amdgcn_exp2f(-dl);
                m_run += dl; l_run *= f;
#pragma unroll
                for (int r = 0; r < 16; ++r) { s0[r] -= dl; s1[r] -= dl; negm[r] = -m_run; }
#pragma unroll
                for (int i = 0; i < 4; ++i)
#pragma unroll
                    for (int r = 0; r < 16; ++r) acc[i][r] *= f;
            }
            float ls = 0.f;
#pragma unroll
            for (int r = 0; r < 16; ++r) { s0[r] = __builtin_amdgcn_exp2f(s0[r]); s1[r] = __builtin_amdgcn_exp2f(s1[r]); ls += s0[r] + s1[r]; }
            l_run += ls;
            u32x4 w;
            w.x = cvtpk(s0[0], s0[1]); w.y = cvtpk(s0[2], s0[3]); w.z = cvtpk(s0[4], s0[5]); w.w = cvtpk(s0[6], s0[7]); pf[0] = __builtin_bit_cast(bf16x8, w);
            w.x = cvtpk(s0[8], s0[9]); w.y = cvtpk(s0[10], s0[11]); w.z = cvtpk(s0[12], s0[13]); w.w = cvtpk(s0[14], s0[15]); pf[1] = __builtin_bit_cast(bf16x8, w);
            w.x = cvtpk(s1[0], s1[1]); w.y = cvtpk(s1[2], s1[3]); w.z = cvtpk(s1[4], s1[5]); w.w = cvtpk(s1[6], s1[7]); pf[2] = __builtin_bit_cast(bf16x8, w);
            w.x = cvtpk(s1[8], s1[9]); w.y = cvtpk(s1[10], s1[11]); w.z = cvtpk(s1[12], s1[13]); w.w = cvtpk(s1[14], s1[15]); pf[3] = __builtin_bit_cast(bf16x8, w);
        }
        if (hasn) { LAS unsigned char* nk = F.lds + ((kt + 1) & 1) * KB; *(LAS u32x4*)(nk + kdst) = rk; *(LAS u32x4*)(F.lds + vnext + vdst0) = rv0; *(LAS u32x4*)(F.lds + vnext + vdst1) = rv1; }
        vprev = vcur; vcur = vnext; vnext = (vnext == 2 * VB) ? 0 : vnext + VB;
        WG_BAR();
    }
    const float inv = 1.f / (l_run + __shfl_xor(l_run, 32));
    float* orow = Op + (size_t)(F.wave * 32 + j) * 1024 + 4 * hh;
#pragma unroll
    for (int blk = 0; blk < 4; ++blk)
#pragma unroll
        for (int g = 0; g < 4; ++g) *(f32x4*)(orow + 32 * blk + 8 * g) = (f32x4){acc[blk][4 * g] * inv, acc[blk][4 * g + 1] * inv, acc[blk][4 * g + 2] * inv, acc[blk][4 * g + 3] * inv};
}

__device__ __forceinline__ void attn_role(Ctx& F, int l) {
    const int bh = F.bx & 7, m = (F.bx >> 3) & 1, k = F.bx >> 4, b = bh >> 2, h = bh & 3;
    const bf16* QR = (const bf16*)(F.ws + WS_QR); const bf16* QC = (const bf16*)(F.ws + WS_QC); const bf16* KR = (const bf16*)(F.ws + WS_KR); const bf16* VT = (const bf16*)(F.ws + WS_VT);
    float* OATT = (float*)(F.ws + WS_XN);
    const bf16* Vtp = VT + (size_t)bh * 128 * KEYS;
    { const int bhm = bh * 2 + m;
      attn_unit(F, QR + ((size_t)bhm * TL + k * 256) * 64, KR + (size_t)bhm * KEYS * 64, Vtp, KEYS / 64, OATT + (size_t)(b * TL + k * 256) * 1024 + (h * 2 + m) * 128); }
    if (l == 0 && F.bx < 16) {
        const int mc = F.bx >> 3, bhm = bh * 2 + mc;
        attn_unit(F, QC + (size_t)bhm * CL * 64, KR + (size_t)bhm * KEYS * 64, Vtp, CL / 64, OATT + (size_t)(ML + b * CL) * 1024 + (h * 2 + mc) * 128);
    }
}

__device__ __forceinline__ void phase4(Ctx& F, int l) {
    const bf16* P = (const bf16*)(F.ws + WS_P); bf16* OC = (bf16*)(F.ws + WS_OC); const float* OATT = (const float*)(F.ws + WS_XN);
    const float* Yf = (const float*)(F.ws + WS_Y); const float* Yb = Yf + (size_t)MT * 512; const bf16* BON = (const bf16*)(F.ws + WS_BON);
    const float lam_init = 0.8f - 0.6f * expf(-0.3f * (float)l);
    const float d1 = wave_sum(F.prm->in[12][l * 64 + F.lane] * F.prm->in[13][l * 64 + F.lane]), d2 = wave_sum(F.prm->in[14][l * 64 + F.lane] * F.prm->in[15][l * 64 + F.lane]);
    const float lam = expf(d1) - expf(d2) + lam_init;
    const float* subg = F.prm->in[16] + l * 128; const float* ln_w = F.prm->in[25] + l * 512; const float* ln_b = F.prm->in[26] + l * 512;
    const int nrows = l == 0 ? MT : ML;
    for (int row = F.gw; row < nrows; row += F.NGW) {
        {
            const int h = F.lane >> 4, dv0 = (F.lane & 15) * 8; const float* o1 = OATT + (size_t)row * 1024 + h * 256 + dv0; const float* o2 = o1 + 128;
            float o[8]; const f32x4 a0 = *(const f32x4*)o1, a1 = *(const f32x4*)(o1 + 4), b0 = *(const f32x4*)o2, b1 = *(const f32x4*)(o2 + 4);
            o[0] = a0.x - lam * b0.x; o[1] = a0.y - lam * b0.y; o[2] = a0.z - lam * b0.z; o[3] = a0.w - lam * b0.w; o[4] = a1.x - lam * b1.x; o[5] = a1.y - lam * b1.y; o[6] = a1.z - lam * b1.z; o[7] = a1.w - lam * b1.w;
            float ss = 0.f;
#pragma unroll
            for (int e = 0; e < 8; ++e) ss += o[e] * o[e];
            const float rs = (1.f - lam_init) / sqrtf(red16(ss) * (1.f / 128.f) + EPS);
            float gg[8]; unpack8(*(const u32x4*)(P + (size_t)row * NINP + B_G + h * 128 + dv0), gg);
#pragma unroll
            for (int e = 0; e < 8; ++e) o[e] = o[e] * rs * subg[dv0 + e] * silu_f(gg[e]);
            *(u32x4*)(OC + (size_t)row * DM + 512 + h * 128 + dv0) = pack8(o);
        }
        {
            const int c0 = F.lane * 8; const float* yf = Yf + (size_t)row * 512 + c0; const float* yb = Yb + (size_t)row * 512 + c0; const bf16* bo = BON + (size_t)row * 512 + c0;
            float y[8]; const f32x4 a0 = *(const f32x4*)yf, a1 = *(const f32x4*)(yf + 4), b0 = *(const f32x4*)yb, b1 = *(const f32x4*)(yb + 4);
            y[0] = a0.x + b0.x; y[1] = a0.y + b0.y; y[2] = a0.z + b0.z; y[3] = a0.w + b0.w; y[4] = a1.x + b1.x; y[5] = a1.y + b1.y; y[6] = a1.z + b1.z; y[7] = a1.w + b1.w;
            float s = 0.f;
#pragma unroll
            for (int e = 0; e < 8; ++e) s += y[e];
            const float mean = red8(s) * (1.f / 64.f); float q = 0.f;
#pragma unroll
            for (int e = 0; e < 8; ++e) { y[e] -= mean; q += y[e] * y[e]; }
            const float rstd = 1.f / sqrtf(red8(q) * (1.f / 64.f) + GN_EPS);
            float gg[8]; unpack8(*(const u32x4*)(P + (size_t)row * NINP + C_G + c0), gg);
            float bn[8], bn2[8]; unpack8(*(const u32x4*)bo, bn); unpack8(*(const u32x4*)(bo + (size_t)MT * 512), bn2);
#pragma unroll
            for (int e = 0; e < 8; ++e) bn[e] += bn2[e];
#pragma unroll
            for (int e = 0; e < 8; ++e) y[e] = (y[e] * rstd * ln_w[c0 + e] + ln_b[c0 + e] + bn[e]) * silu_f(gg[e]);
            *(u32x4*)(OC + (size_t)row * DM + 1024 + c0) = pack8(y);
        }
    }
}

#define XB_TMO      128
#define XB_XCNT(j)  (256  + 64 * (j))
#define XB_XSUB(j)  (1280 + 64 * (j))
#define XB_XGEN(j)  (2304 + 64 * (j))
#define XB_TOP      3328
#define XB_TOPGEN   3392
#define XCD_BAR_WORDS 3456
#define XB_SPIN_CAP (1u << 18)

__device__ __forceinline__ unsigned xb_ld(unsigned* p)              { return __hip_atomic_load(p, __ATOMIC_RELAXED, __HIP_MEMORY_SCOPE_AGENT); }
__device__ __forceinline__ unsigned xb_add(unsigned* p, unsigned v) { return __hip_atomic_fetch_add(p, v, __ATOMIC_RELAXED, __HIP_MEMORY_SCOPE_AGENT); }
__device__ __forceinline__ unsigned xb_xcc_id() { return (unsigned)__builtin_amdgcn_s_getreg((3 << 11) | 20) & 0xFu; }
#define XB_SPIN(cond, bar) do { unsigned _sp = 0; while (cond) { __builtin_amdgcn_s_sleep(1); \
    if ((++_sp & 255u) == 0u) { if (xb_ld(&(bar)[XB_TMO])) break; if (_sp > XB_SPIN_CAP) { atomicAdd(&(bar)[XB_TMO], 1u); break; } } } } while (0)

struct XcdBarrier {
    unsigned* bar; unsigned x;
    volatile LAS unsigned* st;
};

__device__ __forceinline__ XcdBarrier xcd_barrier_post(unsigned* bar, volatile LAS unsigned* st) {
    XcdBarrier b; b.bar = bar; b.x = xb_xcc_id(); b.st = st;
    if (threadIdx.x == 0) (void)xb_add(&bar[XB_XCNT(b.x)], 1u);
    return b;
}
__device__ __forceinline__ void xcd_barrier_complete(unsigned* bar, unsigned x, unsigned& nloc, unsigned& nx) {
    const unsigned G = gridDim.x * gridDim.y * gridDim.z;
    unsigned sum, cnt, mine, sp = 0u;
    for (;;) {
        sum = 0u; cnt = 0u; mine = 0u;
#pragma unroll
        for (unsigned j = 0; j < 16; ++j) { const unsigned c = xb_ld(&bar[XB_XCNT(j)]); sum += c; cnt += (c > 0u) ? 1u : 0u; mine = (j == x) ? c : mine; }
        if (sum == G) break;
        __builtin_amdgcn_s_sleep(1);
        if ((++sp & 255u) == 0u) { if (xb_ld(&bar[XB_TMO])) break; if (sp > XB_SPIN_CAP) { atomicAdd(&bar[XB_TMO], 1u); break; } }
    }
    nloc = mine > 0u ? mine : 1u; nx = cnt > 0u ? cnt : 1u;
}

__device__ __forceinline__ void xcd_barrier(const XcdBarrier& b) {
    asm volatile("s_waitcnt vmcnt(0)" ::: "memory");
    __syncthreads();
    if (threadIdx.x == 0) {
        unsigned* bar = b.bar;
        __builtin_amdgcn_s_waitcnt(0);
        unsigned nloc = b.st[0], nx = b.st[1];
        if (nloc == 0u) { xcd_barrier_complete(bar, b.x, nloc, nx); b.st[0] = nloc; b.st[1] = nx; }
        const unsigned old = xb_add(&bar[XB_XSUB(b.x)], 1u);
        const unsigned gen = old / nloc;
        if (old + 1u == (gen + 1u) * nloc) {
            __builtin_amdgcn_fence(__ATOMIC_RELEASE, "agent");
            asm volatile("s_waitcnt vmcnt(0)" ::: "memory");
            const unsigned og = xb_add(&bar[XB_TOP], 1u);
            const unsigned tg = og / nx;
            if (og + 1u == (tg + 1u) * nx) xb_add(&bar[XB_TOPGEN], 1u);
            else XB_SPIN(xb_ld(&bar[XB_TOPGEN]) == tg, bar);
            __builtin_amdgcn_fence(__ATOMIC_ACQUIRE, "agent");
            xb_add(&bar[XB_XGEN(b.x)], 1u);
            asm volatile("s_waitcnt vmcnt(0)" ::: "memory");
        } else {
            XB_SPIN(xb_ld(&bar[XB_XGEN(b.x)]) == gen, bar);
            __builtin_amdgcn_fence(__ATOMIC_ACQUIRE, "agent");
            asm volatile("s_waitcnt vmcnt(0)" ::: "memory");
        }
    }
    __syncthreads();
}

#ifndef R_P0T
#define R_P0T 1
#endif
#ifndef R_P1
#define R_P1 1
#endif
#ifndef R_P2
#define R_P2 1
#endif
#ifndef R_P3A
#define R_P3A 1
#endif
#ifndef R_SCAN
#define R_SCAN 1
#endif
#ifndef R_ATTN
#define R_ATTN 1
#endif
#ifndef R_P4
#define R_P4 1
#endif
#ifndef R_P5
#define R_P5 1
#endif
#ifndef R_BAR
#define R_BAR 1
#endif
__global__ void __launch_bounds__(NTHREADS, 2) fwd_kernel(Params prm) {
    extern __shared__ __attribute__((aligned(16))) unsigned char lds_raw[];
    cg::grid_group grid = cg::this_grid();
    Ctx F;
    F.prm = &prm; F.out = prm.out; F.ws = prm.ws; F.lds = (LAS unsigned char*)lds_raw;
    F.tid = threadIdx.x; F.lane = F.tid & 63; F.wave = __builtin_amdgcn_readfirstlane(F.tid >> 6); F.bx = blockIdx.x; F.G = gridDim.x;
    F.gw = F.bx * NWAVES + F.wave; F.NGW = F.G * NWAVES;
    volatile LAS unsigned* MISC = (volatile LAS unsigned*)(F.lds + LDS_BYTES - 256);
    if (F.tid < 4) MISC[F.tid] = 0u;
    __syncthreads();
    XcdBarrier bar = xcd_barrier_post((unsigned*)(F.ws + WS_CTL + 16384), MISC);
#ifdef TS_SEL
    unsigned long long ts_prev = 0, ts_dt = 0; int ts_n = 0;
#ifndef TS_BLK
#define TS_BLK 0
#endif
#ifdef TS_WORK
#define GRID_BAR() do { { const unsigned long long t_ = __builtin_amdgcn_s_memrealtime(); if (ts_n == TS_SEL) ts_dt = t_ - ts_prev; } xcd_barrier(bar); ts_prev = __builtin_amdgcn_s_memrealtime(); ++ts_n; } while (0)
#else
#define GRID_BAR() do { xcd_barrier(bar); { const unsigned long long t_ = __builtin_amdgcn_s_memrealtime(); if (ts_n == TS_SEL) ts_dt = t_ - ts_prev; ts_prev = t_; ++ts_n; } } while (0)
#endif
#else
#define GRID_BAR() do { for (int rb_ = 0; rb_ < R_BAR; ++rb_) xcd_barrier(bar); } while (0)
#endif

#ifndef NO_P0
    LAUNDER(F); phase0(F);
#endif
    if (prm.out == nullptr) grid.sync();
    GRID_BAR();
#ifdef TS_SEL
    ts_prev = __builtin_amdgcn_s_memrealtime();
#endif
#pragma unroll 1
    for (int l = 0; l < 2; ++l) {
#ifndef NO_P1
        for (int rp_ = 0; rp_ < R_P1; ++rp_) { LAUNDER(F); phase1(F, l); }
#endif
        GRID_BAR();
#ifndef NO_P2
        for (int rp_ = 0; rp_ < R_P2; ++rp_) {
            pg8::Gemm g{(const pg8::bf16_t*)(F.ws + WS_XN), (const pg8::bf16_t*)(F.ws + WS_WIN) + (size_t)l * NINP * DM, MT, NINP, DM, DM};
            pg8::EpiBf16 E{(pg8::bf16_t*)(F.ws + WS_P), NINP, nullptr, 0, 0, 1.f};
            if (l == 0) { pg8::StaticOrder S; S.init(MT, NINP, F.G, F.bx); pg8::gemm_phase<pg8::EpiBf16, pg8::StaticOrder, true, true>(F.lds, g, S, E); }
            else { pg8::CtxSparseOrder S; S.init(ML, MC, NINP, F.G, F.bx); pg8::gemm_phase<pg8::EpiBf16, pg8::CtxSparseOrder, true, true>(F.lds, g, S, E); }
        }
#endif
        GRID_BAR();
#ifndef NO_P3A
        { LAUNDER(F); phase3a(F, l); }
        GRID_BAR();
        { LAUNDER(F); phase3b1(F, l); }
        GRID_BAR();
        { LAUNDER(F); phase3b(F, l); }
        GRID_BAR();
        for (int rp_ = 0; rp_ < R_ATTN; ++rp_) { LAUNDER(F); attn_role(F, l); }
        GRID_BAR();
        for (int rp_ = 0; rp_ < R_P4; ++rp_) { LAUNDER(F); phase4(F, l); }
#endif
        GRID_BAR();
#ifndef NO_P5
        for (int rp_ = 0; rp_ < R_P5; ++rp_) {
            const int rows = l == 0 ? MT : ML;
            pg8::Gemm g{(const pg8::bf16_t*)(F.ws + WS_OC), (const pg8::bf16_t*)(F.ws + WS_WOUT) + (size_t)l * DM * DM, rows, DM, DM, DM};
            pg8::StaticOrder S; S.init(rows, DM, F.G, F.bx);
            pg8::EpiF32 E{(float*)(F.ws + WS_P), DM};
            pg8::gemm_phase<pg8::EpiF32, pg8::StaticOrder, true, true>(F.lds, g, S, E);
        }
#endif
        GRID_BAR();
    }
#ifndef NO_P6
    LAUNDER(F); phase6(F);
#endif
#ifdef TS_SEL
    GRID_BAR();
    if (F.bx == TS_BLK && F.wave == 0) { float v = F.out[F.lane]; float a = fabsf(v); float m = a;
        for (int o = 1; o < 64; o <<= 1) m = fminf(m, __shfl_xor(m, o));
        const unsigned long long bal = __ballot(a == m); const int win = __ffsll((long long)bal) - 1;
#ifdef TS_R2
        ts_dt = ((volatile unsigned*)(F.ws + WS_CTL))[2048 + TS_R2];
#endif
        if (F.lane == win) F.out[F.lane] = v + 0.04f + (float)ts_dt * 0.01f * TS_SCALE; }
#endif
}

extern "C" void kernel_launch(void* const* d_in, const int* in_sizes, int n_in, void* d_out, int out_size, void* d_ws, size_t ws_size, hipStream_t stream) {
    static int grid = 0;
    if (grid == 0) {
        if (n_in != 28 || out_size != ML * DM || ws_size < WS_END) { fprintf(stderr, "kernel_launch: unexpected shapes: n_in %d out %d ws %zu (need %zu)\n", n_in, out_size, ws_size, (size_t)WS_END); grid = -1; return; }
        int dev = 0, cus = 0, per_cu = 0;
        if (hipGetDevice(&dev) != hipSuccess || hipDeviceGetAttribute(&cus, hipDeviceAttributeMultiprocessorCount, dev) != hipSuccess) { grid = -1; return; }
        if (hipFuncSetAttribute((const void*)fwd_kernel, hipFuncAttributeMaxDynamicSharedMemorySize, LDS_BYTES) != hipSuccess) { fprintf(stderr, "kernel_launch: hipFuncSetAttribute failed\n"); grid = -1; return; }
        if (hipOccupancyMaxActiveBlocksPerMultiprocessor(&per_cu, (const void*)fwd_kernel, NTHREADS, LDS_BYTES) != hipSuccess || per_cu < 1) { fprintf(stderr, "kernel_launch: occupancy query says %d blocks per CU\n", per_cu); grid = -1; return; }
        (void)hipGetLastError();
        grid = cus;
        if (grid != 256) { fprintf(stderr, "kernel_launch: expected 256 CUs, got %d\n", cus); grid = -1; return; }
    }
    if (grid < 0) return;
    if (hipMemsetAsync((char*)d_ws + WS_CTL, 0, CTL_ZERO_BYTES, stream) != hipSuccess) { fprintf(stderr, "kernel_launch: memset failed\n"); return; }
    Params p{};
    for (int i = 0; i < 28; ++i) p.in[i] = (const float*)d_in[i];
    p.out = (float*)d_out; p.ws = (unsigned char*)d_ws;
    void* args[] = {&p};
    hipError_t e = hipLaunchCooperativeKernel((void*)fwd_kernel, dim3(grid), dim3(NTHREADS), args, LDS_BYTES, stream);
    if (e != hipSuccess) fprintf(stderr, "cooperative launch failed: %s (grid %d)\n", hipGetErrorString(e), grid);
}
```

```cpp
#include <hip/hip_runtime.h>
#include <hip/hip_cooperative_groups.h>
#include <cstdio>
#include <cstdint>
namespace cg = cooperative_groups;
namespace pg8 {
#define PG8_LAS __attribute__((address_space(3)))
typedef unsigned short bf16_t;
typedef short bf16x8 __attribute__((ext_vector_type(8)));
typedef float f32x4 __attribute__((ext_vector_type(4)));
typedef unsigned u32x4 __attribute__((ext_vector_type(4)));
constexpr int BM = 256, BK = 64, HALF = 128, HTB = HALF * BK * 2  , STAGE_BYTES = 8 * HTB, NXCD = 8, WGM = 8;

__host__ __device__ __forceinline__ int lds_byte(int r, int c) { const int st = (r >> 4) * 2 + (c >> 5), rr = r & 15, cc = c & 31, ob = rr * 64 + cc * 2; return st * 1024 + (ob ^ (((ob >> 9) & 1) << 5)); }
__host__ __device__ __forceinline__ void stage_rc(int b, int& R, int& C) { const int st = b / 1024, sb = b % 1024, swz = sb ^ (((sb >> 9) & 1) << 5); R = (st >> 1) * 16 + swz / 64; C = (st & 1) * 32 + (swz % 64) / 2; }
__host__ __device__ __forceinline__ int perm32(int rho) { const int n = rho >> 4, i = rho & 15; return 8 * (i >> 2) + 4 * n + (i & 3); }

struct Unit { int pm, pn; };
struct Gemm { const bf16_t* A; const bf16_t* Bt; int M, N, K, ld; };

struct StaticOrder {
    int nM, nN, nwg, G, c;
    __host__ __device__ void init(int M, int N, int G_, int c_) { nM = M / BM; nN = N / BM; nwg = nM * nN; G = G_; c = c_; }
    __host__ __device__ bool next(int i, Unit& u) const {
        const long L = (long)i * G + c; if (L >= nwg) return false;
        int wgid = (int)L; { const int q = nwg / NXCD, r = nwg % NXCD, xcd = wgid % NXCD, off = wgid / NXCD; wgid = (xcd < r ? xcd * (q + 1) : r * (q + 1) + (xcd - r) * q) + off; }
        const int nig = WGM * nN, gid = wgid / nig, fm = gid * WGM, gsz = (nM - fm) < WGM ? (nM - fm) : WGM;
        u.pm = fm + ((wgid % nig) % gsz); u.pn = (wgid % nig) / gsz; return true;
    }
    __device__ __forceinline__ void a_ready(const Unit&) const {}
    __device__ __forceinline__ void done(const Unit&) const {}
};


struct CtxSparseOrder {
    StaticOrder base; int nMl, nctx, G, c;
    __host__ __device__ void init(int Mlat, int Mctx, int N, int G_, int c_) { base.init(Mlat, N, G_, c_); nMl = Mlat / BM; nctx = (Mctx / BM) * 11; G = G_; c = c_; }
    __host__ __device__ bool next(int i, Unit& u) const {
        if (base.next(i, u)) return true;
        const long L = (long)i * G + c - base.nwg; if (L < 0 || L >= nctx) return false;
        const int k = (int)L % 11; u.pm = nMl + (int)L / 11; u.pn = k < 4 ? 8 + k : 10 + k; return true;
    }
    __device__ __forceinline__ void a_ready(const Unit&) const {}
    __device__ __forceinline__ void done(const Unit&) const {}
};


struct OneUnit {
    int pm, pn; bool has;
    __host__ __device__ bool next(int i, Unit& u) const { if (i > 0 || !has) return false; u.pm = pm; u.pn = pn; return true; }
    __device__ __forceinline__ void a_ready(const Unit&) const {}
    __device__ __forceinline__ void done(const Unit&) const {}
};

__device__ __forceinline__ unsigned cvt_pk_bf16(float lo, float hi) { unsigned r; asm volatile("v_cvt_pk_bf16_f32 %0, %1, %2" : "=v"(r) : "v"(lo), "v"(hi)); return r; }
struct EpiBf16 {
    static constexpr bool PERM = true, AFTER_DRAIN = false;
    bf16_t* O; int ldc; const float* bias; int split_cols; size_t split_stride; float scale0;
    __device__ __forceinline__ void operator()(const f32x4 (&acc)[2][2][4][2], const Unit& u, int wr, int wc, int fr, int fq) const {
        const int row0 = u.pm * BM + wr * 64 + fr; int colt = u.pn * BM; bf16_t* base = O;
        float sc = 1.f; if (split_cols) { const int t = colt / split_cols; base += (size_t)t * split_stride; colt -= t * split_cols; if (t == 0) sc = scale0; }
        const int col0 = colt + wc * 32 + 8 * fq, bcol0 = u.pn * BM + wc * 32 + 8 * fq;
        f32x4 bv[2][2];
#pragma unroll
        for (int bj = 0; bj < 2; ++bj)
#pragma unroll
            for (int n = 0; n < 2; ++n) bv[bj][n] = bias ? *(const f32x4*)(bias + bcol0 + bj * HALF + 4 * n) : (f32x4){0.f, 0.f, 0.f, 0.f};
#pragma unroll
        for (int ai = 0; ai < 2; ++ai)
#pragma unroll
            for (int m = 0; m < 4; ++m) { bf16_t* rowp = base + (size_t)(row0 + ai * HALF + m * 16) * ldc + col0;
#pragma unroll
                for (int bj = 0; bj < 2; ++bj) { f32x4 v0 = acc[ai][bj][m][0] + bv[bj][0], v1 = acc[ai][bj][m][1] + bv[bj][1];
                    v0 = v0 * sc; v1 = v1 * sc; u32x4 w; w.x = cvt_pk_bf16(v0[0], v0[1]); w.y = cvt_pk_bf16(v0[2], v0[3]); w.z = cvt_pk_bf16(v1[0], v1[1]); w.w = cvt_pk_bf16(v1[2], v1[3]);
                    *(u32x4*)(rowp + bj * HALF) = w; } }
    }
};
struct EpiF32 {
    static constexpr bool PERM = false, AFTER_DRAIN = false;
    float* O; int ldc;
    __device__ __forceinline__ void operator()(const f32x4 (&acc)[2][2][4][2], const Unit& u, int wr, int wc, int fr, int fq) const {
        const int col0 = u.pn * BM + wc * 32 + 4 * fq;
#pragma unroll
        for (int ai = 0; ai < 2; ++ai)
#pragma unroll
            for (int m = 0; m < 4; ++m) { float* rowp = O + (size_t)(u.pm * BM + ai * HALF + wr * 64 + m * 16 + fr) * ldc + col0;
#pragma unroll
                for (int bj = 0; bj < 2; ++bj)
#pragma unroll
                    for (int n = 0; n < 2; ++n) *(f32x4*)(rowp + bj * HALF + n * 16) = acc[ai][bj][m][n]; }
    }
};
template <class Epi, class Sched, bool ALIGN_EPI = false, bool SP2 = false>
__device__ __forceinline__ void gemm_phase(PG8_LAS unsigned char* lds, const Gemm g, const Sched& S, const Epi& E) {
    int tid_ = threadIdx.x; asm volatile("" : "+v"(tid_));
    const int tid = tid_, wid = __builtin_amdgcn_readfirstlane(tid >> 6), lane = tid & 63, wr = wid >> 2, wc = wid & 3, fr = lane & 15, fq = lane >> 4;
    const int K = g.ld, nt = g.K / BK;
    unsigned voffA[2], voffB[2];
#pragma unroll
    for (int i = 0; i < 2; ++i) { int R, C; stage_rc(tid * 16 + i * 8192, R, C); const int Rb = Epi::PERM ? ((R & ~31) + perm32(R & 31)) : R;
        voffA[i] = (unsigned)(R * K + C) * 2u; voffB[i] = (unsigned)(Rb * K + C) * 2u; }
    const size_t kstep = (size_t)(BK * 2);
    const size_t hstep = (size_t)HALF * K * 2;
    const size_t tstep = 2 * hstep;
    const unsigned ldsw = (unsigned)wid * 1024u;
    const int aoff = lds_byte(wr * 64 + fr, fq * 8), boff = lds_byte(wc * 32 + fr, fq * 8);
#define PG8_SA(b, h) (((b) * 2 + (h)) * HTB)
#define PG8_SB(b, h) ((4 + (b) * 2 + (h)) * HTB)
#define PG8_STAGE(bufoff, gbase, voff) do { _Pragma("unroll") for (int _i = 0; _i < 2; ++_i) \
        __builtin_amdgcn_global_load_lds((const unsigned*)((const char*)(gbase) + (voff)[_i]), (PG8_LAS unsigned*)(lds + (bufoff) + ldsw + _i * 8192), 16, 0, 0); } while (0)
#define PG8_LDA(dst, b, h) do { _Pragma("unroll") for (int m = 0; m < 4; ++m) _Pragma("unroll") for (int k = 0; k < 2; ++k) dst[m][k] = *(const PG8_LAS bf16x8*)(lds + PG8_SA(b, h) + aoff + m * 2048 + k * 1024); } while (0)
#define PG8_LDB(dst, b, h) do { _Pragma("unroll") for (int n = 0; n < 2; ++n) _Pragma("unroll") for (int k = 0; k < 2; ++k) dst[n][k] = *(const PG8_LAS bf16x8*)(lds + PG8_SB(b, h) + boff + n * 2048 + k * 1024); } while (0)
#define PG8_MMA(ai, bj, At, Bt) do { __builtin_amdgcn_s_setprio(1); _Pragma("unroll") for (int m = 0; m < 4; ++m) _Pragma("unroll") for (int n = 0; n < 2; ++n) _Pragma("unroll") for (int k = 0; k < 2; ++k) \
        acc[ai][bj][m][n] = __builtin_amdgcn_mfma_f32_16x16x32_bf16(Bt[n][k], At[m][k], acc[ai][bj][m][n], 0, 0, 0); __builtin_amdgcn_s_setprio(0); } while (0)
#define PG8_WAIT_V(n) asm volatile("s_waitcnt vmcnt(" #n ")" ::: "memory")
#define PG8_WAIT_L(n) asm volatile("s_waitcnt lgkmcnt(" #n ")" ::: "memory")
#define PG8_BAR __builtin_amdgcn_s_barrier()
#define PG8_SCHED __builtin_amdgcn_sched_barrier(0)
    Unit cur, nxt; int ui = 0;
    if (!S.next(0, cur)) return;
    f32x4 acc[2][2][4][2];
#pragma unroll
    for (int a = 0; a < 2; ++a)
#pragma unroll
        for (int b = 0; b < 2; ++b)
#pragma unroll
            for (int m = 0; m < 4; ++m)
#pragma unroll
                for (int n = 0; n < 2; ++n) acc[a][b][m][n] = (f32x4){0.f, 0.f, 0.f, 0.f};
    bf16x8 At[4][2], B0[2][2], B1[2][2];
    const char* cA = (const char*)g.A + (size_t)cur.pm * tstep; const char* cB = (const char*)g.Bt + (size_t)cur.pn * tstep;
    S.a_ready(cur);
    if constexpr (SP2) {
        PG8_STAGE(PG8_SB(0, 0), cB, voffB); PG8_STAGE(PG8_SB(0, 1), cB + hstep, voffB); PG8_STAGE(PG8_SA(0, 0), cA, voffA); PG8_STAGE(PG8_SA(0, 1), cA + hstep, voffA);
        if (wr == 1) PG8_BAR;
        PG8_WAIT_V(2); PG8_BAR;
        PG8_STAGE(PG8_SB(1, 0), cB + kstep, voffB); PG8_STAGE(PG8_SA(1, 0), cA + kstep, voffA); PG8_STAGE(PG8_SB(1, 1), cB + hstep + kstep, voffB);
        PG8_WAIT_V(6); PG8_BAR;
    } else {
        PG8_STAGE(PG8_SB(0, 0), cB, voffB); PG8_STAGE(PG8_SA(0, 0), cA, voffA); PG8_STAGE(PG8_SB(0, 1), cB + hstep, voffB); PG8_STAGE(PG8_SA(0, 1), cA + hstep, voffA);
        if (wr == 1) PG8_BAR;
        PG8_WAIT_V(4); PG8_BAR;
        PG8_STAGE(PG8_SB(1, 0), cB + kstep, voffB); PG8_STAGE(PG8_SA(1, 0), cA + kstep, voffA); PG8_STAGE(PG8_SB(1, 1), cB + hstep + kstep, voffB);
        PG8_WAIT_V(6); PG8_BAR;
    }
    for (;;) {
        const bool has_next = S.next(ui + 1, nxt);
        const char* nA = has_next ? (const char*)g.A + (size_t)nxt.pm * tstep : cA; const char* nB = has_next ? (const char*)g.Bt + (size_t)nxt.pn * tstep : cB;
        for (int t = 0; t < nt; t += 2) {
            const bool last = (t == nt - 2);
            const char* a1 = cA + (size_t)(t + 1) * kstep;
            const char* a2 = last ? nA : cA + (size_t)(t + 2) * kstep; const char* b2 = last ? nB : cB + (size_t)(t + 2) * kstep;
            const char* a3 = a2 + kstep; const char* b3 = b2 + kstep;
            if (last && has_next) S.a_ready(nxt);
            if constexpr (SP2) {
            PG8_LDB(B0, 0, 0); PG8_LDB(B1, 0, 1); PG8_SCHED; PG8_LDA(At, 0, 0); PG8_STAGE(PG8_SA(1, 1), a1 + hstep, voffA);
            PG8_WAIT_V(8); PG8_WAIT_L(0); PG8_BAR; PG8_MMA(0, 0, At, B0); PG8_MMA(0, 1, At, B1); PG8_BAR; PG8_SCHED;
            PG8_LDA(At, 0, 1); PG8_STAGE(PG8_SB(0, 0), b2, voffB); PG8_STAGE(PG8_SB(0, 1), b2 + hstep, voffB); PG8_STAGE(PG8_SA(0, 0), a2, voffA);
            PG8_WAIT_V(8); PG8_WAIT_L(0); PG8_BAR; PG8_MMA(1, 0, At, B0); PG8_MMA(1, 1, At, B1); PG8_BAR; PG8_SCHED;
            PG8_LDB(B0, 1, 0); PG8_LDB(B1, 1, 1); PG8_SCHED; PG8_LDA(At, 1, 0); PG8_STAGE(PG8_SA(0, 1), a2 + hstep, voffA);
            PG8_WAIT_V(8); PG8_WAIT_L(0); PG8_BAR; PG8_MMA(0, 0, At, B0); PG8_MMA(0, 1, At, B1); PG8_BAR; PG8_SCHED;
            PG8_LDA(At, 1, 1); PG8_STAGE(PG8_SB(1, 0), b3, voffB); PG8_STAGE(PG8_SB(1, 1), b3 + hstep, voffB); PG8_STAGE(PG8_SA(1, 0), a3, voffA);
            PG8_WAIT_V(8); PG8_WAIT_L(0); PG8_BAR; PG8_MMA(1, 0, At, B0); PG8_MMA(1, 1, At, B1); PG8_BAR; PG8_SCHED;
            } else {
            PG8_LDB(B0, 0, 0); PG8_SCHED; PG8_LDA(At, 0, 0); PG8_STAGE(PG8_SA(1, 1), a1 + hstep, voffA);
            PG8_WAIT_L(8); PG8_BAR; PG8_WAIT_L(0); PG8_MMA(0, 0, At, B0); PG8_BAR; PG8_SCHED;
            PG8_LDB(B1, 0, 1); PG8_STAGE(PG8_SB(0, 0), b2, voffB);
            PG8_BAR; PG8_WAIT_L(0); PG8_MMA(0, 1, At, B1); PG8_BAR;
            PG8_LDA(At, 0, 1); PG8_STAGE(PG8_SA(0, 0), a2, voffA);
            PG8_BAR; PG8_WAIT_L(0); PG8_MMA(1, 0, At, B0); PG8_BAR; PG8_SCHED;
            PG8_STAGE(PG8_SB(0, 1), b2 + hstep, voffB);
            PG8_WAIT_V(6); PG8_BAR; PG8_MMA(1, 1, At, B1); PG8_BAR;
            PG8_LDB(B0, 1, 0); PG8_SCHED; PG8_LDA(At, 1, 0); PG8_STAGE(PG8_SA(0, 1), a2 + hstep, voffA);
            PG8_WAIT_L(8); PG8_BAR; PG8_WAIT_L(0); PG8_MMA(0, 0, At, B0); PG8_BAR; PG8_SCHED;
            PG8_LDB(B1, 1, 1); PG8_STAGE(PG8_SB(1, 0), b3, voffB);
            PG8_BAR; PG8_WAIT_L(0); PG8_MMA(0, 1, At, B1); PG8_BAR;
            PG8_LDA(At, 1, 1); PG8_STAGE(PG8_SA(1, 0), a3, voffA);
            PG8_BAR; PG8_WAIT_L(0); PG8_MMA(1, 0, At, B0); PG8_BAR; PG8_SCHED;
            PG8_STAGE(PG8_SB(1, 1), b3 + hstep, voffB);
            PG8_WAIT_V(6); PG8_BAR; PG8_MMA(1, 1, At, B1); PG8_BAR;
            }
        }
        if constexpr (ALIGN_EPI) { if (wr == 0) PG8_BAR; }
        if constexpr (!Epi::AFTER_DRAIN) { E(acc, cur, wr, wc, fr, fq); S.done(cur); }
        if (!has_next) break;
#pragma unroll
        for (int a = 0; a < 2; ++a)
#pragma unroll
            for (int b = 0; b < 2; ++b)
#pragma unroll
                for (int m = 0; m < 4; ++m)
#pragma unroll
                    for (int n = 0; n < 2; ++n) acc[a][b][m][n] = (f32x4){0.f, 0.f, 0.f, 0.f};
        cur = nxt; cA = nA; cB = nB; ++ui;
        if constexpr (ALIGN_EPI) { if (wr == 1) PG8_BAR; }
    }
    PG8_WAIT_V(0);
    if constexpr (!ALIGN_EPI) { if (wr == 0) PG8_BAR; }
    PG8_BAR;
    if constexpr (Epi::AFTER_DRAIN) { E.fused(acc, cur, wr, wc, fr, fq, lds, wid, lane); S.done(cur); }
#undef PG8_SA
#undef PG8_SB
#undef PG8_STAGE
#undef PG8_LDA
#undef PG8_LDB
#undef PG8_MMA
#undef PG8_WAIT_V
#undef PG8_WAIT_L
#undef PG8_BAR
#undef PG8_SCHED
}
}

constexpr int NB = 2, TL = 4096, DM = 2048, CL = 256, NIN = 7872, NINP = 7936;
constexpr int ML = NB * TL, MC = NB * CL, MT = ML + MC;
constexpr int KEYS = CL + TL;
constexpr int NSTEP = KEYS;
constexpr int A_U = 0, A_V = 512, A_G = 1024, B_Q = 1536, B_K = 2048, B_V = 2560, B_G = 3072, C_R = 3584, C_K = 4096, C_V = 4608, C_LF = 5120, C_LB = 5216, C_G = 5312,
              D_B = 5824, D_C = 6336, D_X = 6848, D_G = 7360;
constexpr float EPS = 1e-6f, GN_EPS = 64e-5f;
constexpr float QSCALE = 0.125f * 1.4426950408889634f;

constexpr size_t MiB = 1u << 20;
constexpr size_t WS_CTL = 0, CTL_ZERO_BYTES = 1 * MiB;
constexpr size_t CTL_MODACC = 65536;
constexpr size_t WS_ROPE = 1 * MiB - 16384;
constexpr size_t WS_WIN = 1 * MiB;
constexpr size_t WS_WOUT = 63 * MiB;
constexpr size_t WS_XN = 79 * MiB;
constexpr size_t WS_P = 113 * MiB;
constexpr size_t WS_QR = 245 * MiB;
constexpr size_t WS_QC = 253 * MiB;
constexpr size_t WS_KR = 254 * MiB;
constexpr size_t WS_VT = 263 * MiB;
constexpr size_t WS_CHK = 272 * MiB;
constexpr size_t WS_Y = 402 * MiB;
constexpr size_t WS_BON = 436 * MiB;
constexpr size_t WS_OC = 453 * MiB;
constexpr size_t WS_LW = 487 * MiB;
constexpr size_t WS_SST = 488 * MiB;
constexpr size_t WS_END = 489 * MiB;
static_assert(WS_WIN + (size_t)2 * NINP * DM * 2 <= WS_WOUT && WS_WOUT + (size_t)2 * DM * DM * 2 <= WS_XN && WS_XN + (size_t)MT * DM * 2 <= WS_P && WS_P + (size_t)MT * NINP * 2 <= WS_QR, "ws map 1");
static_assert(WS_QR + (size_t)16 * TL * 64 * 2 <= WS_QC && WS_QC + (size_t)16 * CL * 64 * 2 <= WS_KR && WS_KR + (size_t)16 * KEYS * 64 * 2 <= WS_VT && WS_VT + (size_t)8 * 128 * KEYS * 2 <= WS_CHK, "ws map 2");
static_assert(WS_Y + (size_t)2 * MT * 512 * 4 <= WS_BON && WS_BON + (size_t)2 * MT * 512 * 2 <= WS_OC && WS_OC + (size_t)MT * DM * 2 <= WS_END, "ws map 3");
static_assert((size_t)MT * 1024 * 4 <= WS_P - WS_XN && (size_t)MT * DM * 4 <= WS_QR - WS_P, "overlays");

constexpr int LDS_BYTES = 147456;
constexpr int NWAVES = 8, NTHREADS = 512;

typedef unsigned short bf16;
typedef short bf16x8 __attribute__((ext_vector_type(8)));
typedef float f32x4 __attribute__((ext_vector_type(4)));
typedef float f32x2 __attribute__((ext_vector_type(2)));
typedef float f32x16 __attribute__((ext_vector_type(16)));
typedef unsigned u32x4 __attribute__((ext_vector_type(4)));
typedef unsigned u32x2 __attribute__((ext_vector_type(2)));
typedef __bf16 bf16x2_t __attribute__((ext_vector_type(2)));
#define LAS __attribute__((address_space(3)))

struct Params { const float* in[28]; float* out; unsigned char* ws; };

struct Ctx {
    const Params* prm; float* out; unsigned char* ws;
    LAS unsigned char* lds;
    int tid, lane, wave, bx, G, gw, NGW;
};

__device__ __forceinline__ unsigned cvtpk(float lo, float hi) { f32x2 v = {lo, hi}; bf16x2_t b = __builtin_convertvector(v, bf16x2_t); return __builtin_bit_cast(unsigned, b); }
__device__ __forceinline__ float bflo(unsigned u) { return __builtin_bit_cast(float, u << 16); }
__device__ __forceinline__ float bfhi(unsigned u) { return __builtin_bit_cast(float, u & 0xffff0000u); }
__device__ __forceinline__ void unpack8(const u32x4 v, float* f) { f[0] = bflo(v.x); f[1] = bfhi(v.x); f[2] = bflo(v.y); f[3] = bfhi(v.y); f[4] = bflo(v.z); f[5] = bfhi(v.z); f[6] = bflo(v.w); f[7] = bfhi(v.w); }
__device__ __forceinline__ u32x4 pack8(const float* f) { u32x4 r; r.x = cvtpk(f[0], f[1]); r.y = cvtpk(f[2], f[3]); r.z = cvtpk(f[4], f[5]); r.w = cvtpk(f[6], f[7]); return r; }
__device__ __forceinline__ float silu_f(float x) { return x * __builtin_amdgcn_rcpf(1.f + __expf(-x)); }
__device__ __forceinline__ float wave_sum(float v) {
#pragma unroll
    for (int o = 1; o < 64; o <<= 1) v += __shfl_xor(v, o);
    return v;
}
template <int CTRL> __device__ __forceinline__ float dpp_f(float v) { return __builtin_bit_cast(float, __builtin_amdgcn_update_dpp(0, __builtin_bit_cast(int, v), CTRL, 0xf, 0xf, true)); }
__device__ __forceinline__ float red4(float v) { v += dpp_f<0xB1>(v); v += dpp_f<0x4E>(v); return v; }
__device__ __forceinline__ float red8(float v) { v = red4(v); v += dpp_f<0x141>(v); return v; }
__device__ __forceinline__ float red16(float v) { v = red8(v); v += dpp_f<0x140>(v); return v; }
#define LAUNDER(F) do { asm volatile("" : "+v"(F.tid), "+v"(F.lane)); asm volatile("" : "+s"(F.wave), "+s"(F.bx), "+s"(F.gw)); } while (0)
__device__ __forceinline__ f32x16 zero16() { f32x16 z;
#pragma unroll
    for (int r = 0; r < 16; ++r) z[r] = 0.f;
    return z; }
#define MROW(reg, hh) (((reg) & 3) + 8 * ((reg) >> 2) + 4 * (hh))
#define LDS_WAIT() asm volatile("s_waitcnt lgkmcnt(0)" ::: "memory")
#define WG_BAR() do { asm volatile("s_waitcnt lgkmcnt(0)" ::: "memory"); __builtin_amdgcn_s_barrier(); asm volatile("" ::: "memory"); } while (0)

#ifndef R_P0T
#define R_P0T 1
#endif
__device__ __forceinline__ void p0_transpose_item(const float* W, int K, int N, bf16* WT, LAS float* scr, int item, int lane) {
    const int nblk = N / 64, kb = item / nblk, nb = item % nblk, k0 = 64 * kb, n0 = 64 * nb;
#pragma unroll 8
    for (int i = 0; i < 16; ++i) { const int kk = 4 * i + (lane >> 4), n4 = lane & 15; const f32x4 w = *(const f32x4*)(W + (size_t)(k0 + kk) * N + n0 + 4 * n4);
        LAS float* d = scr + kk * 65 + 4 * n4; d[0] = w.x; d[1] = w.y; d[2] = w.z; d[3] = w.w; }
    LDS_WAIT();
    const int c = lane & 7;
#pragma unroll
    for (int j = 0; j < 8; ++j) { const int n = (lane >> 3) + 8 * j; const LAS float* s = scr + (8 * c) * 65 + n;
        u32x4 o; o.x = cvtpk(s[0 * 65], s[1 * 65]); o.y = cvtpk(s[2 * 65], s[3 * 65]); o.z = cvtpk(s[4 * 65], s[5 * 65]); o.w = cvtpk(s[6 * 65], s[7 * 65]);
        *(u32x4*)(WT + (size_t)(n0 + n) * K + k0 + 8 * c) = o; }
    LDS_WAIT();
}

__device__ __forceinline__ void p0_weights(Ctx& F, int l, int widx, int nw) {
    LAS float* scr = (LAS float*)(F.lds + F.wave * 16896);
    const float* w_in = F.prm->in[8] + (size_t)l * DM * NIN; const float* w_out = F.prm->in[9] + (size_t)l * DM * DM;
    bf16* WIN = (bf16*)(F.ws + WS_WIN) + (size_t)l * NINP * DM; bf16* WOUT = (bf16*)(F.ws + WS_WOUT) + (size_t)l * DM * DM;
    constexpr int I_IN = (DM / 64) * (NIN / 64), I_OUT = (DM / 64) * (DM / 64);
    for (int it = widx; it < I_IN + I_OUT; it += nw) {
        if (it < I_IN) p0_transpose_item(w_in, DM, NIN, WIN, scr, it, F.lane);
        else p0_transpose_item(w_out, DM, DM, WOUT, scr, it - I_IN, F.lane);
    }
    const float* cvec = F.prm->in[1]; const float* cctx = F.prm->in[3]; const float* w_mod = F.prm->in[4];
    float* MODACC = (float*)(F.ws + WS_CTL + CTL_MODACC);
    for (int it = widx; it < 32 * 24; it += nw) {
        const int ks = it / 24, cb = it % 24, k0 = ks * 64, n0 = cb * 256 + 4 * F.lane;
        scr[F.lane] = silu_f(cvec[k0 + F.lane]); scr[64 + F.lane] = silu_f(cvec[DM + k0 + F.lane]); scr[128 + F.lane] = silu_f(cctx[k0 + F.lane]);
        LDS_WAIT();
        f32x4 a0 = {0.f, 0.f, 0.f, 0.f}, a1 = a0, a2 = a0;
        const float* wp = w_mod + ((size_t)l * DM + k0) * 6144 + n0;
#pragma unroll 8
        for (int k = 0; k < 64; ++k) { const f32x4 w = *(const f32x4*)(wp + (size_t)k * 6144); a0 += w * scr[k]; a1 += w * scr[64 + k]; a2 += w * scr[128 + k]; }
        float* ma = MODACC + (size_t)(l * 3) * 6144 + n0;
#pragma unroll
        for (int e = 0; e < 4; ++e) { atomicAdd(ma + e, a0[e]); atomicAdd(ma + 6144 + e, a1[e]); atomicAdd(ma + 2 * 6144 + e, a2[e]); }
        LDS_WAIT();
    }
}
__device__ __forceinline__ void phase0(Ctx& F) {
    p0_weights(F, 0, F.gw, F.NGW); p0_weights(F, 1, F.gw, F.NGW);
    {   const float* w2a = F.prm->in[19]; const float* a2a = F.prm->in[21]; bf16* LW = (bf16*)(F.ws + WS_LW);
        const int gt = F.bx * NTHREADS + F.tid, GT = F.G * NTHREADS;
        for (int idx = gt; idx < 4 * 512 * 64; idx += GT) { const int pd = idx / (512 * 64), rem = idx % (512 * 64), k = rem >> 9, chg = rem & 511, hq = chg >> 6, ch = chg & 63;
            const float v = w2a[((size_t)pd * 64 + k) * 512 + chg]; const unsigned hi = cvtpk(v, 0.f) & 0xffffu; const float lo = v - bflo(hi);
            bf16* base = LW + (size_t)(pd * 8 + hq) * 12288; base[ch * 64 + k] = (bf16)hi; base[4096 + ch * 64 + k] = (bf16)(cvtpk(lo, 0.f) & 0xffffu); }
        for (int idx = gt; idx < 4 * 512 * 32; idx += GT) { const int pd = idx / (512 * 32), rem = idx % (512 * 32), k = rem >> 9, chg = rem & 511, hq = chg >> 6, ch = chg & 63;
            const float v = a2a[((size_t)pd * 32 + k) * 512 + chg]; const unsigned hi = cvtpk(v, 0.f) & 0xffffu; const float lo = v - bflo(hi);
            bf16* base = LW + (size_t)(pd * 8 + hq) * 12288 + 8192; base[ch * 32 + k] = (bf16)hi; base[2048 + ch * 32 + k] = (bf16)(cvtpk(lo, 0.f) & 0xffffu); }
    }
    if (F.bx == 0) {
        float* rope = (float*)(F.ws + WS_ROPE);
        for (int i = F.tid; i < 1024; i += NTHREADS) { const int pos = i >> 4, f = i & 15; const float inv = powf(10000.f, -(float)(2 * f) / 32.f); const float ang = (float)pos * inv;
            rope[i] = cosf(ang); rope[1024 + i] = sinf(ang); }
    }
}

__device__ __forceinline__ void ld_row(const float* p, int lane, f32x4* v) {
#pragma unroll
    for (int j = 0; j < 8; ++j) v[j] = *(const f32x4*)(p + 4 * lane + 256 * j);
}
__device__ __forceinline__ float sumsq8(const f32x4* v) { float s = 0.f;
#pragma unroll
    for (int j = 0; j < 8; ++j) s += (v[j].x * v[j].x + v[j].y * v[j].y) + (v[j].z * v[j].z + v[j].w * v[j].w);
    return s; }
__device__ __forceinline__ void ld_mod(const Ctx& F, int l, int r, int part, int lane, f32x4* v) {
    const float* ma = (const float*)(F.ws + WS_CTL + CTL_MODACC) + (size_t)(l * 3 + r) * 6144 + part * DM; const float* bm = F.prm->in[5] + (size_t)l * 6144 + part * DM;
#pragma unroll
    for (int j = 0; j < 8; ++j) v[j] = *(const f32x4*)(ma + 4 * lane + 256 * j) + *(const f32x4*)(bm + 4 * lane + 256 * j);
}
__device__ __forceinline__ void phase1(Ctx& F, int l) {
    const float* x = F.prm->in[0]; const float* ctx = F.prm->in[2]; const float* g_pre = F.prm->in[6] + (size_t)l * DM; const float* g_post0 = F.prm->in[7];
    const float* O = (const float*)(F.ws + WS_P); bf16* XN = (bf16*)(F.ws + WS_XN);
    LAS float* MV = (LAS float*)F.lds;
    {   const float* ma = (const float*)(F.ws + WS_CTL + CTL_MODACC); const float* bm = F.prm->in[5];
        for (int idx = F.tid; idx < 3 * 512; idx += NTHREADS) { const int r = idx >> 9, n = (idx & 511) * 4;
            const f32x4 shv = *(const f32x4*)(ma + (size_t)(l * 3 + r) * 6144 + n) + *(const f32x4*)(bm + (size_t)l * 6144 + n);
            const f32x4 scv = *(const f32x4*)(ma + (size_t)(l * 3 + r) * 6144 + DM + n) + *(const f32x4*)(bm + (size_t)l * 6144 + DM + n);
            *(LAS f32x4*)(MV + (r * 3 + 0) * DM + n) = shv; *(LAS f32x4*)(MV + (r * 3 + 1) * DM + n) = (scv + 1.f) * *(const f32x4*)(g_pre + n);
            if (l == 1) { const f32x4 gt = *(const f32x4*)(ma + (size_t)r * 6144 + 2 * DM + n) + *(const f32x4*)(bm + 2 * DM + n); *(LAS f32x4*)(MV + (r * 3 + 2) * DM + n) = gt * *(const f32x4*)(g_post0 + n); } }
    }
    WG_BAR();
    for (int row = F.gw; row < MT; row += F.NGW) {
        const bool lat = row < ML; const int r = lat ? (row / TL) : 2;
        const LAS float* mv = MV + r * 3 * DM + 4 * F.lane;
        const float* src = lat ? x + (size_t)row * DM : ctx + (size_t)(row - ML) * DM;
        f32x4 xv[8]; ld_row(src, F.lane, xv);
        if (l == 1) {
            f32x4 ov[8]; ld_row(O + (size_t)row * DM, F.lane, ov);
            const float rs = 1.f / sqrtf(wave_sum(sumsq8(ov)) * (1.f / DM) + EPS);
#pragma unroll
            for (int j = 0; j < 8; ++j) xv[j] = xv[j] + *(const LAS f32x4*)(mv + 2 * DM + 256 * j) * (ov[j] * rs);
            if (lat) {
#pragma unroll
                for (int j = 0; j < 8; ++j) *(f32x4*)(F.out + (size_t)row * DM + 4 * F.lane + 256 * j) = xv[j];
            }
        }
        const float rs = 1.f / sqrtf(wave_sum(sumsq8(xv)) * (1.f / DM) + EPS);
#pragma unroll
        for (int j = 0; j < 8; ++j) { const f32x4 h = (xv[j] * rs) * *(const LAS f32x4*)(mv + DM + 256 * j) + *(const LAS f32x4*)(mv + 256 * j);
            u32x2 w; w.x = cvtpk(h.x, h.y); w.y = cvtpk(h.z, h.w); *(u32x2*)(XN + (size_t)row * DM + 4 * F.lane + 256 * j) = w; }
    }
    WG_BAR();
}
__device__ __forceinline__ void phase6(Ctx& F) {
    const float* g_post1 = F.prm->in[7] + DM; const float* O = (const float*)(F.ws + WS_P);
    for (int row = F.gw; row < ML; row += F.NGW) {
        const int r = row / TL;
        f32x4 xv[8], ov[8], gt[8], gp[8]; ld_row(F.out + (size_t)row * DM, F.lane, xv); ld_row(O + (size_t)row * DM, F.lane, ov); ld_mod(F, 1, r, 2, F.lane, gt); ld_row(g_post1, F.lane, gp);
        const float rs = 1.f / sqrtf(wave_sum(sumsq8(ov)) * (1.f / DM) + EPS);
#pragma unroll
        for (int j = 0; j < 8; ++j) *(f32x4*)(F.out + (size_t)row * DM + 4 * F.lane + 256 * j) = xv[j] + gt[j] * (ov[j] * rs * gp[j]);
    }
}

__device__ __forceinline__ void sgu_item(Ctx& F, int l, int cb, int h) {
    const bf16* P = (const bf16*)(F.ws + WS_P); bf16* OC = (bf16*)(F.ws + WS_OC);
    const float* w_s = F.prm->in[10] + (size_t)(l * 4 + h) * 128 * 128; const float* b_s = F.prm->in[11] + (size_t)(l * 4 + h) * 128;
    const int row0 = cb < 64 ? (cb >> 5) * TL + (cb & 31) * 128 : ML + ((cb - 64) >> 1) * CL + ((cb - 64) & 1) * 128;
    LAS unsigned char* WB = F.lds;
    LAS unsigned char* VTB = F.lds + 34816;
    LAS float* MX = (LAS float*)(F.lds + 69632);
    {
        const int row = F.tid >> 2, qt = F.tid & 3; const bf16* src = P + (size_t)(row0 + row) * NINP + A_V + h * 128 + qt * 32;
        float v[32];
#pragma unroll
        for (int i = 0; i < 4; ++i) unpack8(*(const u32x4*)(src + 8 * i), v + 8 * i);
        float s_ = 0.f;
#pragma unroll
        for (int i = 0; i < 32; ++i) s_ += v[i];
        const float mean = red4(s_) * (1.f / 128.f); float q = 0.f;
#pragma unroll
        for (int i = 0; i < 32; ++i) { v[i] -= mean; q += v[i] * v[i]; }
        const float rstd = 1.f / sqrtf(red4(q) * (1.f / 128.f) + EPS);
#pragma unroll
        for (int i = 0; i < 32; i += 2) { const unsigned w = cvtpk(v[i] * rstd, v[i + 1] * rstd);
            *(LAS unsigned short*)(VTB + (qt * 32 + i) * 272 + 2 * row) = (unsigned short)w; *(LAS unsigned short*)(VTB + (qt * 32 + i + 1) * 272 + 2 * row) = (unsigned short)(w >> 16); }
    }
    for (int idx = F.tid; idx < 4096; idx += NTHREADS) { const int p = idx >> 5, q4 = idx & 31; const f32x4 w = *(const f32x4*)(w_s + p * 128 + 4 * q4);
        *(LAS u32x2*)(WB + p * 272 + 8 * q4) = (u32x2){cvtpk(w.x, w.y), cvtpk(w.z, w.w)}; }
    WG_BAR();
    {   const int l31 = F.lane & 31, hh = F.lane >> 5, mt = F.wave >> 1;
#pragma unroll
        for (int nn = 0; nn < 2; ++nn) { const int nt = (F.wave & 1) * 2 + nn; f32x16 d = zero16();
#pragma unroll
            for (int ks = 0; ks < 8; ++ks) d = __builtin_amdgcn_mfma_f32_32x32x16_bf16(*(const LAS bf16x8*)(WB + (32 * mt + l31) * 272 + (16 * ks + 8 * hh) * 2), *(const LAS bf16x8*)(VTB + (32 * nt + l31) * 272 + (16 * ks + 8 * hh) * 2), d, 0, 0, 0);
#pragma unroll
            for (int r = 0; r < 16; ++r) MX[(32 * mt + MROW(r, hh)) * 132 + 32 * nt + l31] = d[r]; }
    }
    WG_BAR();
    const int pg = F.tid >> 5, dg = F.tid & 31;
    f32x4 acc[8];
#pragma unroll
    for (int i = 0; i < 8; ++i) acc[i] = *(const LAS f32x4*)(MX + (8 * pg + i) * 132 + 4 * dg);
#pragma unroll
    for (int i = 0; i < 8; ++i) { const int p = 8 * pg + i; const float bs = b_s[p]; const bf16* pr = P + (size_t)(row0 + p) * NINP + h * 128 + 4 * dg;
        const u32x2 uu = *(const u32x2*)(pr + A_U), gg = *(const u32x2*)(pr + A_G);
        const float o0 = bflo(uu.x) * (acc[i].x + bs) * silu_f(bflo(gg.x)), o1 = bfhi(uu.x) * (acc[i].y + bs) * silu_f(bfhi(gg.x));
        const float o2 = bflo(uu.y) * (acc[i].z + bs) * silu_f(bflo(gg.y)), o3 = bfhi(uu.y) * (acc[i].w + bs) * silu_f(bfhi(gg.y));
        u32x2 w; w.x = cvtpk(o0, o1); w.y = cvtpk(o2, o3); *(u32x2*)(OC + (size_t)(row0 + p) * DM + h * 128 + 4 * dg) = w; }
    WG_BAR();
}

__device__ __forceinline__ void conv_item(Ctx& F, int l, int item) {
    const bf16* P = (const bf16*)(F.ws + WS_P); bf16* OC = (bf16*)(F.ws + WS_OC); const float* cw = F.prm->in[27] + (size_t)l * 3 * 512;
    const int row = item * 16 + (F.tid >> 5), c0 = (F.tid & 31) * 16;
    int t, tlen; if (row < ML) { t = row & (TL - 1); tlen = TL; } else { t = (row - ML) & (CL - 1); tlen = CL; }
    const bf16* pr = P + (size_t)row * NINP;
    float z0[16], z1[16], z2[16], tmp[16];
#pragma unroll
    for (int i = 0; i < 2; ++i) {
        float a[8], b[8];
        unpack8(*(const u32x4*)(pr + D_C + c0 + 8 * i), a); unpack8(*(const u32x4*)(pr + D_X + c0 + 8 * i), b);
#pragma unroll
        for (int e = 0; e < 8; ++e) z1[8 * i + e] = a[e] * b[e];
        if (t > 0) { unpack8(*(const u32x4*)(pr - NINP + D_C + c0 + 8 * i), a); unpack8(*(const u32x4*)(pr - NINP + D_X + c0 + 8 * i), b);
#pragma unroll
            for (int e = 0; e < 8; ++e) z0[8 * i + e] = a[e] * b[e]; }
        else {
#pragma unroll
            for (int e = 0; e < 8; ++e) z0[8 * i + e] = 0.f; }
        if (t < tlen - 1) { unpack8(*(const u32x4*)(pr + NINP + D_C + c0 + 8 * i), a); unpack8(*(const u32x4*)(pr + NINP + D_X + c0 + 8 * i), b);
#pragma unroll
            for (int e = 0; e < 8; ++e) z2[8 * i + e] = a[e] * b[e]; }
        else {
#pragma unroll
            for (int e = 0; e < 8; ++e) z2[8 * i + e] = 0.f; }
    }
#pragma unroll
    for (int i = 0; i < 2; ++i) {
        float bg[8], gg[8]; unpack8(*(const u32x4*)(pr + D_B + c0 + 8 * i), bg); unpack8(*(const u32x4*)(pr + D_G + c0 + 8 * i), gg);
#pragma unroll
        for (int e = 0; e < 8; ++e) { const int c = c0 + 8 * i + e; const float y = cw[c] * z0[8 * i + e] + cw[512 + c] * z1[8 * i + e] + cw[1024 + c] * z2[8 * i + e]; tmp[e] = bg[e] * y * silu_f(gg[e]); }
        *(u32x4*)(OC + (size_t)row * DM + 1536 + c0 + 8 * i) = pack8(tmp);
    }
}

__device__ __forceinline__ void attnprep_item(Ctx& F, int l, int rb, int h) {
    const bf16* P = (const bf16*)(F.ws + WS_P); const float* rope = (const float*)(F.ws + WS_ROPE);
    bf16* QR = (bf16*)(F.ws + WS_QR); bf16* QC = (bf16*)(F.ws + WS_QC); bf16* KR = (bf16*)(F.ws + WS_KR); bf16* VT = (bf16*)(F.ws + WS_VT);
    const bool lat = rb < 128; const int b = lat ? (rb >> 6) : ((rb - 128) >> 2), t0 = lat ? (rb & 63) * 64 : ((rb - 128) & 3) * 64;
    const int row0 = lat ? b * TL + t0 : ML + b * CL + t0;
    {
        const int tk = F.tid >> 3, sub = F.tid & 7, isk = sub >> 2, hq = sub & 3, m = hq >> 1, half = hq & 1, t = t0 + tk;
        const bf16* src = P + (size_t)(row0 + tk) * NINP + (isk ? B_K : B_Q) + h * 128 + 32 * hq;
        float xx[32], oo[32];
#pragma unroll
        for (int i = 0; i < 4; ++i) unpack8(*(const u32x4*)(src + 8 * i), xx + 8 * i);
        if (lat) { const int pos = half ? (t & 63) : (t >> 6); const float* cs = rope + pos * 16; const float* sn = rope + 1024 + pos * 16;
#pragma unroll
            for (int i = 0; i < 16; ++i) { const float c = cs[i], s = sn[i]; oo[i] = xx[i] * c - xx[i + 16] * s; oo[i + 16] = xx[i + 16] * c + xx[i] * s; } }
        else {
#pragma unroll
            for (int i = 0; i < 32; ++i) oo[i] = xx[i]; }
        if (!isk) {
#pragma unroll
            for (int i = 0; i < 32; ++i) oo[i] *= QSCALE; }
        const int bhm = (b * 4 + h) * 2 + m;
        bf16* dst = isk ? KR + ((size_t)bhm * KEYS + (lat ? CL + t : t)) * 64 + 32 * half : (lat ? QR + ((size_t)bhm * TL + t) * 64 + 32 * half : QC + ((size_t)bhm * CL + t) * 64 + 32 * half);
        if (isk || lat || l == 0) {
#pragma unroll
            for (int i = 0; i < 4; ++i) *(u32x4*)(dst + 8 * i) = pack8(oo + 8 * i); }
    }
    LAS unsigned char* VL = F.lds;
#pragma unroll
    for (int pass = 0; pass < 2; ++pass) { const int idx = F.tid + 512 * pass, key = idx >> 4, c = idx & 15;
        *(LAS u32x4*)(VL + key * 272 + 16 * c) = *(const u32x4*)(P + (size_t)(row0 + key) * NINP + B_V + h * 128 + 8 * c); }
    WG_BAR();
    const int keybase = lat ? CL + t0 : t0;
#pragma unroll
    for (int pass = 0; pass < 2; ++pass) { const int idx = F.tid + 512 * pass, dv = idx >> 3, kc = idx & 7; unsigned short e[8];
#pragma unroll
        for (int i = 0; i < 8; ++i) e[i] = *(const LAS unsigned short*)(VL + (8 * kc + i) * 272 + 2 * dv);
        u32x4 o; o.x = e[0] | ((unsigned)e[1] << 16); o.y = e[2] | ((unsigned)e[3] << 16); o.z = e[4] | ((unsigned)e[5] << 16); o.w = e[6] | ((unsigned)e[7] << 16);
        *(u32x4*)(VT + ((size_t)(b * 4 + h) * 128 + dv) * KEYS + keybase + 8 * kc) = o; }
    WG_BAR();
}

constexpr int NCHUNK = NSTEP / 64;
constexpr int CHKB = 62464;
constexpr int CK_W1F = 0, CK_RF = 8192, CK_BTF = 16384, CK_ARBF = 24576, CK_YCA = 30720  , CK_VF = 36864  , CK_W2A = 45056, CK_GA = 53248, CK_CLV = 61440;
static_assert((size_t)32 * NCHUNK * CHKB <= WS_Y - WS_CHK, "chunk records");

__device__ __forceinline__ bf16x8 frag16(const LAS unsigned char* tile, int row, int k0) { return *(const LAS bf16x8*)(tile + row * 144 + k0 * 2); }
__device__ __forceinline__ bf16x8 fragP(const LAS unsigned char* tile, int row, int base, int hh) {
    const u32x2 lo = *(const LAS u32x2*)(tile + row * 144 + (base + 4 * hh) * 2), hi = *(const LAS u32x2*)(tile + row * 144 + (base + 8 + 4 * hh) * 2);
    const u32x4 w = {lo.x, lo.y, hi.x, hi.y}; return __builtin_bit_cast(bf16x8, w);
}
template <int S8> __device__ __forceinline__ bf16x8 pk8(const f32x16& a) {
    const u32x4 w = {cvtpk(a[S8], a[S8 + 1]), cvtpk(a[S8 + 2], a[S8 + 3]), cvtpk(a[S8 + 4], a[S8 + 5]), cvtpk(a[S8 + 6], a[S8 + 7])}; return __builtin_bit_cast(bf16x8, w);
}
__device__ __forceinline__ f32x16 tile_prod(const LAS unsigned char* At, int m0, const LAS unsigned char* Bt, int n0, int l31, int hh) {
    f32x16 d = zero16();
#pragma unroll
    for (int q = 0; q < 4; ++q) d = __builtin_amdgcn_mfma_f32_32x32x16_bf16(frag16(At, m0 + l31, 16 * q + 8 * hh), frag16(Bt, n0 + l31, 16 * q + 8 * hh), d, 0, 0, 0);
    return d;
}
__device__ __forceinline__ void st_acc32(unsigned char* p, const f32x16& d) {
    *(u32x4*)p = (u32x4){cvtpk(d[0], d[1]), cvtpk(d[2], d[3]), cvtpk(d[4], d[5]), cvtpk(d[6], d[7])};
    *(u32x4*)(p + 16) = (u32x4){cvtpk(d[8], d[9]), cvtpk(d[10], d[11]), cvtpk(d[12], d[13]), cvtpk(d[14], d[15])};
}
__device__ __forceinline__ f32x16 ld_acc32(const LAS unsigned char* p) {
    const u32x4 a = *(const LAS u32x4*)p, b = *(const LAS u32x4*)(p + 16); f32x16 d;
    d[0] = bflo(a.x); d[1] = bfhi(a.x); d[2] = bflo(a.y); d[3] = bfhi(a.y); d[4] = bflo(a.z); d[5] = bfhi(a.z); d[6] = bflo(a.w); d[7] = bfhi(a.w);
    d[8] = bflo(b.x); d[9] = bfhi(b.x); d[10] = bflo(b.y); d[11] = bfhi(b.y); d[12] = bflo(b.z); d[13] = bfhi(b.z); d[14] = bflo(b.w); d[15] = bfhi(b.w); return d;
}
__device__ __forceinline__ f32x16 acc_from(const u32x4 a, const u32x4 b) { f32x16 d;
    d[0] = bflo(a.x); d[1] = bfhi(a.x); d[2] = bflo(a.y); d[3] = bfhi(a.y); d[4] = bflo(a.z); d[5] = bfhi(a.z); d[6] = bflo(a.w); d[7] = bfhi(a.w);
    d[8] = bflo(b.x); d[9] = bfhi(b.x); d[10] = bflo(b.y); d[11] = bfhi(b.y); d[12] = bflo(b.z); d[13] = bfhi(b.z); d[14] = bflo(b.w); d[15] = bfhi(b.w); return d; }
__device__ __forceinline__ float softplus_f(float x) { return fmaxf(x, 0.f) + __logf(1.f + __expf(-fabsf(x))); }
__device__ __forceinline__ int scan_row(int c, int i, int dir, int b) {
    const bool isctx = c < 4; const int bi = (isctx ? 64 * c : 64 * (c - 4)) + i;
    return isctx ? ML + b * CL + (dir ? CL - 1 - bi : bi) : b * TL + (dir ? TL - 1 - bi : bi);
}

struct R1In { u32x4 g_l, g_r, g_k, g_v, p_l, p_r, p_k, p_v; u32x2 g_a, p_a; };
__device__ __forceinline__ void r1_load(Ctx& F, int item, R1In& in) {
    const int scan = item / NCHUNK, c = item % NCHUNK, dir = scan >> 4, b = (scan >> 3) & 1, h = scan & 7;
    const bf16* P = (const bf16*)(F.ws + WS_P);
    const int i = F.tid >> 3, sub = F.tid & 7, c0 = 8 * sub, gc0 = h * 64 + c0;
    const bool isctx = c < 4; const int bi = (isctx ? 64 * c : 64 * (c - 4)) + i;
    const int row = scan_row(c, i, dir, b);
    const bf16* pr = P + (size_t)row * NINP; const bf16* pp = (bi > 0) ? (dir ? pr + NINP : pr - NINP) : pr;
    const int CLX = dir == 0 ? C_LF : C_LB;
    in.g_l = *(const u32x4*)(pr + CLX + c0); in.g_r = *(const u32x4*)(pr + C_R + gc0); in.g_k = *(const u32x4*)(pr + C_K + gc0); in.g_v = *(const u32x4*)(pr + C_V + gc0); in.g_a = *(const u32x2*)(pr + CLX + 64 + 4 * sub);
    in.p_l = *(const u32x4*)(pp + CLX + c0); in.p_r = *(const u32x4*)(pp + C_R + gc0); in.p_k = *(const u32x4*)(pp + C_K + gc0); in.p_v = *(const u32x4*)(pp + C_V + gc0); in.p_a = *(const u32x2*)(pp + CLX + 64 + 4 * sub);
}
__device__ __forceinline__ void rwkv1_item(Ctx& F, int l, int item, R1In& in, int next_item) {
    const int scan = item / NCHUNK, c = item % NCHUNK, dir = scan >> 4, b = (scan >> 3) & 1, h = scan & 7;
    const bf16* P = (const bf16*)(F.ws + WS_P); unsigned char* rec = F.ws + WS_CHK + (size_t)item * CHKB;
    bf16* BON = (bf16*)(F.ws + WS_BON) + (size_t)dir * MT * 512;
    LAS unsigned char* TA = F.lds; LAS unsigned char* TB = F.lds + 9216; LAS unsigned char* TK = F.lds + 18432; LAS unsigned char* TR = F.lds + 27648;
    LAS unsigned char* TAT = F.lds + 36864; LAS unsigned char* TBT = F.lds + 46080; LAS unsigned char* TKT = F.lds + 55296; LAS unsigned char* TVT = F.lds + 64512;
    LAS unsigned char* TT = F.lds + 73728;
    LAS float* AAB = (LAS float*)(F.lds + 82944);
    LAS float* CLS = (LAS float*)(F.lds + 100352);
    LAS unsigned char* A21B = F.lds + 116736; LAS unsigned char* T11T = F.lds + 119296;
    LAS unsigned char* LWH = F.lds;             LAS unsigned char* LWL = F.lds + 9216;
    LAS unsigned char* LAH = F.lds + 18432;     LAS unsigned char* LAL = F.lds + 23552;
    LAS unsigned char* XWH = F.lds + 28672;     LAS unsigned char* XWL = F.lds + 37888;
    LAS unsigned char* XAH = F.lds + 47104;     LAS unsigned char* XAL = F.lds + 52224;
    LAS float* OW = (LAS float*)(F.lds + 57344);
    LAS float* OA = (LAS float*)(F.lds + 74752);
    const int i = F.tid >> 3, sub = F.tid & 7, c0 = 8 * sub, gc0 = h * 64 + c0;
    const bool isctx = c < 4; const int bi = (isctx ? 64 * c : 64 * (c - 4)) + i;
    const int row = scan_row(c, i, dir, b);
    const bool hasprev = bi > 0;
    const bf16* pr = P + (size_t)row * NINP; const bf16* pp = dir ? pr + NINP : pr - NINP;
    const int pd = l * 2 + dir;
    const float* mu = F.prm->in[17] + (size_t)pd * 1632; const float* w0 = F.prm->in[18] + (size_t)pd * 512; const float* w2 = F.prm->in[19] + (size_t)pd * 64 * 512;
    const float* a0 = F.prm->in[20] + (size_t)pd * 512; const float* a2 = F.prm->in[21] + (size_t)pd * 32 * 512; const float* k_k = F.prm->in[22] + (size_t)pd * 512;
    const float* k_a = F.prm->in[23] + (size_t)pd * 512; const float* r_k = F.prm->in[24] + (size_t)pd * 512;
    const int CLX = dir == 0 ? C_LF : C_LB;
    f32x4 pm_[16];
    { const float* pv_[8] = {mu + gc0, mu + 512 + gc0, mu + 1024 + gc0, w0 + gc0, a0 + gc0, k_k + gc0, k_a + gc0, r_k + gc0};
#pragma unroll
      for (int v = 0; v < 8; ++v) { pm_[2 * v] = *(const f32x4*)(pv_[v]); pm_[2 * v + 1] = *(const f32x4*)(pv_[v] + 4); } }
#define PM(v, e) (pm_[2 * (v) + ((e) >> 2)][(e) & 3])
    const u32x4 zz4 = {0u, 0u, 0u, 0u}; const u32x2 zz2 = {0u, 0u};
    const u32x4 g_l = in.g_l, g_r = in.g_r, g_k = in.g_k, g_v = in.g_v; const u32x2 g_a = in.g_a;
    const u32x4 p_l = hasprev ? in.p_l : zz4, p_r = hasprev ? in.p_r : zz4, p_k = hasprev ? in.p_k : zz4, p_v = hasprev ? in.p_v : zz4; const u32x2 p_a = hasprev ? in.p_a : zz2;
    {
        const unsigned char* lwg = F.ws + WS_LW + (size_t)(pd * 8 + h) * 24576;
        { const int p = F.tid, r = p >> 3, cq = p & 7; *(LAS u32x4*)(LWH + r * 144 + cq * 16) = *(const u32x4*)(lwg + p * 16); *(LAS u32x4*)(LWL + r * 144 + cq * 16) = *(const u32x4*)(lwg + 8192 + p * 16); }
        { const int p = F.tid & 255, r = p >> 2, cq = p & 3; LAS unsigned char* dst = (F.tid < 256 ? LAH : LAL); *(LAS u32x4*)(dst + r * 80 + cq * 16) = *(const u32x4*)(lwg + 16384 + (F.tid < 256 ? 0 : 4096) + p * 16); }
    }
    {   float f[8], pv[8], th[8], tl[8]; unpack8(g_l, f); unpack8(p_l, pv);
        const f32x4 mw0 = *(const f32x4*)(mu + 1536 + c0), mw1 = *(const f32x4*)(mu + 1536 + c0 + 4), ma0 = *(const f32x4*)(mu + 1600 + 4 * sub); const float muw[8] = {mw0.x, mw0.y, mw0.z, mw0.w, mw1.x, mw1.y, mw1.z, mw1.w}, mua[4] = {ma0.x, ma0.y, ma0.z, ma0.w};
#pragma unroll
        for (int e = 0; e < 8; ++e) { const float z = f[e] + (pv[e] - f[e]) * muw[e]; const float ez = __expf(-2.f * fabsf(z)); const float t0 = (1.f - ez) * __builtin_amdgcn_rcpf(1.f + ez); const float tv = z < 0.f ? -t0 : t0;
            th[e] = bflo(cvtpk(tv, 0.f)); tl[e] = tv - th[e]; }
        *(LAS u32x4*)(XWH + i * 144 + 2 * c0) = pack8(th); *(LAS u32x4*)(XWL + i * 144 + 2 * c0) = pack8(tl);
        const float fz[4] = {bflo(g_a.x), bfhi(g_a.x), bflo(g_a.y), bfhi(g_a.y)}, pz[4] = {bflo(p_a.x), bfhi(p_a.x), bflo(p_a.y), bfhi(p_a.y)}; float zh[4], zl[4];
#pragma unroll
        for (int e = 0; e < 4; ++e) { const float z = fz[e] + (pz[e] - fz[e]) * mua[e]; zh[e] = bflo(cvtpk(z, 0.f)); zl[e] = z - zh[e]; }
        *(LAS u32x2*)(XAH + i * 80 + 8 * sub) = (u32x2){cvtpk(zh[0], zh[1]), cvtpk(zh[2], zh[3])}; *(LAS u32x2*)(XAL + i * 80 + 8 * sub) = (u32x2){cvtpk(zl[0], zl[1]), cvtpk(zl[2], zl[3])};
    }
    WG_BAR();
    {
        const int l31 = F.lane & 31, hh = F.lane >> 5, mt = (F.wave >> 1) & 1, nt = F.wave & 1;
        f32x16 d = zero16();
        if (F.wave < 4) {
#pragma unroll
            for (int q = 0; q < 4; ++q) { const bf16x8 ah = frag16(XWH, 32 * mt + l31, 16 * q + 8 * hh), al_ = frag16(XWL, 32 * mt + l31, 16 * q + 8 * hh), bh = frag16(LWH, 32 * nt + l31, 16 * q + 8 * hh), bl = frag16(LWL, 32 * nt + l31, 16 * q + 8 * hh);
                d = __builtin_amdgcn_mfma_f32_32x32x16_bf16(ah, bh, d, 0, 0, 0); d = __builtin_amdgcn_mfma_f32_32x32x16_bf16(ah, bl, d, 0, 0, 0); d = __builtin_amdgcn_mfma_f32_32x32x16_bf16(al_, bh, d, 0, 0, 0); }
#pragma unroll
            for (int r = 0; r < 16; ++r) OW[(32 * mt + MROW(r, hh)) * 68 + 32 * nt + l31] = d[r];
        } else {
#pragma unroll
            for (int q = 0; q < 2; ++q) { const int ko = (16 * q + 8 * hh) * 2;
                const bf16x8 ah = *(const LAS bf16x8*)(XAH + (32 * mt + l31) * 80 + ko), al_ = *(const LAS bf16x8*)(XAL + (32 * mt + l31) * 80 + ko), bh = *(const LAS bf16x8*)(LAH + (32 * nt + l31) * 80 + ko), bl = *(const LAS bf16x8*)(LAL + (32 * nt + l31) * 80 + ko);
                d = __builtin_amdgcn_mfma_f32_32x32x16_bf16(ah, bh, d, 0, 0, 0); d = __builtin_amdgcn_mfma_f32_32x32x16_bf16(ah, bl, d, 0, 0, 0); d = __builtin_amdgcn_mfma_f32_32x32x16_bf16(al_, bh, d, 0, 0, 0); }
#pragma unroll
            for (int r = 0; r < 16; ++r) OA[(32 * mt + MROW(r, hh)) * 68 + 32 * nt + l31] = d[r];
        }
    }
    WG_BAR();
    float wp[8], ap[8];
    { const f32x4 a = *(const LAS f32x4*)(OW + i * 68 + c0), bq = *(const LAS f32x4*)(OW + i * 68 + c0 + 4), cq = *(const LAS f32x4*)(OA + i * 68 + c0), dq = *(const LAS f32x4*)(OA + i * 68 + c0 + 4);
      const float ow[8] = {a.x, a.y, a.z, a.w, bq.x, bq.y, bq.z, bq.w}, oa[8] = {cq.x, cq.y, cq.z, cq.w, dq.x, dq.y, dq.z, dq.w};
#pragma unroll
      for (int e = 0; e < 8; ++e) { wp[e] = PM(3, e) + ow[e]; ap[e] = PM(4, e) + oa[e]; } }
    float lw[8], kk[8], al[8], km[8], rr[8], vv[8];
    {   float fr[8], fk[8], fv[8], qr[8], qk[8], qv[8]; unpack8(g_r, fr); unpack8(g_k, fk); unpack8(g_v, fv); unpack8(p_r, qr); unpack8(p_k, qk); unpack8(p_v, qv);
        float n2 = 0.f, bsum = 0.f;
#pragma unroll
        for (int e = 0; e < 8; ++e) { const int gc = gc0 + e;
            rr[e] = fr[e] + (qr[e] - fr[e]) * PM(0, e); const float kx = fk[e] + (qk[e] - fk[e]) * PM(1, e); vv[e] = fv[e] + (qv[e] - fv[e]) * PM(2, e);
            const float w = -softplus_f(-wp[e]) - 0.5f; lw[e] = -__expf(w);
            al[e] = __builtin_amdgcn_rcpf(1.f + __expf(-ap[e]));
            kk[e] = kx * PM(5, e); n2 += kk[e] * kk[e];
            km[e] = kx * (1.f + (al[e] - 1.f) * PM(6, e));
            bsum += rr[e] * km[e] * PM(7, e); }
        n2 = red8(n2); bsum = red8(bsum);
        const float inv = __builtin_amdgcn_rsqf(fmaxf(n2, 1e-24f)); float bon[8];
#pragma unroll
        for (int e = 0; e < 8; ++e) { kk[e] *= inv; bon[e] = bsum * vv[e]; }
        *(u32x4*)(BON + (size_t)row * 512 + gc0) = pack8(bon);
    }
    *(LAS f32x4*)(CLS + i * 64 + c0) = (f32x4){lw[0], lw[1], lw[2], lw[3]}; *(LAS f32x4*)(CLS + i * 64 + c0 + 4) = (f32x4){lw[4], lw[5], lw[6], lw[7]};
    WG_BAR();
    if (F.tid < 64) {
        float x[64];
#pragma unroll
        for (int q = 0; q < 64; ++q) x[q] = CLS[q * 64 + F.tid];
#pragma unroll
        for (int q = 1; q < 64; ++q) x[q] += x[q - 1];
#pragma unroll
        for (int q = 0; q < 64; ++q) CLS[q * 64 + F.tid] = x[q];
    }
    WG_BAR();
    {   float cl[8], cL[8];
        { const f32x4 a = *(const LAS f32x4*)(CLS + i * 64 + c0), bq = *(const LAS f32x4*)(CLS + i * 64 + c0 + 4), cc = *(const LAS f32x4*)(CLS + 63 * 64 + c0), dd = *(const LAS f32x4*)(CLS + 63 * 64 + c0 + 4);
          cl[0] = a.x; cl[1] = a.y; cl[2] = a.z; cl[3] = a.w; cl[4] = bq.x; cl[5] = bq.y; cl[6] = bq.z; cl[7] = bq.w; cL[0] = cc.x; cL[1] = cc.y; cL[2] = cc.z; cL[3] = cc.w; cL[4] = dd.x; cL[5] = dd.y; cL[6] = dd.z; cL[7] = dd.w; }
        float tA[8], tB[8], tK[8], tR[8], tBt[8], tKt[8];
#pragma unroll
        for (int e = 0; e < 8; ++e) { const float eA = __expf(cl[e] - lw[e]), eI = __expf(-cl[e]), eR = __expf(cl[e]), eT = __expf(cL[e] - cl[e]); const float ba = kk[e] * al[e];
            tA[e] = -kk[e] * eA; tB[e] = ba * eI; tK[e] = km[e] * eI; tR[e] = rr[e] * eR; tBt[e] = ba * eT; tKt[e] = km[e] * eT; }
        *(LAS u32x4*)(TA + i * 144 + 2 * c0) = pack8(tA); *(LAS u32x4*)(TB + i * 144 + 2 * c0) = pack8(tB); *(LAS u32x4*)(TK + i * 144 + 2 * c0) = pack8(tK); *(LAS u32x4*)(TR + i * 144 + 2 * c0) = pack8(tR);
        const u32x4 qa = pack8(tA), qb = pack8(tBt), qk = pack8(tKt), qv = pack8(vv);
        const unsigned wa[4] = {qa.x, qa.y, qa.z, qa.w}, wb[4] = {qb.x, qb.y, qb.z, qb.w}, wk[4] = {qk.x, qk.y, qk.z, qk.w}, wv[4] = {qv.x, qv.y, qv.z, qv.w};
#pragma unroll
        for (int e0 = 0; e0 < 8; ++e0) { const int e = (e0 + sub) & 7;
            const unsigned ua = e < 2 ? wa[0] : e < 4 ? wa[1] : e < 6 ? wa[2] : wa[3], ub_ = e < 2 ? wb[0] : e < 4 ? wb[1] : e < 6 ? wb[2] : wb[3];
            const unsigned uk = e < 2 ? wk[0] : e < 4 ? wk[1] : e < 6 ? wk[2] : wk[3], uv = e < 2 ? wv[0] : e < 4 ? wv[1] : e < 6 ? wv[2] : wv[3];
            const int sh = (e & 1) * 16; const int o = (c0 + e) * 144 + 2 * i;
            *(LAS unsigned short*)(TAT + o) = (unsigned short)(ua >> sh); *(LAS unsigned short*)(TBT + o) = (unsigned short)(ub_ >> sh);
            *(LAS unsigned short*)(TKT + o) = (unsigned short)(uk >> sh); *(LAS unsigned short*)(TVT + o) = (unsigned short)(uv >> sh); }
    }
    WG_BAR();
    const int l31 = F.lane & 31, hh = F.lane >> 5;
    if (F.wave < 3) { const int it = F.wave > 0, jt = F.wave > 1; const f32x16 d = tile_prod(TA, 32 * it, TB, 32 * jt, l31, hh);
#pragma unroll
        for (int r = 0; r < 16; ++r) { const int ii = 32 * it + MROW(r, hh), j = 32 * jt + l31; AAB[ii * 68 + (j & 7) * 8 + (j >> 3)] = j < ii ? d[r] : 0.f; }
        if (F.wave == 1) {
#pragma unroll
            for (int r = 0; r < 16; r += 2) { const unsigned w = cvtpk(d[r], d[r + 1]); *(LAS unsigned short*)(A21B + MROW(r, hh) * 80 + 2 * l31) = (unsigned short)w; *(LAS unsigned short*)(A21B + MROW(r + 1, hh) * 80 + 2 * l31) = (unsigned short)(w >> 16); } } }
    else if (F.wave == 3) {
#pragma unroll
        for (int r = 0; r < 16; ++r) AAB[(2 * r + hh) * 68 + (l31 & 7) * 8 + 4 + (l31 >> 3)] = 0.f; }
    else if (F.wave == 4) {
#pragma unroll
        for (int f = 0; f < 8; ++f) { const int it = f >> 2, kt = (f >> 1) & 1, s = f & 1; *(bf16x8*)(rec + CK_RF + (f * 64 + F.lane) * 16) = fragP(TR, 32 * it + l31, 32 * kt + 16 * s, hh); } }
    else if (F.wave == 5) {
#pragma unroll
        for (int f = 0; f < 8; ++f) { const int kt = f >> 2, jt = (f >> 1) & 1, s = f & 1; *(bf16x8*)(rec + CK_BTF + (f * 64 + F.lane) * 16) = fragP(TBT, 32 * kt + l31, 32 * jt + 16 * s, hh); } }
    else if (F.wave == 7) { *(float*)(rec + CK_CLV + 4 * F.lane) = __expf(CLS[63 * 64 + F.lane]); }
    WG_BAR();
    {   const int blk = F.tid >> 8, col = (F.tid >> 3) & 31; int dg = col; float town[4];
#pragma unroll
        for (int q = 0; q < 4; ++q) town[q] = 0.f;
        const LAS float* arow = AAB + blk * 32 * 68 + sub * 8 + blk * 4; asm volatile("" : "+v"(arow));
        f32x4 na0 = *(const LAS f32x4*)(arow);
#pragma unroll
        for (int q = 0; q < 4; ++q)
#pragma unroll
            for (int r = 0; r < 8; ++r) { const int ii = 8 * q + r;
                const f32x4 a0 = na0;
                if (ii + 1 < 32) na0 = *(const LAS f32x4*)(arow + (ii + 1) * 68);
                float p = a0.x * town[0];
                if (q >= 1) p += a0.y * town[1]; if (q >= 2) p += a0.z * town[2]; if (q >= 3) p += a0.w * town[3];
                p = red8(p);
                const float tv = p + ((dg == 0) ? 1.f : 0.f); dg -= 1; asm volatile("" : "+v"(dg));
                town[q] = (sub == r) ? tv : town[q];
            }
        LAS unsigned char* ttw = TT + (blk * 32) * 144 + 2 * (blk * 32 + col);
#pragma unroll
        for (int q = 0; q < 4; ++q) { const unsigned short tb = (unsigned short)cvtpk(town[q], 0.f); *(LAS unsigned short*)(ttw + (8 * q + sub) * 144) = tb;
            if (blk == 0) *(LAS unsigned short*)(T11T + col * 80 + 2 * (8 * q + sub)) = tb; }
        if (blk == 1) { const int t = F.tid - 256; *(LAS u32x2*)(TT + (t >> 3) * 144 + 64 + 8 * (t & 7)) = (u32x2){0u, 0u}; }
    }
    WG_BAR();
    if (F.wave == 0) {
        f32x16 m = zero16();
#pragma unroll
        for (int s2 = 0; s2 < 2; ++s2) m = __builtin_amdgcn_mfma_f32_32x32x16_bf16(*(const LAS bf16x8*)(A21B + l31 * 80 + (16 * s2 + 8 * hh) * 2), *(const LAS bf16x8*)(T11T + l31 * 80 + (16 * s2 + 8 * hh) * 2), m, 0, 0, 0);
        f32x16 t21 = zero16();
        t21 = __builtin_amdgcn_mfma_f32_32x32x16_bf16(fragP(TT, 32 + l31, 32, hh), pk8<0>(m), t21, 0, 0, 0);
        t21 = __builtin_amdgcn_mfma_f32_32x32x16_bf16(fragP(TT, 32 + l31, 48, hh), pk8<8>(m), t21, 0, 0, 0);
#pragma unroll
        for (int r = 0; r < 16; r += 2) { const unsigned w = cvtpk(t21[r], t21[r + 1]); *(LAS unsigned short*)(TT + (32 + MROW(r, hh)) * 144 + 2 * l31) = (unsigned short)w; *(LAS unsigned short*)(TT + (32 + MROW(r + 1, hh)) * 144 + 2 * l31) = (unsigned short)(w >> 16); }
    }
    f32x16 X0 = zero16(), X1 = zero16();
    if (F.wave == 0) {
    } else if (F.wave <= 2) {
        const int vt = F.wave - 1;
        f32x16 a00 = tile_prod(TK, 0, TA, 0, l31, hh), a11 = tile_prod(TK, 32, TA, 32, l31, hh); const f32x16 a01 = tile_prod(TK, 0, TA, 32, l31, hh);
#pragma unroll
        for (int r = 0; r < 16; ++r) { const bool keep = MROW(r, hh) < l31; a00[r] = keep ? a00[r] : 0.f; a11[r] = keep ? a11[r] : 0.f; }
        X0 = __builtin_amdgcn_mfma_f32_32x32x16_bf16(pk8<0>(a00), fragP(TVT, 32 * vt + l31, 0, hh), X0, 0, 0, 0);
        X0 = __builtin_amdgcn_mfma_f32_32x32x16_bf16(pk8<8>(a00), fragP(TVT, 32 * vt + l31, 16, hh), X0, 0, 0, 0);
        X1 = __builtin_amdgcn_mfma_f32_32x32x16_bf16(pk8<0>(a01), fragP(TVT, 32 * vt + l31, 0, hh), X1, 0, 0, 0);
        X1 = __builtin_amdgcn_mfma_f32_32x32x16_bf16(pk8<8>(a01), fragP(TVT, 32 * vt + l31, 16, hh), X1, 0, 0, 0);
        X1 = __builtin_amdgcn_mfma_f32_32x32x16_bf16(pk8<0>(a11), fragP(TVT, 32 * vt + l31, 32, hh), X1, 0, 0, 0);
        X1 = __builtin_amdgcn_mfma_f32_32x32x16_bf16(pk8<8>(a11), fragP(TVT, 32 * vt + l31, 48, hh), X1, 0, 0, 0);
    } else if (F.wave == 3) {
#pragma unroll
        for (int blk = 0; blk < 3; ++blk) { const int it = blk > 0, jt = blk > 1; f32x16 d = tile_prod(TB, 32 * jt, TR, 32 * it, l31, hh);
            if (it == jt) {
#pragma unroll
                for (int r = 0; r < 16; ++r) d[r] = MROW(r, hh) <= l31 ? d[r] : 0.f; }
            *(bf16x8*)(rec + CK_ARBF + ((blk * 2 + 0) * 64 + F.lane) * 16) = pk8<0>(d); *(bf16x8*)(rec + CK_ARBF + ((blk * 2 + 1) * 64 + F.lane) * 16) = pk8<8>(d); }
    } else if (F.wave == 4) {
        f32x16 d00 = tile_prod(TK, 0, TR, 0, l31, hh), d11 = tile_prod(TK, 32, TR, 32, l31, hh); const f32x16 d10 = tile_prod(TK, 0, TR, 32, l31, hh);
#pragma unroll
        for (int r = 0; r < 16; ++r) { const bool keep = MROW(r, hh) <= l31; d00[r] = keep ? d00[r] : 0.f; d11[r] = keep ? d11[r] : 0.f; }
#pragma unroll
        for (int vt = 0; vt < 2; ++vt) { f32x16 y0 = zero16(), y1 = zero16();
            y0 = __builtin_amdgcn_mfma_f32_32x32x16_bf16(pk8<0>(d00), fragP(TVT, 32 * vt + l31, 0, hh), y0, 0, 0, 0);
            y0 = __builtin_amdgcn_mfma_f32_32x32x16_bf16(pk8<8>(d00), fragP(TVT, 32 * vt + l31, 16, hh), y0, 0, 0, 0);
            y1 = __builtin_amdgcn_mfma_f32_32x32x16_bf16(pk8<0>(d10), fragP(TVT, 32 * vt + l31, 0, hh), y1, 0, 0, 0);
            y1 = __builtin_amdgcn_mfma_f32_32x32x16_bf16(pk8<8>(d10), fragP(TVT, 32 * vt + l31, 16, hh), y1, 0, 0, 0);
            y1 = __builtin_amdgcn_mfma_f32_32x32x16_bf16(pk8<0>(d11), fragP(TVT, 32 * vt + l31, 32, hh), y1, 0, 0, 0);
            y1 = __builtin_amdgcn_mfma_f32_32x32x16_bf16(pk8<8>(d11), fragP(TVT, 32 * vt + l31, 48, hh), y1, 0, 0, 0);
            st_acc32(rec + CK_YCA + ((0 * 2 + vt) * 64 + F.lane) * 32, y0); st_acc32(rec + CK_YCA + ((1 * 2 + vt) * 64 + F.lane) * 32, y1); }
    } else if (F.wave <= 6) {
        const int kt = F.wave - 5;
#pragma unroll
        for (int vt = 0; vt < 2; ++vt) { const f32x16 d = tile_prod(TKT, 32 * kt, TVT, 32 * vt, l31, hh); st_acc32(rec + CK_GA + ((kt * 2 + vt) * 64 + F.lane) * 32, d); }
    }
    WG_BAR();
    if (F.wave == 1 || F.wave == 2) { const int vt = F.wave - 1;
        f32x16 w0a = zero16(), w1a = zero16();
        w0a = __builtin_amdgcn_mfma_f32_32x32x16_bf16(fragP(TT, l31, 0, hh), pk8<0>(X0), w0a, 0, 0, 0);
        w0a = __builtin_amdgcn_mfma_f32_32x32x16_bf16(fragP(TT, l31, 16, hh), pk8<8>(X0), w0a, 0, 0, 0);
        w1a = __builtin_amdgcn_mfma_f32_32x32x16_bf16(fragP(TT, 32 + l31, 0, hh), pk8<0>(X0), w1a, 0, 0, 0);
        w1a = __builtin_amdgcn_mfma_f32_32x32x16_bf16(fragP(TT, 32 + l31, 16, hh), pk8<8>(X0), w1a, 0, 0, 0);
        w1a = __builtin_amdgcn_mfma_f32_32x32x16_bf16(fragP(TT, 32 + l31, 32, hh), pk8<0>(X1), w1a, 0, 0, 0);
        w1a = __builtin_amdgcn_mfma_f32_32x32x16_bf16(fragP(TT, 32 + l31, 48, hh), pk8<8>(X1), w1a, 0, 0, 0);
        st_acc32(rec + CK_W2A + ((0 * 2 + vt) * 64 + F.lane) * 32, w0a); st_acc32(rec + CK_W2A + ((1 * 2 + vt) * 64 + F.lane) * 32, w1a);
    } else if (F.wave >= 3 && F.wave <= 6) { const int kt = (F.wave - 3) >> 1, it = (F.wave - 3) & 1;
        const f32x16 d = tile_prod(TAT, 32 * kt, TT, 32 * it, l31, hh);
        *(bf16x8*)(rec + CK_W1F + ((((it * 2 + kt) * 2) + 0) * 64 + F.lane) * 16) = pk8<0>(d); *(bf16x8*)(rec + CK_W1F + ((((it * 2 + kt) * 2) + 1) * 64 + F.lane) * 16) = pk8<8>(d);
    }
    WG_BAR();
}

#ifdef TS_R2
#define R2BAR() do { const unsigned long long t0_ = __builtin_amdgcn_s_memrealtime(); WG_BAR(); r2wait += __builtin_amdgcn_s_memrealtime() - t0_; } while (0)
#else
#define R2BAR() WG_BAR()
#endif
template <int NC> __device__ __forceinline__ void rwkv2_role(Ctx& F, int cb) {
    unsigned long long r2wait = 0;
    const int scan = F.bx, dir = scan >> 4, b = (scan >> 3) & 1, h = scan & 7;
    const unsigned char* recs = F.ws + WS_CHK + ((size_t)scan * NCHUNK + cb) * CHKB;
    static_assert(NC % 2 == 0, "the Y waves alternate two register sets");
    bf16* Y = (bf16*)(F.ws + WS_Y) + (size_t)dir * MT * 512 + h * 64;
    const int l31 = F.lane & 31, hh = F.lane >> 5;
    constexpr int RSL = 33792, R_W1F = 0, R_BTF = 8192, R_W2A = 16384, R_GA = 24576, R_CLV = 32768;
    constexpr int EXO = 3 * RSL;
#define FR(off, idx) (*(const LAS bf16x8*)(lf + (off) + (idx) * 1024))
#define MM(a_, b_, c_) c_ = __builtin_amdgcn_mfma_f32_32x32x16_bf16(a_, b_, c_, 0, 0, 0)
    if (F.wave < 2) {
        const int vt = F.wave;
        f32x16 S0 = zero16(), S1 = zero16();
        float* sst = (float*)(F.ws + WS_SST) + ((size_t)(scan * 2 + vt) * 2 * 64 + F.lane) * 16;
        if (cb > 0) {
#pragma unroll
            for (int g = 0; g < 4; ++g) { const f32x4 a_ = *(const f32x4*)(sst + 4 * g), b_ = *(const f32x4*)(sst + 1024 + 4 * g);
#pragma unroll
                for (int e = 0; e < 4; ++e) { S0[4 * g + e] = a_[e]; S1[4 * g + e] = b_[e]; } } }
        R2BAR();
        for (int c = 0; c <= NC; ++c) {
            if (c < NC) {
                const LAS unsigned char* buf = F.lds + (c % 3) * RSL; const LAS unsigned char* lf = buf + F.lane * 16;
                LAS unsigned char* ex = F.lds + EXO + (c & 1) * 16384 + vt * 8192 + F.lane * 16;
                const bf16x8 sb00 = pk8<0>(S0), sb01 = pk8<8>(S0), sb10 = pk8<0>(S1), sb11 = pk8<8>(S1);
                *(LAS bf16x8*)(ex) = sb00; *(LAS bf16x8*)(ex + 1024) = sb01; *(LAS bf16x8*)(ex + 2048) = sb10; *(LAS bf16x8*)(ex + 3072) = sb11;
                f32x16 U0 = ld_acc32(buf + R_W2A + ((0 * 2 + vt) * 64 + F.lane) * 32), U1 = ld_acc32(buf + R_W2A + ((1 * 2 + vt) * 64 + F.lane) * 32);
                MM(FR(R_W1F, 0), sb00, U0); MM(FR(R_W1F, 4), sb00, U1); MM(FR(R_W1F, 1), sb01, U0); MM(FR(R_W1F, 5), sb01, U1);
                MM(FR(R_W1F, 2), sb10, U0); MM(FR(R_W1F, 6), sb10, U1); MM(FR(R_W1F, 3), sb11, U0); MM(FR(R_W1F, 7), sb11, U1);
                { const LAS float* clv = (const LAS float*)(buf + R_CLV);
                  const f32x16 g0 = ld_acc32(buf + R_GA + ((0 * 2 + vt) * 64 + F.lane) * 32), g1 = ld_acc32(buf + R_GA + ((1 * 2 + vt) * 64 + F.lane) * 32);
#pragma unroll
                  for (int g = 0; g < 4; ++g) { const f32x4 ca = *(const LAS f32x4*)(clv + 8 * g + 4 * hh), cb = *(const LAS f32x4*)(clv + 32 + 8 * g + 4 * hh);
#pragma unroll
                      for (int e = 0; e < 4; ++e) { S0[4 * g + e] = S0[4 * g + e] * ca[e] + g0[4 * g + e]; S1[4 * g + e] = S1[4 * g + e] * cb[e] + g1[4 * g + e]; } } }
                const bf16x8 ub00 = pk8<0>(U0), ub01 = pk8<8>(U0), ub10 = pk8<0>(U1), ub11 = pk8<8>(U1);
                *(LAS bf16x8*)(ex + 4096) = ub00; *(LAS bf16x8*)(ex + 5120) = ub01; *(LAS bf16x8*)(ex + 6144) = ub10; *(LAS bf16x8*)(ex + 7168) = ub11;
                MM(FR(R_BTF, 0), ub00, S0); MM(FR(R_BTF, 4), ub00, S1); MM(FR(R_BTF, 1), ub01, S0); MM(FR(R_BTF, 5), ub01, S1);
                MM(FR(R_BTF, 2), ub10, S0); MM(FR(R_BTF, 6), ub10, S1); MM(FR(R_BTF, 3), ub11, S0); MM(FR(R_BTF, 7), ub11, S1);
            }
            R2BAR();
        }
        if (cb + NC < NCHUNK) {
#pragma unroll
            for (int g = 0; g < 4; ++g) { *(f32x4*)(sst + 4 * g) = (f32x4){S0[4 * g], S0[4 * g + 1], S0[4 * g + 2], S0[4 * g + 3]}; *(f32x4*)(sst + 1024 + 4 * g) = (f32x4){S1[4 * g], S1[4 * g + 1], S1[4 * g + 2], S1[4 * g + 3]}; } }
    } else if (F.wave < 6) {
        const int w = F.wave - 2, vt = w & 1, it = w >> 1;
        const long ystep = dir ? -512 : 512;
        bf16x8 fa[8], fb[8]; u32x4 ya[2], yb[2];
        const int o_rf = CK_RF + it * 4096, o_arb = CK_ARBF + it * 2048, o_yc = CK_YCA + ((it * 2 + vt) * 64) * 32;
#define YLD(f, y, c_) do { const unsigned char* g_ = recs + (size_t)(c_) * CHKB + F.lane * 16; \
            _Pragma("unroll") for (int k = 0; k < 4; ++k) { f[k] = *(const bf16x8*)(g_ + o_rf + k * 1024); f[4 + k] = *(const bf16x8*)(g_ + o_arb + k * 1024); } \
            y[0] = *(const u32x4*)(g_ + o_yc + F.lane * 16); y[1] = *(const u32x4*)(g_ + o_yc + F.lane * 16 + 16); } while (0)
#define YDO(f, y, cm1) do { const LAS unsigned char* ex = F.lds + EXO + ((cm1) & 1) * 16384 + vt * 8192 + F.lane * 16; \
            const bf16x8 sb00 = *(const LAS bf16x8*)(ex), sb01 = *(const LAS bf16x8*)(ex + 1024), sb10 = *(const LAS bf16x8*)(ex + 2048), sb11 = *(const LAS bf16x8*)(ex + 3072); \
            const bf16x8 ub00 = *(const LAS bf16x8*)(ex + 4096), ub01 = *(const LAS bf16x8*)(ex + 5120), ub10 = *(const LAS bf16x8*)(ex + 6144), ub11 = *(const LAS bf16x8*)(ex + 7168); \
            f32x16 Yt = acc_from(y[0], y[1]); \
            MM(f[0], sb00, Yt); MM(f[1], sb01, Yt); MM(f[2], sb10, Yt); MM(f[3], sb11, Yt); \
            MM(f[4], ub00, Yt); MM(f[5], ub01, Yt); \
            if (it) { MM(f[6], ub10, Yt); MM(f[7], ub11, Yt); } \
            bf16* yp = Y + (size_t)scan_row(cb + (cm1), 32 * it + 4 * hh, dir, b) * 512 + 32 * vt + l31; \
            _Pragma("unroll") for (int g = 0; g < 4; ++g) { bf16* yg = yp + 8 * g * ystep; \
                _Pragma("unroll") for (int e = 0; e < 4; e += 2) { const unsigned w_ = cvtpk(Yt[4 * g + e], Yt[4 * g + e + 1]); yg[e * ystep] = (bf16)w_; yg[(e + 1) * ystep] = (bf16)(w_ >> 16); } } } while (0)
        YLD(fa, ya, 0); YLD(fb, yb, 1);
        R2BAR();
        R2BAR();
        for (int c = 1; c <= NC; c += 2) {
            YDO(fa, ya, c - 1); YLD(fa, ya, (c + 1 < NC ? c + 1 : NC - 1));
            R2BAR();
            YDO(fb, yb, c); YLD(fb, yb, (c + 2 < NC ? c + 2 : NC - 1));
            R2BAR();
        }
#undef YLD
#undef YDO
    } else {
        int gsrc[17], ldst[17];
#pragma unroll
        for (int k = 0; k < 17; ++k) { int q = F.wave - 6 + 2 * k; q = q < 32 ? q : 32; const int rp = q < 8 ? q : (q < 16 ? q + 8 : q + 28); gsrc[k] = rp * 1024 + F.lane * 16; ldst[k] = q * 1024; }
#define R2_DMA(c_) do { const int cc_ = (c_) < NC ? (c_) : NC - 1; const int sl_ = ((c_) % 3) * RSL; _Pragma("unroll") for (int k = 0; k < 17; ++k) \
            __builtin_amdgcn_global_load_lds((const unsigned*)(recs + (size_t)cc_ * CHKB + gsrc[k]), (LAS unsigned*)(F.lds + sl_ + ldst[k]), 16, 0, 0); } while (0)
        R2_DMA(0); R2_DMA(1);
        asm volatile("s_waitcnt vmcnt(17)" ::: "memory");
        R2BAR();
        for (int c = 0; c <= NC; ++c) {
            R2_DMA(c + 2);
            asm volatile("s_waitcnt vmcnt(17)" ::: "memory");
            R2BAR();
        }
        asm volatile("s_waitcnt vmcnt(0)" ::: "memory");
#define R2_LD(a, b)
#define R2_WR(a, b)
#undef R2_LD
#undef R2_WR
    }
#undef FR
#undef MM
#ifdef TS_R2
    if (F.lane == 0 && F.bx == 0) ((unsigned*)(F.ws + WS_CTL))[2048 + F.wave] += (unsigned)r2wait;
#endif
}

#ifndef R_SGU
#define R_SGU 1
#endif
#ifndef R_R1
#define R_R1 1
#endif
#ifndef R_R2
#define R_R2 1
#endif
#ifndef R_AP
#define R_AP 1
#endif
#ifndef R_CV
#define R_CV 1
#endif
constexpr int NCH1 = 34, NCH2 = NCHUNK - NCH1;
__device__ __forceinline__ void r1_range(Ctx& F, int l, int c0, int nc, int w, int nw) {
    for (int q = w; q < 32 * nc; q += nw) { R1In in; const int item = (q / nc) * NCHUNK + c0 + q % nc; r1_load(F, item, in); rwkv1_item(F, l, item, in, -1); }
}
__device__ __forceinline__ void phase3a(Ctx& F, int l) { r1_range(F, l, 0, NCH1, F.bx, F.G); }
__device__ __forceinline__ void phase3b1(Ctx& F, int l) {
    if (F.bx < 32) { rwkv2_role<NCH1>(F, 0); return; }
    r1_range(F, l, NCH1, NCH2, F.bx - 32, F.G - 32);
}
__device__ __forceinline__ void phase3b(Ctx& F, int l) {
    if (F.bx < 32) { rwkv2_role<NCH2>(F, NCH1); return; }
    const int nsgu = (l == 0 ? 68 : 64) * 4, nap = 136 * 4, ncv = (l == 0 ? MT : ML) / 16;
    const int total = nsgu + nap + ncv;
    for (int it = F.bx - 32; it < total; it += F.G - 32) {
        int r = it;
        if (r < nsgu) { for (int q_ = 0; q_ < R_SGU; ++q_) sgu_item(F, l, r >> 2, r & 3); continue; } r -= nsgu;
        if (r < nap) { for (int q_ = 0; q_ < R_AP; ++q_) attnprep_item(F, l, r >> 2, r & 3); continue; } r -= nap;
        for (int q_ = 0; q_ < R_CV; ++q_) conv_item(F, l, r);
    }
}

__device__ __forceinline__ void attn_unit(Ctx& F, const bf16* Qp, const bf16* Kp, const bf16* Vtp, int nkt, bf16* Op) {
    constexpr int KB = 9216, VB = 18432, VOFF = 2 * KB;
    const int j = F.lane & 31, hh = F.lane >> 5;
    bf16x8 qf[4];
#pragma unroll
    for (int ks = 0; ks < 4; ++ks) qf[ks] = *(const bf16x8*)(Qp + (size_t)(F.wave * 32 + j) * 64 + ks * 16 + hh * 8);
    const int kkey = F.tid >> 3, kch = F.tid & 7;
    const bf16* ksrc = Kp + (size_t)kkey * 64 + kch * 8;
    const bf16* vsrc0 = Vtp + (size_t)kkey * KEYS + kch * 8; const bf16* vsrc1 = vsrc0 + (size_t)64 * KEYS;
    const int kdst = kkey * 144 + kch * 16, vdst0 = VOFF + kkey * 144 + kch * 16, vdst1 = vdst0 + 64 * 144;
    u32x4 rk, rv0, rv1;
    rk = *(const u32x4*)ksrc; rv0 = *(const u32x4*)vsrc0; rv1 = *(const u32x4*)vsrc1;
    *(LAS u32x4*)(F.lds + kdst) = rk; *(LAS u32x4*)(F.lds + vdst0) = rv0; *(LAS u32x4*)(F.lds + vdst1) = rv1;
    WG_BAR();
    const int sw = (j & ~12) | ((j & 4) << 1) | ((j & 8) >> 1);
    const int ka0 = sw * 144 + hh * 16, ka1 = (32 + sw) * 144 + hh * 16, va = VOFF + j * 144 + hh * 16;
    f32x16 acc[4];
#pragma unroll
    for (int i = 0; i < 4; ++i) acc[i] = zero16();
    f32x16 negm = zero16();
    float m_run = 0.f, l_run = 0.f;
    bf16x8 pf[4];
#pragma unroll
    for (int i = 0; i < 4; ++i) pf[i] = (bf16x8){0, 0, 0, 0, 0, 0, 0, 0};
    int vprev = 0, vcur = 0, vnext = VB;
    for (int kt = 0; kt <= nkt; ++kt) {
        const bool hasq = kt < nkt, hasn = kt + 1 < nkt;
        if (hasn) { rk = *(const u32x4*)(ksrc + (size_t)(kt + 1) * 64 * 64); rv0 = *(const u32x4*)(vsrc0 + (kt + 1) * 64); rv1 = *(const u32x4*)(vsrc1 + (kt + 1) * 64); }
        f32x16 s0 = negm, s1 = negm;
        if (hasq) { const LAS unsigned char* kb = F.lds + (kt & 1) * KB;
#pragma unroll
            for (int ks = 0; ks < 4; ++ks) {
                const bf16x8 a0 = *(const LAS bf16x8*)(kb + ka0 + ks * 32), a1 = *(const LAS bf16x8*)(kb + ka1 + ks * 32);
                s0 = __builtin_amdgcn_mfma_f32_32x32x16_bf16(a0, qf[ks], s0, 0, 0, 0);
                s1 = __builtin_amdgcn_mfma_f32_32x32x16_bf16(a1, qf[ks], s1, 0, 0, 0);
            } }
        if (kt > 0) { const LAS unsigned char* vb = F.lds + vprev;
#pragma unroll
            for (int blk = 0; blk < 4; ++blk)
#pragma unroll
                for (int kstep = 0; kstep < 4; ++kstep) {
                    const bf16x8 a = *(const LAS bf16x8*)(vb + va + blk * 32 * 144 + kstep * 32);
                    acc[blk] = __builtin_amdgcn_mfma_f32_32x32x16_bf16(a, pf[kstep], acc[blk], 0, 0, 0);
                } }
        if (hasq) {
            float mx = fmaxf(s0[0], s1[0]);
#pragma unroll
            for (int r = 1; r < 16; ++r) mx = fmaxf(mx, fmaxf(s0[r], s1[r]));
            { const auto rr = __builtin_amdgcn_permlane32_swap(__builtin_bit_cast(unsigned, mx), __builtin_bit_cast(unsigned, mx), false, false);
              mx = fmaxf(__builtin_bit_cast(float, rr[0]), __builtin_bit_cast(float, rr[1])); }
            if (__any(mx > 8.f)) {
                const float dl = fmaxf(mx, 0.f), f = __builtin_amdgcn_exp2f(-dl);
                m_run += dl; l_run *= f;
#pragma unroll
                for (int r = 0; r < 16; ++r) { s0[r] -= dl; s1[r] -= dl; negm[r] = -m_run; }
#pragma unroll
                for (int i = 0; i < 4; ++i)
#pragma unroll
                    for (int r = 0; r < 16; ++r) acc[i][r] *= f;
            }
            float ls = 0.f;
#pragma unroll
            for (int r = 0; r < 16; ++r) { s0[r] = __builtin_amdgcn_exp2f(s0[r]); s1[r] = __builtin_amdgcn_exp2f(s1[r]); ls += s0[r] + s1[r]; }
            l_run += ls;
            u32x4 w;
            w.x = cvtpk(s0[0], s0[1]); w.y = cvtpk(s0[2], s0[3]); w.z = cvtpk(s0[4], s0[5]); w.w = cvtpk(s0[6], s0[7]); pf[0] = __builtin_bit_cast(bf16x8, w);
            w.x = cvtpk(s0[8], s0[9]); w.y = cvtpk(s0[10], s0[11]); w.z = cvtpk(s0[12], s0[13]); w.w = cvtpk(s0[14], s0[15]); pf[1] = __builtin_bit_cast(bf16x8, w);
            w.x = cvtpk(s1[0], s1[1]); w.y = cvtpk(s1[2], s1[3]); w.z = cvtpk(s1[4], s1[5]); w.w = cvtpk(s1[6], s1[7]); pf[2] = __builtin_bit_cast(bf16x8, w);
            w.x = cvtpk(s1[8], s1[9]); w.y = cvtpk(s1[10], s1[11]); w.z = cvtpk(s1[12], s1[13]); w.w = cvtpk(s1[14], s1[15]); pf[3] = __builtin_bit_cast(bf16x8, w);
        }
        if (hasn) { LAS unsigned char* nk = F.lds + ((kt + 1) & 1) * KB; *(LAS u32x4*)(nk + kdst) = rk; *(LAS u32x4*)(F.lds + vnext + vdst0) = rv0; *(LAS u32x4*)(F.lds + vnext + vdst1) = rv1; }
        vprev = vcur; vcur = vnext; vnext = (vnext == 2 * VB) ? 0 : vnext + VB;
        WG_BAR();
    }
    const float inv = 1.f / (l_run + __shfl_xor(l_run, 32));
    bf16* orow = Op + (size_t)(F.wave * 32 + j) * 1024 + 4 * hh;
#pragma unroll
    for (int blk = 0; blk < 4; ++blk)
#pragma unroll
        for (int g = 0; g < 4; ++g) *(u32x2*)(orow + 32 * blk + 8 * g) = (u32x2){cvtpk(acc[blk][4 * g] * inv, acc[blk][4 * g + 1] * inv), cvtpk(acc[blk][4 * g + 2] * inv, acc[blk][4 * g + 3] * inv)};
}

__device__ __forceinline__ void attn_role(Ctx& F, int l) {
    const int bh = F.bx & 7, m = (F.bx >> 3) & 1, k = F.bx >> 4, b = bh >> 2, h = bh & 3;
    const bf16* QR = (const bf16*)(F.ws + WS_QR); const bf16* QC = (const bf16*)(F.ws + WS_QC); const bf16* KR = (const bf16*)(F.ws + WS_KR); const bf16* VT = (const bf16*)(F.ws + WS_VT);
    bf16* OATT = (bf16*)(F.ws + WS_XN);
    const bf16* Vtp = VT + (size_t)bh * 128 * KEYS;
    { const int bhm = bh * 2 + m;
      attn_unit(F, QR + ((size_t)bhm * TL + k * 256) * 64, KR + (size_t)bhm * KEYS * 64, Vtp, KEYS / 64, OATT + (size_t)(b * TL + k * 256) * 1024 + (h * 2 + m) * 128); }
    if (l == 0 && F.bx < 16) {
        const int mc = F.bx >> 3, bhm = bh * 2 + mc;
        attn_unit(F, QC + (size_t)bhm * CL * 64, KR + (size_t)bhm * KEYS * 64, Vtp, CL / 64, OATT + (size_t)(ML + b * CL) * 1024 + (h * 2 + mc) * 128);
    }
}

__device__ __forceinline__ void phase4(Ctx& F, int l) {
    const bf16* P = (const bf16*)(F.ws + WS_P); bf16* OC = (bf16*)(F.ws + WS_OC); const bf16* OATT = (const bf16*)(F.ws + WS_XN);
    const bf16* Yf = (const bf16*)(F.ws + WS_Y); const bf16* Yb = Yf + (size_t)MT * 512; const bf16* BON = (const bf16*)(F.ws + WS_BON);
    const float lam_init = 0.8f - 0.6f * expf(-0.3f * (float)l);
    const float d1 = wave_sum(F.prm->in[12][l * 64 + F.lane] * F.prm->in[13][l * 64 + F.lane]), d2 = wave_sum(F.prm->in[14][l * 64 + F.lane] * F.prm->in[15][l * 64 + F.lane]);
    const float lam = expf(d1) - expf(d2) + lam_init;
    const float* subg = F.prm->in[16] + l * 128; const float* ln_w = F.prm->in[25] + l * 512; const float* ln_b = F.prm->in[26] + l * 512;
    const int nrows = l == 0 ? MT : ML;
    for (int row = F.gw; row < nrows; row += F.NGW) {
        {
            const int h = F.lane >> 4, dv0 = (F.lane & 15) * 8; const bf16* o1 = OATT + (size_t)row * 1024 + h * 256 + dv0; const bf16* o2 = o1 + 128;
            float o[8], oa[8], ob[8]; unpack8(*(const u32x4*)o1, oa); unpack8(*(const u32x4*)o2, ob);
#pragma unroll
            for (int e = 0; e < 8; ++e) o[e] = oa[e] - lam * ob[e];
            float ss = 0.f;
#pragma unroll
            for (int e = 0; e < 8; ++e) ss += o[e] * o[e];
            const float rs = (1.f - lam_init) / sqrtf(red16(ss) * (1.f / 128.f) + EPS);
            float gg[8]; unpack8(*(const u32x4*)(P + (size_t)row * NINP + B_G + h * 128 + dv0), gg);
#pragma unroll
            for (int e = 0; e < 8; ++e) o[e] = o[e] * rs * subg[dv0 + e] * silu_f(gg[e]);
            *(u32x4*)(OC + (size_t)row * DM + 512 + h * 128 + dv0) = pack8(o);
        }
        {
            const int c0 = F.lane * 8; const bf16* yf = Yf + (size_t)row * 512 + c0; const bf16* yb = Yb + (size_t)row * 512 + c0; const bf16* bo = BON + (size_t)row * 512 + c0;
            float y[8], yq[8]; unpack8(*(const u32x4*)yf, y); unpack8(*(const u32x4*)yb, yq);
#pragma unroll
            for (int e = 0; e < 8; ++e) y[e] += yq[e];
            float s = 0.f;
#pragma unroll
            for (int e = 0; e < 8; ++e) s += y[e];
            const float mean = red8(s) * (1.f / 64.f); float q = 0.f;
#pragma unroll
            for (int e = 0; e < 8; ++e) { y[e] -= mean; q += y[e] * y[e]; }
            const float rstd = 1.f / sqrtf(red8(q) * (1.f / 64.f) + GN_EPS);
            float gg[8]; unpack8(*(const u32x4*)(P + (size_t)row * NINP + C_G + c0), gg);
            float bn[8], bn2[8]; unpack8(*(const u32x4*)bo, bn); unpack8(*(const u32x4*)(bo + (size_t)MT * 512), bn2);
#pragma unroll
            for (int e = 0; e < 8; ++e) bn[e] += bn2[e];
#pragma unroll
            for (int e = 0; e < 8; ++e) y[e] = (y[e] * rstd * ln_w[c0 + e] + ln_b[c0 + e] + bn[e]) * silu_f(gg[e]);
            *(u32x4*)(OC + (size_t)row * DM + 1024 + c0) = pack8(y);
        }
    }
}

#define XB_TMO      128
#define XB_XCNT(j)  (256  + 64 * (j))
#define XB_XSUB(j)  (1280 + 64 * (j))
#define XB_XGEN(j)  (2304 + 64 * (j))
#define XB_TOP      3328
#define XB_TOPGEN   3392
#define XCD_BAR_WORDS 3456
#define XB_SPIN_CAP (1u << 18)

__device__ __forceinline__ unsigned xb_ld(unsigned* p)              { return __hip_atomic_load(p, __ATOMIC_RELAXED, __HIP_MEMORY_SCOPE_AGENT); }
__device__ __forceinline__ unsigned xb_add(unsigned* p, unsigned v) { return __hip_atomic_fetch_add(p, v, __ATOMIC_RELAXED, __HIP_MEMORY_SCOPE_AGENT); }
__device__ __forceinline__ unsigned xb_xcc_id() { return (unsigned)__builtin_amdgcn_s_getreg((3 << 11) | 20) & 0xFu; }
#define XB_SPIN(cond, bar) do { unsigned _sp = 0; while (cond) { __builtin_amdgcn_s_sleep(1); \
    if ((++_sp & 255u) == 0u) { if (xb_ld(&(bar)[XB_TMO])) break; if (_sp > XB_SPIN_CAP) { atomicAdd(&(bar)[XB_TMO], 1u); break; } } } } while (0)

struct XcdBarrier {
    unsigned* bar; unsigned x;
    volatile LAS unsigned* st;
};

__device__ __forceinline__ XcdBarrier xcd_barrier_post(unsigned* bar, volatile LAS unsigned* st) {
    XcdBarrier b; b.bar = bar; b.x = xb_xcc_id(); b.st = st;
    if (threadIdx.x == 0) (void)xb_add(&bar[XB_XCNT(b.x)], 1u);
    return b;
}
__device__ __forceinline__ void xcd_barrier_complete(unsigned* bar, unsigned x, unsigned& nloc, unsigned& nx) {
    const unsigned G = gridDim.x * gridDim.y * gridDim.z;
    unsigned sum, cnt, mine, sp = 0u;
    for (;;) {
        sum = 0u; cnt = 0u; mine = 0u;
#pragma unroll
        for (unsigned j = 0; j < 16; ++j) { const unsigned c = xb_ld(&bar[XB_XCNT(j)]); sum += c; cnt += (c > 0u) ? 1u : 0u; mine = (j == x) ? c : mine; }
        if (sum == G) break;
        __builtin_amdgcn_s_sleep(1);
        if ((++sp & 255u) == 0u) { if (xb_ld(&bar[XB_TMO])) break; if (sp > XB_SPIN_CAP) { atomicAdd(&bar[XB_TMO], 1u); break; } }
    }
    nloc = mine > 0u ? mine : 1u; nx = cnt > 0u ? cnt : 1u;
}

__device__ __forceinline__ void xcd_barrier(const XcdBarrier& b) {
    asm volatile("s_waitcnt vmcnt(0)" ::: "memory");
    __syncthreads();
    if (threadIdx.x == 0) {
        unsigned* bar = b.bar;
        __builtin_amdgcn_s_waitcnt(0);
        unsigned nloc = b.st[0], nx = b.st[1];
        if (nloc == 0u) { xcd_barrier_complete(bar, b.x, nloc, nx); b.st[0] = nloc; b.st[1] = nx; }
        const unsigned old = xb_add(&bar[XB_XSUB(b.x)], 1u);
        const unsigned gen = old / nloc;
        if (old + 1u == (gen + 1u) * nloc) {
            __builtin_amdgcn_fence(__ATOMIC_RELEASE, "agent");
            asm volatile("s_waitcnt vmcnt(0)" ::: "memory");
            const unsigned og = xb_add(&bar[XB_TOP], 1u);
            const unsigned tg = og / nx;
            if (og + 1u == (tg + 1u) * nx) xb_add(&bar[XB_TOPGEN], 1u);
            else XB_SPIN(xb_ld(&bar[XB_TOPGEN]) == tg, bar);
            __builtin_amdgcn_fence(__ATOMIC_ACQUIRE, "agent");
            xb_add(&bar[XB_XGEN(b.x)], 1u);
            asm volatile("s_waitcnt vmcnt(0)" ::: "memory");
        } else {
            XB_SPIN(xb_ld(&bar[XB_XGEN(b.x)]) == gen, bar);
            __builtin_amdgcn_fence(__ATOMIC_ACQUIRE, "agent");
            asm volatile("s_waitcnt vmcnt(0)" ::: "memory");
        }
    }
    __syncthreads();
}

#ifndef R_P0T
#define R_P0T 1
#endif
#ifndef R_P1
#define R_P1 1
#endif
#ifndef R_P2
#define R_P2 1
#endif
#ifndef R_P3A
#define R_P3A 1
#endif
#ifndef R_SCAN
#define R_SCAN 1
#endif
#ifndef R_ATTN
#define R_ATTN 1
#endif
#ifndef R_P4
#define R_P4 1
#endif
#ifndef R_P5
#define R_P5 1
#endif
#ifndef R_BAR
#define R_BAR 1
#endif
__global__ void __launch_bounds__(NTHREADS, 2) fwd_kernel(Params prm) {
    extern __shared__ __attribute__((aligned(16))) unsigned char lds_raw[];
    cg::grid_group grid = cg::this_grid();
    Ctx F;
    F.prm = &prm; F.out = prm.out; F.ws = prm.ws; F.lds = (LAS unsigned char*)lds_raw;
    F.tid = threadIdx.x; F.lane = F.tid & 63; F.wave = __builtin_amdgcn_readfirstlane(F.tid >> 6); F.bx = blockIdx.x; F.G = gridDim.x;
    F.gw = F.bx * NWAVES + F.wave; F.NGW = F.G * NWAVES;
    volatile LAS unsigned* MISC = (volatile LAS unsigned*)(F.lds + LDS_BYTES - 256);
    if (F.tid < 4) MISC[F.tid] = 0u;
    __syncthreads();
    XcdBarrier bar = xcd_barrier_post((unsigned*)(F.ws + WS_CTL + 16384), MISC);
#ifdef TS_SEL
    unsigned long long ts_prev = 0, ts_dt = 0; int ts_n = 0;
#ifndef TS_BLK
#define TS_BLK 0
#endif
#ifdef TS_WORK
#define GRID_BAR() do { { const unsigned long long t_ = __builtin_amdgcn_s_memrealtime(); if (ts_n == TS_SEL) ts_dt = t_ - ts_prev; } xcd_barrier(bar); ts_prev = __builtin_amdgcn_s_memrealtime(); ++ts_n; } while (0)
#else
#define GRID_BAR() do { xcd_barrier(bar); { const unsigned long long t_ = __builtin_amdgcn_s_memrealtime(); if (ts_n == TS_SEL) ts_dt = t_ - ts_prev; ts_prev = t_; ++ts_n; } } while (0)
#endif
#else
#define GRID_BAR() do { for (int rb_ = 0; rb_ < R_BAR; ++rb_) xcd_barrier(bar); } while (0)
#endif

#ifndef NO_P0
    LAUNDER(F); phase0(F);
#endif
    if (prm.out == nullptr) grid.sync();
    GRID_BAR();
#ifdef TS_SEL
    ts_prev = __builtin_amdgcn_s_memrealtime();
#endif
#pragma unroll 1
    for (int l = 0; l < 2; ++l) {
#ifndef NO_P1
        for (int rp_ = 0; rp_ < R_P1; ++rp_) { LAUNDER(F); phase1(F, l); }
#endif
        GRID_BAR();
#ifndef NO_P2
        for (int rp_ = 0; rp_ < R_P2; ++rp_) {
            pg8::Gemm g{(const pg8::bf16_t*)(F.ws + WS_XN), (const pg8::bf16_t*)(F.ws + WS_WIN) + (size_t)l * NINP * DM, MT, NINP, DM, DM};
            pg8::EpiBf16 E{(pg8::bf16_t*)(F.ws + WS_P), NINP, nullptr, 0, 0, 1.f};
            if (l == 0) { pg8::StaticOrder S; S.init(MT, NINP, F.G, F.bx); pg8::gemm_phase<pg8::EpiBf16, pg8::StaticOrder, true, true>(F.lds, g, S, E); }
            else { pg8::CtxSparseOrder S; S.init(ML, MC, NINP, F.G, F.bx); pg8::gemm_phase<pg8::EpiBf16, pg8::CtxSparseOrder, true, true>(F.lds, g, S, E); }
        }
#endif
        GRID_BAR();
#ifndef NO_P3A
        { LAUNDER(F); phase3a(F, l); }
        GRID_BAR();
        { LAUNDER(F); phase3b1(F, l); }
        GRID_BAR();
        { LAUNDER(F); phase3b(F, l); }
        GRID_BAR();
        for (int rp_ = 0; rp_ < R_ATTN; ++rp_) { LAUNDER(F); attn_role(F, l); }
        GRID_BAR();
        for (int rp_ = 0; rp_ < R_P4; ++rp_) { LAUNDER(F); phase4(F, l); }
#endif
        GRID_BAR();
#ifndef NO_P5
        for (int rp_ = 0; rp_ < R_P5; ++rp_) {
            const int rows = l == 0 ? MT : ML;
            pg8::Gemm g{(const pg8::bf16_t*)(F.ws + WS_OC), (const pg8::bf16_t*)(F.ws + WS_WOUT) + (size_t)l * DM * DM, rows, DM, DM, DM};
            pg8::StaticOrder S; S.init(rows, DM, F.G, F.bx);
            pg8::EpiF32 E{(float*)(F.ws + WS_P), DM};
            pg8::gemm_phase<pg8::EpiF32, pg8::StaticOrder, true, true>(F.lds, g, S, E);
        }
#endif
        GRID_BAR();
    }
#ifndef NO_P6
    LAUNDER(F); phase6(F);
#endif
#ifdef TS_SEL
    GRID_BAR();
    if (F.bx == TS_BLK && F.wave == 0) { float v = F.out[F.lane]; float a = fabsf(v); float m = a;
        for (int o = 1; o < 64; o <<= 1) m = fminf(m, __shfl_xor(m, o));
        const unsigned long long bal = __ballot(a == m); const int win = __ffsll((long long)bal) - 1;
#ifdef TS_R2
        ts_dt = ((volatile unsigned*)(F.ws + WS_CTL))[2048 + TS_R2];
#endif
        if (F.lane == win) F.out[F.lane] = v + 0.04f + (float)ts_dt * 0.01f * TS_SCALE; }
#endif
}

extern "C" void kernel_launch(void* const* d_in, const int* in_sizes, int n_in, void* d_out, int out_size, void* d_ws, size_t ws_size, hipStream_t stream) {
    static int grid = 0;
    if (grid == 0) {
        if (n_in != 28 || out_size != ML * DM || ws_size < WS_END) { fprintf(stderr, "kernel_launch: unexpected shapes: n_in %d out %d ws %zu (need %zu)\n", n_in, out_size, ws_size, (size_t)WS_END); grid = -1; return; }
        int dev = 0, cus = 0, per_cu = 0;
        if (hipGetDevice(&dev) != hipSuccess || hipDeviceGetAttribute(&cus, hipDeviceAttributeMultiprocessorCount, dev) != hipSuccess) { grid = -1; return; }
        if (hipFuncSetAttribute((const void*)fwd_kernel, hipFuncAttributeMaxDynamicSharedMemorySize, LDS_BYTES) != hipSuccess) { fprintf(stderr, "kernel_launch: hipFuncSetAttribute failed\n"); grid = -1; return; }
        if (hipOccupancyMaxActiveBlocksPerMultiprocessor(&per_cu, (const void*)fwd_kernel, NTHREADS, LDS_BYTES) != hipSuccess || per_cu < 1) { fprintf(stderr, "kernel_launch: occupancy query says %d blocks per CU\n", per_cu); grid = -1; return; }
        (void)hipGetLastError();
        grid = cus;
        if (grid != 256) { fprintf(stderr, "kernel_launch: expected 256 CUs, got %d\n", cus); grid = -1; return; }
    }
    if (grid < 0) return;
    if (hipMemsetAsync((char*)d_ws + WS_CTL, 0, CTL_ZERO_BYTES, stream) != hipSuccess) { fprintf(stderr, "kernel_launch: memset failed\n"); return; }
    Params p{};
    for (int i = 0; i < 28; ++i) p.in[i] = (const float*)d_in[i];
    p.out = (float*)d_out; p.ws = (unsigned char*)d_ws;
    void* args[] = {&p};
    hipError_t e = hipLaunchCooperativeKernel((void*)fwd_kernel, dim3(grid), dim3(NTHREADS), args, LDS_BYTES, stream);
    if (e != hipSuccess) fprintf(stderr, "cooperative launch failed: %s (grid %d)\n", hipGetErrorString(e), grid);
}
```

```cpp
#include <hip/hip_runtime.h>
#include <hip/hip_cooperative_groups.h>
#include <cstdio>
#include <cstdint>
namespace cg = cooperative_groups;
namespace pg8 {
#define PG8_LAS __attribute__((address_space(3)))
typedef unsigned short bf16_t;
typedef short bf16x8 __attribute__((ext_vector_type(8)));
typedef float f32x4 __attribute__((ext_vector_type(4)));
typedef unsigned u32x4 __attribute__((ext_vector_type(4)));
constexpr int BM = 256, BK = 64, HALF = 128, HTB = HALF * BK * 2  , STAGE_BYTES = 8 * HTB, NXCD = 8, WGM = 8;

__host__ __device__ __forceinline__ int lds_byte(int r, int c) { const int st = (r >> 4) * 2 + (c >> 5), rr = r & 15, cc = c & 31, ob = rr * 64 + cc * 2; return st * 1024 + (ob ^ (((ob >> 9) & 1) << 5)); }
__host__ __device__ __forceinline__ void stage_rc(int b, int& R, int& C) { const int st = b / 1024, sb = b % 1024, swz = sb ^ (((sb >> 9) & 1) << 5); R = (st >> 1) * 16 + swz / 64; C = (st & 1) * 32 + (swz % 64) / 2; }
__host__ __device__ __forceinline__ int perm32(int rho) { const int n = rho >> 4, i = rho & 15; return 8 * (i >> 2) + 4 * n + (i & 3); }

struct Unit { int pm, pn; };
struct Gemm { const bf16_t* A; const bf16_t* Bt; int M, N, K, ld; };

struct StaticOrder {
    int nM, nN, nwg, G, c;
    __host__ __device__ void init(int M, int N, int G_, int c_) { nM = M / BM; nN = N / BM; nwg = nM * nN; G = G_; c = c_; }
    __host__ __device__ bool next(int i, Unit& u) const {
        const long L = (long)i * G + c; if (L >= nwg) return false;
        int wgid = (int)L; { const int q = nwg / NXCD, r = nwg % NXCD, xcd = wgid % NXCD, off = wgid / NXCD; wgid = (xcd < r ? xcd * (q + 1) : r * (q + 1) + (xcd - r) * q) + off; }
        const int nig = WGM * nN, gid = wgid / nig, fm = gid * WGM, gsz = (nM - fm) < WGM ? (nM - fm) : WGM;
        u.pm = fm + ((wgid % nig) % gsz); u.pn = (wgid % nig) / gsz; return true;
    }
    __device__ __forceinline__ void a_ready(const Unit&) const {}
    __device__ __forceinline__ void done(const Unit&) const {}
};


struct CtxSparseOrder {
    StaticOrder base; int nMl, nctx, G, c;
    __host__ __device__ void init(int Mlat, int Mctx, int N, int G_, int c_) { base.init(Mlat, N, G_, c_); nMl = Mlat / BM; nctx = (Mctx / BM) * 11; G = G_; c = c_; }
    __host__ __device__ bool next(int i, Unit& u) const {
        if (base.next(i, u)) return true;
        const long L = (long)i * G + c - base.nwg; if (L < 0 || L >= nctx) return false;
        const int k = (int)L % 11; u.pm = nMl + (int)L / 11; u.pn = k < 4 ? 8 + k : 10 + k; return true;
    }
    __device__ __forceinline__ void a_ready(const Unit&) const {}
    __device__ __forceinline__ void done(const Unit&) const {}
};


struct OneUnit {
    int pm, pn; bool has;
    __host__ __device__ bool next(int i, Unit& u) const { if (i > 0 || !has) return false; u.pm = pm; u.pn = pn; return true; }
    __device__ __forceinline__ void a_ready(const Unit&) const {}
    __device__ __forceinline__ void done(const Unit&) const {}
};

__device__ __forceinline__ unsigned cvt_pk_bf16(float lo, float hi) { unsigned r; asm volatile("v_cvt_pk_bf16_f32 %0, %1, %2" : "=v"(r) : "v"(lo), "v"(hi)); return r; }
struct EpiBf16 {
    static constexpr bool PERM = true, AFTER_DRAIN = false;
    bf16_t* O; int ldc; const float* bias; int split_cols; size_t split_stride; float scale0;
    __device__ __forceinline__ void operator()(const f32x4 (&acc)[2][2][4][2], const Unit& u, int wr, int wc, int fr, int fq) const {
        const int row0 = u.pm * BM + wr * 64 + fr; int colt = u.pn * BM; bf16_t* base = O;
        float sc = 1.f; if (split_cols) { const int t = colt / split_cols; base += (size_t)t * split_stride; colt -= t * split_cols; if (t == 0) sc = scale0; }
        const int col0 = colt + wc * 32 + 8 * fq, bcol0 = u.pn * BM + wc * 32 + 8 * fq;
        f32x4 bv[2][2];
#pragma unroll
        for (int bj = 0; bj < 2; ++bj)
#pragma unroll
            for (int n = 0; n < 2; ++n) bv[bj][n] = bias ? *(const f32x4*)(bias + bcol0 + bj * HALF + 4 * n) : (f32x4){0.f, 0.f, 0.f, 0.f};
#pragma unroll
        for (int ai = 0; ai < 2; ++ai)
#pragma unroll
            for (int m = 0; m < 4; ++m) { bf16_t* rowp = base + (size_t)(row0 + ai * HALF + m * 16) * ldc + col0;
#pragma unroll
                for (int bj = 0; bj < 2; ++bj) { f32x4 v0 = acc[ai][bj][m][0] + bv[bj][0], v1 = acc[ai][bj][m][1] + bv[bj][1];
                    v0 = v0 * sc; v1 = v1 * sc; u32x4 w; w.x = cvt_pk_bf16(v0[0], v0[1]); w.y = cvt_pk_bf16(v0[2], v0[3]); w.z = cvt_pk_bf16(v1[0], v1[1]); w.w = cvt_pk_bf16(v1[2], v1[3]);
                    *(u32x4*)(rowp + bj * HALF) = w; } }
    }
};
struct EpiF32 {
    static constexpr bool PERM = false, AFTER_DRAIN = false;
    float* O; int ldc;
    __device__ __forceinline__ void operator()(const f32x4 (&acc)[2][2][4][2], const Unit& u, int wr, int wc, int fr, int fq) const {
        const int col0 = u.pn * BM + wc * 32 + 4 * fq;
#pragma unroll
        for (int ai = 0; ai < 2; ++ai)
#pragma unroll
            for (int m = 0; m < 4; ++m) { float* rowp = O + (size_t)(u.pm * BM + ai * HALF + wr * 64 + m * 16 + fr) * ldc + col0;
#pragma unroll
                for (int bj = 0; bj < 2; ++bj)
#pragma unroll
                    for (int n = 0; n < 2; ++n) *(f32x4*)(rowp + bj * HALF + n * 16) = acc[ai][bj][m][n]; }
    }
};
template <class Epi, class Sched, bool ALIGN_EPI = false, bool SP2 = false>
__device__ __forceinline__ void gemm_phase(PG8_LAS unsigned char* lds, const Gemm g, const Sched& S, const Epi& E) {
    int tid_ = threadIdx.x; asm volatile("" : "+v"(tid_));
    const int tid = tid_, wid = __builtin_amdgcn_readfirstlane(tid >> 6), lane = tid & 63, wr = wid >> 2, wc = wid & 3, fr = lane & 15, fq = lane >> 4;
    const int K = g.ld, nt = g.K / BK;
    unsigned voffA[2], voffB[2];
#pragma unroll
    for (int i = 0; i < 2; ++i) { int R, C; stage_rc(tid * 16 + i * 8192, R, C); const int Rb = Epi::PERM ? ((R & ~31) + perm32(R & 31)) : R;
        voffA[i] = (unsigned)(R * K + C) * 2u; voffB[i] = (unsigned)(Rb * K + C) * 2u; }
    const size_t kstep = (size_t)(BK * 2);
    const size_t hstep = (size_t)HALF * K * 2;
    const size_t tstep = 2 * hstep;
    const unsigned ldsw = (unsigned)wid * 1024u;
    const int aoff = lds_byte(wr * 64 + fr, fq * 8), boff = lds_byte(wc * 32 + fr, fq * 8);
#define PG8_SA(b, h) (((b) * 2 + (h)) * HTB)
#define PG8_SB(b, h) ((4 + (b) * 2 + (h)) * HTB)
#define PG8_STAGE(bufoff, gbase, voff) do { _Pragma("unroll") for (int _i = 0; _i < 2; ++_i) \
        __builtin_amdgcn_global_load_lds((const unsigned*)((const char*)(gbase) + (voff)[_i]), (PG8_LAS unsigned*)(lds + (bufoff) + ldsw + _i * 8192), 16, 0, 0); } while (0)
#define PG8_LDA(dst, b, h) do { _Pragma("unroll") for (int m = 0; m < 4; ++m) _Pragma("unroll") for (int k = 0; k < 2; ++k) dst[m][k] = *(const PG8_LAS bf16x8*)(lds + PG8_SA(b, h) + aoff + m * 2048 + k * 1024); } while (0)
#define PG8_LDB(dst, b, h) do { _Pragma("unroll") for (int n = 0; n < 2; ++n) _Pragma("unroll") for (int k = 0; k < 2; ++k) dst[n][k] = *(const PG8_LAS bf16x8*)(lds + PG8_SB(b, h) + boff + n * 2048 + k * 1024); } while (0)
#define PG8_MMA(ai, bj, At, Bt) do { __builtin_amdgcn_s_setprio(1); _Pragma("unroll") for (int m = 0; m < 4; ++m) _Pragma("unroll") for (int n = 0; n < 2; ++n) _Pragma("unroll") for (int k = 0; k < 2; ++k) \
        acc[ai][bj][m][n] = __builtin_amdgcn_mfma_f32_16x16x32_bf16(Bt[n][k], At[m][k], acc[ai][bj][m][n], 0, 0, 0); __builtin_amdgcn_s_setprio(0); } while (0)
#define PG8_WAIT_V(n) asm volatile("s_waitcnt vmcnt(" #n ")" ::: "memory")
#define PG8_WAIT_L(n) asm volatile("s_waitcnt lgkmcnt(" #n ")" ::: "memory")
#define PG8_BAR __builtin_amdgcn_s_barrier()
#define PG8_SCHED __builtin_amdgcn_sched_barrier(0)
    Unit cur, nxt; int ui = 0;
    if (!S.next(0, cur)) return;
    f32x4 acc[2][2][4][2];
#pragma unroll
    for (int a = 0; a < 2; ++a)
#pragma unroll
        for (int b = 0; b < 2; ++b)
#pragma unroll
            for (int m = 0; m < 4; ++m)
#pragma unroll
                for (int n = 0; n < 2; ++n) acc[a][b][m][n] = (f32x4){0.f, 0.f, 0.f, 0.f};
    bf16x8 At[4][2], B0[2][2], B1[2][2];
    const char* cA = (const char*)g.A + (size_t)cur.pm * tstep; const char* cB = (const char*)g.Bt + (size_t)cur.pn * tstep;
    S.a_ready(cur);
    if constexpr (SP2) {
        PG8_STAGE(PG8_SB(0, 0), cB, voffB); PG8_STAGE(PG8_SB(0, 1), cB + hstep, voffB); PG8_STAGE(PG8_SA(0, 0), cA, voffA); PG8_STAGE(PG8_SA(0, 1), cA + hstep, voffA);
        if (wr == 1) PG8_BAR;
        PG8_WAIT_V(2); PG8_BAR;
        PG8_STAGE(PG8_SB(1, 0), cB + kstep, voffB); PG8_STAGE(PG8_SA(1, 0), cA + kstep, voffA); PG8_STAGE(PG8_SB(1, 1), cB + hstep + kstep, voffB);
        PG8_WAIT_V(6); PG8_BAR;
    } else {
        PG8_STAGE(PG8_SB(0, 0), cB, voffB); PG8_STAGE(PG8_SA(0, 0), cA, voffA); PG8_STAGE(PG8_SB(0, 1), cB + hstep, voffB); PG8_STAGE(PG8_SA(0, 1), cA + hstep, voffA);
        if (wr == 1) PG8_BAR;
        PG8_WAIT_V(4); PG8_BAR;
        PG8_STAGE(PG8_SB(1, 0), cB + kstep, voffB); PG8_STAGE(PG8_SA(1, 0), cA + kstep, voffA); PG8_STAGE(PG8_SB(1, 1), cB + hstep + kstep, voffB);
        PG8_WAIT_V(6); PG8_BAR;
    }
    for (;;) {
        const bool has_next = S.next(ui + 1, nxt);
        const char* nA = has_next ? (const char*)g.A + (size_t)nxt.pm * tstep : cA; const char* nB = has_next ? (const char*)g.Bt + (size_t)nxt.pn * tstep : cB;
        for (int t = 0; t < nt; t += 2) {
            const bool last = (t == nt - 2);
            const char* a1 = cA + (size_t)(t + 1) * kstep;
            const char* a2 = last ? nA : cA + (size_t)(t + 2) * kstep; const char* b2 = last ? nB : cB + (size_t)(t + 2) * kstep;
            const char* a3 = a2 + kstep; const char* b3 = b2 + kstep;
            if (last && has_next) S.a_ready(nxt);
            if constexpr (SP2) {
            PG8_LDB(B0, 0, 0); PG8_LDB(B1, 0, 1); PG8_SCHED; PG8_LDA(At, 0, 0); PG8_STAGE(PG8_SA(1, 1), a1 + hstep, voffA);
            PG8_WAIT_V(8); PG8_WAIT_L(0); PG8_BAR; PG8_MMA(0, 0, At, B0); PG8_MMA(0, 1, At, B1); PG8_BAR; PG8_SCHED;
            PG8_LDA(At, 0, 1); PG8_STAGE(PG8_SB(0, 0), b2, voffB); PG8_STAGE(PG8_SB(0, 1), b2 + hstep, voffB); PG8_STAGE(PG8_SA(0, 0), a2, voffA);
            PG8_WAIT_V(8); PG8_WAIT_L(0); PG8_BAR; PG8_MMA(1, 0, At, B0); PG8_MMA(1, 1, At, B1); PG8_BAR; PG8_SCHED;
            PG8_LDB(B0, 1, 0); PG8_LDB(B1, 1, 1); PG8_SCHED; PG8_LDA(At, 1, 0); PG8_STAGE(PG8_SA(0, 1), a2 + hstep, voffA);
            PG8_WAIT_V(8); PG8_WAIT_L(0); PG8_BAR; PG8_MMA(0, 0, At, B0); PG8_MMA(0, 1, At, B1); PG8_BAR; PG8_SCHED;
            PG8_LDA(At, 1, 1); PG8_STAGE(PG8_SB(1, 0), b3, voffB); PG8_STAGE(PG8_SB(1, 1), b3 + hstep, voffB); PG8_STAGE(PG8_SA(1, 0), a3, voffA);
            PG8_WAIT_V(8); PG8_WAIT_L(0); PG8_BAR; PG8_MMA(1, 0, At, B0); PG8_MMA(1, 1, At, B1); PG8_BAR; PG8_SCHED;
            } else {
            PG8_LDB(B0, 0, 0); PG8_SCHED; PG8_LDA(At, 0, 0); PG8_STAGE(PG8_SA(1, 1), a1 + hstep, voffA);
            PG8_WAIT_L(8); PG8_BAR; PG8_WAIT_L(0); PG8_MMA(0, 0, At, B0); PG8_BAR; PG8_SCHED;
            PG8_LDB(B1, 0, 1); PG8_STAGE(PG8_SB(0, 0), b2, voffB);
            PG8_BAR; PG8_WAIT_L(0); PG8_MMA(0, 1, At, B1); PG8_BAR;
            PG8_LDA(At, 0, 1); PG8_STAGE(PG8_SA(0, 0), a2, voffA);
            PG8_BAR; PG8_WAIT_L(0); PG8_MMA(1, 0, At, B0); PG8_BAR; PG8_SCHED;
            PG8_STAGE(PG8_SB(0, 1), b2 + hstep, voffB);
            PG8_WAIT_V(6); PG8_BAR; PG8_MMA(1, 1, At, B1); PG8_BAR;
            PG8_LDB(B0, 1, 0); PG8_SCHED; PG8_LDA(At, 1, 0); PG8_STAGE(PG8_SA(0, 1), a2 + hstep, voffA);
            PG8_WAIT_L(8); PG8_BAR; PG8_WAIT_L(0); PG8_MMA(0, 0, At, B0); PG8_BAR; PG8_SCHED;
            PG8_LDB(B1, 1, 1); PG8_STAGE(PG8_SB(1, 0), b3, voffB);
            PG8_BAR; PG8_WAIT_L(0); PG8_MMA(0, 1, At, B1); PG8_BAR;
            PG8_LDA(At, 1, 1); PG8_STAGE(PG8_SA(1, 0), a3, voffA);
            PG8_BAR; PG8_WAIT_L(0); PG8_MMA(1, 0, At, B0); PG8_BAR; PG8_SCHED;
            PG8_STAGE(PG8_SB(1, 1), b3 + hstep, voffB);
            PG8_WAIT_V(6); PG8_BAR; PG8_MMA(1, 1, At, B1); PG8_BAR;
            }
        }
        if constexpr (ALIGN_EPI) { if (wr == 0) PG8_BAR; }
        if constexpr (!Epi::AFTER_DRAIN) { E(acc, cur, wr, wc, fr, fq); S.done(cur); }
        if (!has_next) break;
#pragma unroll
        for (int a = 0; a < 2; ++a)
#pragma unroll
            for (int b = 0; b < 2; ++b)
#pragma unroll
                for (int m = 0; m < 4; ++m)
#pragma unroll
                    for (int n = 0; n < 2; ++n) acc[a][b][m][n] = (f32x4){0.f, 0.f, 0.f, 0.f};
        cur = nxt; cA = nA; cB = nB; ++ui;
        if constexpr (ALIGN_EPI) { if (wr == 1) PG8_BAR; }
    }
    PG8_WAIT_V(0);
    if constexpr (!ALIGN_EPI) { if (wr == 0) PG8_BAR; }
    PG8_BAR;
    if constexpr (Epi::AFTER_DRAIN) { E.fused(acc, cur, wr, wc, fr, fq, lds, wid, lane); S.done(cur); }
#undef PG8_SA
#undef PG8_SB
#undef PG8_STAGE
#undef PG8_LDA
#undef PG8_LDB
#undef PG8_MMA
#undef PG8_WAIT_V
#undef PG8_WAIT_L
#undef PG8_BAR
#undef PG8_SCHED
}
}

constexpr int NB = 2, TL = 4096, DM = 2048, CL = 256, NIN = 7872, NINP = 7936;
constexpr int ML = NB * TL, MC = NB * CL, MT = ML + MC;
constexpr int KEYS = CL + TL;
constexpr int NSTEP = KEYS;
constexpr int A_U = 0, A_V = 512, A_G = 1024, B_Q = 1536, B_K = 2048, B_V = 2560, B_G = 3072, C_R = 3584, C_K = 4096, C_V = 4608, C_LF = 5120, C_LB = 5216, C_G = 5312,
              D_B = 5824, D_C = 6336, D_X = 6848, D_G = 7360;
constexpr float EPS = 1e-6f, GN_EPS = 64e-5f;
constexpr float QSCALE = 0.125f * 1.4426950408889634f;

constexpr size_t MiB = 1u << 20;
constexpr size_t WS_CTL = 0, CTL_ZERO_BYTES = 1 * MiB;
constexpr size_t CTL_MODACC = 65536;
constexpr size_t WS_ROPE = 1 * MiB - 16384;
constexpr size_t WS_WIN = 1 * MiB;
constexpr size_t WS_WOUT = 63 * MiB;
constexpr size_t WS_XN = 79 * MiB;
constexpr size_t WS_P = 113 * MiB;
constexpr size_t WS_QR = 245 * MiB;
constexpr size_t WS_QC = 253 * MiB;
constexpr size_t WS_KR = 254 * MiB;
constexpr size_t WS_VT = 263 * MiB;
constexpr size_t WS_CHK = 272 * MiB;
constexpr size_t WS_Y = 402 * MiB;
constexpr size_t WS_BON = 436 * MiB;
constexpr size_t WS_OC = 453 * MiB;
constexpr size_t WS_LW = 487 * MiB;
constexpr size_t WS_SST = 488 * MiB;
constexpr size_t WS_END = 489 * MiB;
static_assert(WS_WIN + (size_t)2 * NINP * DM * 2 <= WS_WOUT && WS_WOUT + (size_t)2 * DM * DM * 2 <= WS_XN && WS_XN + (size_t)MT * DM * 2 <= WS_P && WS_P + (size_t)MT * NINP * 2 <= WS_QR, "ws map 1");
static_assert(WS_QR + (size_t)16 * TL * 64 * 2 <= WS_QC && WS_QC + (size_t)16 * CL * 64 * 2 <= WS_KR && WS_KR + (size_t)16 * KEYS * 64 * 2 <= WS_VT && WS_VT + (size_t)8 * 128 * KEYS * 2 <= WS_CHK, "ws map 2");
static_assert(WS_Y + (size_t)2 * MT * 512 * 4 <= WS_BON && WS_BON + (size_t)2 * MT * 512 * 2 <= WS_OC && WS_OC + (size_t)MT * DM * 2 <= WS_END, "ws map 3");
static_assert((size_t)MT * 1024 * 4 <= WS_P - WS_XN && (size_t)MT * DM * 4 <= WS_QR - WS_P, "overlays");

constexpr int LDS_BYTES = 147456;
constexpr int NWAVES = 8, NTHREADS = 512;

typedef unsigned short bf16;
typedef short bf16x8 __attribute__((ext_vector_type(8)));
typedef float f32x4 __attribute__((ext_vector_type(4)));
typedef float f32x2 __attribute__((ext_vector_type(2)));
typedef float f32x16 __attribute__((ext_vector_type(16)));
typedef unsigned u32x4 __attribute__((ext_vector_type(4)));
typedef unsigned u32x2 __attribute__((ext_vector_type(2)));
typedef __bf16 bf16x2_t __attribute__((ext_vector_type(2)));
#define LAS __attribute__((address_space(3)))

struct Params { const float* in[28]; float* out; unsigned char* ws; };

struct Ctx {
    const Params* prm; float* out; unsigned char* ws;
    LAS unsigned char* lds;
    int tid, lane, wave, bx, G, gw, NGW;
};

__device__ __forceinline__ unsigned cvtpk(float lo, float hi) { f32x2 v = {lo, hi}; bf16x2_t b = __builtin_convertvector(v, bf16x2_t); return __builtin_bit_cast(unsigned, b); }
__device__ __forceinline__ float bflo(unsigned u) { return __builtin_bit_cast(float, u << 16); }
__device__ __forceinline__ float bfhi(unsigned u) { return __builtin_bit_cast(float, u & 0xffff0000u); }
__device__ __forceinline__ void unpack8(const u32x4 v, float* f) { f[0] = bflo(v.x); f[1] = bfhi(v.x); f[2] = bflo(v.y); f[3] = bfhi(v.y); f[4] = bflo(v.z); f[5] = bfhi(v.z); f[6] = bflo(v.w); f[7] = bfhi(v.w); }
__device__ __forceinline__ u32x4 pack8(const float* f) { u32x4 r; r.x = cvtpk(f[0], f[1]); r.y = cvtpk(f[2], f[3]); r.z = cvtpk(f[4], f[5]); r.w = cvtpk(f[6], f[7]); return r; }
__device__ __forceinline__ float silu_f(float x) { return x * __builtin_amdgcn_rcpf(1.f + __expf(-x)); }
__device__ __forceinline__ float wave_sum(float v) {
#pragma unroll
    for (int o = 1; o < 64; o <<= 1) v += __shfl_xor(v, o);
    return v;
}
template <int CTRL> __device__ __forceinline__ float dpp_f(float v) { return __builtin_bit_cast(float, __builtin_amdgcn_update_dpp(0, __builtin_bit_cast(int, v), CTRL, 0xf, 0xf, true)); }
__device__ __forceinline__ float red4(float v) { v += dpp_f<0xB1>(v); v += dpp_f<0x4E>(v); return v; }
__device__ __forceinline__ float red8(float v) { v = red4(v); v += dpp_f<0x141>(v); return v; }
__device__ __forceinline__ float red16(float v) { v = red8(v); v += dpp_f<0x140>(v); return v; }
#define LAUNDER(F) do { asm volatile("" : "+v"(F.tid), "+v"(F.lane)); asm volatile("" : "+s"(F.wave), "+s"(F.bx), "+s"(F.gw)); } while (0)
__device__ __forceinline__ f32x16 zero16() { f32x16 z;
#pragma unroll
    for (int r = 0; r < 16; ++r) z[r] = 0.f;
    return z; }
#define MROW(reg, hh) (((reg) & 3) + 8 * ((reg) >> 2) + 4 * (hh))
#define LDS_WAIT() asm volatile("s_waitcnt lgkmcnt(0)" ::: "memory")
#define WG_BAR() do { asm volatile("s_waitcnt lgkmcnt(0)" ::: "memory"); __builtin_amdgcn_s_barrier(); asm volatile("" ::: "memory"); } while (0)

#ifndef R_P0T
#define R_P0T 1
#endif
__device__ __forceinline__ void p0_transpose_item(const float* W, int K, int N, bf16* WT, LAS float* scr, int item, int lane) {
    const int nblk = N / 64, kb = item / nblk, nb = item % nblk, k0 = 64 * kb, n0 = 64 * nb;
#pragma unroll 8
    for (int i = 0; i < 16; ++i) { const int kk = 4 * i + (lane >> 4), n4 = lane & 15; const f32x4 w = *(const f32x4*)(W + (size_t)(k0 + kk) * N + n0 + 4 * n4);
        LAS float* d = scr + kk * 65 + 4 * n4; d[0] = w.x; d[1] = w.y; d[2] = w.z; d[3] = w.w; }
    LDS_WAIT();
    const int c = lane & 7;
#pragma unroll
    for (int j = 0; j < 8; ++j) { const int n = (lane >> 3) + 8 * j; const LAS float* s = scr + (8 * c) * 65 + n;
        u32x4 o; o.x = cvtpk(s[0 * 65], s[1 * 65]); o.y = cvtpk(s[2 * 65], s[3 * 65]); o.z = cvtpk(s[4 * 65], s[5 * 65]); o.w = cvtpk(s[6 * 65], s[7 * 65]);
        *(u32x4*)(WT + (size_t)(n0 + n) * K + k0 + 8 * c) = o; }
    LDS_WAIT();
}

__device__ __forceinline__ void p0_weights(Ctx& F, int l, int widx, int nw) {
    LAS float* scr = (LAS float*)(F.lds + F.wave * 16896);
    const float* w_in = F.prm->in[8] + (size_t)l * DM * NIN; const float* w_out = F.prm->in[9] + (size_t)l * DM * DM;
    bf16* WIN = (bf16*)(F.ws + WS_WIN) + (size_t)l * NINP * DM; bf16* WOUT = (bf16*)(F.ws + WS_WOUT) + (size_t)l * DM * DM;
    constexpr int I_IN = (DM / 64) * (NIN / 64), I_OUT = (DM / 64) * (DM / 64);
    for (int it = widx; it < I_IN + I_OUT; it += nw) {
        if (it < I_IN) p0_transpose_item(w_in, DM, NIN, WIN, scr, it, F.lane);
        else p0_transpose_item(w_out, DM, DM, WOUT, scr, it - I_IN, F.lane);
    }
    const float* cvec = F.prm->in[1]; const float* cctx = F.prm->in[3]; const float* w_mod = F.prm->in[4];
    float* MODACC = (float*)(F.ws + WS_CTL + CTL_MODACC);
    for (int it = widx; it < 32 * 24; it += nw) {
        const int ks = it / 24, cb = it % 24, k0 = ks * 64, n0 = cb * 256 + 4 * F.lane;
        scr[F.lane] = silu_f(cvec[k0 + F.lane]); scr[64 + F.lane] = silu_f(cvec[DM + k0 + F.lane]); scr[128 + F.lane] = silu_f(cctx[k0 + F.lane]);
        LDS_WAIT();
        f32x4 a0 = {0.f, 0.f, 0.f, 0.f}, a1 = a0, a2 = a0;
        const float* wp = w_mod + ((size_t)l * DM + k0) * 6144 + n0;
#pragma unroll 8
        for (int k = 0; k < 64; ++k) { const f32x4 w = *(const f32x4*)(wp + (size_t)k * 6144); a0 += w * scr[k]; a1 += w * scr[64 + k]; a2 += w * scr[128 + k]; }
        float* ma = MODACC + (size_t)(l * 3) * 6144 + n0;
#pragma unroll
        for (int e = 0; e < 4; ++e) { atomicAdd(ma + e, a0[e]); atomicAdd(ma + 6144 + e, a1[e]); atomicAdd(ma + 2 * 6144 + e, a2[e]); }
        LDS_WAIT();
    }
}
__device__ __forceinline__ void phase0(Ctx& F) {
    p0_weights(F, 0, F.gw, F.NGW); p0_weights(F, 1, F.gw, F.NGW);
    {   const float* w2a = F.prm->in[19]; const float* a2a = F.prm->in[21]; bf16* LW = (bf16*)(F.ws + WS_LW);
        const int gt = F.bx * NTHREADS + F.tid, GT = F.G * NTHREADS;
        for (int idx = gt; idx < 4 * 512 * 64; idx += GT) { const int pd = idx / (512 * 64), rem = idx % (512 * 64), k = rem >> 9, chg = rem & 511, hq = chg >> 6, ch = chg & 63;
            const float v = w2a[((size_t)pd * 64 + k) * 512 + chg]; const unsigned hi = cvtpk(v, 0.f) & 0xffffu; const float lo = v - bflo(hi);
            bf16* base = LW + (size_t)(pd * 8 + hq) * 12288; base[ch * 64 + k] = (bf16)hi; base[4096 + ch * 64 + k] = (bf16)(cvtpk(lo, 0.f) & 0xffffu); }
        for (int idx = gt; idx < 4 * 512 * 32; idx += GT) { const int pd = idx / (512 * 32), rem = idx % (512 * 32), k = rem >> 9, chg = rem & 511, hq = chg >> 6, ch = chg & 63;
            const float v = a2a[((size_t)pd * 32 + k) * 512 + chg]; const unsigned hi = cvtpk(v, 0.f) & 0xffffu; const float lo = v - bflo(hi);
            bf16* base = LW + (size_t)(pd * 8 + hq) * 12288 + 8192; base[ch * 32 + k] = (bf16)hi; base[2048 + ch * 32 + k] = (bf16)(cvtpk(lo, 0.f) & 0xffffu); }
    }
    if (F.bx == 0) {
        float* rope = (float*)(F.ws + WS_ROPE);
        for (int i = F.tid; i < 1024; i += NTHREADS) { const int pos = i >> 4, f = i & 15; const float inv = powf(10000.f, -(float)(2 * f) / 32.f); const float ang = (float)pos * inv;
            rope[i] = cosf(ang); rope[1024 + i] = sinf(ang); }
    }
}

__device__ __forceinline__ void ld_row(const float* p, int lane, f32x4* v) {
#pragma unroll
    for (int j = 0; j < 8; ++j) v[j] = *(const f32x4*)(p + 4 * lane + 256 * j);
}
__device__ __forceinline__ void ld_row_bf(const bf16* p, int lane, f32x4* v) {
#pragma unroll
    for (int j = 0; j < 8; ++j) { const u32x2 w = *(const u32x2*)(p + 4 * lane + 256 * j); v[j] = (f32x4){bflo(w.x), bfhi(w.x), bflo(w.y), bfhi(w.y)}; }
}
__device__ __forceinline__ float sumsq8(const f32x4* v) { float s = 0.f;
#pragma unroll
    for (int j = 0; j < 8; ++j) s += (v[j].x * v[j].x + v[j].y * v[j].y) + (v[j].z * v[j].z + v[j].w * v[j].w);
    return s; }
__device__ __forceinline__ void ld_mod(const Ctx& F, int l, int r, int part, int lane, f32x4* v) {
    const float* ma = (const float*)(F.ws + WS_CTL + CTL_MODACC) + (size_t)(l * 3 + r) * 6144 + part * DM; const float* bm = F.prm->in[5] + (size_t)l * 6144 + part * DM;
#pragma unroll
    for (int j = 0; j < 8; ++j) v[j] = *(const f32x4*)(ma + 4 * lane + 256 * j) + *(const f32x4*)(bm + 4 * lane + 256 * j);
}
__device__ __forceinline__ void phase1(Ctx& F, int l) {
    const float* x = F.prm->in[0]; const float* ctx = F.prm->in[2]; const float* g_pre = F.prm->in[6] + (size_t)l * DM; const float* g_post0 = F.prm->in[7];
    const bf16* O = (const bf16*)(F.ws + WS_P); bf16* XN = (bf16*)(F.ws + WS_XN);
    LAS float* MV = (LAS float*)F.lds;
    {   const float* ma = (const float*)(F.ws + WS_CTL + CTL_MODACC); const float* bm = F.prm->in[5];
        for (int idx = F.tid; idx < 3 * 512; idx += NTHREADS) { const int r = idx >> 9, n = (idx & 511) * 4;
            const f32x4 shv = *(const f32x4*)(ma + (size_t)(l * 3 + r) * 6144 + n) + *(const f32x4*)(bm + (size_t)l * 6144 + n);
            const f32x4 scv = *(const f32x4*)(ma + (size_t)(l * 3 + r) * 6144 + DM + n) + *(const f32x4*)(bm + (size_t)l * 6144 + DM + n);
            *(LAS f32x4*)(MV + (r * 3 + 0) * DM + n) = shv; *(LAS f32x4*)(MV + (r * 3 + 1) * DM + n) = (scv + 1.f) * *(const f32x4*)(g_pre + n);
            if (l == 1) { const f32x4 gt = *(const f32x4*)(ma + (size_t)r * 6144 + 2 * DM + n) + *(const f32x4*)(bm + 2 * DM + n); *(LAS f32x4*)(MV + (r * 3 + 2) * DM + n) = gt * *(const f32x4*)(g_post0 + n); } }
    }
    WG_BAR();
    for (int row = F.gw; row < MT; row += F.NGW) {
        const bool lat = row < ML; const int r = lat ? (row / TL) : 2;
        const LAS float* mv = MV + r * 3 * DM + 4 * F.lane;
        const float* src = lat ? x + (size_t)row * DM : ctx + (size_t)(row - ML) * DM;
        f32x4 xv[8]; ld_row(src, F.lane, xv);
        if (l == 1) {
            f32x4 ov[8]; ld_row_bf(O + (size_t)row * DM, F.lane, ov);
            const float rs = 1.f / sqrtf(wave_sum(sumsq8(ov)) * (1.f / DM) + EPS);
#pragma unroll
            for (int j = 0; j < 8; ++j) xv[j] = xv[j] + *(const LAS f32x4*)(mv + 2 * DM + 256 * j) * (ov[j] * rs);
            if (lat) {
#pragma unroll
                for (int j = 0; j < 8; ++j) *(f32x4*)(F.out + (size_t)row * DM + 4 * F.lane + 256 * j) = xv[j];
            }
        }
        const float rs = 1.f / sqrtf(wave_sum(sumsq8(xv)) * (1.f / DM) + EPS);
#pragma unroll
        for (int j = 0; j < 8; ++j) { const f32x4 h = (xv[j] * rs) * *(const LAS f32x4*)(mv + DM + 256 * j) + *(const LAS f32x4*)(mv + 256 * j);
            u32x2 w; w.x = cvtpk(h.x, h.y); w.y = cvtpk(h.z, h.w); *(u32x2*)(XN + (size_t)row * DM + 4 * F.lane + 256 * j) = w; }
    }
    WG_BAR();
}
__device__ __forceinline__ void phase6(Ctx& F) {
    const float* g_post1 = F.prm->in[7] + DM; const bf16* O = (const bf16*)(F.ws + WS_P);
    for (int row = F.gw; row < ML; row += F.NGW) {
        const int r = row / TL;
        f32x4 xv[8], ov[8], gt[8], gp[8]; ld_row(F.out + (size_t)row * DM, F.lane, xv); ld_row_bf(O + (size_t)row * DM, F.lane, ov); ld_mod(F, 1, r, 2, F.lane, gt); ld_row(g_post1, F.lane, gp);
        const float rs = 1.f / sqrtf(wave_sum(sumsq8(ov)) * (1.f / DM) + EPS);
#pragma unroll
        for (int j = 0; j < 8; ++j) *(f32x4*)(F.out + (size_t)row * DM + 4 * F.lane + 256 * j) = xv[j] + gt[j] * (ov[j] * rs * gp[j]);
    }
}

__device__ __forceinline__ void sgu_item(Ctx& F, int l, int cb, int h) {
    const bf16* P = (const bf16*)(F.ws + WS_P); bf16* OC = (bf16*)(F.ws + WS_OC);
    const float* w_s = F.prm->in[10] + (size_t)(l * 4 + h) * 128 * 128; const float* b_s = F.prm->in[11] + (size_t)(l * 4 + h) * 128;
    const int row0 = cb < 64 ? (cb >> 5) * TL + (cb & 31) * 128 : ML + ((cb - 64) >> 1) * CL + ((cb - 64) & 1) * 128;
    LAS unsigned char* WB = F.lds;
    LAS unsigned char* VTB = F.lds + 34816;
    LAS float* MX = (LAS float*)(F.lds + 69632);
    {
        const int row = F.tid >> 2, qt = F.tid & 3; const bf16* src = P + (size_t)(row0 + row) * NINP + A_V + h * 128 + qt * 32;
        float v[32];
#pragma unroll
        for (int i = 0; i < 4; ++i) unpack8(*(const u32x4*)(src + 8 * i), v + 8 * i);
        float s_ = 0.f;
#pragma unroll
        for (int i = 0; i < 32; ++i) s_ += v[i];
        const float mean = red4(s_) * (1.f / 128.f); float q = 0.f;
#pragma unroll
        for (int i = 0; i < 32; ++i) { v[i] -= mean; q += v[i] * v[i]; }
        const float rstd = 1.f / sqrtf(red4(q) * (1.f / 128.f) + EPS);
#pragma unroll
        for (int i = 0; i < 32; i += 2) { const unsigned w = cvtpk(v[i] * rstd, v[i + 1] * rstd);
            *(LAS unsigned short*)(VTB + (qt * 32 + i) * 272 + 2 * row) = (unsigned short)w; *(LAS unsigned short*)(VTB + (qt * 32 + i + 1) * 272 + 2 * row) = (unsigned short)(w >> 16); }
    }
    for (int idx = F.tid; idx < 4096; idx += NTHREADS) { const int p = idx >> 5, q4 = idx & 31; const f32x4 w = *(const f32x4*)(w_s + p * 128 + 4 * q4);
        *(LAS u32x2*)(WB + p * 272 + 8 * q4) = (u32x2){cvtpk(w.x, w.y), cvtpk(w.z, w.w)}; }
    WG_BAR();
    {   const int l31 = F.lane & 31, hh = F.lane >> 5, mt = F.wave >> 1;
#pragma unroll
        for (int nn = 0; nn < 2; ++nn) { const int nt = (F.wave & 1) * 2 + nn; f32x16 d = zero16();
#pragma unroll
            for (int ks = 0; ks < 8; ++ks) d = __builtin_amdgcn_mfma_f32_32x32x16_bf16(*(const LAS bf16x8*)(WB + (32 * mt + l31) * 272 + (16 * ks + 8 * hh) * 2), *(const LAS bf16x8*)(VTB + (32 * nt + l31) * 272 + (16 * ks + 8 * hh) * 2), d, 0, 0, 0);
#pragma unroll
            for (int r = 0; r < 16; ++r) MX[(32 * mt + MROW(r, hh)) * 132 + 32 * nt + l31] = d[r]; }
    }
    WG_BAR();
    const int pg = F.tid >> 5, dg = F.tid & 31;
    f32x4 acc[8];
#pragma unroll
    for (int i = 0; i < 8; ++i) acc[i] = *(const LAS f32x4*)(MX + (8 * pg + i) * 132 + 4 * dg);
#pragma unroll
    for (int i = 0; i < 8; ++i) { const int p = 8 * pg + i; const float bs = b_s[p]; const bf16* pr = P + (size_t)(row0 + p) * NINP + h * 128 + 4 * dg;
        const u32x2 uu = *(const u32x2*)(pr + A_U), gg = *(const u32x2*)(pr + A_G);
        const float o0 = bflo(uu.x) * (acc[i].x + bs) * silu_f(bflo(gg.x)), o1 = bfhi(uu.x) * (acc[i].y + bs) * silu_f(bfhi(gg.x));
        const float o2 = bflo(uu.y) * (acc[i].z + bs) * silu_f(bflo(gg.y)), o3 = bfhi(uu.y) * (acc[i].w + bs) * silu_f(bfhi(gg.y));
        u32x2 w; w.x = cvtpk(o0, o1); w.y = cvtpk(o2, o3); *(u32x2*)(OC + (size_t)(row0 + p) * DM + h * 128 + 4 * dg) = w; }
    WG_BAR();
}

__device__ __forceinline__ void conv_item(Ctx& F, int l, int item) {
    const bf16* P = (const bf16*)(F.ws + WS_P); bf16* OC = (bf16*)(F.ws + WS_OC); const float* cw = F.prm->in[27] + (size_t)l * 3 * 512;
    const int row = item * 16 + (F.tid >> 5), c0 = (F.tid & 31) * 16;
    int t, tlen; if (row < ML) { t = row & (TL - 1); tlen = TL; } else { t = (row - ML) & (CL - 1); tlen = CL; }
    const bf16* pr = P + (size_t)row * NINP;
    float z0[16], z1[16], z2[16], tmp[16];
#pragma unroll
    for (int i = 0; i < 2; ++i) {
        float a[8], b[8];
        unpack8(*(const u32x4*)(pr + D_C + c0 + 8 * i), a); unpack8(*(const u32x4*)(pr + D_X + c0 + 8 * i), b);
#pragma unroll
        for (int e = 0; e < 8; ++e) z1[8 * i + e] = a[e] * b[e];
        if (t > 0) { unpack8(*(const u32x4*)(pr - NINP + D_C + c0 + 8 * i), a); unpack8(*(const u32x4*)(pr - NINP + D_X + c0 + 8 * i), b);
#pragma unroll
            for (int e = 0; e < 8; ++e) z0[8 * i + e] = a[e] * b[e]; }
        else {
#pragma unroll
            for (int e = 0; e < 8; ++e) z0[8 * i + e] = 0.f; }
        if (t < tlen - 1) { unpack8(*(const u32x4*)(pr + NINP + D_C + c0 + 8 * i), a); unpack8(*(const u32x4*)(pr + NINP + D_X + c0 + 8 * i), b);
#pragma unroll
            for (int e = 0; e < 8; ++e) z2[8 * i + e] = a[e] * b[e]; }
        else {
#pragma unroll
            for (int e = 0; e < 8; ++e) z2[8 * i + e] = 0.f; }
    }
#pragma unroll
    for (int i = 0; i < 2; ++i) {
        float bg[8], gg[8]; unpack8(*(const u32x4*)(pr + D_B + c0 + 8 * i), bg); unpack8(*(const u32x4*)(pr + D_G + c0 + 8 * i), gg);
#pragma unroll
        for (int e = 0; e < 8; ++e) { const int c = c0 + 8 * i + e; const float y = cw[c] * z0[8 * i + e] + cw[512 + c] * z1[8 * i + e] + cw[1024 + c] * z2[8 * i + e]; tmp[e] = bg[e] * y * silu_f(gg[e]); }
        *(u32x4*)(OC + (size_t)row * DM + 1536 + c0 + 8 * i) = pack8(tmp);
    }
}

__device__ __forceinline__ void attnprep_item(Ctx& F, int l, int rb, int h) {
    const bf16* P = (const bf16*)(F.ws + WS_P); const float* rope = (const float*)(F.ws + WS_ROPE);
    bf16* QR = (bf16*)(F.ws + WS_QR); bf16* QC = (bf16*)(F.ws + WS_QC); bf16* KR = (bf16*)(F.ws + WS_KR); bf16* VT = (bf16*)(F.ws + WS_VT);
    const bool lat = rb < 128; const int b = lat ? (rb >> 6) : ((rb - 128) >> 2), t0 = lat ? (rb & 63) * 64 : ((rb - 128) & 3) * 64;
    const int row0 = lat ? b * TL + t0 : ML + b * CL + t0;
    {
        const int tk = F.tid >> 3, sub = F.tid & 7, isk = sub >> 2, hq = sub & 3, m = hq >> 1, half = hq & 1, t = t0 + tk;
        const bf16* src = P + (size_t)(row0 + tk) * NINP + (isk ? B_K : B_Q) + h * 128 + 32 * hq;
        float xx[32], oo[32];
#pragma unroll
        for (int i = 0; i < 4; ++i) unpack8(*(const u32x4*)(src + 8 * i), xx + 8 * i);
        if (lat) { const int pos = half ? (t & 63) : (t >> 6); const float* cs = rope + pos * 16; const float* sn = rope + 1024 + pos * 16;
#pragma unroll
            for (int i = 0; i < 16; ++i) { const float c = cs[i], s = sn[i]; oo[i] = xx[i] * c - xx[i + 16] * s; oo[i + 16] = xx[i + 16] * c + xx[i] * s; } }
        else {
#pragma unroll
            for (int i = 0; i < 32; ++i) oo[i] = xx[i]; }
        if (!isk) {
#pragma unroll
            for (int i = 0; i < 32; ++i) oo[i] *= QSCALE; }
        const int bhm = (b * 4 + h) * 2 + m;
        bf16* dst = isk ? KR + ((size_t)bhm * KEYS + (lat ? CL + t : t)) * 64 + 32 * half : (lat ? QR + ((size_t)bhm * TL + t) * 64 + 32 * half : QC + ((size_t)bhm * CL + t) * 64 + 32 * half);
        if (isk || lat || l == 0) {
#pragma unroll
            for (int i = 0; i < 4; ++i) *(u32x4*)(dst + 8 * i) = pack8(oo + 8 * i); }
    }
    LAS unsigned char* VL = F.lds;
#pragma unroll
    for (int pass = 0; pass < 2; ++pass) { const int idx = F.tid + 512 * pass, key = idx >> 4, c = idx & 15;
        *(LAS u32x4*)(VL + key * 272 + 16 * c) = *(const u32x4*)(P + (size_t)(row0 + key) * NINP + B_V + h * 128 + 8 * c); }
    WG_BAR();
    const int keybase = lat ? CL + t0 : t0;
#pragma unroll
    for (int pass = 0; pass < 2; ++pass) { const int idx = F.tid + 512 * pass, dv = idx >> 3, kc = idx & 7; unsigned short e[8];
#pragma unroll
        for (int i = 0; i < 8; ++i) e[i] = *(const LAS unsigned short*)(VL + (8 * kc + i) * 272 + 2 * dv);
        u32x4 o; o.x = e[0] | ((unsigned)e[1] << 16); o.y = e[2] | ((unsigned)e[3] << 16); o.z = e[4] | ((unsigned)e[5] << 16); o.w = e[6] | ((unsigned)e[7] << 16);
        *(u32x4*)(VT + ((size_t)(b * 4 + h) * 128 + dv) * KEYS + keybase + 8 * kc) = o; }
    WG_BAR();
}

constexpr int NCHUNK = NSTEP / 64;
constexpr int CHKB = 62464;
constexpr int CK_W1F = 0, CK_RF = 8192, CK_BTF = 16384, CK_ARBF = 24576, CK_YCA = 30720  , CK_VF = 36864  , CK_W2A = 45056, CK_GA = 53248, CK_CLV = 61440;
static_assert((size_t)32 * NCHUNK * CHKB <= WS_Y - WS_CHK, "chunk records");

__device__ __forceinline__ bf16x8 frag16(const LAS unsigned char* tile, int row, int k0) { return *(const LAS bf16x8*)(tile + row * 144 + k0 * 2); }
__device__ __forceinline__ bf16x8 fragP(const LAS unsigned char* tile, int row, int base, int hh) {
    const u32x2 lo = *(const LAS u32x2*)(tile + row * 144 + (base + 4 * hh) * 2), hi = *(const LAS u32x2*)(tile + row * 144 + (base + 8 + 4 * hh) * 2);
    const u32x4 w = {lo.x, lo.y, hi.x, hi.y}; return __builtin_bit_cast(bf16x8, w);
}
template <int S8> __device__ __forceinline__ bf16x8 pk8(const f32x16& a) {
    const u32x4 w = {cvtpk(a[S8], a[S8 + 1]), cvtpk(a[S8 + 2], a[S8 + 3]), cvtpk(a[S8 + 4], a[S8 + 5]), cvtpk(a[S8 + 6], a[S8 + 7])}; return __builtin_bit_cast(bf16x8, w);
}
__device__ __forceinline__ f32x16 tile_prod(const LAS unsigned char* At, int m0, const LAS unsigned char* Bt, int n0, int l31, int hh) {
    f32x16 d = zero16();
#pragma unroll
    for (int q = 0; q < 4; ++q) d = __builtin_amdgcn_mfma_f32_32x32x16_bf16(frag16(At, m0 + l31, 16 * q + 8 * hh), frag16(Bt, n0 + l31, 16 * q + 8 * hh), d, 0, 0, 0);
    return d;
}
__device__ __forceinline__ void st_acc32(unsigned char* p, const f32x16& d) {
    *(u32x4*)p = (u32x4){cvtpk(d[0], d[1]), cvtpk(d[2], d[3]), cvtpk(d[4], d[5]), cvtpk(d[6], d[7])};
    *(u32x4*)(p + 16) = (u32x4){cvtpk(d[8], d[9]), cvtpk(d[10], d[11]), cvtpk(d[12], d[13]), cvtpk(d[14], d[15])};
}
__device__ __forceinline__ f32x16 ld_acc32(const LAS unsigned char* p) {
    const u32x4 a = *(const LAS u32x4*)p, b = *(const LAS u32x4*)(p + 16); f32x16 d;
    d[0] = bflo(a.x); d[1] = bfhi(a.x); d[2] = bflo(a.y); d[3] = bfhi(a.y); d[4] = bflo(a.z); d[5] = bfhi(a.z); d[6] = bflo(a.w); d[7] = bfhi(a.w);
    d[8] = bflo(b.x); d[9] = bfhi(b.x); d[10] = bflo(b.y); d[11] = bfhi(b.y); d[12] = bflo(b.z); d[13] = bfhi(b.z); d[14] = bflo(b.w); d[15] = bfhi(b.w); return d;
}
__device__ __forceinline__ f32x16 acc_from(const u32x4 a, const u32x4 b) { f32x16 d;
    d[0] = bflo(a.x); d[1] = bfhi(a.x); d[2] = bflo(a.y); d[3] = bfhi(a.y); d[4] = bflo(a.z); d[5] = bfhi(a.z); d[6] = bflo(a.w); d[7] = bfhi(a.w);
    d[8] = bflo(b.x); d[9] = bfhi(b.x); d[10] = bflo(b.y); d[11] = bfhi(b.y); d[12] = bflo(b.z); d[13] = bfhi(b.z); d[14] = bflo(b.w); d[15] = bfhi(b.w); return d; }
__device__ __forceinline__ float softplus_f(float x) { return fmaxf(x, 0.f) + __logf(1.f + __expf(-fabsf(x))); }
__device__ __forceinline__ int scan_row(int c, int i, int dir, int b) {
    const bool isctx = c < 4; const int bi = (isctx ? 64 * c : 64 * (c - 4)) + i;
    return isctx ? ML + b * CL + (dir ? CL - 1 - bi : bi) : b * TL + (dir ? TL - 1 - bi : bi);
}

struct R1In { u32x4 g_l, g_r, g_k, g_v, p_l, p_r, p_k, p_v; u32x2 g_a, p_a; };
__device__ __forceinline__ void r1_load(Ctx& F, int item, R1In& in) {
    const int scan = item / NCHUNK, c = item % NCHUNK, dir = scan >> 4, b = (scan >> 3) & 1, h = scan & 7;
    const bf16* P = (const bf16*)(F.ws + WS_P);
    const int i = F.tid >> 3, sub = F.tid & 7, c0 = 8 * sub, gc0 = h * 64 + c0;
    const bool isctx = c < 4; const int bi = (isctx ? 64 * c : 64 * (c - 4)) + i;
    const int row = scan_row(c, i, dir, b);
    const bf16* pr = P + (size_t)row * NINP; const bf16* pp = (bi > 0) ? (dir ? pr + NINP : pr - NINP) : pr;
    const int CLX = dir == 0 ? C_LF : C_LB;
    in.g_l = *(const u32x4*)(pr + CLX + c0); in.g_r = *(const u32x4*)(pr + C_R + gc0); in.g_k = *(const u32x4*)(pr + C_K + gc0); in.g_v = *(const u32x4*)(pr + C_V + gc0); in.g_a = *(const u32x2*)(pr + CLX + 64 + 4 * sub);
    in.p_l = *(const u32x4*)(pp + CLX + c0); in.p_r = *(const u32x4*)(pp + C_R + gc0); in.p_k = *(const u32x4*)(pp + C_K + gc0); in.p_v = *(const u32x4*)(pp + C_V + gc0); in.p_a = *(const u32x2*)(pp + CLX + 64 + 4 * sub);
}
__device__ __forceinline__ void rwkv1_item(Ctx& F, int l, int item, R1In& in, int next_item) {
    const int scan = item / NCHUNK, c = item % NCHUNK, dir = scan >> 4, b = (scan >> 3) & 1, h = scan & 7;
    const bf16* P = (const bf16*)(F.ws + WS_P); unsigned char* rec = F.ws + WS_CHK + (size_t)item * CHKB;
    bf16* BON = (bf16*)(F.ws + WS_BON) + (size_t)dir * MT * 512;
    LAS unsigned char* TA = F.lds; LAS unsigned char* TB = F.lds + 9216; LAS unsigned char* TK = F.lds + 18432; LAS unsigned char* TR = F.lds + 27648;
    LAS unsigned char* TAT = F.lds + 36864; LAS unsigned char* TBT = F.lds + 46080; LAS unsigned char* TKT = F.lds + 55296; LAS unsigned char* TVT = F.lds + 64512;
    LAS unsigned char* TT = F.lds + 73728;
    LAS float* AAB = (LAS float*)(F.lds + 82944);
    LAS float* CLS = (LAS float*)(F.lds + 100352);
    LAS unsigned char* A21B = F.lds + 116736; LAS unsigned char* T11T = F.lds + 119296;
    LAS unsigned char* LWH = F.lds;             LAS unsigned char* LWL = F.lds + 9216;
    LAS unsigned char* LAH = F.lds + 18432;     LAS unsigned char* LAL = F.lds + 23552;
    LAS unsigned char* XWH = F.lds + 28672;     LAS unsigned char* XWL = F.lds + 37888;
    LAS unsigned char* XAH = F.lds + 47104;     LAS unsigned char* XAL = F.lds + 52224;
    LAS float* OW = (LAS float*)(F.lds + 57344);
    LAS float* OA = (LAS float*)(F.lds + 74752);
    const int i = F.tid >> 3, sub = F.tid & 7, c0 = 8 * sub, gc0 = h * 64 + c0;
    const bool isctx = c < 4; const int bi = (isctx ? 64 * c : 64 * (c - 4)) + i;
    const int row = scan_row(c, i, dir, b);
    const bool hasprev = bi > 0;
    const bf16* pr = P + (size_t)row * NINP; const bf16* pp = dir ? pr + NINP : pr - NINP;
    const int pd = l * 2 + dir;
    const float* mu = F.prm->in[17] + (size_t)pd * 1632; const float* w0 = F.prm->in[18] + (size_t)pd * 512; const float* w2 = F.prm->in[19] + (size_t)pd * 64 * 512;
    const float* a0 = F.prm->in[20] + (size_t)pd * 512; const float* a2 = F.prm->in[21] + (size_t)pd * 32 * 512; const float* k_k = F.prm->in[22] + (size_t)pd * 512;
    const float* k_a = F.prm->in[23] + (size_t)pd * 512; const float* r_k = F.prm->in[24] + (size_t)pd * 512;
    const int CLX = dir == 0 ? C_LF : C_LB;
    f32x4 pm_[16];
    { const float* pv_[8] = {mu + gc0, mu + 512 + gc0, mu + 1024 + gc0, w0 + gc0, a0 + gc0, k_k + gc0, k_a + gc0, r_k + gc0};
#pragma unroll
      for (int v = 0; v < 8; ++v) { pm_[2 * v] = *(const f32x4*)(pv_[v]); pm_[2 * v + 1] = *(const f32x4*)(pv_[v] + 4); } }
#define PM(v, e) (pm_[2 * (v) + ((e) >> 2)][(e) & 3])
    const u32x4 zz4 = {0u, 0u, 0u, 0u}; const u32x2 zz2 = {0u, 0u};
    const u32x4 g_l = in.g_l, g_r = in.g_r, g_k = in.g_k, g_v = in.g_v; const u32x2 g_a = in.g_a;
    const u32x4 p_l = hasprev ? in.p_l : zz4, p_r = hasprev ? in.p_r : zz4, p_k = hasprev ? in.p_k : zz4, p_v = hasprev ? in.p_v : zz4; const u32x2 p_a = hasprev ? in.p_a : zz2;
    {
        const unsigned char* lwg = F.ws + WS_LW + (size_t)(pd * 8 + h) * 24576;
        { const int p = F.tid, r = p >> 3, cq = p & 7; *(LAS u32x4*)(LWH + r * 144 + cq * 16) = *(const u32x4*)(lwg + p * 16); *(LAS u32x4*)(LWL + r * 144 + cq * 16) = *(const u32x4*)(lwg + 8192 + p * 16); }
        { const int p = F.tid & 255, r = p >> 2, cq = p & 3; LAS unsigned char* dst = (F.tid < 256 ? LAH : LAL); *(LAS u32x4*)(dst + r * 80 + cq * 16) = *(const u32x4*)(lwg + 16384 + (F.tid < 256 ? 0 : 4096) + p * 16); }
    }
    {   float f[8], pv[8], th[8], tl[8]; unpack8(g_l, f); unpack8(p_l, pv);
        const f32x4 mw0 = *(const f32x4*)(mu + 1536 + c0), mw1 = *(const f32x4*)(mu + 1536 + c0 + 4), ma0 = *(const f32x4*)(mu + 1600 + 4 * sub); const float muw[8] = {mw0.x, mw0.y, mw0.z, mw0.w, mw1.x, mw1.y, mw1.z, mw1.w}, mua[4] = {ma0.x, ma0.y, ma0.z, ma0.w};
#pragma unroll
        for (int e = 0; e < 8; ++e) { const float z = f[e] + (pv[e] - f[e]) * muw[e]; const float ez = __expf(-2.f * fabsf(z)); const float t0 = (1.f - ez) * __builtin_amdgcn_rcpf(1.f + ez); const float tv = z < 0.f ? -t0 : t0;
            th[e] = bflo(cvtpk(tv, 0.f)); tl[e] = tv - th[e]; }
        *(LAS u32x4*)(XWH + i * 144 + 2 * c0) = pack8(th); *(LAS u32x4*)(XWL + i * 144 + 2 * c0) = pack8(tl);
        const float fz[4] = {bflo(g_a.x), bfhi(g_a.x), bflo(g_a.y), bfhi(g_a.y)}, pz[4] = {bflo(p_a.x), bfhi(p_a.x), bflo(p_a.y), bfhi(p_a.y)}; float zh[4], zl[4];
#pragma unroll
        for (int e = 0; e < 4; ++e) { const float z = fz[e] + (pz[e] - fz[e]) * mua[e]; zh[e] = bflo(cvtpk(z, 0.f)); zl[e] = z - zh[e]; }
        *(LAS u32x2*)(XAH + i * 80 + 8 * sub) = (u32x2){cvtpk(zh[0], zh[1]), cvtpk(zh[2], zh[3])}; *(LAS u32x2*)(XAL + i * 80 + 8 * sub) = (u32x2){cvtpk(zl[0], zl[1]), cvtpk(zl[2], zl[3])};
    }
    WG_BAR();
    {
        const int l31 = F.lane & 31, hh = F.lane >> 5, mt = (F.wave >> 1) & 1, nt = F.wave & 1;
        f32x16 d = zero16();
        if (F.wave < 4) {
#pragma unroll
            for (int q = 0; q < 4; ++q) { const bf16x8 ah = frag16(XWH, 32 * mt + l31, 16 * q + 8 * hh), al_ = frag16(XWL, 32 * mt + l31, 16 * q + 8 * hh), bh = frag16(LWH, 32 * nt + l31, 16 * q + 8 * hh), bl = frag16(LWL, 32 * nt + l31, 16 * q + 8 * hh);
                d = __builtin_amdgcn_mfma_f32_32x32x16_bf16(ah, bh, d, 0, 0, 0); d = __builtin_amdgcn_mfma_f32_32x32x16_bf16(ah, bl, d, 0, 0, 0); d = __builtin_amdgcn_mfma_f32_32x32x16_bf16(al_, bh, d, 0, 0, 0); }
#pragma unroll
            for (int r = 0; r < 16; ++r) OW[(32 * mt + MROW(r, hh)) * 68 + 32 * nt + l31] = d[r];
        } else {
#pragma unroll
            for (int q = 0; q < 2; ++q) { const int ko = (16 * q + 8 * hh) * 2;
                const bf16x8 ah = *(const LAS bf16x8*)(XAH + (32 * mt + l31) * 80 + ko), al_ = *(const LAS bf16x8*)(XAL + (32 * mt + l31) * 80 + ko), bh = *(const LAS bf16x8*)(LAH + (32 * nt + l31) * 80 + ko), bl = *(const LAS bf16x8*)(LAL + (32 * nt + l31) * 80 + ko);
                d = __builtin_amdgcn_mfma_f32_32x32x16_bf16(ah, bh, d, 0, 0, 0); d = __builtin_amdgcn_mfma_f32_32x32x16_bf16(ah, bl, d, 0, 0, 0); d = __builtin_amdgcn_mfma_f32_32x32x16_bf16(al_, bh, d, 0, 0, 0); }
#pragma unroll
            for (int r = 0; r < 16; ++r) OA[(32 * mt + MROW(r, hh)) * 68 + 32 * nt + l31] = d[r];
        }
    }
    WG_BAR();
    float wp[8], ap[8];
    { const f32x4 a = *(const LAS f32x4*)(OW + i * 68 + c0), bq = *(const LAS f32x4*)(OW + i * 68 + c0 + 4), cq = *(const LAS f32x4*)(OA + i * 68 + c0), dq = *(const LAS f32x4*)(OA + i * 68 + c0 + 4);
      const float ow[8] = {a.x, a.y, a.z, a.w, bq.x, bq.y, bq.z, bq.w}, oa[8] = {cq.x, cq.y, cq.z, cq.w, dq.x, dq.y, dq.z, dq.w};
#pragma unroll
      for (int e = 0; e < 8; ++e) { wp[e] = PM(3, e) + ow[e]; ap[e] = PM(4, e) + oa[e]; } }
    float lw[8], kk[8], al[8], km[8], rr[8], vv[8];
    {   float fr[8], fk[8], fv[8], qr[8], qk[8], qv[8]; unpack8(g_r, fr); unpack8(g_k, fk); unpack8(g_v, fv); unpack8(p_r, qr); unpack8(p_k, qk); unpack8(p_v, qv);
        float n2 = 0.f, bsum = 0.f;
#pragma unroll
        for (int e = 0; e < 8; ++e) { const int gc = gc0 + e;
            rr[e] = fr[e] + (qr[e] - fr[e]) * PM(0, e); const float kx = fk[e] + (qk[e] - fk[e]) * PM(1, e); vv[e] = fv[e] + (qv[e] - fv[e]) * PM(2, e);
            const float w = -softplus_f(-wp[e]) - 0.5f; lw[e] = -__expf(w);
            al[e] = __builtin_amdgcn_rcpf(1.f + __expf(-ap[e]));
            kk[e] = kx * PM(5, e); n2 += kk[e] * kk[e];
            km[e] = kx * (1.f + (al[e] - 1.f) * PM(6, e));
            bsum += rr[e] * km[e] * PM(7, e); }
        n2 = red8(n2); bsum = red8(bsum);
        const float inv = __builtin_amdgcn_rsqf(fmaxf(n2, 1e-24f)); float bon[8];
#pragma unroll
        for (int e = 0; e < 8; ++e) { kk[e] *= inv; bon[e] = bsum * vv[e]; }
        *(u32x4*)(BON + (size_t)row * 512 + gc0) = pack8(bon);
    }
    *(LAS f32x4*)(CLS + i * 64 + c0) = (f32x4){lw[0], lw[1], lw[2], lw[3]}; *(LAS f32x4*)(CLS + i * 64 + c0 + 4) = (f32x4){lw[4], lw[5], lw[6], lw[7]};
    WG_BAR();
    if (F.tid < 64) {
        float x[64];
#pragma unroll
        for (int q = 0; q < 64; ++q) x[q] = CLS[q * 64 + F.tid];
#pragma unroll
        for (int q = 1; q < 64; ++q) x[q] += x[q - 1];
#pragma unroll
        for (int q = 0; q < 64; ++q) CLS[q * 64 + F.tid] = x[q];
    }
    WG_BAR();
    {   float cl[8], cL[8];
        { const f32x4 a = *(const LAS f32x4*)(CLS + i * 64 + c0), bq = *(const LAS f32x4*)(CLS + i * 64 + c0 + 4), cc = *(const LAS f32x4*)(CLS + 63 * 64 + c0), dd = *(const LAS f32x4*)(CLS + 63 * 64 + c0 + 4);
          cl[0] = a.x; cl[1] = a.y; cl[2] = a.z; cl[3] = a.w; cl[4] = bq.x; cl[5] = bq.y; cl[6] = bq.z; cl[7] = bq.w; cL[0] = cc.x; cL[1] = cc.y; cL[2] = cc.z; cL[3] = cc.w; cL[4] = dd.x; cL[5] = dd.y; cL[6] = dd.z; cL[7] = dd.w; }
        float tA[8], tB[8], tK[8], tR[8], tBt[8], tKt[8];
#pragma unroll
        for (int e = 0; e < 8; ++e) { const float eA = __expf(cl[e] - lw[e]), eI = __expf(-cl[e]), eR = __expf(cl[e]), eT = __expf(cL[e] - cl[e]); const float ba = kk[e] * al[e];
            tA[e] = -kk[e] * eA; tB[e] = ba * eI; tK[e] = km[e] * eI; tR[e] = rr[e] * eR; tBt[e] = ba * eT; tKt[e] = km[e] * eT; }
        *(LAS u32x4*)(TA + i * 144 + 2 * c0) = pack8(tA); *(LAS u32x4*)(TB + i * 144 + 2 * c0) = pack8(tB); *(LAS u32x4*)(TK + i * 144 + 2 * c0) = pack8(tK); *(LAS u32x4*)(TR + i * 144 + 2 * c0) = pack8(tR);
        const u32x4 qa = pack8(tA), qb = pack8(tBt), qk = pack8(tKt), qv = pack8(vv);
        const unsigned wa[4] = {qa.x, qa.y, qa.z, qa.w}, wb[4] = {qb.x, qb.y, qb.z, qb.w}, wk[4] = {qk.x, qk.y, qk.z, qk.w}, wv[4] = {qv.x, qv.y, qv.z, qv.w};
#pragma unroll
        for (int e0 = 0; e0 < 8; ++e0) { const int e = (e0 + sub) & 7;
            const unsigned ua = e < 2 ? wa[0] : e < 4 ? wa[1] : e < 6 ? wa[2] : wa[3], ub_ = e < 2 ? wb[0] : e < 4 ? wb[1] : e < 6 ? wb[2] : wb[3];
            const unsigned uk = e < 2 ? wk[0] : e < 4 ? wk[1] : e < 6 ? wk[2] : wk[3], uv = e < 2 ? wv[0] : e < 4 ? wv[1] : e < 6 ? wv[2] : wv[3];
            const int sh = (e & 1) * 16; const int o = (c0 + e) * 144 + 2 * i;
            *(LAS unsigned short*)(TAT + o) = (unsigned short)(ua >> sh); *(LAS unsigned short*)(TBT + o) = (unsigned short)(ub_ >> sh);
            *(LAS unsigned short*)(TKT + o) = (unsigned short)(uk >> sh); *(LAS unsigned short*)(TVT + o) = (unsigned short)(uv >> sh); }
    }
    WG_BAR();
    const int l31 = F.lane & 31, hh = F.lane >> 5;
    if (F.wave < 3) { const int it = F.wave > 0, jt = F.wave > 1; const f32x16 d = tile_prod(TA, 32 * it, TB, 32 * jt, l31, hh);
#pragma unroll
        for (int r = 0; r < 16; ++r) { const int ii = 32 * it + MROW(r, hh), j = 32 * jt + l31; AAB[ii * 68 + (j & 7) * 8 + (j >> 3)] = j < ii ? d[r] : 0.f; }
        if (F.wave == 1) {
#pragma unroll
            for (int r = 0; r < 16; r += 2) { const unsigned w = cvtpk(d[r], d[r + 1]); *(LAS unsigned short*)(A21B + MROW(r, hh) * 80 + 2 * l31) = (unsigned short)w; *(LAS unsigned short*)(A21B + MROW(r + 1, hh) * 80 + 2 * l31) = (unsigned short)(w >> 16); } } }
    else if (F.wave == 3) {
#pragma unroll
        for (int r = 0; r < 16; ++r) AAB[(2 * r + hh) * 68 + (l31 & 7) * 8 + 4 + (l31 >> 3)] = 0.f; }
    else if (F.wave == 4) {
#pragma unroll
        for (int f = 0; f < 8; ++f) { const int it = f >> 2, kt = (f >> 1) & 1, s = f & 1; *(bf16x8*)(rec + CK_RF + (f * 64 + F.lane) * 16) = fragP(TR, 32 * it + l31, 32 * kt + 16 * s, hh); } }
    else if (F.wave == 5) {
#pragma unroll
        for (int f = 0; f < 8; ++f) { const int kt = f >> 2, jt = (f >> 1) & 1, s = f & 1; *(bf16x8*)(rec + CK_BTF + (f * 64 + F.lane) * 16) = fragP(TBT, 32 * kt + l31, 32 * jt + 16 * s, hh); } }
    else if (F.wave == 7) { *(float*)(rec + CK_CLV + 4 * F.lane) = __expf(CLS[63 * 64 + F.lane]); }
    WG_BAR();
    {   const int blk = F.tid >> 8, col = (F.tid >> 3) & 31; int dg = col; float town[4];
#pragma unroll
        for (int q = 0; q < 4; ++q) town[q] = 0.f;
        const LAS float* arow = AAB + blk * 32 * 68 + sub * 8 + blk * 4; asm volatile("" : "+v"(arow));
        f32x4 na0 = *(const LAS f32x4*)(arow);
#pragma unroll
        for (int q = 0; q < 4; ++q)
#pragma unroll
            for (int r = 0; r < 8; ++r) { const int ii = 8 * q + r;
                const f32x4 a0 = na0;
                if (ii + 1 < 32) na0 = *(const LAS f32x4*)(arow + (ii + 1) * 68);
                float p = a0.x * town[0];
                if (q >= 1) p += a0.y * town[1]; if (q >= 2) p += a0.z * town[2]; if (q >= 3) p += a0.w * town[3];
                p = red8(p);
                const float tv = p + ((dg == 0) ? 1.f : 0.f); dg -= 1; asm volatile("" : "+v"(dg));
                town[q] = (sub == r) ? tv : town[q];
            }
        LAS unsigned char* ttw = TT + (blk * 32) * 144 + 2 * (blk * 32 + col);
#pragma unroll
        for (int q = 0; q < 4; ++q) { const unsigned short tb = (unsigned short)cvtpk(town[q], 0.f); *(LAS unsigned short*)(ttw + (8 * q + sub) * 144) = tb;
            if (blk == 0) *(LAS unsigned short*)(T11T + col * 80 + 2 * (8 * q + sub)) = tb; }
        if (blk == 1) { const int t = F.tid - 256; *(LAS u32x2*)(TT + (t >> 3) * 144 + 64 + 8 * (t & 7)) = (u32x2){0u, 0u}; }
    }
    WG_BAR();
    if (F.wave == 0) {
        f32x16 m = zero16();
#pragma unroll
        for (int s2 = 0; s2 < 2; ++s2) m = __builtin_amdgcn_mfma_f32_32x32x16_bf16(*(const LAS bf16x8*)(A21B + l31 * 80 + (16 * s2 + 8 * hh) * 2), *(const LAS bf16x8*)(T11T + l31 * 80 + (16 * s2 + 8 * hh) * 2), m, 0, 0, 0);
        f32x16 t21 = zero16();
        t21 = __builtin_amdgcn_mfma_f32_32x32x16_bf16(fragP(TT, 32 + l31, 32, hh), pk8<0>(m), t21, 0, 0, 0);
        t21 = __builtin_amdgcn_mfma_f32_32x32x16_bf16(fragP(TT, 32 + l31, 48, hh), pk8<8>(m), t21, 0, 0, 0);
#pragma unroll
        for (int r = 0; r < 16; r += 2) { const unsigned w = cvtpk(t21[r], t21[r + 1]); *(LAS unsigned short*)(TT + (32 + MROW(r, hh)) * 144 + 2 * l31) = (unsigned short)w; *(LAS unsigned short*)(TT + (32 + MROW(r + 1, hh)) * 144 + 2 * l31) = (unsigned short)(w >> 16); }
    }
    f32x16 X0 = zero16(), X1 = zero16();
    if (F.wave == 0) {
    } else if (F.wave <= 2) {
        const int vt = F.wave - 1;
        f32x16 a00 = tile_prod(TK, 0, TA, 0, l31, hh), a11 = tile_prod(TK, 32, TA, 32, l31, hh); const f32x16 a01 = tile_prod(TK, 0, TA, 32, l31, hh);
#pragma unroll
        for (int r = 0; r < 16; ++r) { const bool keep = MROW(r, hh) < l31; a00[r] = keep ? a00[r] : 0.f; a11[r] = keep ? a11[r] : 0.f; }
        X0 = __builtin_amdgcn_mfma_f32_32x32x16_bf16(pk8<0>(a00), fragP(TVT, 32 * vt + l31, 0, hh), X0, 0, 0, 0);
        X0 = __builtin_amdgcn_mfma_f32_32x32x16_bf16(pk8<8>(a00), fragP(TVT, 32 * vt + l31, 16, hh), X0, 0, 0, 0);
        X1 = __builtin_amdgcn_mfma_f32_32x32x16_bf16(pk8<0>(a01), fragP(TVT, 32 * vt + l31, 0, hh), X1, 0, 0, 0);
        X1 = __builtin_amdgcn_mfma_f32_32x32x16_bf16(pk8<8>(a01), fragP(TVT, 32 * vt + l31, 16, hh), X1, 0, 0, 0);
        X1 = __builtin_amdgcn_mfma_f32_32x32x16_bf16(pk8<0>(a11), fragP(TVT, 32 * vt + l31, 32, hh), X1, 0, 0, 0);
        X1 = __builtin_amdgcn_mfma_f32_32x32x16_bf16(pk8<8>(a11), fragP(TVT, 32 * vt + l31, 48, hh), X1, 0, 0, 0);
    } else if (F.wave == 3) {
#pragma unroll
        for (int blk = 0; blk < 3; ++blk) { const int it = blk > 0, jt = blk > 1; f32x16 d = tile_prod(TB, 32 * jt, TR, 32 * it, l31, hh);
            if (it == jt) {
#pragma unroll
                for (int r = 0; r < 16; ++r) d[r] = MROW(r, hh) <= l31 ? d[r] : 0.f; }
            *(bf16x8*)(rec + CK_ARBF + ((blk * 2 + 0) * 64 + F.lane) * 16) = pk8<0>(d); *(bf16x8*)(rec + CK_ARBF + ((blk * 2 + 1) * 64 + F.lane) * 16) = pk8<8>(d); }
    } else if (F.wave == 4) {
        f32x16 d00 = tile_prod(TK, 0, TR, 0, l31, hh), d11 = tile_prod(TK, 32, TR, 32, l31, hh); const f32x16 d10 = tile_prod(TK, 0, TR, 32, l31, hh);
#pragma unroll
        for (int r = 0; r < 16; ++r) { const bool keep = MROW(r, hh) <= l31; d00[r] = keep ? d00[r] : 0.f; d11[r] = keep ? d11[r] : 0.f; }
#pragma unroll
        for (int vt = 0; vt < 2; ++vt) { f32x16 y0 = zero16(), y1 = zero16();
            y0 = __builtin_amdgcn_mfma_f32_32x32x16_bf16(pk8<0>(d00), fragP(TVT, 32 * vt + l31, 0, hh), y0, 0, 0, 0);
            y0 = __builtin_amdgcn_mfma_f32_32x32x16_bf16(pk8<8>(d00), fragP(TVT, 32 * vt + l31, 16, hh), y0, 0, 0, 0);
            y1 = __builtin_amdgcn_mfma_f32_32x32x16_bf16(pk8<0>(d10), fragP(TVT, 32 * vt + l31, 0, hh), y1, 0, 0, 0);
            y1 = __builtin_amdgcn_mfma_f32_32x32x16_bf16(pk8<8>(d10), fragP(TVT, 32 * vt + l31, 16, hh), y1, 0, 0, 0);
            y1 = __builtin_amdgcn_mfma_f32_32x32x16_bf16(pk8<0>(d11), fragP(TVT, 32 * vt + l31, 32, hh), y1, 0, 0, 0);
            y1 = __builtin_amdgcn_mfma_f32_32x32x16_bf16(pk8<8>(d11), fragP(TVT, 32 * vt + l31, 48, hh), y1, 0, 0, 0);
            st_acc32(rec + CK_YCA + ((0 * 2 + vt) * 64 + F.lane) * 32, y0); st_acc32(rec + CK_YCA + ((1 * 2 + vt) * 64 + F.lane) * 32, y1); }
    } else if (F.wave <= 6) {
        const int kt = F.wave - 5;
#pragma unroll
        for (int vt = 0; vt < 2; ++vt) { const f32x16 d = tile_prod(TKT, 32 * kt, TVT, 32 * vt, l31, hh); st_acc32(rec + CK_GA + ((kt * 2 + vt) * 64 + F.lane) * 32, d); }
    }
    WG_BAR();
    if (F.wave == 1 || F.wave == 2) { const int vt = F.wave - 1;
        f32x16 w0a = zero16(), w1a = zero16();
        w0a = __builtin_amdgcn_mfma_f32_32x32x16_bf16(fragP(TT, l31, 0, hh), pk8<0>(X0), w0a, 0, 0, 0);
        w0a = __builtin_amdgcn_mfma_f32_32x32x16_bf16(fragP(TT, l31, 16, hh), pk8<8>(X0), w0a, 0, 0, 0);
        w1a = __builtin_amdgcn_mfma_f32_32x32x16_bf16(fragP(TT, 32 + l31, 0, hh), pk8<0>(X0), w1a, 0, 0, 0);
        w1a = __builtin_amdgcn_mfma_f32_32x32x16_bf16(fragP(TT, 32 + l31, 16, hh), pk8<8>(X0), w1a, 0, 0, 0);
        w1a = __builtin_amdgcn_mfma_f32_32x32x16_bf16(fragP(TT, 32 + l31, 32, hh), pk8<0>(X1), w1a, 0, 0, 0);
        w1a = __builtin_amdgcn_mfma_f32_32x32x16_bf16(fragP(TT, 32 + l31, 48, hh), pk8<8>(X1), w1a, 0, 0, 0);
        st_acc32(rec + CK_W2A + ((0 * 2 + vt) * 64 + F.lane) * 32, w0a); st_acc32(rec + CK_W2A + ((1 * 2 + vt) * 64 + F.lane) * 32, w1a);
    } else if (F.wave >= 3 && F.wave <= 6) { const int kt = (F.wave - 3) >> 1, it = (F.wave - 3) & 1;
        const f32x16 d = tile_prod(TAT, 32 * kt, TT, 32 * it, l31, hh);
        *(bf16x8*)(rec + CK_W1F + ((((it * 2 + kt) * 2) + 0) * 64 + F.lane) * 16) = pk8<0>(d); *(bf16x8*)(rec + CK_W1F + ((((it * 2 + kt) * 2) + 1) * 64 + F.lane) * 16) = pk8<8>(d);
    }
    WG_BAR();
}

#ifdef TS_R2
#define R2BAR() do { const unsigned long long t0_ = __builtin_amdgcn_s_memrealtime(); WG_BAR(); r2wait += __builtin_amdgcn_s_memrealtime() - t0_; } while (0)
#else
#define R2BAR() WG_BAR()
#endif
template <int NC> __device__ __forceinline__ void rwkv2_role(Ctx& F, int cb) {
    unsigned long long r2wait = 0;
    const int scan = F.bx, dir = scan >> 4, b = (scan >> 3) & 1, h = scan & 7;
    const unsigned char* recs = F.ws + WS_CHK + ((size_t)scan * NCHUNK + cb) * CHKB;
    static_assert(NC % 2 == 0, "the Y waves alternate two register sets");
    bf16* Y = (bf16*)(F.ws + WS_Y) + (size_t)dir * MT * 512 + h * 64;
    const int l31 = F.lane & 31, hh = F.lane >> 5;
    constexpr int RSL = 33792, R_W1F = 0, R_BTF = 8192, R_W2A = 16384, R_GA = 24576, R_CLV = 32768;
    constexpr int EXO = 3 * RSL;
#define FR(off, idx) (*(const LAS bf16x8*)(lf + (off) + (idx) * 1024))
#define MM(a_, b_, c_) c_ = __builtin_amdgcn_mfma_f32_32x32x16_bf16(a_, b_, c_, 0, 0, 0)
    if (F.wave < 2) {
        const int vt = F.wave;
        f32x16 S0 = zero16(), S1 = zero16();
        float* sst = (float*)(F.ws + WS_SST) + ((size_t)(scan * 2 + vt) * 2 * 64 + F.lane) * 16;
        if (cb > 0) {
#pragma unroll
            for (int g = 0; g < 4; ++g) { const f32x4 a_ = *(const f32x4*)(sst + 4 * g), b_ = *(const f32x4*)(sst + 1024 + 4 * g);
#pragma unroll
                for (int e = 0; e < 4; ++e) { S0[4 * g + e] = a_[e]; S1[4 * g + e] = b_[e]; } } }
        R2BAR();
        for (int c = 0; c <= NC; ++c) {
            if (c < NC) {
                const LAS unsigned char* buf = F.lds + (c % 3) * RSL; const LAS unsigned char* lf = buf + F.lane * 16;
                LAS unsigned char* ex = F.lds + EXO + (c & 1) * 16384 + vt * 8192 + F.lane * 16;
                const bf16x8 sb00 = pk8<0>(S0), sb01 = pk8<8>(S0), sb10 = pk8<0>(S1), sb11 = pk8<8>(S1);
                *(LAS bf16x8*)(ex) = sb00; *(LAS bf16x8*)(ex + 1024) = sb01; *(LAS bf16x8*)(ex + 2048) = sb10; *(LAS bf16x8*)(ex + 3072) = sb11;
                f32x16 U0 = ld_acc32(buf + R_W2A + ((0 * 2 + vt) * 64 + F.lane) * 32), U1 = ld_acc32(buf + R_W2A + ((1 * 2 + vt) * 64 + F.lane) * 32);
                MM(FR(R_W1F, 0), sb00, U0); MM(FR(R_W1F, 4), sb00, U1); MM(FR(R_W1F, 1), sb01, U0); MM(FR(R_W1F, 5), sb01, U1);
                MM(FR(R_W1F, 2), sb10, U0); MM(FR(R_W1F, 6), sb10, U1); MM(FR(R_W1F, 3), sb11, U0); MM(FR(R_W1F, 7), sb11, U1);
                { const LAS float* clv = (const LAS float*)(buf + R_CLV);
                  const f32x16 g0 = ld_acc32(buf + R_GA + ((0 * 2 + vt) * 64 + F.lane) * 32), g1 = ld_acc32(buf + R_GA + ((1 * 2 + vt) * 64 + F.lane) * 32);
#pragma unroll
                  for (int g = 0; g < 4; ++g) { const f32x4 ca = *(const LAS f32x4*)(clv + 8 * g + 4 * hh), cb = *(const LAS f32x4*)(clv + 32 + 8 * g + 4 * hh);
#pragma unroll
                      for (int e = 0; e < 4; ++e) { S0[4 * g + e] = S0[4 * g + e] * ca[e] + g0[4 * g + e]; S1[4 * g + e] = S1[4 * g + e] * cb[e] + g1[4 * g + e]; } } }
                const bf16x8 ub00 = pk8<0>(U0), ub01 = pk8<8>(U0), ub10 = pk8<0>(U1), ub11 = pk8<8>(U1);
                *(LAS bf16x8*)(ex + 4096) = ub00; *(LAS bf16x8*)(ex + 5120) = ub01; *(LAS bf16x8*)(ex + 6144) = ub10; *(LAS bf16x8*)(ex + 7168) = ub11;
                MM(FR(R_BTF, 0), ub00, S0); MM(FR(R_BTF, 4), ub00, S1); MM(FR(R_BTF, 1), ub01, S0); MM(FR(R_BTF, 5), ub01, S1);
                MM(FR(R_BTF, 2), ub10, S0); MM(FR(R_BTF, 6), ub10, S1); MM(FR(R_BTF, 3), ub11, S0); MM(FR(R_BTF, 7), ub11, S1);
            }
            R2BAR();
        }
        if (cb + NC < NCHUNK) {
#pragma unroll
            for (int g = 0; g < 4; ++g) { *(f32x4*)(sst + 4 * g) = (f32x4){S0[4 * g], S0[4 * g + 1], S0[4 * g + 2], S0[4 * g + 3]}; *(f32x4*)(sst + 1024 + 4 * g) = (f32x4){S1[4 * g], S1[4 * g + 1], S1[4 * g + 2], S1[4 * g + 3]}; } }
    } else if (F.wave < 6) {
        const int w = F.wave - 2, vt = w & 1, it = w >> 1;
        const long ystep = dir ? -512 : 512;
        bf16x8 fa[8], fb[8]; u32x4 ya[2], yb[2];
        const int o_rf = CK_RF + it * 4096, o_arb = CK_ARBF + it * 2048, o_yc = CK_YCA + ((it * 2 + vt) * 64) * 32;
#define YLD(f, y, c_) do { const unsigned char* g_ = recs + (size_t)(c_) * CHKB + F.lane * 16; \
            _Pragma("unroll") for (int k = 0; k < 4; ++k) { f[k] = *(const bf16x8*)(g_ + o_rf + k * 1024); f[4 + k] = *(const bf16x8*)(g_ + o_arb + k * 1024); } \
            y[0] = *(const u32x4*)(g_ + o_yc + F.lane * 16); y[1] = *(const u32x4*)(g_ + o_yc + F.lane * 16 + 16); } while (0)
#define YDO(f, y, cm1) do { const LAS unsigned char* ex = F.lds + EXO + ((cm1) & 1) * 16384 + vt * 8192 + F.lane * 16; \
            const bf16x8 sb00 = *(const LAS bf16x8*)(ex), sb01 = *(const LAS bf16x8*)(ex + 1024), sb10 = *(const LAS bf16x8*)(ex + 2048), sb11 = *(const LAS bf16x8*)(ex + 3072); \
            const bf16x8 ub00 = *(const LAS bf16x8*)(ex + 4096), ub01 = *(const LAS bf16x8*)(ex + 5120), ub10 = *(const LAS bf16x8*)(ex + 6144), ub11 = *(const LAS bf16x8*)(ex + 7168); \
            f32x16 Yt = acc_from(y[0], y[1]); \
            MM(f[0], sb00, Yt); MM(f[1], sb01, Yt); MM(f[2], sb10, Yt); MM(f[3], sb11, Yt); \
            MM(f[4], ub00, Yt); MM(f[5], ub01, Yt); \
            if (it) { MM(f[6], ub10, Yt); MM(f[7], ub11, Yt); } \
            bf16* yp = Y + (size_t)scan_row(cb + (cm1), 32 * it + 4 * hh, dir, b) * 512 + 32 * vt + l31; \
            _Pragma("unroll") for (int g = 0; g < 4; ++g) { bf16* yg = yp + 8 * g * ystep; \
                _Pragma("unroll") for (int e = 0; e < 4; e += 2) { const unsigned w_ = cvtpk(Yt[4 * g + e], Yt[4 * g + e + 1]); yg[e * ystep] = (bf16)w_; yg[(e + 1) * ystep] = (bf16)(w_ >> 16); } } } while (0)
        YLD(fa, ya, 0); YLD(fb, yb, 1);
        R2BAR();
        R2BAR();
        for (int c = 1; c <= NC; c += 2) {
            YDO(fa, ya, c - 1); YLD(fa, ya, (c + 1 < NC ? c + 1 : NC - 1));
            R2BAR();
            YDO(fb, yb, c); YLD(fb, yb, (c + 2 < NC ? c + 2 : NC - 1));
            R2BAR();
        }
#undef YLD
#undef YDO
    } else {
        int gsrc[17], ldst[17];
#pragma unroll
        for (int k = 0; k < 17; ++k) { int q = F.wave - 6 + 2 * k; q = q < 32 ? q : 32; const int rp = q < 8 ? q : (q < 16 ? q + 8 : q + 28); gsrc[k] = rp * 1024 + F.lane * 16; ldst[k] = q * 1024; }
#define R2_DMA(c_) do { const int cc_ = (c_) < NC ? (c_) : NC - 1; const int sl_ = ((c_) % 3) * RSL; _Pragma("unroll") for (int k = 0; k < 17; ++k) \
            __builtin_amdgcn_global_load_lds((const unsigned*)(recs + (size_t)cc_ * CHKB + gsrc[k]), (LAS unsigned*)(F.lds + sl_ + ldst[k]), 16, 0, 0); } while (0)
        R2_DMA(0); R2_DMA(1);
        asm volatile("s_waitcnt vmcnt(17)" ::: "memory");
        R2BAR();
        for (int c = 0; c <= NC; ++c) {
            R2_DMA(c + 2);
            asm volatile("s_waitcnt vmcnt(17)" ::: "memory");
            R2BAR();
        }
        asm volatile("s_waitcnt vmcnt(0)" ::: "memory");
#define R2_LD(a, b)
#define R2_WR(a, b)
#undef R2_LD
#undef R2_WR
    }
#undef FR
#undef MM
#ifdef TS_R2
    if (F.lane == 0 && F.bx == 0) ((unsigned*)(F.ws + WS_CTL))[2048 + F.wave] += (unsigned)r2wait;
#endif
}

#ifndef R_SGU
#define R_SGU 1
#endif
#ifndef R_R1
#define R_R1 1
#endif
#ifndef R_R2
#define R_R2 1
#endif
#ifndef R_AP
#define R_AP 1
#endif
#ifndef R_CV
#define R_CV 1
#endif
constexpr int NCH1 = 34, NCH2 = NCHUNK - NCH1;
__device__ __forceinline__ void r1_range(Ctx& F, int l, int c0, int nc, int w, int nw) {
    for (int q = w; q < 32 * nc; q += nw) { R1In in; const int item = (q / nc) * NCHUNK + c0 + q % nc; r1_load(F, item, in); rwkv1_item(F, l, item, in, -1); }
}
__device__ __forceinline__ void phase3a(Ctx& F, int l) { r1_range(F, l, 0, NCH1, F.bx, F.G); }
__device__ __forceinline__ void phase3b1(Ctx& F, int l) {
    if (F.bx < 32) { rwkv2_role<NCH1>(F, 0); return; }
    r1_range(F, l, NCH1, NCH2, F.bx - 32, F.G - 32);
}
__device__ __forceinline__ void phase3b(Ctx& F, int l) {
    if (F.bx < 32) { rwkv2_role<NCH2>(F, NCH1); return; }
    const int nsgu = (l == 0 ? 68 : 64) * 4, nap = 136 * 4, ncv = (l == 0 ? MT : ML) / 16;
    const int total = nsgu + nap + ncv;
    for (int it = F.bx - 32; it < total; it += F.G - 32) {
        int r = it;
        if (r < nsgu) { for (int q_ = 0; q_ < R_SGU; ++q_) sgu_item(F, l, r >> 2, r & 3); continue; } r -= nsgu;
        if (r < nap) { for (int q_ = 0; q_ < R_AP; ++q_) attnprep_item(F, l, r >> 2, r & 3); continue; } r -= nap;
        for (int q_ = 0; q_ < R_CV; ++q_) conv_item(F, l, r);
    }
}

__device__ __forceinline__ void attn_unit(Ctx& F, const bf16* Qp, const bf16* Kp, const bf16* Vtp, int nkt, bf16* Op) {
    constexpr int KB = 9216, VB = 18432, VOFF = 2 * KB;
    const int j = F.lane & 31, hh = F.lane >> 5;
    bf16x8 qf[4];
#pragma unroll
    for (int ks = 0; ks < 4; ++ks) qf[ks] = *(const bf16x8*)(Qp + (size_t)(F.wave * 32 + j) * 64 + ks * 16 + hh * 8);
    const int kkey = F.tid >> 3, kch = F.tid & 7;
    const bf16* ksrc = Kp + (size_t)kkey * 64 + kch * 8;
    const bf16* vsrc0 = Vtp + (size_t)kkey * KEYS + kch * 8; const bf16* vsrc1 = vsrc0 + (size_t)64 * KEYS;
    const int kdst = kkey * 144 + kch * 16, vdst0 = VOFF + kkey * 144 + kch * 16, vdst1 = vdst0 + 64 * 144;
    u32x4 rk, rv0, rv1;
    rk = *(const u32x4*)ksrc; rv0 = *(const u32x4*)vsrc0; rv1 = *(const u32x4*)vsrc1;
    *(LAS u32x4*)(F.lds + kdst) = rk; *(LAS u32x4*)(F.lds + vdst0) = rv0; *(LAS u32x4*)(F.lds + vdst1) = rv1;
    WG_BAR();
    const int sw = (j & ~12) | ((j & 4) << 1) | ((j & 8) >> 1);
    const int ka0 = sw * 144 + hh * 16, ka1 = (32 + sw) * 144 + hh * 16, va = VOFF + j * 144 + hh * 16;
    f32x16 acc[4];
#pragma unroll
    for (int i = 0; i < 4; ++i) acc[i] = zero16();
    f32x16 negm = zero16();
    float m_run = 0.f, l_run = 0.f;
    bf16x8 pf[4];
#pragma unroll
    for (int i = 0; i < 4; ++i) pf[i] = (bf16x8){0, 0, 0, 0, 0, 0, 0, 0};
    int vprev = 0, vcur = 0, vnext = VB;
    for (int kt = 0; kt <= nkt; ++kt) {
        const bool hasq = kt < nkt, hasn = kt + 1 < nkt;
        if (hasn) { rk = *(const u32x4*)(ksrc + (size_t)(kt + 1) * 64 * 64); rv0 = *(const u32x4*)(vsrc0 + (kt + 1) * 64); rv1 = *(const u32x4*)(vsrc1 + (kt + 1) * 64); }
        f32x16 s0 = negm, s1 = negm;
        if (hasq) { const LAS unsigned char* kb = F.lds + (kt & 1) * KB;
#pragma unroll
            for (int ks = 0; ks < 4; ++ks) {
                const bf16x8 a0 = *(const LAS bf16x8*)(kb + ka0 + ks * 32), a1 = *(const LAS bf16x8*)(kb + ka1 + ks * 32);
                s0 = __builtin_amdgcn_mfma_f32_32x32x16_bf16(a0, qf[ks], s0, 0, 0, 0);
                s1 = __builtin_amdgcn_mfma_f32_32x32x16_bf16(a1, qf[ks], s1, 0, 0, 0);
            } }
        if (kt > 0) { const LAS unsigned char* vb = F.lds + vprev;
#pragma unroll
            for (int blk = 0; blk < 4; ++blk)
#pragma unroll
                for (int kstep = 0; kstep < 4; ++kstep) {
                    const bf16x8 a = *(const LAS bf16x8*)(vb + va + blk * 32 * 144 + kstep * 32);
                    acc[blk] = __builtin_amdgcn_mfma_f32_32x32x16_bf16(a, pf[kstep], acc[blk], 0, 0, 0);
                } }
        if (hasq) {
            float mx = fmaxf(s0[0], s1[0]);
#pragma unroll
            for (int r = 1; r < 16; ++r) mx = fmaxf(mx, fmaxf(s0[r], s1[r]));
            { const auto rr = __builtin_amdgcn_permlane32_swap(__builtin_bit_cast(unsigned, mx), __builtin_bit_cast(unsigned, mx), false, false);
              mx = fmaxf(__builtin_bit_cast(float, rr[0]), __builtin_bit_cast(float, rr[1])); }
            if (__any(mx > 8.f)) {
                const float dl = fmaxf(mx, 0.f), f = __builtin_amdgcn_exp2f(-dl);
                m_run += dl; l_run *= f;
#pragma unroll
                for (int r = 0; r < 16; ++r) { s0[r] -= dl; s1[r] -= dl; negm[r] = -m_run; }
#pragma unroll
                for (int i = 0; i < 4; ++i)
#pragma unroll
                    for (int r = 0; r < 16; ++r) acc[i][r] *= f;
            }
            float ls = 0.f;
#pragma unroll
            for (int r = 0; r < 16; ++r) { s0[r] = __builtin_amdgcn_exp2f(s0[r]); s1[r] = __builtin_amdgcn_exp2f(s1[r]); ls += s0[r] + s1[r]; }
            l_run += ls;
            u32x4 w;
            w.x = cvtpk(s0[0], s0[1]); w.y = cvtpk(s0[2], s0[3]); w.z = cvtpk(s0[4], s0[5]); w.w = cvtpk(s0[6], s0[7]); pf[0] = __builtin_bit_cast(bf16x8, w);
            w.x = cvtpk(s0[8], s0[9]); w.y = cvtpk(s0[10], s0[11]); w.z = cvtpk(s0[12], s0[13]); w.w = cvtpk(s0[14], s0[15]); pf[1] = __builtin_bit_cast(bf16x8, w);
            w.x = cvtpk(s1[0], s1[1]); w.y = cvtpk(s1[2], s1[3]); w.z = cvtpk(s1[4], s1[5]); w.w = cvtpk(s1[6], s1[7]); pf[2] = __builtin_bit_cast(bf16x8, w);
            w.x = cvtpk(s1[8], s1[9]); w.y = cvtpk(s1[10], s1[11]); w.z = cvtpk(s1[12], s1[13]); w.w = cvtpk(s1[14], s1[15]); pf[3] = __builtin_bit_cast(bf16x8, w);
        }
        if (hasn) { LAS unsigned char* nk = F.lds + ((kt + 1) & 1) * KB; *(LAS u32x4*)(nk + kdst) = rk; *(LAS u32x4*)(F.lds + vnext + vdst0) = rv0; *(LAS u32x4*)(F.lds + vnext + vdst1) = rv1; }
        vprev = vcur; vcur = vnext; vnext = (vnext == 2 * VB) ? 0 : vnext + VB;
        WG_BAR();
    }
    const float inv = 1.f / (l_run + __shfl_xor(l_run, 32));
    bf16* orow = Op + (size_t)(F.wave * 32 + j) * 1024 + 4 * hh;
#pragma unroll
    for (int blk = 0; blk < 4; ++blk)
#pragma unroll
        for (int g = 0; g < 4; ++g) *(u32x2*)(orow + 32 * blk + 8 * g) = (u32x2){cvtpk(acc[blk][4 * g] * inv, acc[blk][4 * g + 1] * inv), cvtpk(acc[blk][4 * g + 2] * inv, acc[blk][4 * g + 3] * inv)};
}

__device__ __forceinline__ void attn_role(Ctx& F, int l) {
    const int bh = F.bx & 7, m = (F.bx >> 3) & 1, k = F.bx >> 4, b = bh >> 2, h = bh & 3;
    const bf16* QR = (const bf16*)(F.ws + WS_QR); const bf16* QC = (const bf16*)(F.ws + WS_QC); const bf16* KR = (const bf16*)(F.ws + WS_KR); const bf16* VT = (const bf16*)(F.ws + WS_VT);
    bf16* OATT = (bf16*)(F.ws + WS_XN);
    const bf16* Vtp = VT + (size_t)bh * 128 * KEYS;
    { const int bhm = bh * 2 + m;
      attn_unit(F, QR + ((size_t)bhm * TL + k * 256) * 64, KR + (size_t)bhm * KEYS * 64, Vtp, KEYS / 64, OATT + (size_t)(b * TL + k * 256) * 1024 + (h * 2 + m) * 128); }
    if (l == 0 && F.bx < 16) {
        const int mc = F.bx >> 3, bhm = bh * 2 + mc;
        attn_unit(F, QC + (size_t)bhm * CL * 64, KR + (size_t)bhm * KEYS * 64, Vtp, CL / 64, OATT + (size_t)(ML + b * CL) * 1024 + (h * 2 + mc) * 128);
    }
}

__device__ __forceinline__ void phase4(Ctx& F, int l) {
    const bf16* P = (const bf16*)(F.ws + WS_P); bf16* OC = (bf16*)(F.ws + WS_OC); const bf16* OATT = (const bf16*)(F.ws + WS_XN);
    const bf16* Yf = (const bf16*)(F.ws + WS_Y); const bf16* Yb = Yf + (size_t)MT * 512; const bf16* BON = (const bf16*)(F.ws + WS_BON);
    const float lam_init = 0.8f - 0.6f * expf(-0.3f * (float)l);
    const float d1 = wave_sum(F.prm->in[12][l * 64 + F.lane] * F.prm->in[13][l * 64 + F.lane]), d2 = wave_sum(F.prm->in[14][l * 64 + F.lane] * F.prm->in[15][l * 64 + F.lane]);
    const float lam = expf(d1) - expf(d2) + lam_init;
    const float* subg = F.prm->in[16] + l * 128; const float* ln_w = F.prm->in[25] + l * 512; const float* ln_b = F.prm->in[26] + l * 512;
    const int nrows = l == 0 ? MT : ML;
    for (int row = F.gw; row < nrows; row += F.NGW) {
        {
            const int h = F.lane >> 4, dv0 = (F.lane & 15) * 8; const bf16* o1 = OATT + (size_t)row * 1024 + h * 256 + dv0; const bf16* o2 = o1 + 128;
            float o[8], oa[8], ob[8]; unpack8(*(const u32x4*)o1, oa); unpack8(*(const u32x4*)o2, ob);
#pragma unroll
            for (int e = 0; e < 8; ++e) o[e] = oa[e] - lam * ob[e];
            float ss = 0.f;
#pragma unroll
            for (int e = 0; e < 8; ++e) ss += o[e] * o[e];
            const float rs = (1.f - lam_init) / sqrtf(red16(ss) * (1.f / 128.f) + EPS);
            float gg[8]; unpack8(*(const u32x4*)(P + (size_t)row * NINP + B_G + h * 128 + dv0), gg);
#pragma unroll
            for (int e = 0; e < 8; ++e) o[e] = o[e] * rs * subg[dv0 + e] * silu_f(gg[e]);
            *(u32x4*)(OC + (size_t)row * DM + 512 + h * 128 + dv0) = pack8(o);
        }
        {
            const int c0 = F.lane * 8; const bf16* yf = Yf + (size_t)row * 512 + c0; const bf16* yb = Yb + (size_t)row * 512 + c0; const bf16* bo = BON + (size_t)row * 512 + c0;
            float y[8], yq[8]; unpack8(*(const u32x4*)yf, y); unpack8(*(const u32x4*)yb, yq);
#pragma unroll
            for (int e = 0; e < 8; ++e) y[e] += yq[e];
            float s = 0.f;
#pragma unroll
            for (int e = 0; e < 8; ++e) s += y[e];
            const float mean = red8(s) * (1.f / 64.f); float q = 0.f;
#pragma unroll
            for (int e = 0; e < 8; ++e) { y[e] -= mean; q += y[e] * y[e]; }
            const float rstd = 1.f / sqrtf(red8(q) * (1.f / 64.f) + GN_EPS);
            float gg[8]; unpack8(*(const u32x4*)(P + (size_t)row * NINP + C_G + c0), gg);
            float bn[8], bn2[8]; unpack8(*(const u32x4*)bo, bn); unpack8(*(const u32x4*)(bo + (size_t)MT * 512), bn2);
#pragma unroll
            for (int e = 0; e < 8; ++e) bn[e] += bn2[e];
#pragma unroll
            for (int e = 0; e < 8; ++e) y[e] = (y[e] * rstd * ln_w[c0 + e] + ln_b[c0 + e] + bn[e]) * silu_f(gg[e]);
            *(u32x4*)(OC + (size_t)row * DM + 1024 + c0) = pack8(y);
        }
    }
}

#define XB_TMO      128
#define XB_XCNT(j)  (256  + 64 * (j))
#define XB_XSUB(j)  (1280 + 64 * (j))
#define XB_XGEN(j)  (2304 + 64 * (j))
#define XB_TOP      3328
#define XB_TOPGEN   3392
#define XCD_BAR_WORDS 3456
#define XB_SPIN_CAP (1u << 18)

__device__ __forceinline__ unsigned xb_ld(unsigned* p)              { return __hip_atomic_load(p, __ATOMIC_RELAXED, __HIP_MEMORY_SCOPE_AGENT); }
__device__ __forceinline__ unsigned xb_add(unsigned* p, unsigned v) { return __hip_atomic_fetch_add(p, v, __ATOMIC_RELAXED, __HIP_MEMORY_SCOPE_AGENT); }
__device__ __forceinline__ unsigned xb_xcc_id() { return (unsigned)__builtin_amdgcn_s_getreg((3 << 11) | 20) & 0xFu; }
#define XB_SPIN(cond, bar) do { unsigned _sp = 0; while (cond) { __builtin_amdgcn_s_sleep(1); \
    if ((++_sp & 255u) == 0u) { if (xb_ld(&(bar)[XB_TMO])) break; if (_sp > XB_SPIN_CAP) { atomicAdd(&(bar)[XB_TMO], 1u); break; } } } } while (0)

struct XcdBarrier {
    unsigned* bar; unsigned x;
    volatile LAS unsigned* st;
};

__device__ __forceinline__ XcdBarrier xcd_barrier_post(unsigned* bar, volatile LAS unsigned* st) {
    XcdBarrier b; b.bar = bar; b.x = xb_xcc_id(); b.st = st;
    if (threadIdx.x == 0) (void)xb_add(&bar[XB_XCNT(b.x)], 1u);
    return b;
}
__device__ __forceinline__ void xcd_barrier_complete(unsigned* bar, unsigned x, unsigned& nloc, unsigned& nx) {
    const unsigned G = gridDim.x * gridDim.y * gridDim.z;
    unsigned sum, cnt, mine, sp = 0u;
    for (;;) {
        sum = 0u; cnt = 0u; mine = 0u;
#pragma unroll
        for (unsigned j = 0; j < 16; ++j) { const unsigned c = xb_ld(&bar[XB_XCNT(j)]); sum += c; cnt += (c > 0u) ? 1u : 0u; mine = (j == x) ? c : mine; }
        if (sum == G) break;
        __builtin_amdgcn_s_sleep(1);
        if ((++sp & 255u) == 0u) { if (xb_ld(&bar[XB_TMO])) break; if (sp > XB_SPIN_CAP) { atomicAdd(&bar[XB_TMO], 1u); break; } }
    }
    nloc = mine > 0u ? mine : 1u; nx = cnt > 0u ? cnt : 1u;
}

__device__ __forceinline__ void xcd_barrier(const XcdBarrier& b) {
    asm volatile("s_waitcnt vmcnt(0)" ::: "memory");
    __syncthreads();
    if (threadIdx.x == 0) {
        unsigned* bar = b.bar;
        __builtin_amdgcn_s_waitcnt(0);
        unsigned nloc = b.st[0], nx = b.st[1];
        if (nloc == 0u) { xcd_barrier_complete(bar, b.x, nloc, nx); b.st[0] = nloc; b.st[1] = nx; }
        const unsigned old = xb_add(&bar[XB_XSUB(b.x)], 1u);
        const unsigned gen = old / nloc;
        if (old + 1u == (gen + 1u) * nloc) {
            __builtin_amdgcn_fence(__ATOMIC_RELEASE, "agent");
            asm volatile("s_waitcnt vmcnt(0)" ::: "memory");
            const unsigned og = xb_add(&bar[XB_TOP], 1u);
            const unsigned tg = og / nx;
            if (og + 1u == (tg + 1u) * nx) xb_add(&bar[XB_TOPGEN], 1u);
            else XB_SPIN(xb_ld(&bar[XB_TOPGEN]) == tg, bar);
            __builtin_amdgcn_fence(__ATOMIC_ACQUIRE, "agent");
            xb_add(&bar[XB_XGEN(b.x)], 1u);
            asm volatile("s_waitcnt vmcnt(0)" ::: "memory");
        } else {
            XB_SPIN(xb_ld(&bar[XB_XGEN(b.x)]) == gen, bar);
            __builtin_amdgcn_fence(__ATOMIC_ACQUIRE, "agent");
            asm volatile("s_waitcnt vmcnt(0)" ::: "memory");
        }
    }
    __syncthreads();
}

#ifndef R_P0T
#define R_P0T 1
#endif
#ifndef R_P1
#define R_P1 1
#endif
#ifndef R_P2
#define R_P2 1
#endif
#ifndef R_P3A
#define R_P3A 1
#endif
#ifndef R_SCAN
#define R_SCAN 1
#endif
#ifndef R_ATTN
#define R_ATTN 1
#endif
#ifndef R_P4
#define R_P4 1
#endif
#ifndef R_P5
#define R_P5 1
#endif
#ifndef R_BAR
#define R_BAR 1
#endif
__global__ void __launch_bounds__(NTHREADS, 2) fwd_kernel(Params prm) {
    extern __shared__ __attribute__((aligned(16))) unsigned char lds_raw[];
    cg::grid_group grid = cg::this_grid();
    Ctx F;
    F.prm = &prm; F.out = prm.out; F.ws = prm.ws; F.lds = (LAS unsigned char*)lds_raw;
    F.tid = threadIdx.x; F.lane = F.tid & 63; F.wave = __builtin_amdgcn_readfirstlane(F.tid >> 6); F.bx = blockIdx.x; F.G = gridDim.x;
    F.gw = F.bx * NWAVES + F.wave; F.NGW = F.G * NWAVES;
    volatile LAS unsigned* MISC = (volatile LAS unsigned*)(F.lds + LDS_BYTES - 256);
    if (F.tid < 4) MISC[F.tid] = 0u;
    __syncthreads();
    XcdBarrier bar = xcd_barrier_post((unsigned*)(F.ws + WS_CTL + 16384), MISC);
#ifdef TS_SEL
    unsigned long long ts_prev = 0, ts_dt = 0; int ts_n = 0;
#ifndef TS_BLK
#define TS_BLK 0
#endif
#ifdef TS_WORK
#define GRID_BAR() do { { const unsigned long long t_ = __builtin_amdgcn_s_memrealtime(); if (ts_n == TS_SEL) ts_dt = t_ - ts_prev; } xcd_barrier(bar); ts_prev = __builtin_amdgcn_s_memrealtime(); ++ts_n; } while (0)
#else
#define GRID_BAR() do { xcd_barrier(bar); { const unsigned long long t_ = __builtin_amdgcn_s_memrealtime(); if (ts_n == TS_SEL) ts_dt = t_ - ts_prev; ts_prev = t_; ++ts_n; } } while (0)
#endif
#else
#define GRID_BAR() do { for (int rb_ = 0; rb_ < R_BAR; ++rb_) xcd_barrier(bar); } while (0)
#endif

#ifndef NO_P0
    LAUNDER(F); phase0(F);
#endif
    if (prm.out == nullptr) grid.sync();
    GRID_BAR();
#ifdef TS_SEL
    ts_prev = __builtin_amdgcn_s_memrealtime();
#endif
#pragma unroll 1
    for (int l = 0; l < 2; ++l) {
#ifndef NO_P1
        for (int rp_ = 0; rp_ < R_P1; ++rp_) { LAUNDER(F); phase1(F, l); }
#endif
        GRID_BAR();
#ifndef NO_P2
        for (int rp_ = 0; rp_ < R_P2; ++rp_) {
            pg8::Gemm g{(const pg8::bf16_t*)(F.ws + WS_XN), (const pg8::bf16_t*)(F.ws + WS_WIN) + (size_t)l * NINP * DM, MT, NINP, DM, DM};
            pg8::EpiBf16 E{(pg8::bf16_t*)(F.ws + WS_P), NINP, nullptr, 0, 0, 1.f};
            if (l == 0) { pg8::StaticOrder S; S.init(MT, NINP, F.G, F.bx); pg8::gemm_phase<pg8::EpiBf16, pg8::StaticOrder, true, true>(F.lds, g, S, E); }
            else { pg8::CtxSparseOrder S; S.init(ML, MC, NINP, F.G, F.bx); pg8::gemm_phase<pg8::EpiBf16, pg8::CtxSparseOrder, true, true>(F.lds, g, S, E); }
        }
#endif
        GRID_BAR();
#ifndef NO_P3A
        { LAUNDER(F); phase3a(F, l); }
        GRID_BAR();
        { LAUNDER(F); phase3b1(F, l); }
        GRID_BAR();
        { LAUNDER(F); phase3b(F, l); }
        GRID_BAR();
        for (int rp_ = 0; rp_ < R_ATTN; ++rp_) { LAUNDER(F); attn_role(F, l); }
        GRID_BAR();
        for (int rp_ = 0; rp_ < R_P4; ++rp_) { LAUNDER(F); phase4(F, l); }
#endif
        GRID_BAR();
#ifndef NO_P5
        for (int rp_ = 0; rp_ < R_P5; ++rp_) {
            const int rows = l == 0 ? MT : ML;
            pg8::Gemm g{(const pg8::bf16_t*)(F.ws + WS_OC), (const pg8::bf16_t*)(F.ws + WS_WOUT) + (size_t)l * DM * DM, rows, DM, DM, DM};
            pg8::StaticOrder S; S.init(rows, DM, F.G, F.bx);
            pg8::EpiBf16 E{(pg8::bf16_t*)(F.ws + WS_P), DM, nullptr, 0, 0, 1.f};
            pg8::gemm_phase<pg8::EpiBf16, pg8::StaticOrder, true, true>(F.lds, g, S, E);
        }
#endif
        GRID_BAR();
    }
#ifndef NO_P6
    LAUNDER(F); phase6(F);
#endif
#ifdef TS_SEL
    GRID_BAR();
    if (F.bx == TS_BLK && F.wave == 0) { float v = F.out[F.lane]; float a = fabsf(v); float m = a;
        for (int o = 1; o < 64; o <<= 1) m = fminf(m, __shfl_xor(m, o));
        const unsigned long long bal = __ballot(a == m); const int win = __ffsll((long long)bal) - 1;
#ifdef TS_R2
        ts_dt = ((volatile unsigned*)(F.ws + WS_CTL))[2048 + TS_R2];
#endif
        if (F.lane == win) F.out[F.lane] = v + 0.04f + (float)ts_dt * 0.01f * TS_SCALE; }
#endif
}

extern "C" void kernel_launch(void* const* d_in, const int* in_sizes, int n_in, void* d_out, int out_size, void* d_ws, size_t ws_size, hipStream_t stream) {
    static int grid = 0;
    if (grid == 0) {
        if (n_in != 28 || out_size != ML * DM || ws_size < WS_END) { fprintf(stderr, "kernel_launch: unexpected shapes: n_in %d out %d ws %zu (need %zu)\n", n_in, out_size, ws_size, (size_t)WS_END); grid = -1; return; }
        int dev = 0, cus = 0, per_cu = 0;
        if (hipGetDevice(&dev) != hipSuccess || hipDeviceGetAttribute(&cus, hipDeviceAttributeMultiprocessorCount, dev) != hipSuccess) { grid = -1; return; }
        if (hipFuncSetAttribute((const void*)fwd_kernel, hipFuncAttributeMaxDynamicSharedMemorySize, LDS_BYTES) != hipSuccess) { fprintf(stderr, "kernel_launch: hipFuncSetAttribute failed\n"); grid = -1; return; }
        if (hipOccupancyMaxActiveBlocksPerMultiprocessor(&per_cu, (const void*)fwd_kernel, NTHREADS, LDS_BYTES) != hipSuccess || per_cu < 1) { fprintf(stderr, "kernel_launch: occupancy query says %d blocks per CU\n", per_cu); grid = -1; return; }
        (void)hipGetLastError();
        grid = cus;
        if (grid != 256) { fprintf(stderr, "kernel_launch: expected 256 CUs, got %d\n", cus); grid = -1; return; }
    }
    if (grid < 0) return;
    if (hipMemsetAsync((char*)d_ws + WS_CTL, 0, CTL_ZERO_BYTES, stream) != hipSuccess) { fprintf(stderr, "kernel_launch: memset failed\n"); return; }
    Params p{};
    for (int i = 0; i < 28; ++i) p.in[i] = (const float*)d_in[i];
    p.out = (float*)d_out; p.ws = (unsigned char*)d_ws;
    void* args[] = {&p};
    hipError_t e = hipLaunchCooperativeKernel((void*)fwd_kernel, dim3(grid), dim3(NTHREADS), args, LDS_BYTES, stream);
    if (e != hipSuccess) fprintf(stderr, "cooperative launch failed: %s (grid %d)\n", hipGetErrorString(e), grid);
}
```
